# Optimizing an MI355X kernel written in HIP

```python
import jax, jax.numpy as jnp
from jax import lax
import numpy as np

D_MODEL = 1024
BATCH = 4
SEQ = 8192
DEPTH = 2
DEC_BATCH = 128
DEC_SEQ = 8
PAST_LEN = 16384
PAGE_SIZE = 128

N_EVEN = (DEPTH + 1) // 2
N_ODD = DEPTH // 2
CHUNK = 128
A_GROUPS = 4
A_GD = 128
A_WIDTH = A_GROUPS * A_GD
POOL_WINDOWS = (2, 4, 8, 16)
B_GD = 128
B_WIDTH = len(POOL_WINDOWS) * B_GD
POOL_CTX = max(POOL_WINDOWS) - 1
AB_IN = 2 * A_WIDTH + B_WIDTH
AB_OUT = A_WIDTH + B_WIDTH
N_HEADS = 16
N_KV = 4
HEAD_DIM = 64
GQA = N_HEADS // N_KV
WINDOW = 128
ROT_DIM = HEAD_DIM // 4
ROPE_THETA = 500000.0
QKV_OUT = (N_HEADS + 2 * N_KV) * HEAD_DIM
N_MEM = 256
MEM_HEADS = 4
MEM_HD = 128
MEM_WIDTH = MEM_HEADS * MEM_HD
D_FF = 2816
CONV_W = 3
EPS = 1e-6

kernel_name = "hybrid_gmlp_pool_swa_mem_convffn_step"


def rmsnorm(x, g):
    xf = x.astype(jnp.float32)
    y = xf * lax.rsqrt(jnp.mean(xf * xf, -1, keepdims=True) + EPS)
    return (y * g.astype(jnp.float32)).astype(x.dtype)


def layernorm(x, g):
    xf = x.astype(jnp.float32)
    xc = xf - jnp.mean(xf, -1, keepdims=True)
    y = xc * lax.rsqrt(jnp.mean(xc * xc, -1, keepdims=True) + EPS)
    return (y * g.astype(jnp.float32)).astype(x.dtype)


def gelu(x):
    return jax.nn.gelu(x, approximate=False)


def rope_partial(x, pos):
    half = ROT_DIM // 2
    inv = ROPE_THETA ** (-jnp.arange(half, dtype=jnp.float32) / half)
    ang = pos.astype(jnp.float32)[:, None] * inv[None, :]
    cos = jnp.cos(ang)[None, :, None, :]
    sin = jnp.sin(ang)[None, :, None, :]
    xr = x[..., :ROT_DIM].astype(jnp.float32)
    x1, x2 = xr[..., :half], xr[..., half:]
    rot = jnp.concatenate([x1 * cos - x2 * sin, x2 * cos + x1 * sin], -1).astype(x.dtype)
    return jnp.concatenate([rot, x[..., ROT_DIM:]], -1)


def mix_ab(h, pool_ctx, pos, w_in, v_gain, w_s, b_s, pool_w, pool_scale, w_out):
    N, T, _ = h.shape
    proj = h @ w_in
    u = gelu(proj[..., :A_WIDTH])
    v = layernorm(gelu(proj[..., A_WIDTH:2 * A_WIDTH]), v_gain)
    p = proj[..., 2 * A_WIDTH:]
    L = min(T, CHUNK)
    nc = T // L
    ws = jnp.where(jnp.tril(jnp.ones((L, L), bool)), w_s[:, :L, :L], 0.0)
    vc = v.reshape(N, nc, L, A_GROUPS, A_GD)
    sg = jnp.einsum('gij,ncjgd->ncigd', ws, vc) + b_s[:, :L].T[None, None, :, :, None]
    a_out = u * sg.reshape(N, T, A_WIDTH)
    p_ext = jnp.concatenate([pool_ctx, p], 1)
    cs = jnp.cumsum(p_ext.astype(jnp.float32), axis=1)
    cs = jnp.concatenate([jnp.zeros((N, 1, B_WIDTH), jnp.float32), cs], 1)
    outs = []
    for gi, w in enumerate(POOL_WINDOWS):
        sl = slice(gi * B_GD, (gi + 1) * B_GD)
        s = cs[:, POOL_CTX + 1:POOL_CTX + 1 + T, sl] - cs[:, POOL_CTX + 1 - w:POOL_CTX + 1 - w + T, sl]
        cnt = jnp.minimum(pos + 1, w).astype(jnp.float32)[None, :, None]
        outs.append(s / cnt)
    pooled = (jnp.concatenate(outs, -1) - p.astype(jnp.float32)).astype(h.dtype)
    pooled = pooled.reshape(N, T, len(POOL_WINDOWS), B_GD)
    b_out = jnp.einsum('ntgd,gde->ntge', pooled, pool_w).reshape(N, T, B_WIDTH) * pool_scale
    y = jnp.concatenate([a_out, b_out], -1) @ w_out
    return y, p_ext[:, -POOL_CTX:], v


def sink_attend(q, k, v, mask, sinks):
    s = jnp.einsum('...qkgd,...skd->...kgqs', q, k).astype(jnp.float32) * (HEAD_DIM ** -0.5)
    s = jnp.where(mask, s, -jnp.inf)
    sink = jnp.broadcast_to(sinks.reshape(N_KV, GQA, 1, 1).astype(jnp.float32), s.shape[:-1] + (1,))
    pr = jax.nn.softmax(jnp.concatenate([s, sink], -1), axis=-1)[..., :-1]
    return jnp.einsum('...kgqs,...skd->...qkgd', pr.astype(v.dtype), v)


def swa_qkv(h, pos, w_qkv, q_gain, k_gain):
    N, T, _ = h.shape
    qkv = h @ w_qkv
    q = qkv[..., :N_HEADS * HEAD_DIM].reshape(N, T, N_HEADS, HEAD_DIM)
    k = qkv[..., N_HEADS * HEAD_DIM:(N_HEADS + N_KV) * HEAD_DIM].reshape(N, T, N_KV, HEAD_DIM)
    v = qkv[..., (N_HEADS + N_KV) * HEAD_DIM:].reshape(N, T, N_KV, HEAD_DIM)
    q = rope_partial(rmsnorm(q, q_gain), pos)
    k = rope_partial(rmsnorm(k, k_gain), pos)
    return q, k, v


def swa_prompt(h, pos, w_qkv, q_gain, k_gain, sinks, w_o):
    N, T, _ = h.shape
    q, k, v = swa_qkv(h, pos, w_qkv, q_gain, k_gain)
    nb = T // WINDOW
    qb = q.reshape(N, nb, WINDOW, N_KV, GQA, HEAD_DIM)
    kb = k.reshape(N, nb, WINDOW, N_KV, HEAD_DIM)
    vb = v.reshape(N, nb, WINDOW, N_KV, HEAD_DIM)
    pad = ((0, 0), (1, 0), (0, 0), (0, 0), (0, 0))
    kk = jnp.concatenate([jnp.pad(kb, pad)[:, :-1], kb], 2)
    vv = jnp.concatenate([jnp.pad(vb, pad)[:, :-1], vb], 2)
    i = jnp.arange(WINDOW)[:, None]
    s = jnp.arange(2 * WINDOW)[None, :]
    band = (s > i) & (s <= i + WINDOW)
    valid = band[None] & ((jnp.arange(nb)[:, None, None] > 0) | (s[None] >= WINDOW))
    o = sink_attend(qb, kk, vv, valid[:, None, None], sinks)
    y = o.reshape(N, T, N_HEADS * HEAD_DIM) @ w_o
    return y, k[:, -WINDOW:], v[:, -WINDOW:]


def swa_sample(h, k_ctx, v_ctx, pos, w_qkv, q_gain, k_gain, sinks, w_o):
    N, T, _ = h.shape
    q, k, v = swa_qkv(h, pos, w_qkv, q_gain, k_gain)
    kk = jnp.concatenate([k_ctx, k], 1)
    vv = jnp.concatenate([v_ctx, v], 1)
    i = jnp.arange(T)[:, None]
    s = jnp.arange(WINDOW + T)[None, :]
    mask = (s > i) & (s <= i + WINDOW)
    o = sink_attend(q.reshape(N, T, N_KV, GQA, HEAD_DIM), kk, vv, mask, sinks)
    y = o.reshape(N, T, N_HEADS * HEAD_DIM) @ w_o
    return y, kk[:, -WINDOW:], vv[:, -WINDOW:]


def mem_kv(mem, g_mem, w_kv, k_gain):
    N = mem.shape[0]
    m = rmsnorm(mem, g_mem) @ w_kv
    k = rmsnorm(m[..., :MEM_WIDTH].reshape(N, N_MEM, MEM_HEADS, MEM_HD), k_gain)
    v = m[..., MEM_WIDTH:].reshape(N, N_MEM, MEM_HEADS, MEM_HD)
    return k, v


def mem_attend(h, k, v, w_q, q_gain, w_o):
    N, T, _ = h.shape
    q = rmsnorm((h @ w_q).reshape(N, T, MEM_HEADS, MEM_HD), q_gain)
    s = jnp.einsum('nthd,nmhd->nhtm', q, k).astype(jnp.float32) * (MEM_HD ** -0.5)
    pr = jax.nn.softmax(s, axis=-1).astype(v.dtype)
    o = jnp.einsum('nhtm,nmhd->nthd', pr, v)
    return o.reshape(N, T, MEM_WIDTH) @ w_o


def conv_ffn(h, g_ctx, w_up, conv_w, conv_b, w_down):
    T = h.shape[1]
    up = h @ w_up
    g, u = up[..., :D_FF], up[..., D_FF:]
    g_ext = jnp.concatenate([g_ctx, g], 1)
    gc = conv_b
    for j in range(CONV_W):
        gc = gc + conv_w[j] * g_ext[:, j:j + T]
    y = (gelu(gc) * u) @ w_down
    return y, g_ext[:, -(CONV_W - 1):]


def setup_inputs(seed: int = 0) -> dict:
    key = jax.random.key(seed)
    ks = iter(jax.random.split(key, 48))

    def nrm(shape, scale):
        return jax.random.normal(next(ks), shape, jnp.float32) * scale

    def gain(shape):
        return 1.0 + nrm(shape, 0.02)

    D = D_MODEL
    return {
        "x_prompt": nrm((BATCH, SEQ, D), 1.0),
        "x_sample": nrm((DEC_BATCH, DEC_SEQ, D), 1.0),
        "cache_pool": nrm((N_EVEN, DEC_BATCH, POOL_CTX, B_WIDTH), 1.0),
        "cache_swa_k": nrm((N_ODD, DEC_BATCH, WINDOW, N_KV, HEAD_DIM), 1.0),
        "cache_swa_v": nrm((N_ODD, DEC_BATCH, WINDOW, N_KV, HEAD_DIM), 1.0),
        "cache_mem_k": nrm((DEPTH, DEC_BATCH, N_MEM, MEM_HEADS, MEM_HD), 1.0),
        "cache_mem_v": nrm((DEPTH, DEC_BATCH, N_MEM, MEM_HEADS, MEM_HD), 1.0),
        "cache_ffn_conv": nrm((DEPTH, DEC_BATCH, CONV_W - 1, D_FF), 1.0),
        "mem_prompt": nrm((BATCH, N_MEM, D), 1.0),
        "ln_mix": gain((DEPTH, D)),
        "ln_mem": gain((DEPTH, D)),
        "ln_memkv": gain((DEPTH, D)),
        "ln_ffn": gain((DEPTH, D)),
        "ab_w_in": nrm((N_EVEN, D, AB_IN), D ** -0.5),
        "ab_v_gain": gain((N_EVEN, A_WIDTH)),
        "ab_w_s": nrm((N_EVEN, A_GROUPS, CHUNK, CHUNK), CHUNK ** -0.5),
        "ab_b_s": 1.0 + nrm((N_EVEN, A_GROUPS, CHUNK), 0.1),
        "ab_pool_w": nrm((N_EVEN, len(POOL_WINDOWS), B_GD, B_GD), B_GD ** -0.5),
        "ab_pool_scale": 1.0 + nrm((N_EVEN, B_WIDTH), 0.1),
        "ab_w_out": nrm((N_EVEN, AB_OUT, D), AB_OUT ** -0.5),
        "c_w_qkv": nrm((N_ODD, D, QKV_OUT), D ** -0.5),
        "c_q_gain": gain((N_ODD, HEAD_DIM)),
        "c_k_gain": gain((N_ODD, HEAD_DIM)),
        "c_sinks": nrm((N_ODD, N_HEADS), 0.5),
        "c_w_o": nrm((N_ODD, N_HEADS * HEAD_DIM, D), (N_HEADS * HEAD_DIM) ** -0.5),
        "m_w_q": nrm((DEPTH, D, MEM_WIDTH), D ** -0.5),
        "m_w_kv": nrm((DEPTH, D, 2 * MEM_WIDTH), D ** -0.5),
        "m_q_gain": gain((DEPTH, MEM_HD)),
        "m_k_gain": gain((DEPTH, MEM_HD)),
        "m_w_o": nrm((DEPTH, MEM_WIDTH, D), MEM_WIDTH ** -0.5),
        "f_w_up": nrm((DEPTH, D, 2 * D_FF), D ** -0.5),
        "f_conv_w": nrm((DEPTH, CONV_W, D_FF), CONV_W ** -0.5),
        "f_conv_b": nrm((DEPTH, D_FF), 0.02),
        "f_w_down": nrm((DEPTH, D_FF, D), D_FF ** -0.5),
    }


def reference(x_prompt, x_sample, cache_pool, cache_swa_k, cache_swa_v, cache_mem_k, cache_mem_v,
              cache_ffn_conv, mem_prompt, ln_mix, ln_mem, ln_memkv, ln_ffn, ab_w_in, ab_v_gain,
              ab_w_s, ab_b_s, ab_pool_w, ab_pool_scale, ab_w_out, c_w_qkv, c_q_gain, c_k_gain,
              c_sinks, c_w_o, m_w_q, m_w_kv, m_q_gain, m_k_gain, m_w_o, f_w_up, f_conv_w,
              f_conv_b, f_w_down):
    xp, xs = x_prompt, x_sample
    Bp, Tp, _ = xp.shape
    Bs, Ts, _ = xs.shape
    pos_p = jnp.arange(Tp)
    pos_s = PAST_LEN + jnp.arange(Ts)
    pool_p, pool_s, chunk_v_s = [], [], []
    swa_kp, swa_vp, swa_ks, swa_vs = [], [], [], []
    mem_kp, mem_vp, conv_p, conv_s = [], [], [], []
    for l in range(DEPTH):
        j = l // 2
        hp = rmsnorm(xp, ln_mix[l])
        hs = rmsnorm(xs, ln_mix[l])
        if l % 2 == 0:
            zp = jnp.zeros((Bp, POOL_CTX, B_WIDTH), xp.dtype)
            yp, stp, _ = mix_ab(hp, zp, pos_p, ab_w_in[j], ab_v_gain[j], ab_w_s[j], ab_b_s[j],
                                ab_pool_w[j], ab_pool_scale[j], ab_w_out[j])
            ys, sts, vs = mix_ab(hs, cache_pool[j], pos_s, ab_w_in[j], ab_v_gain[j], ab_w_s[j],
                                 ab_b_s[j], ab_pool_w[j], ab_pool_scale[j], ab_w_out[j])
            pool_p.append(stp)
            pool_s.append(sts)
            chunk_v_s.append(vs)
        else:
            yp, kp, vp = swa_prompt(hp, pos_p, c_w_qkv[j], c_q_gain[j], c_k_gain[j], c_sinks[j], c_w_o[j])
            ys, ks_, vs_ = swa_sample(hs, cache_swa_k[j], cache_swa_v[j], pos_s, c_w_qkv[j],
                                      c_q_gain[j], c_k_gain[j], c_sinks[j], c_w_o[j])
            swa_kp.append(kp)
            swa_vp.append(vp)
            swa_ks.append(ks_)
            swa_vs.append(vs_)
        xp = xp + yp
        xs = xs + ys
        mk, mv = mem_kv(mem_prompt, ln_memkv[l], m_w_kv[l], m_k_gain[l])
        mem_kp.append(mk)
        mem_vp.append(mv)
        xp = xp + mem_attend(rmsnorm(xp, ln_mem[l]), mk, mv, m_w_q[l], m_q_gain[l], m_w_o[l])
        xs = xs + mem_attend(rmsnorm(xs, ln_mem[l]), cache_mem_k[l], cache_mem_v[l], m_w_q[l],
                             m_q_gain[l], m_w_o[l])
        zc = jnp.zeros((Bp, CONV_W - 1, D_FF), xp.dtype)
        fp, cp = conv_ffn(rmsnorm(xp, ln_ffn[l]), zc, f_w_up[l], f_conv_w[l], f_conv_b[l], f_w_down[l])
        fs, cs = conv_ffn(rmsnorm(xs, ln_ffn[l]), cache_ffn_conv[l], f_w_up[l], f_conv_w[l],
                          f_conv_b[l], f_w_down[l])
        conv_p.append(cp)
        conv_s.append(cs)
        xp = xp + fp
        xs = xs + fs
    return (xp, xs,
            jnp.stack(pool_p), jnp.stack(pool_s), jnp.stack(chunk_v_s),
            jnp.stack(swa_kp), jnp.stack(swa_vp), jnp.stack(swa_ks), jnp.stack(swa_vs),
            jnp.stack(mem_kp), jnp.stack(mem_vp),
            jnp.stack(conv_p), jnp.stack(conv_s))
```

```cpp
#include <hip/hip_runtime.h>
#include <hip/hip_cooperative_groups.h>
#include <cstdio>
#include <cstdint>
#include <type_traits>
namespace cg = cooperative_groups;
namespace pg8 {
#define PG8_LAS __attribute__((address_space(3)))
typedef unsigned short bf16_t;
typedef short bf16x8 __attribute__((ext_vector_type(8)));
typedef float f32x4 __attribute__((ext_vector_type(4)));
typedef unsigned u32x4 __attribute__((ext_vector_type(4)));
constexpr int BM = 256, BK = 64, HALF = 128, HTB = HALF * BK * 2  , STAGE_BYTES = 8 * HTB, NXCD = 8, WGM = 8;

__host__ __device__ __forceinline__ int lds_byte(int r, int c) { const int st = (r >> 4) * 2 + (c >> 5), rr = r & 15, cc = c & 31, ob = rr * 64 + cc * 2; return st * 1024 + (ob ^ (((ob >> 9) & 1) << 5)); }
__host__ __device__ __forceinline__ void stage_rc(int b, int& R, int& C) { const int st = b / 1024, sb = b % 1024, swz = sb ^ (((sb >> 9) & 1) << 5); R = (st >> 1) * 16 + swz / 64; C = (st & 1) * 32 + (swz % 64) / 2; }
__host__ __device__ __forceinline__ int perm32(int rho) { const int n = rho >> 4, i = rho & 15; return 8 * (i >> 2) + 4 * n + (i & 3); }

struct Unit { int pm, pn; int rb; int half; int q; int cb; };
struct Gemm { const bf16_t* A; const bf16_t* Bt; int M, N, K; };

struct StaticOrder {
    int nM, nN, nwg, G, c;
    __host__ __device__ void init(int M, int N, int G_, int c_) { nM = M / BM; nN = N / BM; nwg = nM * nN; G = G_; c = c_; }
    __host__ __device__ bool next(int i, Unit& u) const {
        const long L = (long)i * G + c; if (L >= nwg) return false;
        int wgid = (int)L; { const int q = nwg / NXCD, r = nwg % NXCD, xcd = wgid % NXCD, off = wgid / NXCD; wgid = (xcd < r ? xcd * (q + 1) : r * (q + 1) + (xcd - r) * q) + off; }
        const int nig = WGM * nN, gid = wgid / nig, fm = gid * WGM, gsz = (nM - fm) < WGM ? (nM - fm) : WGM;
        u.pm = fm + ((wgid % nig) % gsz); u.pn = (wgid % nig) / gsz; u.rb = u.pm * BM; u.half = 0; u.q = 0; u.cb = u.pn * BM; return true;
    }
    __device__ __forceinline__ void a_ready(const Unit&) const {}
    __device__ __forceinline__ void done(const Unit&) const {}
};
struct SplitOrder {
    StaticOrder P; int nP, nS, nN, G, c;
    __host__ __device__ void init(int N, int G_, int c_) { P.init(32768, N, G_, c_); nP = P.nwg; nN = N / BM; nS = 8 * nN; G = G_; c = c_; }
    __host__ __device__ bool next(int i, Unit& u) const {
        const long L = (long)i * G + c;
        if (L < nP) return P.next(i, u);
        const int j = (int)(L - nP); if (j >= nS) return false;
        const int hm = j & 7; u.pn = j >> 3; u.pm = 128 + (hm >> 1); u.rb = 32768 + 128 * hm; u.half = 1; u.q = 0; u.cb = u.pn * BM; return true;
    }
    __device__ __forceinline__ void a_ready(const Unit&) const {}
    __device__ __forceinline__ void done(const Unit&) const {}
};


__device__ __forceinline__ unsigned cvt_pk_bf16(float lo, float hi) { unsigned r; asm volatile("v_cvt_pk_bf16_f32 %0, %1, %2" : "=v"(r) : "v"(lo), "v"(hi)); return r; }
typedef float f32x2 __attribute__((ext_vector_type(2)));
__device__ __forceinline__ f32x2 gelu_pk(f32x2 v) {
    f32x2 x = v * 0.70710678118f;
    x.x = __builtin_amdgcn_fmed3f(x.x, -2.9f, 2.9f); x.y = __builtin_amdgcn_fmed3f(x.y, -2.9f, 2.9f);
    const f32x2 t = x * x;
    f32x2 p = t * (-4.953124630e-07f) + 1.987094038e-05f;
    p = p * t + (-3.472001117e-04f); p = p * t + 3.517547622e-03f; p = p * t + (-2.333305031e-02f); p = p * t + 1.087993085e-01f; p = p * t + (-3.740358949e-01f); p = p * t + 1.128076553e+00f;
    const f32x2 hv = v * 0.5f;
    return hv * (x * p) + hv;
}

__device__ __forceinline__ float bf_lo(unsigned w) { return __builtin_bit_cast(float, w << 16); }
__device__ __forceinline__ float bf_hi(unsigned w) { return __builtin_bit_cast(float, w & 0xffff0000u); }
__device__ __forceinline__ void ld8bf(const bf16_t* p, float (&o)[8]) { const u32x4 w = *(const u32x4*)p;
    o[0] = bf_lo(w.x); o[1] = bf_hi(w.x); o[2] = bf_lo(w.y); o[3] = bf_hi(w.y); o[4] = bf_lo(w.z); o[5] = bf_hi(w.z); o[6] = bf_lo(w.w); o[7] = bf_hi(w.w); }
__device__ __forceinline__ void ld8f(const float* p, float (&o)[8]) { const f32x4 a = *(const f32x4*)p, b = *(const f32x4*)(p + 4);
    o[0] = a[0]; o[1] = a[1]; o[2] = a[2]; o[3] = a[3]; o[4] = b[0]; o[5] = b[1]; o[6] = b[2]; o[7] = b[3]; }
__device__ __forceinline__ void zero8(float (&o)[8]) {
#pragma unroll
    for (int j = 0; j < 8; ++j) o[j] = 0.f; }

struct EpiAct {
    static constexpr bool PERM = true, AFTER_DRAIN = false;
    bf16_t* O; int ldc; int gelu_tiles; const float* SS;
    __device__ __forceinline__ void operator()(const f32x4 (&acc)[2][2][4][2], const Unit& u, int wr, int wc, int fr, int fq) const {
        asm volatile("" : "+v"(fr), "+v"(fq));
        const int row0 = u.rb + wr * 64 + fr, col0 = u.cb + wc * 32 + 8 * fq;
        const bool act = u.pn < gelu_tiles;
        float rsv[2][4];
#pragma unroll
        for (int ai = 0; ai < 2; ++ai)
#pragma unroll
            for (int m = 0; m < 4; ++m) rsv[ai][m] = SS[row0 + (u.half ? 0 : ai * HALF) + m * 16];
#pragma unroll
        for (int ai = 0; ai < 2; ++ai) if (ai == 0 || !u.half)
#pragma unroll
            for (int m = 0; m < 4; ++m) { bf16_t* rowp = O + (size_t)(row0 + ai * HALF + m * 16) * ldc + col0;
                const float rs = rsqrtf(rsv[ai][m] * (1.f / 1024.f) + 1e-6f);
#pragma unroll
                for (int bj = 0; bj < 2; ++bj) if (bj == 0 || !u.q) { f32x4 v0 = acc[ai][bj][m][0] * rs, v1 = acc[ai][bj][m][1] * rs;
                    if (act) { f32x2 a = gelu_pk((f32x2){v0[0], v0[1]}), b = gelu_pk((f32x2){v0[2], v0[3]}), c = gelu_pk((f32x2){v1[0], v1[1]}), d = gelu_pk((f32x2){v1[2], v1[3]});
                        v0 = (f32x4){a.x, a.y, b.x, b.y}; v1 = (f32x4){c.x, c.y, d.x, d.y}; }
                    u32x4 w; w.x = cvt_pk_bf16(v0[0], v0[1]); w.y = cvt_pk_bf16(v0[2], v0[3]); w.z = cvt_pk_bf16(v1[0], v1[1]); w.w = cvt_pk_bf16(v1[2], v1[3]);
                    *(u32x4*)(rowp + bj * HALF) = w; } }
    }
};

struct EpiQKV {
    static constexpr bool PERM = true, AFTER_DRAIN = false;
    bf16_t* Q; float* KV; const float* SS;
    __device__ __forceinline__ void operator()(const f32x4 (&acc)[2][2][4][2], const Unit& u, int wr, int wc, int fr, int fq) const {
        asm volatile("" : "+v"(fr), "+v"(fq));
        const int row0 = u.rb + wr * 64 + fr;
        float rs[2][4];
#pragma unroll
        for (int ai = 0; ai < 2; ++ai) if (ai == 0 || !u.half)
#pragma unroll
            for (int m = 0; m < 4; ++m) rs[ai][m] = rsqrtf(SS[row0 + (u.half ? 0 : ai * HALF) + m * 16] * (1.f / 1024.f) + 1e-6f);
        if (u.pn < 4) {
            const int col0 = u.cb + wc * 32 + 8 * fq;
#pragma unroll
            for (int ai = 0; ai < 2; ++ai) if (ai == 0 || !u.half)
#pragma unroll
                for (int m = 0; m < 4; ++m) { bf16_t* rowp = Q + (size_t)(row0 + ai * HALF + m * 16) * 1024 + col0;
#pragma unroll
                    for (int bj = 0; bj < 2; ++bj) if (bj == 0 || !u.q) { const f32x4 v0 = acc[ai][bj][m][0] * rs[ai][m], v1 = acc[ai][bj][m][1] * rs[ai][m];
                        u32x4 w; w.x = cvt_pk_bf16(v0[0], v0[1]); w.y = cvt_pk_bf16(v0[2], v0[3]); w.z = cvt_pk_bf16(v1[0], v1[1]); w.w = cvt_pk_bf16(v1[2], v1[3]);
                        *(u32x4*)(rowp + bj * HALF) = w; } }
        } else {
            const int col0 = (u.cb - 1024) + wc * 32 + 8 * fq;
#pragma unroll
            for (int ai = 0; ai < 2; ++ai) if (ai == 0 || !u.half)
#pragma unroll
                for (int m = 0; m < 4; ++m) { float* rowp = KV + (size_t)(row0 + ai * HALF + m * 16) * 512 + col0;
#pragma unroll
                    for (int bj = 0; bj < 2; ++bj) if (bj == 0 || !u.q) { *(f32x4*)(rowp + bj * HALF) = acc[ai][bj][m][0] * rs[ai][m]; *(f32x4*)(rowp + bj * HALF + 4) = acc[ai][bj][m][1] * rs[ai][m]; } }
        }
    }
};

struct EpiRes {
    static constexpr bool PERM = true, AFTER_DRAIN = false;
    float* C; const float* resP; const float* resS; int inplace; bf16_t* XB0; float* SS; int wxb;
    static constexpr int ldc = 1024, split = 32768;
    __device__ __forceinline__ void row_out(const f32x4 v0, const f32x4 v1, int row, int col, float& ss) const {
        if (C) { float* rowp = C + (size_t)row * ldc + col; *(f32x4*)rowp = v0; *(f32x4*)(rowp + 4) = v1; }
        if (wxb) { u32x4 w; w.x = cvt_pk_bf16(v0[0], v0[1]); w.y = cvt_pk_bf16(v0[2], v0[3]); w.z = cvt_pk_bf16(v1[0], v1[1]); w.w = cvt_pk_bf16(v1[2], v1[3]);
            *(u32x4*)(XB0 + (size_t)row * ldc + col) = w;
            ss += (v0[0] * v0[0] + v0[1] * v0[1]) + (v0[2] * v0[2] + v0[3] * v0[3]) + (v1[0] * v1[0] + v1[1] * v1[1]) + (v1[2] * v1[2] + v1[3] * v1[3]); }
    }
    __device__ __forceinline__ void operator()(const f32x4 (&acc)[2][2][4][2], const Unit& u, int wr, int wc, int fr, int fq) const {
        asm volatile("" : "+v"(fr), "+v"(fq));
        const int row0 = u.rb + wr * 64 + fr, col0 = u.cb + wc * 32 + 8 * fq;
        if (inplace) {
#pragma unroll
            for (int ai = 0; ai < 2; ++ai) if (ai == 0 || !u.half)
#pragma unroll
              for (int mh = 0; mh < 4; mh += 2) {
                u32x4 rw[2][2];
#pragma unroll
                for (int mm = 0; mm < 2; ++mm) { const int row = row0 + ai * HALF + (mh + mm) * 16;
#pragma unroll
                    for (int bj = 0; bj < 2; ++bj) if (bj == 0 || !u.q) rw[mm][bj] = *(const u32x4*)(XB0 + (size_t)row * ldc + col0 + bj * HALF); }
#pragma unroll
                for (int mm = 0; mm < 2; ++mm) { const int m = mh + mm, row = row0 + ai * HALF + m * 16; float ss = 0.f;
#pragma unroll
                    for (int bj = 0; bj < 2; ++bj) if (bj == 0 || !u.q) { const u32x4 w = rw[mm][bj];
                        const f32x4 v0 = acc[ai][bj][m][0] + (f32x4){bf_lo(w.x), bf_hi(w.x), bf_lo(w.y), bf_hi(w.y)}, v1 = acc[ai][bj][m][1] + (f32x4){bf_lo(w.z), bf_hi(w.z), bf_lo(w.w), bf_hi(w.w)};
                        row_out(v0, v1, row, col0 + bj * HALF, ss); }
                    if (wxb) { ss += __shfl_xor(ss, 16); ss += __shfl_xor(ss, 32); if (fq == 0) unsafeAtomicAdd(SS + row, ss); } }
              }
        } else {
#pragma unroll
            for (int ai = 0; ai < 2; ++ai) if (ai == 0 || !u.half)
#pragma unroll
                for (int m = 0; m < 4; ++m) { const int row = row0 + ai * HALF + m * 16; float ss = 0.f;
                    const float* rp = resP ? ((row < split ? resP + (size_t)row * ldc : resS + (size_t)(row - split) * ldc) + col0) : nullptr;
                    f32x4 rv[2][2];
#pragma unroll
                    for (int bj = 0; bj < 2; ++bj) if (bj == 0 || !u.q) { rv[bj][0] = rp ? *(const f32x4*)(rp + bj * HALF) : (f32x4){0.f, 0.f, 0.f, 0.f}; rv[bj][1] = rp ? *(const f32x4*)(rp + bj * HALF + 4) : (f32x4){0.f, 0.f, 0.f, 0.f}; }
#pragma unroll
                    for (int bj = 0; bj < 2; ++bj) if (bj == 0 || !u.q) row_out(acc[ai][bj][m][0] + rv[bj][0], acc[ai][bj][m][1] + rv[bj][1], row, col0 + bj * HALF, ss);
                    if (wxb) { ss += __shfl_xor(ss, 16); ss += __shfl_xor(ss, 32); if (fq == 0) unsafeAtomicAdd(SS + row, ss); } }
        }
    }
};

struct EpiG {
    static constexpr bool PERM = true, AFTER_DRAIN = false;
    bf16_t* G; float* outP; float* outS; const float* SS;
    __device__ __forceinline__ void operator()(const f32x4 (&acc)[2][2][4][2], const Unit& u, int wr, int wc, int fr, int fq) const {
        asm volatile("" : "+v"(fr), "+v"(fq));
        const int row0 = u.rb + wr * 64 + fr, col0 = u.pn * BM + wc * 32 + 8 * fq;
        float rsv[2][4];
#pragma unroll
        for (int ai = 0; ai < 2; ++ai)
#pragma unroll
            for (int m = 0; m < 4; ++m) rsv[ai][m] = SS[row0 + (u.half ? 0 : ai * HALF) + m * 16];
#pragma unroll
        for (int ai = 0; ai < 2; ++ai) if (ai == 0 || !u.half)
#pragma unroll
            for (int m = 0; m < 4; ++m) { const int row = row0 + ai * HALF + m * 16; bf16_t* rowp = G + (size_t)row * 2816 + col0;
                float* co = nullptr;
                if (row < 32768) { const int t = row & 8191; if (t >= 8190) co = outP + ((size_t)(row >> 13) * 2 + (t - 8190)) * 2816 + col0; }
                else { const int i = row & 7; if (i >= 6) co = outS + ((size_t)((row - 32768) >> 3) * 2 + (i - 6)) * 2816 + col0; }
                const float rs = rsqrtf(rsv[ai][m] * (1.f / 1024.f) + 1e-6f);
#pragma unroll
                for (int bj = 0; bj < 2; ++bj) { const f32x4 v0 = acc[ai][bj][m][0] * rs, v1 = acc[ai][bj][m][1] * rs;
                    u32x4 w; w.x = cvt_pk_bf16(v0[0], v0[1]); w.y = cvt_pk_bf16(v0[2], v0[3]); w.z = cvt_pk_bf16(v1[0], v1[1]); w.w = cvt_pk_bf16(v1[2], v1[3]);
                    *(u32x4*)(rowp + bj * HALF) = w;
                    if (co) { *(f32x4*)(co + bj * HALF) = v0; *(f32x4*)(co + bj * HALF + 4) = v1; } } }
    }
};

typedef unsigned u32x2 __attribute__((ext_vector_type(2)));
struct EpiH {
    static constexpr bool PERM = true, AFTER_DRAIN = false;
    const bf16_t* G; bf16_t* H; const float* cw; const float* cb; const float* ctx; const float* SS;
    static __device__ __forceinline__ void unpk4(const u32x2 w, float (&o)[4]) { o[0] = bf_lo(w.x); o[1] = bf_hi(w.x); o[2] = bf_lo(w.y); o[3] = bf_hi(w.y); }
    static __device__ __forceinline__ void ld4f(const float* p, float (&o)[4]) { const f32x4 a = *(const f32x4*)p; o[0] = a[0]; o[1] = a[1]; o[2] = a[2]; o[3] = a[3]; }
    static __device__ __forceinline__ u32x2 shf(const u32x2 w, int src) { u32x2 r; r.x = (unsigned)__shfl((int)w.x, src); r.y = (unsigned)__shfl((int)w.y, src); return r; }
    static __device__ __forceinline__ void finish(const float (&g0)[4], const float (&g1)[4], const float (&g2)[4], const float (&w0)[4], const float (&w1)[4], const float (&w2)[4], const float (&bb)[4],
                                                  const f32x4 v, float rs, bf16_t* dst) {
        float h[4];
#pragma unroll
        for (int j = 0; j < 4; j += 2) {
            const f32x2 gc = (f32x2){bb[j] + w0[j] * g2[j] + w1[j] * g1[j] + w2[j] * g0[j], bb[j + 1] + w0[j + 1] * g2[j + 1] + w1[j + 1] * g1[j + 1] + w2[j + 1] * g0[j + 1]};
            const f32x2 ge = gelu_pk(gc); h[j] = ge.x * v[j] * rs; h[j + 1] = ge.y * v[j + 1] * rs; }
        u32x2 w; w.x = cvt_pk_bf16(h[0], h[1]); w.y = cvt_pk_bf16(h[2], h[3]);
        *(u32x2*)dst = w;
    }
    __device__ __forceinline__ void operator()(const f32x4 (&acc)[2][2][4][2], const Unit& u, int wr, int wc, int fr, int fq) const {
        asm volatile("" : "+v"(fr), "+v"(fq));
        const int row0 = u.rb + wr * 64 + fr;
        const int lane = fq * 16 + fr;
        const int s1 = fr >= 1 ? lane - 1 : lane + 15, s2 = fr >= 2 ? lane - 2 : lane + 14;
#pragma unroll
        for (int bj = 0; bj < 2; ++bj)
#pragma unroll
          for (int hv = 0; hv < 2; ++hv) {
            const int col = u.pn * BM + bj * HALF + wc * 32 + 8 * fq + 4 * hv;
            float w0[4], w1[4], w2[4], bb[4];
            ld4f(cw + col, w0); ld4f(cw + 2816 + col, w1); ld4f(cw + 2 * 2816 + col, w2); ld4f(cb + col, bb);
            if (u.pm < 128) {
#pragma unroll
                for (int ai = 0; ai < 2; ++ai) {
                    const int R0 = u.rb + ai * HALF + wr * 64;
                    const bf16_t* gp = G + (size_t)(R0 + fr) * 2816 + col;
                    u32x2 gq[4];
#pragma unroll
                    for (int m = 0; m < 4; ++m) gq[m] = *(const u32x2*)(gp + (size_t)m * 16 * 2816);
                    u32x2 prv = (u32x2){0u, 0u};
                    if ((R0 & 8191) != 0) prv = *(const u32x2*)(gp - (size_t)16 * 2816);
#pragma unroll
                    for (int m = 0; m < 4; ++m) {
                        const u32x2 q1 = shf(fr == 15 ? prv : gq[m], s1), q2 = shf(fr >= 14 ? prv : gq[m], s2);
                        float g0[4], g1[4], g2[4]; unpk4(gq[m], g0); unpk4(q1, g1); unpk4(q2, g2);
                        finish(g0, g1, g2, w0, w1, w2, bb, acc[ai][bj][m][hv], rsqrtf(SS[R0 + fr + 16 * m] * (1.f / 1024.f) + 1e-6f), H + (size_t)(R0 + fr + 16 * m) * 2816 + col);
                        prv = gq[m];
                    }
                }
            } else {
                const int i = fr & 7;
                u32x2 gq[4]; float ssv[4];
#pragma unroll
                for (int m = 0; m < 4; ++m) { const int row = row0 + m * 16; gq[m] = *(const u32x2*)(G + (size_t)row * 2816 + col); ssv[m] = SS[row]; }
#pragma unroll
                for (int mh = 0; mh < 4; mh += 2) {
                f32x4 c0[4], c1[4];
#pragma unroll
                for (int m = mh; m < mh + 2; ++m) { const int row = row0 + m * 16; const float* cx = ctx + (size_t)((row - 32768) >> 3) * 2 * 2816 + col;
                    c0[m] = *(const f32x4*)cx; c1[m] = *(const f32x4*)(cx + 2816); }
#pragma unroll
                for (int m = mh; m < mh + 2; ++m) { const int row = row0 + m * 16; const u32x2 cur = gq[m];
                    const u32x2 q1 = shf(cur, lane - 1), q2 = shf(cur, lane - 2);
                    float g0[4], g1[4], g2[4]; unpk4(cur, g0); unpk4(q1, g1); unpk4(q2, g2);
#pragma unroll
                    for (int j = 0; j < 4; ++j) { const float x1 = c1[m][j], x0 = c0[m][j];
                        if (i < 1) g1[j] = x1;
                        if (i < 2) g2[j] = (i == 1) ? x1 : x0; }
                    finish(g0, g1, g2, w0, w1, w2, bb, acc[0][bj][m][hv], rsqrtf(ssv[m] * (1.f / 1024.f) + 1e-6f), H + (size_t)row * 2816 + col); }
                }
            }
        }
    }
};

template <class Epi, class Sched, bool ALIGN_EPI = false, bool SP2 = false>
__device__ __forceinline__ void gemm_phase(PG8_LAS unsigned char* lds, const Gemm g, const Sched& S, const Epi& E, int wave0) {
    int tid_ = threadIdx.x; (void)wave0; asm volatile("" : "+v"(tid_));
    const int tid = tid_, wid = __builtin_amdgcn_readfirstlane(tid >> 6), lane = tid & 63, wr = wid >> 2, wc = wid & 3, fr = lane & 15, fq = lane >> 4;
    const int K = g.K, nt = K / BK;
    unsigned voffA[2], voffB[2];
#pragma unroll
    for (int i = 0; i < 2; ++i) { int R, C; stage_rc(tid * 16 + i * 8192, R, C); const int Rb = Epi::PERM ? ((R & ~31) + perm32(R & 31)) : R;
        voffA[i] = (unsigned)(R * K + C) * 2u; voffB[i] = (unsigned)(Rb * K + C) * 2u; }
    const size_t kstep = (size_t)(BK * 2);
    const size_t hstep = (size_t)HALF * K * 2;
    const size_t tstep = 2 * hstep;
    const unsigned ldsw = (unsigned)wid * 1024u;
    const int aoff = lds_byte(wr * 64 + fr, fq * 8), boff = lds_byte(wc * 32 + fr, fq * 8);
#define PG8_SA(b, h) (((b) * 2 + (h)) * HTB)
#define PG8_SB(b, h) ((4 + (b) * 2 + (h)) * HTB)
#define PG8_STAGE(bufoff, gbase, voff) do { _Pragma("unroll") for (int _i = 0; _i < 2; ++_i) \
        __builtin_amdgcn_global_load_lds((const unsigned*)((const char*)(gbase) + (voff)[_i]), (PG8_LAS unsigned*)(lds + (bufoff) + ldsw + _i * 8192), 16, 0, 0); } while (0)
#define PG8_LDA(dst, b, h) do { _Pragma("unroll") for (int m = 0; m < 4; ++m) _Pragma("unroll") for (int k = 0; k < 2; ++k) dst[m][k] = *(const PG8_LAS bf16x8*)(lds + PG8_SA(b, h) + aoff + m * 2048 + k * 1024); } while (0)
#define PG8_LDB(dst, b, h) do { _Pragma("unroll") for (int n = 0; n < 2; ++n) _Pragma("unroll") for (int k = 0; k < 2; ++k) dst[n][k] = *(const PG8_LAS bf16x8*)(lds + PG8_SB(b, h) + boff + n * 2048 + k * 1024); } while (0)
#define PG8_MMA(ai, bj, At, Bt) do { __builtin_amdgcn_s_setprio(1); _Pragma("unroll") for (int m = 0; m < 4; ++m) _Pragma("unroll") for (int n = 0; n < 2; ++n) _Pragma("unroll") for (int k = 0; k < 2; ++k) \
        acc[ai][bj][m][n] = __builtin_amdgcn_mfma_f32_16x16x32_bf16(Bt[n][k], At[m][k], acc[ai][bj][m][n], 0, 0, 0); __builtin_amdgcn_s_setprio(0); } while (0)
#define PG8_WAIT_V(n) asm volatile("s_waitcnt vmcnt(" #n ")" ::: "memory")
#define PG8_WAIT_L(n) asm volatile("s_waitcnt lgkmcnt(" #n ")" ::: "memory")
#define PG8_BAR __builtin_amdgcn_s_barrier()
#define PG8_SCHED __builtin_amdgcn_sched_barrier(0)
    Unit cur, nxt; int ui = 0;
    if (!S.next(0, cur)) return;
    f32x4 acc[2][2][4][2];
#pragma unroll
    for (int a = 0; a < 2; ++a)
#pragma unroll
        for (int b = 0; b < 2; ++b)
#pragma unroll
            for (int m = 0; m < 4; ++m)
#pragma unroll
                for (int n = 0; n < 2; ++n) acc[a][b][m][n] = (f32x4){0.f, 0.f, 0.f, 0.f};
    bf16x8 At[4][2], B0[2][2], B1[2][2];
    const char* cA = (const char*)g.A + (size_t)cur.rb * K * 2; const char* cB = (const char*)g.Bt + (size_t)cur.pn * tstep;
    S.a_ready(cur);
    if constexpr (SP2) {
        PG8_STAGE(PG8_SB(0, 0), cB, voffB); PG8_STAGE(PG8_SB(0, 1), cB + hstep, voffB); PG8_STAGE(PG8_SA(0, 0), cA, voffA); PG8_STAGE(PG8_SA(0, 1), cA + hstep, voffA);
        if (wr == 1) PG8_BAR;
        PG8_WAIT_V(2); PG8_BAR;
        PG8_STAGE(PG8_SB(1, 0), cB + kstep, voffB); PG8_STAGE(PG8_SA(1, 0), cA + kstep, voffA); PG8_STAGE(PG8_SB(1, 1), cB + hstep + kstep, voffB);
        PG8_WAIT_V(6); PG8_BAR;
    } else {
        PG8_STAGE(PG8_SB(0, 0), cB, voffB); PG8_STAGE(PG8_SA(0, 0), cA, voffA); PG8_STAGE(PG8_SB(0, 1), cB + hstep, voffB); PG8_STAGE(PG8_SA(0, 1), cA + hstep, voffA);
        if (wr == 1) PG8_BAR;
        PG8_WAIT_V(4); PG8_BAR;
        PG8_STAGE(PG8_SB(1, 0), cB + kstep, voffB); PG8_STAGE(PG8_SA(1, 0), cA + kstep, voffA); PG8_STAGE(PG8_SB(1, 1), cB + hstep + kstep, voffB);
        PG8_WAIT_V(6); PG8_BAR;
    }
    for (;;) {
        const bool has_next = S.next(ui + 1, nxt);
        const char* nA = has_next ? (const char*)g.A + (size_t)nxt.rb * K * 2 : cA; const char* nB = has_next ? (const char*)g.Bt + (size_t)nxt.pn * tstep : cB;
        for (int t = 0; t < nt; t += 2) {
            const bool last = (t == nt - 2);
            const char* a1 = cA + (size_t)(t + 1) * kstep;
            const char* a2 = last ? nA : cA + (size_t)(t + 2) * kstep; const char* b2 = last ? nB : cB + (size_t)(t + 2) * kstep;
            const char* a3 = a2 + kstep; const char* b3 = b2 + kstep;
            if (last && has_next) S.a_ready(nxt);
            if constexpr (SP2) {
            PG8_LDB(B0, 0, 0); PG8_LDB(B1, 0, 1); PG8_SCHED; PG8_LDA(At, 0, 0); PG8_STAGE(PG8_SA(1, 1), a1 + hstep, voffA);
            PG8_WAIT_V(8); PG8_WAIT_L(0); PG8_BAR; PG8_MMA(0, 0, At, B0); PG8_MMA(0, 1, At, B1); PG8_BAR; PG8_SCHED;
            PG8_LDA(At, 0, 1); PG8_STAGE(PG8_SB(0, 0), b2, voffB); PG8_STAGE(PG8_SB(0, 1), b2 + hstep, voffB); PG8_STAGE(PG8_SA(0, 0), a2, voffA);
            PG8_WAIT_V(8); PG8_WAIT_L(0); PG8_BAR; if (!cur.half) { PG8_MMA(1, 0, At, B0); PG8_MMA(1, 1, At, B1); } PG8_BAR; PG8_SCHED;
            PG8_LDB(B0, 1, 0); PG8_LDB(B1, 1, 1); PG8_SCHED; PG8_LDA(At, 1, 0); PG8_STAGE(PG8_SA(0, 1), a2 + hstep, voffA);
            PG8_WAIT_V(8); PG8_WAIT_L(0); PG8_BAR; PG8_MMA(0, 0, At, B0); PG8_MMA(0, 1, At, B1); PG8_BAR; PG8_SCHED;
            PG8_LDA(At, 1, 1); PG8_STAGE(PG8_SB(1, 0), b3, voffB); PG8_STAGE(PG8_SB(1, 1), b3 + hstep, voffB); PG8_STAGE(PG8_SA(1, 0), a3, voffA);
            PG8_WAIT_V(8); PG8_WAIT_L(0); PG8_BAR; if (!cur.half) { PG8_MMA(1, 0, At, B0); PG8_MMA(1, 1, At, B1); } PG8_BAR; PG8_SCHED;
            } else {
            PG8_LDB(B0, 0, 0); PG8_SCHED; PG8_LDA(At, 0, 0); PG8_STAGE(PG8_SA(1, 1), a1 + hstep, voffA);
            PG8_WAIT_L(8); PG8_BAR; PG8_WAIT_L(0); PG8_MMA(0, 0, At, B0); PG8_BAR; PG8_SCHED;
            PG8_LDB(B1, 0, 1); PG8_STAGE(PG8_SB(0, 0), b2, voffB);
            PG8_BAR; PG8_WAIT_L(0); PG8_MMA(0, 1, At, B1); PG8_BAR;
            PG8_LDA(At, 0, 1); PG8_STAGE(PG8_SA(0, 0), a2, voffA);
            PG8_BAR; PG8_WAIT_L(0); if (!cur.half) PG8_MMA(1, 0, At, B0); PG8_BAR; PG8_SCHED;
            PG8_STAGE(PG8_SB(0, 1), b2 + hstep, voffB);
            PG8_WAIT_V(6); PG8_BAR; if (!cur.half) PG8_MMA(1, 1, At, B1); PG8_BAR;
            PG8_LDB(B0, 1, 0); PG8_SCHED; PG8_LDA(At, 1, 0); PG8_STAGE(PG8_SA(0, 1), a2 + hstep, voffA);
            PG8_WAIT_L(8); PG8_BAR; PG8_WAIT_L(0); PG8_MMA(0, 0, At, B0); PG8_BAR; PG8_SCHED;
            PG8_LDB(B1, 1, 1); PG8_STAGE(PG8_SB(1, 0), b3, voffB);
            PG8_BAR; PG8_WAIT_L(0); PG8_MMA(0, 1, At, B1); PG8_BAR;
            PG8_LDA(At, 1, 1); PG8_STAGE(PG8_SA(1, 0), a3, voffA);
            PG8_BAR; PG8_WAIT_L(0); if (!cur.half) PG8_MMA(1, 0, At, B0); PG8_BAR; PG8_SCHED;
            PG8_STAGE(PG8_SB(1, 1), b3 + hstep, voffB);
            PG8_WAIT_V(6); PG8_BAR; if (!cur.half) PG8_MMA(1, 1, At, B1); PG8_BAR;
            }
        }
        if constexpr (ALIGN_EPI) { if (wr == 0) PG8_BAR; }
        if constexpr (!Epi::AFTER_DRAIN) { E(acc, cur, wr, wc, fr, fq); S.done(cur); }
        if (!has_next) break;
#pragma unroll
        for (int a = 0; a < 2; ++a)
#pragma unroll
            for (int b = 0; b < 2; ++b)
#pragma unroll
                for (int m = 0; m < 4; ++m)
#pragma unroll
                    for (int n = 0; n < 2; ++n) acc[a][b][m][n] = (f32x4){0.f, 0.f, 0.f, 0.f};
        cur = nxt; cA = nA; cB = nB; ++ui;
        if constexpr (ALIGN_EPI) { if (wr == 1) PG8_BAR; }
    }
    PG8_WAIT_V(0);
    if constexpr (!ALIGN_EPI) { if (wr == 0) PG8_BAR; }
    PG8_BAR;
    if constexpr (Epi::AFTER_DRAIN) { E.fused(acc, cur, wr, wc, fr, fq, lds, wid, lane); S.done(cur); }
#undef PG8_SA
#undef PG8_SB
#undef PG8_STAGE
#undef PG8_LDA
#undef PG8_LDB
#undef PG8_MMA
#undef PG8_WAIT_V
#undef PG8_WAIT_L
#undef PG8_BAR
#undef PG8_SCHED
}

template <class Epi>
__device__ __forceinline__ void mini_gemm(PG8_LAS unsigned char* lds, const bf16_t* A, const bf16_t* Bt, int K, int ntn, const Epi& E, int c, int G, int wave0, int row_base = 32768) {
    int tid_ = threadIdx.x; (void)wave0; asm volatile("" : "+v"(tid_));
    const int tid = tid_, wid = __builtin_amdgcn_readfirstlane(tid >> 6), lane = tid & 63, wr = wid >> 2, wc = wid & 3, fr = lane & 15, fq = lane >> 4;
    constexpr int LS = 136, BUFB = 2 * 128 * LS * 2;
    const int lr = tid >> 2, lp = (tid & 3) * 4;
    const int nst = K / 128;
#pragma unroll 1
    for (int t = c; t < 8 * ntn; t += G) {
        const int tm = t & 7, tn = t >> 3;
        const bf16_t* ga = A + ((size_t)row_base + 128 * tm + lr) * K + lp * 8;
        const bf16_t* gb = Bt + ((size_t)128 * tn + lr) * K + lp * 8;
        u32x4 ra[2][4], rb[2][4];
#pragma unroll
        for (int s2 = 0; s2 < 2; ++s2)
#pragma unroll
            for (int j = 0; j < 4; ++j) { ra[s2][j] = *(const u32x4*)(ga + 128 * s2 + 8 * j); rb[s2][j] = *(const u32x4*)(gb + 128 * s2 + 8 * j); }
        f32x4 acc[4][2];
#pragma unroll
        for (int m = 0; m < 4; ++m)
#pragma unroll
            for (int n = 0; n < 2; ++n) acc[m][n] = (f32x4){0.f, 0.f, 0.f, 0.f};
#pragma unroll 1
        for (int st = 0; st < nst; st += 2) {
#pragma unroll
          for (int s2 = 0; s2 < 2; ++s2) {
            PG8_LAS bf16_t* As = (PG8_LAS bf16_t*)(lds + s2 * BUFB); PG8_LAS bf16_t* Bs = As + 128 * LS;
#pragma unroll
            for (int j = 0; j < 4; ++j) { *(PG8_LAS u32x4*)(As + lr * LS + (lp + j) * 8) = ra[s2][j]; *(PG8_LAS u32x4*)(Bs + lr * LS + (lp + j) * 8) = rb[s2][j]; }
            __syncthreads();
            if (st + 2 < nst) {
#pragma unroll
                for (int j = 0; j < 4; ++j) { ra[s2][j] = *(const u32x4*)(ga + 128 * (st + 2 + s2) + 8 * j); rb[s2][j] = *(const u32x4*)(gb + 128 * (st + 2 + s2) + 8 * j); } }
#pragma unroll
            for (int kc = 0; kc < 4; ++kc) {
                bf16x8 af[4], bfr[2];
#pragma unroll
                for (int m = 0; m < 4; ++m) af[m] = *(const PG8_LAS bf16x8*)(As + (64 * wr + 16 * m + fr) * LS + 32 * kc + 8 * fq);
#pragma unroll
                for (int n = 0; n < 2; ++n) bfr[n] = *(const PG8_LAS bf16x8*)(Bs + (32 * wc + 8 * (fr >> 2) + 4 * n + (fr & 3)) * LS + 32 * kc + 8 * fq);
#pragma unroll
                for (int m = 0; m < 4; ++m)
#pragma unroll
                    for (int n = 0; n < 2; ++n) acc[m][n] = __builtin_amdgcn_mfma_f32_16x16x32_bf16(bfr[n], af[m], acc[m][n], 0, 0, 0);
            }
          }
        }
        f32x4 accf[2][2][4][2];
#pragma unroll
        for (int a = 0; a < 2; ++a)
#pragma unroll
            for (int bq = 0; bq < 2; ++bq)
#pragma unroll
                for (int m = 0; m < 4; ++m)
#pragma unroll
                    for (int n = 0; n < 2; ++n) accf[a][bq][m][n] = (a == 0 && bq == 0) ? acc[m][n] : (f32x4){0.f, 0.f, 0.f, 0.f};
        Unit u; u.pm = 128 + (tm >> 1); u.pn = tn >> 1; u.rb = row_base + 128 * tm; u.half = 1; u.q = 1; u.cb = 128 * tn;
        E(accf, u, wr, wc, fr, fq);
        __syncthreads();
    }
}
}

#define LAS __attribute__((address_space(3)))
typedef unsigned short bf16;
typedef unsigned v4u __attribute__((ext_vector_type(4)));
typedef unsigned v2u __attribute__((ext_vector_type(2)));
typedef float f32x4 __attribute__((ext_vector_type(4)));
typedef short bf16x8 __attribute__((ext_vector_type(8)));

constexpr int NTHR = 512, NWAVES = 8;
constexpr int MP = 32768, MS = 1024, MT = MP + MS;
constexpr int D = 1024, DFF = 2816;
constexpr int LDS_BYTES = 147456;
constexpr float EPS = 1e-6f;

enum { I_XP = 0, I_XS, I_CPOOL, I_CSK, I_CSV, I_CMK, I_CMV, I_CFC, I_MEMP, I_LNMIX, I_LNMEM, I_LNMEMKV, I_LNFFN, I_ABWIN, I_ABVG, I_ABWS, I_ABBS, I_ABPW, I_ABPS, I_ABWOUT,
       I_CWQKV, I_CQG, I_CKG, I_CSINK, I_CWO, I_MWQ, I_MWKV, I_MQG, I_MKG, I_MWO, I_FWUP, I_FCW, I_FCB, I_FWDN, N_IN };
constexpr size_t O_YP = 0, O_YS = O_YP + (size_t)MP * D, O_POOLP = O_YS + (size_t)MS * D, O_POOLS = O_POOLP + 4 * 15 * 512, O_CHV = O_POOLS + 128 * 15 * 512,
                 O_SKP = O_CHV + 128 * 8 * 512, O_SVP = O_SKP + 4 * 128 * 256, O_SKS = O_SVP + 4 * 128 * 256, O_SVS = O_SKS + (size_t)128 * 128 * 256,
                 O_MKP = O_SVS + (size_t)128 * 128 * 256, O_MVP = O_MKP + 2 * 4 * 256 * 512, O_FCP = O_MVP + 2 * 4 * 256 * 512, O_FCS = O_FCP + 2 * 4 * 2 * DFF,
                 O_END = O_FCS + (size_t)2 * 128 * 2 * DFF;
constexpr size_t MiB = 1u << 20;
constexpr size_t W_WIN = 0, W_WOUT = W_WIN + 1536 * 1024 * 2, W_WQKV = W_WOUT + 1024 * 1024 * 2, W_CWO = W_WQKV + 1536 * 1024 * 2, W_LAYER = W_CWO + 1024 * 1024 * 2;
constexpr size_t WL_WQ = 0, WL_WKV = WL_WQ + 512 * 1024 * 2, WL_WO = WL_WKV + 1024 * 1024 * 2, WL_WUP = WL_WO + 1024 * 512 * 2, WL_WDN = WL_WUP + (size_t)2 * DFF * 1024 * 2,
                 WL_SIZE = WL_WDN + (size_t)1024 * DFF * 2;
constexpr size_t W_MN = W_LAYER + 2 * WL_SIZE;
constexpr size_t W_MKV = W_MN + 2 * 1024 * 1024 * 2;
constexpr size_t W_SS = W_MKV + 2 * 1024 * 1024 * 4;
constexpr size_t W_SMALL_END = W_SS + (size_t)6 * MT * 4;
static_assert(W_SMALL_END <= 72 * MiB, "weights region");
constexpr size_t W_XN = 72 * MiB;
constexpr size_t W_G = 138 * MiB;
constexpr size_t W_PROJ = W_G;
constexpr size_t W_AO = W_PROJ + 99 * MiB;
constexpr size_t W_H = 320 * MiB;
constexpr size_t W_KV32 = W_H;
constexpr size_t W_MQ = W_KV32 + 66 * MiB;
constexpr size_t W_MO = W_MQ + 33 * MiB;
constexpr size_t W_END = 502 * MiB;
constexpr size_t W_CTL = 504 * MiB, CTL_BYTES = 65536, W_NEED = W_CTL + CTL_BYTES;
constexpr int LDS_CTL_OFF = LDS_BYTES - 64;
static_assert(W_XN + (size_t)MT * 1024 * 2 <= W_G && W_PROJ + (size_t)MT * 1536 * 2 <= W_AO && W_AO + (size_t)MT * 1024 * 2 <= W_H && W_G + (size_t)MT * DFF * 2 <= W_H, "ws map 1");
static_assert(W_KV32 + (size_t)MT * 512 * 4 <= W_MQ && W_MQ + (size_t)MT * 512 * 2 <= W_MO && W_MO + (size_t)MT * 512 * 2 <= W_END && W_H + (size_t)MT * DFF * 2 <= W_END, "ws map 2");

struct Params { const float* in[N_IN]; float* out; unsigned char* ws; };

__device__ __forceinline__ unsigned pk2(float lo, float hi) { return pg8::cvt_pk_bf16(lo, hi); }
__device__ __forceinline__ unsigned f2bf(float f) { return pg8::cvt_pk_bf16(f, 0.f) & 0xffffu; }
__device__ __forceinline__ float bflo(unsigned w) { return __builtin_bit_cast(float, w << 16); }
__device__ __forceinline__ float bfhi(unsigned w) { return __builtin_bit_cast(float, w & 0xffff0000u); }
__device__ __forceinline__ float bf1(bf16 h) { return __builtin_bit_cast(float, (unsigned)h << 16); }
__device__ __forceinline__ void unpack8(const v4u w, float (&o)[8]) { o[0] = bflo(w.x); o[1] = bfhi(w.x); o[2] = bflo(w.y); o[3] = bfhi(w.y); o[4] = bflo(w.z); o[5] = bfhi(w.z); o[6] = bflo(w.w); o[7] = bfhi(w.w); }
__device__ __forceinline__ bf16x8 pack8(const float (&o)[8]) { v4u w; w.x = pk2(o[0], o[1]); w.y = pk2(o[2], o[3]); w.z = pk2(o[4], o[5]); w.w = pk2(o[6], o[7]); return __builtin_bit_cast(bf16x8, w); }
typedef short v4i16_t __attribute__((ext_vector_type(4)));
__device__ __forceinline__ v2u vtr(const LAS bf16* p) { return __builtin_bit_cast(v2u, __builtin_amdgcn_ds_read_tr16_b64_v4i16((LAS v4i16_t*)p)); }
__device__ __forceinline__ float wave_sum(float v) {
#pragma unroll
    for (int o = 1; o < 64; o <<= 1) v += __shfl_xor(v, o);
    return v;
}
__device__ __forceinline__ float gelu1(float v) { const pg8::f32x2 r = pg8::gelu_pk((pg8::f32x2){v, 0.f}); return r.x; }
__device__ __forceinline__ void rope_cs(float pos, int e, float& c, float& s) {
    const float inv = exp2f(-(float)e * (0.125f * 18.931568569324174f));
    const float ang = pos * inv;
    const float k = rintf(ang * 0.15915494309189535f);
    float r = fmaf(-k, 6.28125f, ang);
    r = fmaf(-k, 0.0019353071795864769f, r);
    s = __sinf(r); c = __cosf(r);
}

#define XB_TMO      128
#define XB_XCNT(j)  (256  + 64 * (j))
#define XB_XSUB(j)  (1280 + 64 * (j))
#define XB_XGEN(j)  (2304 + 64 * (j))
#define XB_TOP      3328
#define XB_TOPGEN   3392
#define XCD_BAR_WORDS 3456
#define XB_SPIN_CAP (1u << 18)

__device__ __forceinline__ unsigned xb_ld(unsigned* p)              { return __hip_atomic_load(p, __ATOMIC_RELAXED, __HIP_MEMORY_SCOPE_AGENT); }
__device__ __forceinline__ unsigned xb_add(unsigned* p, unsigned v) { return __hip_atomic_fetch_add(p, v, __ATOMIC_RELAXED, __HIP_MEMORY_SCOPE_AGENT); }
__device__ __forceinline__ unsigned xb_xcc_id() { return (unsigned)__builtin_amdgcn_s_getreg((3 << 11) | 20) & 0xFu; }
#define XB_SPIN(cond, bar) do { unsigned _sp = 0; while (cond) { __builtin_amdgcn_s_sleep(1); \
    if ((++_sp & 255u) == 0u) { if (xb_ld(&(bar)[XB_TMO])) break; if (_sp > XB_SPIN_CAP) { atomicAdd(&(bar)[XB_TMO], 1u); break; } } } } while (0)

struct XcdBarrier {
    unsigned* bar; unsigned x; int w0;
    volatile LAS unsigned* st;
};

__device__ __forceinline__ XcdBarrier xcd_barrier_post(unsigned* bar, volatile LAS unsigned* st) {
    XcdBarrier b; b.bar = bar; b.x = xb_xcc_id(); b.st = st; b.w0 = __builtin_amdgcn_readfirstlane((int)threadIdx.x >> 6);
    if (threadIdx.x == 0) (void)xb_add(&bar[XB_XCNT(b.x)], 1u);
    return b;
}
__device__ __forceinline__ void xcd_barrier_complete(unsigned* bar, unsigned x, unsigned& nloc, unsigned& nx) {
    const unsigned G = gridDim.x * gridDim.y * gridDim.z;
    unsigned sum, cnt, mine, sp = 0u;
    for (;;) {
        sum = 0u; cnt = 0u; mine = 0u;
#pragma unroll
        for (unsigned j = 0; j < 16; ++j) { const unsigned c = xb_ld(&bar[XB_XCNT(j)]); sum += c; cnt += (c > 0u) ? 1u : 0u; mine = (j == x) ? c : mine; }
        if (sum == G) break;
        __builtin_amdgcn_s_sleep(1);
        if ((++sp & 255u) == 0u) { if (xb_ld(&bar[XB_TMO])) break; if (sp > XB_SPIN_CAP) { atomicAdd(&bar[XB_TMO], 1u); break; } }
    }
    nloc = mine > 0u ? mine : 1u; nx = cnt > 0u ? cnt : 1u;
}

__device__ __forceinline__ void xcd_barrier(const XcdBarrier& b) {
    asm volatile("s_waitcnt vmcnt(0)" ::: "memory");
    __syncthreads();
    if (threadIdx.x == 0) {
        unsigned* bar = b.bar;
        __builtin_amdgcn_s_waitcnt(0);
        unsigned nloc = b.st[0], nx = b.st[1];
        if (nloc == 0u) { xcd_barrier_complete(bar, b.x, nloc, nx); b.st[0] = nloc; b.st[1] = nx; }
        const unsigned old = xb_add(&bar[XB_XSUB(b.x)], 1u);
        const unsigned gen = old / nloc;
        if (old + 1u == (gen + 1u) * nloc) {
            __builtin_amdgcn_fence(__ATOMIC_RELEASE, "agent");
            asm volatile("s_waitcnt vmcnt(0)" ::: "memory");
            const unsigned og = xb_add(&bar[XB_TOP], 1u);
            const unsigned tg = og / nx;
            if (og + 1u == (tg + 1u) * nx) xb_add(&bar[XB_TOPGEN], 1u);
            else XB_SPIN(xb_ld(&bar[XB_TOPGEN]) == tg, bar);
            __builtin_amdgcn_fence(__ATOMIC_ACQUIRE, "agent");
            xb_add(&bar[XB_XGEN(b.x)], 1u);
            asm volatile("s_waitcnt vmcnt(0)" ::: "memory");
        } else {
            XB_SPIN(xb_ld(&bar[XB_XGEN(b.x)]) == gen, bar);
            __builtin_amdgcn_fence(__ATOMIC_ACQUIRE, "agent");
            asm volatile("s_waitcnt vmcnt(0)" ::: "memory");
        }
    }
    __syncthreads();
}

__device__ __forceinline__ void transpose_item(const float* W, const float* gain, int ldn, int nblk, bf16* WT, int ldk, int koff, LAS float* scr, int item, int lane) {
    const int kb = item / nblk, nb = item % nblk, k0 = 64 * kb, n0 = 32 * nb;
    float wv[32];
#pragma unroll
    for (int i = 0; i < 32; ++i) wv[i] = W[(size_t)(k0 + 2 * i + (lane >> 5)) * ldn + n0 + (lane & 31)];
    if (gain) {
#pragma unroll
        for (int i = 0; i < 32; ++i) wv[i] *= gain[k0 + 2 * i + (lane >> 5)]; }
#pragma unroll
    for (int i = 0; i < 32; ++i) scr[(2 * i + (lane >> 5)) * 33 + (lane & 31)] = wv[i];
    asm volatile("s_waitcnt lgkmcnt(0)" ::: "memory");
    const int c = lane & 7;
#pragma unroll
    for (int j = 0; j < 4; ++j) { const int n = (lane >> 3) + 8 * j; const LAS float* s = scr + (8 * c) * 33 + n;
        v4u o; o.x = pk2(s[0 * 33], s[1 * 33]); o.y = pk2(s[2 * 33], s[3 * 33]); o.z = pk2(s[4 * 33], s[5 * 33]); o.w = pk2(s[6 * 33], s[7 * 33]);
        *(v4u*)(WT + (size_t)(n0 + n) * ldk + koff + k0 + 8 * c) = o; }
    asm volatile("s_waitcnt lgkmcnt(0)" ::: "memory");
}
__device__ __forceinline__ void rms_row(const float* xrow, const float* g, bf16* orow, int lane) {
    const f32x4* xr = (const f32x4*)xrow + lane; const f32x4* gr = (const f32x4*)g + lane;
    f32x4 v[4]; float s = 0.f;
#pragma unroll
    for (int j = 0; j < 4; ++j) { v[j] = xr[64 * j]; s += (v[j].x * v[j].x + v[j].y * v[j].y) + (v[j].z * v[j].z + v[j].w * v[j].w); }
    const float rs = rsqrtf(wave_sum(s) * (1.f / 1024.f) + EPS);
    unsigned long long* o8 = (unsigned long long*)orow + lane;
#pragma unroll
    for (int j = 0; j < 4; ++j) { const f32x4 gg = gr[64 * j];
        o8[64 * j] = (unsigned long long)pk2(v[j].x * rs * gg.x, v[j].y * rs * gg.y) | ((unsigned long long)pk2(v[j].z * rs * gg.z, v[j].w * rs * gg.w) << 32); }
}
__device__ __forceinline__ void xb_row(const float* xrow, bf16* orow, float* ss, int lane) {
    const f32x4* xr = (const f32x4*)xrow + lane;
    f32x4 v[4]; float s = 0.f;
#pragma unroll
    for (int j = 0; j < 4; ++j) { v[j] = xr[64 * j]; s += (v[j].x * v[j].x + v[j].y * v[j].y) + (v[j].z * v[j].z + v[j].w * v[j].w); }
    s = wave_sum(s);
    unsigned long long* o8 = (unsigned long long*)orow + lane;
#pragma unroll
    for (int j = 0; j < 4; ++j) o8[64 * j] = (unsigned long long)pk2(v[j].x, v[j].y) | ((unsigned long long)pk2(v[j].z, v[j].w) << 32);
    if (lane == 0) *ss = s;
}

struct TItem { const float* W; int ldn, nblk, nitems; bf16* WT; int ldk, koff; };

__device__ __forceinline__ void prologue(const Params& p, LAS unsigned char* lds, int gw, int ngw, int wave, int lane) {
    unsigned char* ws = p.ws;
    LAS float* scr = (LAS float*)(lds + wave * 16384);
#define TR(Wp, gn_, K_, N_, ldn_, dst_, ldk_, koff_) do { const int nblk_ = (N_) / 32, nit_ = ((K_) / 64) * nblk_; \
        for (int it = gw; it < nit_; it += ngw) transpose_item((Wp), (gn_), (ldn_), nblk_, (bf16*)(dst_), (ldk_), (koff_), scr, it, lane); } while (0)
    const float* nog = nullptr;
    TR(p.in[I_ABWIN], p.in[I_LNMIX], 1024, 1536, 1536, ws + W_WIN, 1024, 0);
    TR(p.in[I_ABWOUT], nog, 512, 1024, 1024, ws + W_WOUT, 1024, 0);
    TR(p.in[I_CWQKV], p.in[I_LNMIX] + D, 1024, 1536, 1536, ws + W_WQKV, 1024, 0);
    TR(p.in[I_CWO], nog, 1024, 1024, 1024, ws + W_CWO, 1024, 0);
#pragma unroll 1
    for (int l = 0; l < 2; ++l) {
        unsigned char* wl = ws + W_LAYER + l * WL_SIZE;
        TR(p.in[I_MWQ] + (size_t)l * 1024 * 512, p.in[I_LNMEM] + l * D, 1024, 512, 512, wl + WL_WQ, 1024, 0);
        TR(p.in[I_MWKV] + (size_t)l * 1024 * 1024, nog, 1024, 1024, 1024, wl + WL_WKV, 1024, 0);
        TR(p.in[I_MWO] + (size_t)l * 512 * 1024, nog, 512, 1024, 1024, wl + WL_WO, 512, 0);
        TR(p.in[I_FWUP] + (size_t)l * 1024 * 2 * DFF, p.in[I_LNFFN] + l * D, 1024, 2 * DFF, 2 * DFF, wl + WL_WUP, 1024, 0);
        TR(p.in[I_FWDN] + (size_t)l * DFF * 1024, nog, DFF, 1024, 1024, wl + WL_WDN, DFF, 0);
    }
#undef TR
    {
        const float* pw = p.in[I_ABPW]; const float* ps = p.in[I_ABPS]; const float* wo = p.in[I_ABWOUT] + (size_t)512 * 1024;
        bf16* WT = (bf16*)(ws + W_WOUT);
        const int gt = gw * 64 + lane, ngt = ngw * 64;
        for (int o = gt; o < 128 * 1024; o += ngt) {
            const int n = o & 1023, d = o >> 10;
            float a[4] = {0.f, 0.f, 0.f, 0.f};
#pragma unroll 4
            for (int e = 0; e < 128; ++e) {
#pragma unroll
                for (int g = 0; g < 4; ++g) a[g] += pw[((size_t)g * 128 + d) * 128 + e] * ps[g * 128 + e] * wo[((size_t)g * 128 + e) * 1024 + n]; }
#pragma unroll
            for (int g = 0; g < 4; ++g) WT[(size_t)n * 1024 + 512 + g * 128 + d] = (bf16)f2bf(a[g]); }
    }
    for (int m0 = gw * 4; m0 < MT; m0 += ngw * 4) {
        f32x4 v[4][4];
#pragma unroll
        for (int r = 0; r < 4; ++r) { const int m = m0 + r; const f32x4* xr = (const f32x4*)(m < MP ? p.in[I_XP] + (size_t)m * D : p.in[I_XS] + (size_t)(m - MP) * D) + lane;
#pragma unroll
            for (int j = 0; j < 4; ++j) v[r][j] = xr[64 * j]; }
#pragma unroll
        for (int r = 0; r < 4; ++r) { const int m = m0 + r; float sq = 0.f;
#pragma unroll
            for (int j = 0; j < 4; ++j) sq += (v[r][j].x * v[r][j].x + v[r][j].y * v[r][j].y) + (v[r][j].z * v[r][j].z + v[r][j].w * v[r][j].w);
            sq = wave_sum(sq);
            unsigned long long* o8 = (unsigned long long*)((bf16*)(ws + W_XN) + (size_t)m * D) + lane;
#pragma unroll
            for (int j = 0; j < 4; ++j) o8[64 * j] = (unsigned long long)pk2(v[r][j].x, v[r][j].y) | ((unsigned long long)pk2(v[r][j].z, v[r][j].w) << 32);
            if (lane == 0) ((float*)(ws + W_SS))[m] = sq; }
    }
    for (int o = gw * 64 + lane; o < 5 * MT; o += ngw * 64) ((float*)(ws + W_SS))[MT + o] = 0.f;
    for (int m = gw; m < 2048; m += ngw) { const int l = m >> 10, r = m & 1023;
        rms_row(p.in[I_MEMP] + (size_t)r * D, p.in[I_LNMEMKV] + l * D, (bf16*)(ws + W_MN) + (size_t)m * D, lane); }
}

constexpr int SG_VS = 520;
template <int W> __device__ __forceinline__ void pool_block(const float (&prev)[16], const float (&cur)[16], float (&o)[16], int t0, bool clampcnt) {
#pragma unroll
    for (int k = 0; k < 16; ++k) { float s = 0.f;
#pragma unroll
        for (int kk = 0; kk < W; ++kk) s += (k - kk >= 0) ? cur[(k - kk) & 15] : prev[(16 + k - kk) & 15];
        float inv = 1.f / (float)W;
        if (clampcnt) { const int t1 = t0 + k + 1; if (t1 < W) inv = __builtin_amdgcn_rcpf((float)t1); }
        o[k] = s * inv - cur[k]; }
}
__device__ __forceinline__ void pool_dispatch(int gi, const float (&prev)[16], const float (&cur)[16], float (&o)[16], int t0, bool clampcnt) {
    if (gi == 0) pool_block<2>(prev, cur, o, t0, clampcnt); else if (gi == 1) pool_block<4>(prev, cur, o, t0, clampcnt);
    else if (gi == 2) pool_block<8>(prev, cur, o, t0, clampcnt); else pool_block<16>(prev, cur, o, t0, clampcnt);
}

__device__ __forceinline__ void sgu_prompt_unit(const Params& p, LAS unsigned char* lds, int unit, int tid, int wave, int lane) {
    const bf16* PROJ = (const bf16*)(p.ws + W_PROJ); bf16* AO = (bf16*)(p.ws + W_AO);
    LAS bf16* Vn = (LAS bf16*)lds;
    const int b = unit >> 6, ch = unit & 63; const size_t r0 = (size_t)b * 8192 + ch * 128;
    {
        float gn[8]; pg8::ld8f(p.in[I_ABVG] + 8 * lane, gn);
        v4u raw[16];
#pragma unroll
        for (int jj = 0; jj < 16; ++jj) raw[jj] = *(const v4u*)(PROJ + (r0 + wave + 8 * jj) * 1536 + 512 + 8 * lane);
#pragma unroll
        for (int jj = 0; jj < 16; ++jj) { const int j = wave + 8 * jj;
            float x[8]; unpack8(raw[jj], x);
            float s = 0.f;
#pragma unroll
            for (int e = 0; e < 8; ++e) s += x[e];
            const float mean = wave_sum(s) * (1.f / 512.f); float q = 0.f;
#pragma unroll
            for (int e = 0; e < 8; ++e) { x[e] -= mean; q += x[e] * x[e]; }
            const float rstd = rsqrtf(wave_sum(q) * (1.f / 512.f) + EPS);
#pragma unroll
            for (int e = 0; e < 8; ++e) x[e] *= rstd * gn[e];
            *(LAS bf16x8*)(Vn + j * SG_VS + 8 * lane) = pack8(x); }
    }
    __syncthreads();
    {
        const int q16 = lane & 15, kq = lane >> 4, nch = (wave >> 1) + 1; int i = 16 * wave + q16;
#pragma unroll 1
        for (int g = 0; g < 4; ++g) {
            asm volatile("" : "+v"(i));
            f32x4 acc[8];
#pragma unroll
            for (int dt = 0; dt < 8; ++dt) acc[dt] = (f32x4){0.f, 0.f, 0.f, 0.f};
            const float* wsr = p.in[I_ABWS] + ((size_t)g * 128 + i) * 128;
            float wva[4][8]; v2u uu8[8];
#pragma unroll
            for (int c = 0; c < 4; ++c) pg8::ld8f(wsr + 32 * c + 8 * kq, wva[c]);
#pragma unroll
            for (int dt = 0; dt < 8; ++dt) uu8[dt] = *(const v2u*)(PROJ + (r0 + i) * 1536 + g * 128 + 16 * dt + 4 * kq);
#pragma unroll
            for (int c = 0; c < 4; ++c) if (c < nch) {
                float (&wv)[8] = wva[c];
#pragma unroll
                for (int e = 0; e < 8; ++e) if (32 * c + 8 * kq + e > i) wv[e] = 0.f;
                const bf16x8 bfrag = pack8(wv);
#pragma unroll
                for (int dt = 0; dt < 8; ++dt) { const LAS bf16* vp = Vn + (32 * c + 8 * kq + (q16 >> 2)) * SG_VS + g * 128 + 16 * dt + 4 * (q16 & 3);
                    const v2u lo = vtr(vp), hi = vtr(vp + 4 * SG_VS);
                    v4u av; av.x = lo.x; av.y = lo.y; av.z = hi.x; av.w = hi.y;
                    acc[dt] = __builtin_amdgcn_mfma_f32_16x16x32_bf16(__builtin_bit_cast(bf16x8, av), bfrag, acc[dt], 0, 0, 0); }
            }
            const float bs = p.in[I_ABBS][g * 128 + i];
#pragma unroll
            for (int dt = 0; dt < 8; ++dt) { const v2u uu = uu8[dt];
                const float o0 = bflo(uu.x) * (acc[dt][0] + bs), o1 = bfhi(uu.x) * (acc[dt][1] + bs), o2 = bflo(uu.y) * (acc[dt][2] + bs), o3 = bfhi(uu.y) * (acc[dt][3] + bs);
                v2u w; w.x = pk2(o0, o1); w.y = pk2(o2, o3);
                *(v2u*)(AO + (r0 + i) * 1024 + g * 128 + 16 * dt + 4 * kq) = w; }
        }
    }
    {
        const int c = tid, gi = c >> 7;
        const bf16* pp = PROJ + 1024 + c;
        float prev[16], cur[16], o[16];
#pragma unroll
        for (int k = 0; k < 16; ++k) prev[k] = (ch > 0) ? bf1(pp[(r0 - 16 + k) * 1536]) : 0.f;
        bf16 nxt[16];
#pragma unroll
        for (int k = 0; k < 16; ++k) nxt[k] = pp[(r0 + k) * 1536];
#pragma unroll 1
        for (int blk = 0; blk < 8; ++blk) {
#pragma unroll
            for (int k = 0; k < 16; ++k) cur[k] = bf1(nxt[k]);
            if (blk < 7) {
#pragma unroll
                for (int k = 0; k < 16; ++k) nxt[k] = pp[(r0 + 16 * (blk + 1) + k) * 1536]; }
            pool_dispatch(gi, prev, cur, o, ch * 128 + 16 * blk, ch == 0 && blk == 0);
#pragma unroll
            for (int k = 0; k < 16; ++k) AO[(r0 + 16 * blk + k) * 1024 + 512 + c] = (bf16)f2bf(o[k]);
            if (ch == 63 && blk == 7) {
#pragma unroll
                for (int k = 1; k < 16; ++k) p.out[O_POOLP + ((size_t)b * 15 + (k - 1)) * 512 + c] = cur[k]; }
#pragma unroll
            for (int k = 0; k < 16; ++k) prev[k] = cur[k];
        }
    }
    __syncthreads();
}

__device__ __forceinline__ void sgu_sample_unit(const Params& p, LAS unsigned char* lds, int b, int tid, int wave, int lane) {
    const bf16* PROJ = (const bf16*)(p.ws + W_PROJ); bf16* AO = (bf16*)(p.ws + W_AO);
    LAS float* red = (LAS float*)lds;
    const int c = tid, g = c >> 7; const size_t rs = (size_t)MP + 8 * b;
    float x[8], st[16];
#pragma unroll
    for (int j = 0; j < 8; ++j) { x[j] = bf1(PROJ[(rs + j) * 1536 + 512 + c]); st[j] = wave_sum(x[j]); st[8 + j] = wave_sum(x[j] * x[j]); }
    if (lane == 0) {
#pragma unroll
        for (int j = 0; j < 16; ++j) red[wave * 16 + j] = st[j]; }
    __syncthreads();
    float v[8]; const float gn = p.in[I_ABVG][c];
#pragma unroll
    for (int j = 0; j < 8; ++j) { float s = 0.f, q = 0.f;
#pragma unroll
        for (int w = 0; w < 8; ++w) { s += red[w * 16 + j]; q += red[w * 16 + 8 + j]; }
        const float mean = s * (1.f / 512.f), var = fmaxf(q * (1.f / 512.f) - mean * mean, 0.f);
        v[j] = (x[j] - mean) * rsqrtf(var + EPS) * gn;
        p.out[O_CHV + ((size_t)b * 8 + j) * 512 + c] = v[j]; }
    const float* wsg = p.in[I_ABWS] + (size_t)g * 128 * 128;
#pragma unroll
    for (int i = 0; i < 8; ++i) { float sg = p.in[I_ABBS][g * 128 + i];
#pragma unroll
        for (int j = 0; j < 8; ++j) if (j <= i) sg += wsg[i * 128 + j] * v[j];
        AO[(rs + i) * 1024 + c] = (bf16)f2bf(bf1(PROJ[(rs + i) * 1536 + c]) * sg); }
    float pe[24];
    pe[0] = 0.f;
#pragma unroll
    for (int k = 0; k < 15; ++k) pe[1 + k] = p.in[I_CPOOL][((size_t)b * 15 + k) * 512 + c];
#pragma unroll
    for (int i = 0; i < 8; ++i) pe[16 + i] = bf1(PROJ[(rs + i) * 1536 + 1024 + c]);
    const int W = 2 << g; const float invW = __builtin_amdgcn_rcpf((float)W);
#pragma unroll
    for (int i = 0; i < 8; ++i) { float s = 0.f;
#pragma unroll
        for (int kk = 0; kk < 16; ++kk) if (kk < W) s += pe[16 + i - kk];
        AO[(rs + i) * 1024 + 512 + c] = (bf16)f2bf(s * invW - pe[16 + i]); }
#pragma unroll
    for (int k = 0; k < 15; ++k) p.out[O_POOLS + ((size_t)b * 15 + k) * 512 + c] = pe[9 + k];
    __syncthreads();
}

constexpr int SWA_KS = 72, SWA_VS = 72, SWA_VOFF = 256 * SWA_KS * 2;
template <bool SAMPLE>
__device__ __forceinline__ void swa_unit(const Params& p, LAS unsigned char* lds, int unit, int tid, int wave, int lane) {
    const bf16* Q = (const bf16*)(p.ws + W_PROJ); const float* KV = (const float*)(p.ws + W_KV32); bf16* AO = (bf16*)(p.ws + W_AO);
    LAS bf16* Kl = (LAS bf16*)lds; LAS bf16* Vt = (LAS bf16*)(lds + SWA_VOFF);
    int b, kvh, nb;
    if (!SAMPLE) { nb = unit & 63; kvh = (unit >> 6) & 3; b = unit >> 8; } else { kvh = unit & 3; b = unit >> 2; nb = 0; }
    constexpr int NKEY = SAMPLE ? 160 : 256;
    {
        const int sub = tid & 7;
        float kg[8]; pg8::ld8f(p.in[I_CKG] + 8 * sub, kg);
        constexpr int NIT = SAMPLE ? 3 : 4;
        float kk[NIT][8], vv[NIT][8];
#pragma unroll
        for (int it = 0; it < NIT; ++it) { const int s = (tid >> 3) + 64 * it;
            const float* kp = nullptr; const float* vp = nullptr;
            if (!SAMPLE) { const int trel = (nb - 1) * 128 + s;
                if (trel >= 0) { kp = KV + ((size_t)b * 8192 + trel) * 512 + kvh * 64 + sub * 8; vp = kp + 256; } }
            else { if (s < 128) { const size_t o = (((size_t)b * 128 + s) * 4 + kvh) * 64 + sub * 8; kp = p.in[I_CSK] + o; vp = p.in[I_CSV] + o; }
                else if (s < 136) { kp = KV + ((size_t)MP + 8 * b + (s - 128)) * 512 + kvh * 64 + sub * 8; vp = kp + 256; } }
            if (kp) { pg8::ld8f(kp, kk[it]); pg8::ld8f(vp, vv[it]); } else { pg8::zero8(kk[it]); pg8::zero8(vv[it]); } }
#pragma unroll
        for (int it = 0; it < NIT; ++it) { const int s = (tid >> 3) + 64 * it;
            __builtin_amdgcn_sched_barrier(0);
            if (s < NKEY) {
            bool norm; float pos;
            if (!SAMPLE) { const int trel = (nb - 1) * 128 + s; norm = trel >= 0; pos = (float)trel; }
            else { norm = (s >= 128 && s < 136); pos = (float)(16384 + s - 128); }
            float (&k)[8] = kk[it]; float (&v)[8] = vv[it];
            asm volatile("" : "+v"(pos));
            if (norm) { float ss = 0.f;
#pragma unroll
                for (int e = 0; e < 8; ++e) ss += k[e] * k[e];
                ss += __shfl_xor(ss, 1); ss += __shfl_xor(ss, 2); ss += __shfl_xor(ss, 4);
                const float rs = rsqrtf(ss * (1.f / 64.f) + EPS);
#pragma unroll
                for (int e = 0; e < 8; ++e) k[e] *= rs * kg[e];
#pragma unroll
                for (int e = 0; e < 8; ++e) { const float pk = __shfl_xor(k[e], 1); float cs, sn; rope_cs(pos, e, cs, sn);
                    if (sub == 0) k[e] = k[e] * cs - pk * sn; else if (sub == 1) k[e] = k[e] * cs + pk * sn; }
            }
            *(LAS bf16x8*)(Kl + s * SWA_KS + sub * 8) = pack8(k);
            *(LAS bf16x8*)(Vt + s * SWA_VS + sub * 8) = pack8(v);
            if (!SAMPLE) { if (nb == 63 && s >= 128) { const size_t o = (((size_t)b * 128 + (s - 128)) * 4 + kvh) * 64 + sub * 8;
                    *(f32x4*)(p.out + O_SKP + o) = (f32x4){k[0], k[1], k[2], k[3]}; *(f32x4*)(p.out + O_SKP + o + 4) = (f32x4){k[4], k[5], k[6], k[7]};
                    *(f32x4*)(p.out + O_SVP + o) = (f32x4){v[0], v[1], v[2], v[3]}; *(f32x4*)(p.out + O_SVP + o + 4) = (f32x4){v[4], v[5], v[6], v[7]}; } }
            else { if (s >= 8 && s < 136) { const size_t o = (((size_t)b * 128 + (s - 8)) * 4 + kvh) * 64 + sub * 8;
                    *(f32x4*)(p.out + O_SKS + o) = (f32x4){k[0], k[1], k[2], k[3]}; *(f32x4*)(p.out + O_SKS + o + 4) = (f32x4){k[4], k[5], k[6], k[7]};
                    *(f32x4*)(p.out + O_SVS + o) = (f32x4){v[0], v[1], v[2], v[3]}; *(f32x4*)(p.out + O_SVS + o + 4) = (f32x4){v[4], v[5], v[6], v[7]}; } }
            }
        }
    }
    __syncthreads();
    constexpr int NPASS = SAMPLE ? 1 : 4;
    if (!SAMPLE || wave < 2) {
        asm volatile("" : "+v"(lane));
        float rc[8], rsn[8];
        { const int q16 = lane & 15; const float pos0 = SAMPLE ? (float)(16384 + (q16 & 7)) : (float)(nb * 128 + 16 * wave + q16);
#pragma unroll
          for (int e = 0; e < 8; ++e) rope_cs(pos0, e, rc[e], rsn[e]); }
        float qgs[2][8];
        {
#pragma unroll
          for (int dc = 0; dc < 2; ++dc) { pg8::ld8f(p.in[I_CQG] + 32 * dc + 8 * (lane >> 4), qgs[dc]);
#pragma unroll
            for (int e = 0; e < 8; ++e) qgs[dc][e] *= 0.125f; } }
        v4u qraw[2];
        { const int q16 = lane & 15, kq = lane >> 4;
          const size_t row0 = SAMPLE ? (size_t)MP + 8 * b + (q16 & 7) : (size_t)b * 8192 + nb * 128 + 16 * wave + q16;
          const int h0 = kvh * 4 + (SAMPLE ? 2 * wave + (q16 >> 3) : 0);
#pragma unroll
          for (int dc = 0; dc < 2; ++dc) qraw[dc] = *(const v4u*)(Q + row0 * 1024 + h0 * 64 + 32 * dc + 8 * kq); }
#pragma unroll 1
        for (int ps = 0; ps < NPASS; ++ps) {
            int q16 = lane & 15, kq = lane >> 4; asm volatile("" : "+v"(q16), "+v"(kq));
            int g, i, c0; size_t row; float pos;
            if (!SAMPLE) { g = ps; i = 16 * wave + q16; row = (size_t)b * 8192 + nb * 128 + i; pos = (float)(nb * 128 + i); c0 = wave >> 1; }
            else { g = 2 * wave + (q16 >> 3); i = q16 & 7; row = (size_t)MP + 8 * b + i; pos = (float)(16384 + i); c0 = 0; }
            const int h = kvh * 4 + g;
            float qv[2][8];
#pragma unroll
            for (int dc = 0; dc < 2; ++dc) unpack8(qraw[dc], qv[dc]);
            if (!SAMPLE && ps + 1 < NPASS) {
#pragma unroll
                for (int dc = 0; dc < 2; ++dc) qraw[dc] = *(const v4u*)(Q + row * 1024 + (h + 1) * 64 + 32 * dc + 8 * kq); }
            float ss = 0.f;
#pragma unroll
            for (int dc = 0; dc < 2; ++dc)
#pragma unroll
                for (int e = 0; e < 8; ++e) ss += qv[dc][e] * qv[dc][e];
            ss += __shfl_xor(ss, 16); ss += __shfl_xor(ss, 32);
            const float rs = rsqrtf(ss * (1.f / 64.f) + EPS);
#pragma unroll
            for (int dc = 0; dc < 2; ++dc) {
#pragma unroll
                for (int e = 0; e < 8; ++e) qv[dc][e] *= rs * qgs[dc][e]; }
#pragma unroll
            for (int e = 0; e < 8; ++e) { const float pk = __shfl_xor(qv[0][e], 16); const float cs = rc[e], sn = rsn[e];
                if (kq == 0) qv[0][e] = qv[0][e] * cs - pk * sn; else if (kq == 1) qv[0][e] = qv[0][e] * cs + pk * sn; }
            bf16x8 qf[2];
#pragma unroll
            for (int dc = 0; dc < 2; ++dc) qf[dc] = pack8(qv[dc]);
            f32x4 S[5][2];
            const float sink = p.in[I_CSINK][h];
            float mx = sink;
#pragma unroll
            for (int cc = 0; cc < 5; ++cc)
#pragma unroll
                for (int tt = 0; tt < 2; ++tt) { const int kb = 32 * (c0 + cc) + 16 * tt; f32x4 a = (f32x4){0.f, 0.f, 0.f, 0.f};
#pragma unroll
                    for (int dc = 0; dc < 2; ++dc) { const bf16x8 kf = *(const LAS bf16x8*)(Kl + (kb + q16) * SWA_KS + 32 * dc + 8 * kq);
                        a = __builtin_amdgcn_mfma_f32_16x16x32_bf16(kf, qf[dc], a, 0, 0, 0); }
                    const int rel = (kb >> 4) - wave;
                    const bool full = !SAMPLE && rel >= 1 && rel <= 7 && (nb > 0 || kb >= 128);
                    if (!full) {
#pragma unroll
                        for (int e = 0; e < 4; ++e) { const int s = kb + 4 * kq + e; const bool ok = (s > i) && (s <= i + 128) && (SAMPLE || nb > 0 || s >= 128);
                            a[e] = ok ? a[e] : -INFINITY; } }
#pragma unroll
                    for (int e = 0; e < 4; ++e) mx = fmaxf(mx, a[e]);
                    S[cc][tt] = a; }
            mx = fmaxf(mx, __shfl_xor(mx, 16)); mx = fmaxf(mx, __shfl_xor(mx, 32));
            float den = 0.f;
#pragma unroll
            for (int cc = 0; cc < 5; ++cc)
#pragma unroll
                for (int tt = 0; tt < 2; ++tt)
#pragma unroll
                    for (int e = 0; e < 4; ++e) { const float pe = __expf(S[cc][tt][e] - mx); S[cc][tt][e] = pe; den += pe; }
            den += __shfl_xor(den, 16); den += __shfl_xor(den, 32);
            den += __expf(sink - mx);
            const float rden = 1.f / den;
            bf16x8 pf[5];
#pragma unroll
            for (int cc = 0; cc < 5; ++cc) { float t8[8];
#pragma unroll
                for (int e = 0; e < 4; ++e) { t8[e] = S[cc][0][e]; t8[4 + e] = S[cc][1][e]; }
                pf[cc] = pack8(t8); }
#pragma unroll
            for (int dt = 0; dt < 4; ++dt) { f32x4 o = (f32x4){0.f, 0.f, 0.f, 0.f};
#pragma unroll
                for (int cc = 0; cc < 5; ++cc) { const LAS bf16* vp = Vt + (32 * (c0 + cc) + 4 * kq + (q16 >> 2)) * SWA_VS + 16 * dt + 4 * (q16 & 3);
                    const v2u lo = vtr(vp), hi = vtr(vp + 16 * SWA_VS);
                    v4u av; av.x = lo.x; av.y = lo.y; av.z = hi.x; av.w = hi.y;
                    o = __builtin_amdgcn_mfma_f32_16x16x32_bf16(__builtin_bit_cast(bf16x8, av), pf[cc], o, 0, 0, 0); }
                v2u w; w.x = pk2(o[0] * rden, o[1] * rden); w.y = pk2(o[2] * rden, o[3] * rden);
                *(v2u*)(AO + row * 1024 + h * 64 + 16 * dt + 4 * kq) = w; }
        }
    }
    __syncthreads();
}

constexpr int MEM_KS = 136, MEM_VS = 136, MEM_VOFF = 256 * MEM_KS * 2;
static_assert(MEM_VOFF + 256 * MEM_VS * 2 <= LDS_CTL_OFF && 128 * SG_VS * 2 <= LDS_CTL_OFF, "LDS");
template <bool SAMPLE>
__device__ __forceinline__ void mem_unit(const Params& p, int l, LAS unsigned char* lds, int unit, int tid, int wave, int lane) {
    const bf16* MQ = (const bf16*)(p.ws + W_MQ); bf16* MO = (bf16*)(p.ws + W_MO);
    LAS bf16* Kl = (LAS bf16*)lds; LAS bf16* Vt = (LAS bf16*)(lds + MEM_VOFF);
    int b, h, qt;
    if (!SAMPLE) { qt = unit & 15; h = (unit >> 4) & 3; b = unit >> 6; } else { h = unit & 3; b = unit >> 2; qt = 0; }
    {
        const int sub = tid & 15;
        float kg[8]; pg8::ld8f(p.in[I_MKG] + l * 128 + 8 * sub, kg);
#pragma unroll 1
        for (int hb = 0; hb < 2; ++hb) {
            float kk[4][8], vv[4][8];
#pragma unroll
            for (int it = 0; it < 4; ++it) { const int s = (tid >> 4) + 32 * (4 * hb + it);
                const float* kp; const float* vp;
                if (!SAMPLE) { kp = (const float*)(p.ws + W_MKV) + ((size_t)l * 1024 + b * 256 + s) * 1024 + h * 128 + sub * 8; vp = kp + 512; }
                else { const size_t o = ((((size_t)l * 128 + b) * 256 + s) * 4 + h) * 128 + sub * 8; kp = p.in[I_CMK] + o; vp = p.in[I_CMV] + o; }
                pg8::ld8f(kp, kk[it]); pg8::ld8f(vp, vv[it]); }
#pragma unroll
            for (int it = 0; it < 4; ++it) { const int s = (tid >> 4) + 32 * (4 * hb + it);
                float (&k)[8] = kk[it]; float (&v)[8] = vv[it];
                if (!SAMPLE) { float ss = 0.f;
#pragma unroll
                    for (int e = 0; e < 8; ++e) ss += k[e] * k[e];
                    ss += __shfl_xor(ss, 1); ss += __shfl_xor(ss, 2); ss += __shfl_xor(ss, 4); ss += __shfl_xor(ss, 8);
                    const float rs = rsqrtf(ss * (1.f / 128.f) + EPS);
#pragma unroll
                    for (int e = 0; e < 8; ++e) k[e] *= rs * kg[e];
                    if (qt == 0) { const size_t o = ((((size_t)l * 4 + b) * 256 + s) * 4 + h) * 128 + sub * 8;
                        *(f32x4*)(p.out + O_MKP + o) = (f32x4){k[0], k[1], k[2], k[3]}; *(f32x4*)(p.out + O_MKP + o + 4) = (f32x4){k[4], k[5], k[6], k[7]};
                        *(f32x4*)(p.out + O_MVP + o) = (f32x4){v[0], v[1], v[2], v[3]}; *(f32x4*)(p.out + O_MVP + o + 4) = (f32x4){v[4], v[5], v[6], v[7]}; }
                }
                *(LAS bf16x8*)(Kl + s * MEM_KS + sub * 8) = pack8(k);
                *(LAS bf16x8*)(Vt + s * MEM_VS + sub * 8) = pack8(v);
            }
        }
    }
    __syncthreads();
    if (!SAMPLE || wave == 0) {
#pragma unroll 1
      for (int qq = 0; qq < (SAMPLE ? 1 : 4); ++qq) {
        int q16 = lane & 15, kq = lane >> 4; asm volatile("" : "+v"(q16), "+v"(kq));
        size_t row; bool st;
        if (!SAMPLE) { row = (size_t)b * 8192 + (qt * 4 + qq) * 128 + 16 * wave + q16; st = true; } else { row = (size_t)MP + 8 * b + (q16 & 7); st = q16 < 8; }
        bf16x8 qf[4];
        {
            float qv[4][8]; float ss = 0.f;
#pragma unroll
            for (int dc = 0; dc < 4; ++dc) { unpack8(*(const v4u*)(MQ + row * 512 + h * 128 + 32 * dc + 8 * kq), qv[dc]);
#pragma unroll
                for (int e = 0; e < 8; ++e) ss += qv[dc][e] * qv[dc][e]; }
            ss += __shfl_xor(ss, 16); ss += __shfl_xor(ss, 32);
            const float rs = rsqrtf(ss * (1.f / 128.f) + EPS) * 0.08838834764831845f;
#pragma unroll
            for (int dc = 0; dc < 4; ++dc) { float qg[8]; pg8::ld8f(p.in[I_MQG] + l * 128 + 32 * dc + 8 * kq, qg);
#pragma unroll
                for (int e = 0; e < 8; ++e) qv[dc][e] *= rs * qg[e];
                qf[dc] = pack8(qv[dc]); }
        }
        f32x4 S[8][2]; float mx = -INFINITY;
#pragma unroll
        for (int cc = 0; cc < 8; ++cc)
#pragma unroll
            for (int tt = 0; tt < 2; ++tt) { const int kb = 32 * cc + 16 * tt; f32x4 a = (f32x4){0.f, 0.f, 0.f, 0.f};
#pragma unroll
                for (int dc = 0; dc < 4; ++dc) { const bf16x8 kf = *(const LAS bf16x8*)(Kl + (kb + q16) * MEM_KS + 32 * dc + 8 * kq);
                    a = __builtin_amdgcn_mfma_f32_16x16x32_bf16(kf, qf[dc], a, 0, 0, 0); }
#pragma unroll
                for (int e = 0; e < 4; ++e) mx = fmaxf(mx, a[e]);
                S[cc][tt] = a; }
        mx = fmaxf(mx, __shfl_xor(mx, 16)); mx = fmaxf(mx, __shfl_xor(mx, 32));
        float den = 0.f;
#pragma unroll
        for (int cc = 0; cc < 8; ++cc)
#pragma unroll
            for (int tt = 0; tt < 2; ++tt)
#pragma unroll
                for (int e = 0; e < 4; ++e) { const float pe = __expf(S[cc][tt][e] - mx); S[cc][tt][e] = pe; den += pe; }
        den += __shfl_xor(den, 16); den += __shfl_xor(den, 32);
        const float rden = 1.f / den;
        bf16x8 pf[8];
#pragma unroll
        for (int cc = 0; cc < 8; ++cc) { float t8[8];
#pragma unroll
            for (int e = 0; e < 4; ++e) { t8[e] = S[cc][0][e]; t8[4 + e] = S[cc][1][e]; }
            pf[cc] = pack8(t8); }
#pragma unroll
        for (int dt = 0; dt < 8; ++dt) { f32x4 o = (f32x4){0.f, 0.f, 0.f, 0.f};
#pragma unroll
            for (int cc = 0; cc < 8; ++cc) { const LAS bf16* vp = Vt + (32 * cc + 4 * kq + (q16 >> 2)) * MEM_VS + 16 * dt + 4 * (q16 & 3);
                const v2u lo = vtr(vp), hi = vtr(vp + 16 * MEM_VS);
                v4u av; av.x = lo.x; av.y = lo.y; av.z = hi.x; av.w = hi.y;
                o = __builtin_amdgcn_mfma_f32_16x16x32_bf16(__builtin_bit_cast(bf16x8, av), pf[cc], o, 0, 0, 0); }
            if (st) { v2u w; w.x = pk2(o[0] * rden, o[1] * rden); w.y = pk2(o[2] * rden, o[3] * rden);
                *(v2u*)(MO + row * 512 + h * 128 + 16 * dt + 4 * kq) = w; } }
      }
    }
    __syncthreads();
}

#ifndef REP_LIGHT
#define REP_LIGHT 1
#endif
#ifndef REP_G9
#define REP_G9 1
#endif
#ifndef REP_G10
#define REP_G10 1
#endif
#ifndef REP_PRO
#define REP_PRO 1
#endif
#ifndef REP_MEM
#define REP_MEM 1
#endif
#ifndef REP_P15
#define REP_P15 1
#endif
#ifndef REP_SYNC
#define REP_SYNC 1
#endif
#define GSYNC() do { for (int r_ = 0; r_ < REP_SYNC; ++r_) xcd_barrier(xbar); } while (0)
#define PHASE_IDS int t_ = threadIdx.x; asm volatile("" : "+v"(t_)); const int tid = t_, lane = tid & 63, wave = __builtin_amdgcn_readfirstlane(tid >> 6); const int gw = bx * NWAVES + wave; (void)gw; (void)lane; (void)tid;
__global__ void __launch_bounds__(NTHR, 2) fwd_megakernel(Params p) {
    extern __shared__ __attribute__((aligned(16))) unsigned char lds_raw[];
    LAS unsigned char* lds = (LAS unsigned char*)lds_raw;
    cg::grid_group grid = cg::this_grid();
    const int G = gridDim.x, bx = blockIdx.x;
    const int wave0 = __builtin_amdgcn_readfirstlane((int)threadIdx.x >> 6);
    const int ngw = G * NWAVES;
    unsigned char* ws = p.ws;
    bf16* XN = (bf16*)(ws + W_XN);
    float* SSb = (float*)(ws + W_SS);
    float* X = p.out;
    typedef pg8::bf16_t pb;

    if (threadIdx.x < 16) ((LAS unsigned*)(lds + LDS_CTL_OFF))[threadIdx.x] = 0u;
    __syncthreads();
    const XcdBarrier xbar = xcd_barrier_post((unsigned*)(ws + W_CTL), (volatile LAS unsigned*)(lds + LDS_CTL_OFF));
    for (int rep = 0; rep < REP_LIGHT * REP_PRO; ++rep) { PHASE_IDS prologue(p, lds, gw, ngw, wave, lane); }
    grid.sync();

    auto layer_body = [&](auto LC) __attribute__((always_inline)) {
        constexpr int l = decltype(LC)::value;
        unsigned char* wl = ws + W_LAYER + (size_t)l * WL_SIZE;
        if (l == 0) {
            { pg8::Gemm g{(const pb*)XN, (const pb*)(ws + W_WIN), MT, 1536, 1024}; pg8::StaticOrder S; S.init(MP, 1536, G, bx);
              pg8::EpiAct E{(pb*)(ws + W_PROJ), 1536, 4, SSb};
              pg8::gemm_phase<pg8::EpiAct, pg8::StaticOrder, true, true>(lds, g, S, E, wave0);
              pg8::mini_gemm(lds, g.A, g.Bt, 1024, 12, E, bx, G, wave0); }
#pragma unroll 1
            for (int ll = 0; ll < 2; ++ll) {
              pg8::EpiRes E{(float*)(ws + W_MKV) + (size_t)ll * 1024 * 1024, nullptr, nullptr, 0, nullptr, nullptr, 0};
              pg8::mini_gemm(lds, (const pb*)(ws + W_MN) + (size_t)ll * 1024 * 1024, (const pb*)(ws + W_LAYER + (size_t)ll * WL_SIZE + WL_WKV), 1024, 8, E, (bx + G - 96 - 64 * ll) % G, G, wave0, 0); }
        } else {
            pg8::Gemm g{(const pb*)XN, (const pb*)(ws + W_WQKV), MT, 1536, 1024}; pg8::StaticOrder S; S.init(MP, 1536, G, bx);
            pg8::EpiQKV E{(pb*)(ws + W_PROJ), (float*)(ws + W_KV32), SSb + (size_t)3 * MT};
            pg8::gemm_phase<pg8::EpiQKV, pg8::StaticOrder, true, true>(lds, g, S, E, wave0);
            pg8::mini_gemm(lds, g.A, g.Bt, 1024, 12, E, bx, G, wave0);
        }
        GSYNC();
        if (l == 0) {
#ifndef NO_SGU
            PHASE_IDS
            for (int rep = 0; rep < REP_LIGHT; ++rep)
            for (int u = bx; u < 256 + 128; u += G) { if (u < 256) sgu_prompt_unit(p, lds, u, tid, wave, lane); else sgu_sample_unit(p, lds, u - 256, tid, wave, lane); }
#endif
        } else {
#ifndef NO_SWA
            PHASE_IDS
            for (int rep = 0; rep < REP_LIGHT; ++rep)
            for (int u = bx; u < 1024 + 512; u += G) { if (u < 1024) swa_unit<false>(p, lds, u, tid, wave, lane); else swa_unit<true>(p, lds, u - 1024, tid, wave, lane); }
#endif
        }
        GSYNC();
        {
            pg8::Gemm g{(const pb*)(ws + W_AO), (const pb*)(ws + (l == 0 ? W_WOUT : W_CWO)), MT, 1024, 1024}; pg8::StaticOrder S; S.init(MP, 1024, G, bx);
            pg8::EpiRes E{nullptr, p.in[I_XP], p.in[I_XS], l != 0, (pb*)XN, SSb + (size_t)(1 + 3 * l) * MT, 1};
            pg8::gemm_phase<pg8::EpiRes, pg8::StaticOrder, true, true>(lds, g, S, E, wave0);
            pg8::mini_gemm(lds, g.A, g.Bt, 1024, 8, E, bx, G, wave0);
        }
        GSYNC();
        {
            pg8::Gemm g{(const pb*)XN, (const pb*)(wl + WL_WQ), MT, 512, 1024}; pg8::StaticOrder S; S.init(MP, 512, G, bx);
            pg8::EpiAct E{(pb*)(ws + W_MQ), 512, 0, SSb + (size_t)(1 + 3 * l) * MT};
            pg8::gemm_phase<pg8::EpiAct, pg8::StaticOrder, true, true>(lds, g, S, E, wave0);
            pg8::mini_gemm(lds, g.A, g.Bt, 1024, 4, E, bx, G, wave0);
        }
        GSYNC();
#ifndef NO_MEM
        { PHASE_IDS
        for (int rep = 0; rep < REP_LIGHT * REP_MEM; ++rep)
        for (int u = bx; u < 256 + 512; u += G) { if (u < 256) mem_unit<false>(p, l, lds, u, tid, wave, lane); else mem_unit<true>(p, l, lds, u - 256, tid, wave, lane); } }
#endif
        GSYNC();
        {
            pg8::Gemm g{(const pb*)(ws + W_MO), (const pb*)(wl + WL_WO), MT, 1024, 512}; pg8::StaticOrder S; S.init(MP, 1024, G, bx);
            pg8::EpiRes E{nullptr, nullptr, nullptr, 1, (pb*)XN, SSb + (size_t)(2 + 3 * l) * MT, 1};
            pg8::gemm_phase<pg8::EpiRes, pg8::StaticOrder, true, true>(lds, g, S, E, wave0);
            pg8::mini_gemm(lds, g.A, g.Bt, 512, 8, E, bx, G, wave0);
        }
        GSYNC();
        {
            pg8::Gemm g{(const pb*)XN, (const pb*)(wl + WL_WUP), MT, DFF, 1024}; pg8::SplitOrder S; S.init(DFF, G, bx);
            pg8::EpiG E{(pb*)(ws + W_G), p.out + O_FCP + (size_t)l * 4 * 2 * DFF, p.out + O_FCS + (size_t)l * 128 * 2 * DFF, SSb + (size_t)(2 + 3 * l) * MT};
            for (int rep = 0; rep < REP_G9; ++rep) pg8::gemm_phase<pg8::EpiG, pg8::SplitOrder, true, true>(lds, g, S, E, wave0);
        }
        GSYNC();
        {
            pg8::Gemm g{(const pb*)XN, (const pb*)(wl + WL_WUP) + (size_t)DFF * 1024, MT, DFF, 1024}; pg8::SplitOrder S; S.init(DFF, G, bx);
            pg8::EpiH E{(const pb*)(ws + W_G), (pb*)(ws + W_H), p.in[I_FCW] + (size_t)l * 3 * DFF, p.in[I_FCB] + (size_t)l * DFF, p.in[I_CFC] + (size_t)l * 128 * 2 * DFF, SSb + (size_t)(2 + 3 * l) * MT};
            for (int rep = 0; rep < REP_G10; ++rep) pg8::gemm_phase<pg8::EpiH, pg8::SplitOrder, true, true>(lds, g, S, E, wave0);
        }
        GSYNC();
        {
            pg8::Gemm g{(const pb*)(ws + W_H), (const pb*)(wl + WL_WDN), MT, 1024, DFF}; pg8::StaticOrder S; S.init(MP, 1024, G, bx);
            pg8::EpiRes E{l == 0 ? nullptr : X, nullptr, nullptr, 1, (pb*)XN, SSb + (size_t)3 * MT, l == 0};
            pg8::gemm_phase<pg8::EpiRes, pg8::StaticOrder, true, true>(lds, g, S, E, wave0);
            pg8::mini_gemm(lds, g.A, g.Bt, DFF, 8, E, bx, G, wave0);
        }
        GSYNC();
    };
    layer_body(std::integral_constant<int, 0>{});
    layer_body(std::integral_constant<int, 1>{});
}

extern "C" void kernel_launch(void* const* d_in, const int* in_sizes, int n_in, void* d_out, int out_size, void* d_ws, size_t ws_size, hipStream_t stream) {
    static int grid_blocks = 0;
    if (grid_blocks == 0) {
        if (n_in != N_IN || (size_t)out_size != O_END || ws_size < W_NEED) { fprintf(stderr, "kernel_launch: unexpected shapes: n_in %d out %d ws %zu (need %zu)\n", n_in, out_size, ws_size, (size_t)W_NEED); grid_blocks = -1; return; }
        int dev = 0, cus = 0, per_cu = 0;
        hipGetDevice(&dev);
        hipDeviceGetAttribute(&cus, hipDeviceAttributeMultiprocessorCount, dev);
        if (hipFuncSetAttribute((const void*)fwd_megakernel, hipFuncAttributeMaxDynamicSharedMemorySize, LDS_BYTES) != hipSuccess) { fprintf(stderr, "kernel_launch: hipFuncSetAttribute failed\n"); grid_blocks = -1; return; }
        if (hipOccupancyMaxActiveBlocksPerMultiprocessor(&per_cu, (const void*)fwd_megakernel, NTHR, LDS_BYTES) != hipSuccess || per_cu < 1) { fprintf(stderr, "kernel_launch: occupancy query failed (%d)\n", per_cu); (void)hipGetLastError(); grid_blocks = -1; return; }
        grid_blocks = cus * per_cu;
    }
    if (grid_blocks < 0) return;
    if (hipMemsetAsync((char*)d_ws + W_CTL, 0, CTL_BYTES, stream) != hipSuccess) { fprintf(stderr, "kernel_launch: memset failed\n"); return; }
    Params p{};
    for (int i = 0; i < N_IN; ++i) p.in[i] = (const float*)d_in[i];
    p.out = (float*)d_out; p.ws = (unsigned char*)d_ws;
    void* args[] = {&p};
    hipError_t e = hipLaunchCooperativeKernel((const void*)fwd_megakernel, dim3(grid_blocks), dim3(NTHR), args, LDS_BYTES, stream);
    if (e != hipSuccess) fprintf(stderr, "cooperative launch failed: %s (grid %d)\n", hipGetErrorString(e), grid_blocks);
}
```

```cpp
#include <hip/hip_runtime.h>
#include <hip/hip_cooperative_groups.h>
#include <cstdio>
#include <cstdint>
#include <type_traits>
namespace cg = cooperative_groups;
namespace pg8 {
#define PG8_LAS __attribute__((address_space(3)))
typedef unsigned short bf16_t;
typedef short bf16x8 __attribute__((ext_vector_type(8)));
typedef float f32x4 __attribute__((ext_vector_type(4)));
typedef unsigned u32x4 __attribute__((ext_vector_type(4)));
constexpr int BM = 256, BK = 64, HALF = 128, HTB = HALF * BK * 2  , STAGE_BYTES = 8 * HTB, NXCD = 8, WGM = 8;

__host__ __device__ __forceinline__ int lds_byte(int r, int c) { const int st = (r >> 4) * 2 + (c >> 5), rr = r & 15, cc = c & 31, ob = rr * 64 + cc * 2; return st * 1024 + (ob ^ (((ob >> 9) & 1) << 5)); }
__host__ __device__ __forceinline__ void stage_rc(int b, int& R, int& C) { const int st = b / 1024, sb = b % 1024, swz = sb ^ (((sb >> 9) & 1) << 5); R = (st >> 1) * 16 + swz / 64; C = (st & 1) * 32 + (swz % 64) / 2; }
__host__ __device__ __forceinline__ int perm32(int rho) { const int n = rho >> 4, i = rho & 15; return 8 * (i >> 2) + 4 * n + (i & 3); }

struct Unit { int pm, pn; int rb; int half; int q; int cb; };
struct Gemm { const bf16_t* A; const bf16_t* Bt; int M, N, K; };

struct StaticOrder {
    int nM, nN, nwg, G, c;
    __host__ __device__ void init(int M, int N, int G_, int c_) { nM = M / BM; nN = N / BM; nwg = nM * nN; G = G_; c = c_; }
    __host__ __device__ bool next(int i, Unit& u) const {
        const long L = (long)i * G + c; if (L >= nwg) return false;
        int wgid = (int)L; { const int q = nwg / NXCD, r = nwg % NXCD, xcd = wgid % NXCD, off = wgid / NXCD; wgid = (xcd < r ? xcd * (q + 1) : r * (q + 1) + (xcd - r) * q) + off; }
        const int nig = WGM * nN, gid = wgid / nig, fm = gid * WGM, gsz = (nM - fm) < WGM ? (nM - fm) : WGM;
        u.pm = fm + ((wgid % nig) % gsz); u.pn = (wgid % nig) / gsz; u.rb = u.pm * BM; u.half = 0; u.q = 0; u.cb = u.pn * BM; return true;
    }
    __device__ __forceinline__ void a_ready(const Unit&) const {}
    __device__ __forceinline__ void done(const Unit&) const {}
};
struct SplitOrder {
    StaticOrder P; int nP, nS, nN, G, c;
    __host__ __device__ void init(int N, int G_, int c_) { P.init(32768, N, G_, c_); nP = P.nwg; nN = N / BM; nS = 8 * nN; G = G_; c = c_; }
    __host__ __device__ bool next(int i, Unit& u) const {
        const long L = (long)i * G + c;
        if (L < nP) return P.next(i, u);
        const int j = (int)(L - nP); if (j >= nS) return false;
        const int hm = j & 7; u.pn = j >> 3; u.pm = 128 + (hm >> 1); u.rb = 32768 + 128 * hm; u.half = 1; u.q = 0; u.cb = u.pn * BM; return true;
    }
    __device__ __forceinline__ void a_ready(const Unit&) const {}
    __device__ __forceinline__ void done(const Unit&) const {}
};


__device__ __forceinline__ unsigned cvt_pk_bf16(float lo, float hi) { unsigned r; asm volatile("v_cvt_pk_bf16_f32 %0, %1, %2" : "=v"(r) : "v"(lo), "v"(hi)); return r; }
typedef float f32x2 __attribute__((ext_vector_type(2)));
__device__ __forceinline__ f32x2 gelu_pk(f32x2 v) {
    f32x2 x = v * 0.70710678118f;
    x.x = __builtin_amdgcn_fmed3f(x.x, -2.9f, 2.9f); x.y = __builtin_amdgcn_fmed3f(x.y, -2.9f, 2.9f);
    const f32x2 t = x * x;
    f32x2 p = t * (-4.953124630e-07f) + 1.987094038e-05f;
    p = p * t + (-3.472001117e-04f); p = p * t + 3.517547622e-03f; p = p * t + (-2.333305031e-02f); p = p * t + 1.087993085e-01f; p = p * t + (-3.740358949e-01f); p = p * t + 1.128076553e+00f;
    const f32x2 hv = v * 0.5f;
    return hv * (x * p) + hv;
}

__device__ __forceinline__ float bf_lo(unsigned w) { return __builtin_bit_cast(float, w << 16); }
__device__ __forceinline__ float bf_hi(unsigned w) { return __builtin_bit_cast(float, w & 0xffff0000u); }
__device__ __forceinline__ void ld8bf(const bf16_t* p, float (&o)[8]) { const u32x4 w = *(const u32x4*)p;
    o[0] = bf_lo(w.x); o[1] = bf_hi(w.x); o[2] = bf_lo(w.y); o[3] = bf_hi(w.y); o[4] = bf_lo(w.z); o[5] = bf_hi(w.z); o[6] = bf_lo(w.w); o[7] = bf_hi(w.w); }
__device__ __forceinline__ void ld8f(const float* p, float (&o)[8]) { const f32x4 a = *(const f32x4*)p, b = *(const f32x4*)(p + 4);
    o[0] = a[0]; o[1] = a[1]; o[2] = a[2]; o[3] = a[3]; o[4] = b[0]; o[5] = b[1]; o[6] = b[2]; o[7] = b[3]; }
__device__ __forceinline__ void zero8(float (&o)[8]) {
#pragma unroll
    for (int j = 0; j < 8; ++j) o[j] = 0.f; }

struct EpiAct {
    static constexpr bool PERM = true, AFTER_DRAIN = false;
    bf16_t* O; int ldc; int gelu_tiles; const float* SS;
    __device__ __forceinline__ void operator()(const f32x4 (&acc)[2][2][4][2], const Unit& u, int wr, int wc, int fr, int fq) const {
        asm volatile("" : "+v"(fr), "+v"(fq));
        const int row0 = u.rb + wr * 64 + fr, col0 = u.cb + wc * 32 + 8 * fq;
        const bool act = u.pn < gelu_tiles;
        float rsv[2][4];
#pragma unroll
        for (int ai = 0; ai < 2; ++ai)
#pragma unroll
            for (int m = 0; m < 4; ++m) rsv[ai][m] = SS[row0 + (u.half ? 0 : ai * HALF) + m * 16];
#pragma unroll
        for (int ai = 0; ai < 2; ++ai) if (ai == 0 || !u.half)
#pragma unroll
            for (int m = 0; m < 4; ++m) { bf16_t* rowp = O + (size_t)(row0 + ai * HALF + m * 16) * ldc + col0;
                const float rs = rsqrtf(rsv[ai][m] * (1.f / 1024.f) + 1e-6f);
#pragma unroll
                for (int bj = 0; bj < 2; ++bj) if (bj == 0 || !u.q) { f32x4 v0 = acc[ai][bj][m][0] * rs, v1 = acc[ai][bj][m][1] * rs;
                    if (act) { f32x2 a = gelu_pk((f32x2){v0[0], v0[1]}), b = gelu_pk((f32x2){v0[2], v0[3]}), c = gelu_pk((f32x2){v1[0], v1[1]}), d = gelu_pk((f32x2){v1[2], v1[3]});
                        v0 = (f32x4){a.x, a.y, b.x, b.y}; v1 = (f32x4){c.x, c.y, d.x, d.y}; }
                    u32x4 w; w.x = cvt_pk_bf16(v0[0], v0[1]); w.y = cvt_pk_bf16(v0[2], v0[3]); w.z = cvt_pk_bf16(v1[0], v1[1]); w.w = cvt_pk_bf16(v1[2], v1[3]);
                    *(u32x4*)(rowp + bj * HALF) = w; } }
    }
};

struct EpiQKV {
    static constexpr bool PERM = true, AFTER_DRAIN = false;
    bf16_t* Q; float* KV; const float* SS;
    __device__ __forceinline__ void operator()(const f32x4 (&acc)[2][2][4][2], const Unit& u, int wr, int wc, int fr, int fq) const {
        asm volatile("" : "+v"(fr), "+v"(fq));
        const int row0 = u.rb + wr * 64 + fr;
        float rs[2][4];
#pragma unroll
        for (int ai = 0; ai < 2; ++ai) if (ai == 0 || !u.half)
#pragma unroll
            for (int m = 0; m < 4; ++m) rs[ai][m] = rsqrtf(SS[row0 + (u.half ? 0 : ai * HALF) + m * 16] * (1.f / 1024.f) + 1e-6f);
        if (u.pn < 4) {
            const int col0 = u.cb + wc * 32 + 8 * fq;
#pragma unroll
            for (int ai = 0; ai < 2; ++ai) if (ai == 0 || !u.half)
#pragma unroll
                for (int m = 0; m < 4; ++m) { bf16_t* rowp = Q + (size_t)(row0 + ai * HALF + m * 16) * 1024 + col0;
#pragma unroll
                    for (int bj = 0; bj < 2; ++bj) if (bj == 0 || !u.q) { const f32x4 v0 = acc[ai][bj][m][0] * rs[ai][m], v1 = acc[ai][bj][m][1] * rs[ai][m];
                        u32x4 w; w.x = cvt_pk_bf16(v0[0], v0[1]); w.y = cvt_pk_bf16(v0[2], v0[3]); w.z = cvt_pk_bf16(v1[0], v1[1]); w.w = cvt_pk_bf16(v1[2], v1[3]);
                        *(u32x4*)(rowp + bj * HALF) = w; } }
        } else {
            const int col0 = (u.cb - 1024) + wc * 32 + 8 * fq;
#pragma unroll
            for (int ai = 0; ai < 2; ++ai) if (ai == 0 || !u.half)
#pragma unroll
                for (int m = 0; m < 4; ++m) { float* rowp = KV + (size_t)(row0 + ai * HALF + m * 16) * 512 + col0;
#pragma unroll
                    for (int bj = 0; bj < 2; ++bj) if (bj == 0 || !u.q) { *(f32x4*)(rowp + bj * HALF) = acc[ai][bj][m][0] * rs[ai][m]; *(f32x4*)(rowp + bj * HALF + 4) = acc[ai][bj][m][1] * rs[ai][m]; } }
        }
    }
};

struct EpiRes {
    static constexpr bool PERM = true, AFTER_DRAIN = false;
    float* C; const float* resP; const float* resS; int inplace; bf16_t* XB0; float* SS; int wxb;
    static constexpr int ldc = 1024, split = 32768;
    __device__ __forceinline__ void row_out(const f32x4 v0, const f32x4 v1, int row, int col, float& ss) const {
        if (C) { float* rowp = C + (size_t)row * ldc + col; *(f32x4*)rowp = v0; *(f32x4*)(rowp + 4) = v1; }
        if (wxb) { u32x4 w; w.x = cvt_pk_bf16(v0[0], v0[1]); w.y = cvt_pk_bf16(v0[2], v0[3]); w.z = cvt_pk_bf16(v1[0], v1[1]); w.w = cvt_pk_bf16(v1[2], v1[3]);
            *(u32x4*)(XB0 + (size_t)row * ldc + col) = w;
            ss += (v0[0] * v0[0] + v0[1] * v0[1]) + (v0[2] * v0[2] + v0[3] * v0[3]) + (v1[0] * v1[0] + v1[1] * v1[1]) + (v1[2] * v1[2] + v1[3] * v1[3]); }
    }
    __device__ __forceinline__ void operator()(const f32x4 (&acc)[2][2][4][2], const Unit& u, int wr, int wc, int fr, int fq) const {
        asm volatile("" : "+v"(fr), "+v"(fq));
        const int row0 = u.rb + wr * 64 + fr, col0 = u.cb + wc * 32 + 8 * fq;
        if (inplace) {
#pragma unroll
            for (int ai = 0; ai < 2; ++ai) if (ai == 0 || !u.half)
#pragma unroll
              for (int mh = 0; mh < 4; mh += 2) {
                u32x4 rw[2][2];
#pragma unroll
                for (int mm = 0; mm < 2; ++mm) { const int row = row0 + ai * HALF + (mh + mm) * 16;
#pragma unroll
                    for (int bj = 0; bj < 2; ++bj) if (bj == 0 || !u.q) rw[mm][bj] = *(const u32x4*)(XB0 + (size_t)row * ldc + col0 + bj * HALF); }
#pragma unroll
                for (int mm = 0; mm < 2; ++mm) { const int m = mh + mm, row = row0 + ai * HALF + m * 16; float ss = 0.f;
#pragma unroll
                    for (int bj = 0; bj < 2; ++bj) if (bj == 0 || !u.q) { const u32x4 w = rw[mm][bj];
                        const f32x4 v0 = acc[ai][bj][m][0] + (f32x4){bf_lo(w.x), bf_hi(w.x), bf_lo(w.y), bf_hi(w.y)}, v1 = acc[ai][bj][m][1] + (f32x4){bf_lo(w.z), bf_hi(w.z), bf_lo(w.w), bf_hi(w.w)};
                        row_out(v0, v1, row, col0 + bj * HALF, ss); }
                    if (wxb) { ss += __shfl_xor(ss, 16); ss += __shfl_xor(ss, 32); if (fq == 0) unsafeAtomicAdd(SS + row, ss); } }
              }
        } else {
#pragma unroll
            for (int ai = 0; ai < 2; ++ai) if (ai == 0 || !u.half)
#pragma unroll
                for (int m = 0; m < 4; ++m) { const int row = row0 + ai * HALF + m * 16; float ss = 0.f;
                    const float* rp = resP ? ((row < split ? resP + (size_t)row * ldc : resS + (size_t)(row - split) * ldc) + col0) : nullptr;
                    f32x4 rv[2][2];
#pragma unroll
                    for (int bj = 0; bj < 2; ++bj) if (bj == 0 || !u.q) { rv[bj][0] = rp ? *(const f32x4*)(rp + bj * HALF) : (f32x4){0.f, 0.f, 0.f, 0.f}; rv[bj][1] = rp ? *(const f32x4*)(rp + bj * HALF + 4) : (f32x4){0.f, 0.f, 0.f, 0.f}; }
#pragma unroll
                    for (int bj = 0; bj < 2; ++bj) if (bj == 0 || !u.q) row_out(acc[ai][bj][m][0] + rv[bj][0], acc[ai][bj][m][1] + rv[bj][1], row, col0 + bj * HALF, ss);
                    if (wxb) { ss += __shfl_xor(ss, 16); ss += __shfl_xor(ss, 32); if (fq == 0) unsafeAtomicAdd(SS + row, ss); } }
        }
    }
};

struct EpiG {
    static constexpr bool PERM = true, AFTER_DRAIN = false;
    bf16_t* G; float* outP; float* outS; const float* SS;
    __device__ __forceinline__ void operator()(const f32x4 (&acc)[2][2][4][2], const Unit& u, int wr, int wc, int fr, int fq) const {
        asm volatile("" : "+v"(fr), "+v"(fq));
        const int row0 = u.rb + wr * 64 + fr, col0 = u.pn * BM + wc * 32 + 8 * fq;
        float rsv[2][4];
#pragma unroll
        for (int ai = 0; ai < 2; ++ai)
#pragma unroll
            for (int m = 0; m < 4; ++m) rsv[ai][m] = SS[row0 + (u.half ? 0 : ai * HALF) + m * 16];
#pragma unroll
        for (int ai = 0; ai < 2; ++ai) if (ai == 0 || !u.half)
#pragma unroll
            for (int m = 0; m < 4; ++m) { const int row = row0 + ai * HALF + m * 16; bf16_t* rowp = G + (size_t)row * 2816 + col0;
                float* co = nullptr;
                if (row < 32768) { const int t = row & 8191; if (t >= 8190) co = outP + ((size_t)(row >> 13) * 2 + (t - 8190)) * 2816 + col0; }
                else { const int i = row & 7; if (i >= 6) co = outS + ((size_t)((row - 32768) >> 3) * 2 + (i - 6)) * 2816 + col0; }
                const float rs = rsqrtf(rsv[ai][m] * (1.f / 1024.f) + 1e-6f);
#pragma unroll
                for (int bj = 0; bj < 2; ++bj) { const f32x4 v0 = acc[ai][bj][m][0] * rs, v1 = acc[ai][bj][m][1] * rs;
                    u32x4 w; w.x = cvt_pk_bf16(v0[0], v0[1]); w.y = cvt_pk_bf16(v0[2], v0[3]); w.z = cvt_pk_bf16(v1[0], v1[1]); w.w = cvt_pk_bf16(v1[2], v1[3]);
                    *(u32x4*)(rowp + bj * HALF) = w;
                    if (co) { *(f32x4*)(co + bj * HALF) = v0; *(f32x4*)(co + bj * HALF + 4) = v1; } } }
    }
};

typedef unsigned u32x2 __attribute__((ext_vector_type(2)));
struct EpiH {
    static constexpr bool PERM = true, AFTER_DRAIN = false;
    const bf16_t* G; bf16_t* H; const float* cw; const float* cb; const float* ctx; const float* SS;
    static __device__ __forceinline__ void unpk4(const u32x2 w, float (&o)[4]) { o[0] = bf_lo(w.x); o[1] = bf_hi(w.x); o[2] = bf_lo(w.y); o[3] = bf_hi(w.y); }
    static __device__ __forceinline__ void ld4f(const float* p, float (&o)[4]) { const f32x4 a = *(const f32x4*)p; o[0] = a[0]; o[1] = a[1]; o[2] = a[2]; o[3] = a[3]; }
    static __device__ __forceinline__ u32x2 shf(const u32x2 w, int src) { u32x2 r; r.x = (unsigned)__shfl((int)w.x, src); r.y = (unsigned)__shfl((int)w.y, src); return r; }
    static __device__ __forceinline__ void finish(const float (&g0)[4], const float (&g1)[4], const float (&g2)[4], const float (&w0)[4], const float (&w1)[4], const float (&w2)[4], const float (&bb)[4],
                                                  const f32x4 v, float rs, bf16_t* dst) {
        float h[4];
#pragma unroll
        for (int j = 0; j < 4; j += 2) {
            const f32x2 gc = (f32x2){bb[j] + w0[j] * g2[j] + w1[j] * g1[j] + w2[j] * g0[j], bb[j + 1] + w0[j + 1] * g2[j + 1] + w1[j + 1] * g1[j + 1] + w2[j + 1] * g0[j + 1]};
            const f32x2 ge = gelu_pk(gc); h[j] = ge.x * v[j] * rs; h[j + 1] = ge.y * v[j + 1] * rs; }
        u32x2 w; w.x = cvt_pk_bf16(h[0], h[1]); w.y = cvt_pk_bf16(h[2], h[3]);
        *(u32x2*)dst = w;
    }
    __device__ __forceinline__ void operator()(const f32x4 (&acc)[2][2][4][2], const Unit& u, int wr, int wc, int fr, int fq) const {
        asm volatile("" : "+v"(fr), "+v"(fq));
        const int row0 = u.rb + wr * 64 + fr;
        const int lane = fq * 16 + fr;
        const int s1 = fr >= 1 ? lane - 1 : lane + 15, s2 = fr >= 2 ? lane - 2 : lane + 14;
#pragma unroll
        for (int bj = 0; bj < 2; ++bj)
#pragma unroll
          for (int hv = 0; hv < 2; ++hv) {
            const int col = u.pn * BM + bj * HALF + wc * 32 + 8 * fq + 4 * hv;
            float w0[4], w1[4], w2[4], bb[4];
            ld4f(cw + col, w0); ld4f(cw + 2816 + col, w1); ld4f(cw + 2 * 2816 + col, w2); ld4f(cb + col, bb);
            if (u.pm < 128) {
#pragma unroll
                for (int ai = 0; ai < 2; ++ai) {
                    const int R0 = u.rb + ai * HALF + wr * 64;
                    const bf16_t* gp = G + (size_t)(R0 + fr) * 2816 + col;
                    u32x2 gq[4];
#pragma unroll
                    for (int m = 0; m < 4; ++m) gq[m] = *(const u32x2*)(gp + (size_t)m * 16 * 2816);
                    u32x2 prv = (u32x2){0u, 0u};
                    if ((R0 & 8191) != 0) prv = *(const u32x2*)(gp - (size_t)16 * 2816);
#pragma unroll
                    for (int m = 0; m < 4; ++m) {
                        const u32x2 q1 = shf(fr == 15 ? prv : gq[m], s1), q2 = shf(fr >= 14 ? prv : gq[m], s2);
                        float g0[4], g1[4], g2[4]; unpk4(gq[m], g0); unpk4(q1, g1); unpk4(q2, g2);
                        finish(g0, g1, g2, w0, w1, w2, bb, acc[ai][bj][m][hv], rsqrtf(SS[R0 + fr + 16 * m] * (1.f / 1024.f) + 1e-6f), H + (size_t)(R0 + fr + 16 * m) * 2816 + col);
                        prv = gq[m];
                    }
                }
            } else {
                const int i = fr & 7;
                u32x2 gq[4]; float ssv[4];
#pragma unroll
                for (int m = 0; m < 4; ++m) { const int row = row0 + m * 16; gq[m] = *(const u32x2*)(G + (size_t)row * 2816 + col); ssv[m] = SS[row]; }
#pragma unroll
                for (int mh = 0; mh < 4; mh += 2) {
                f32x4 c0[4], c1[4];
#pragma unroll
                for (int m = mh; m < mh + 2; ++m) { const int row = row0 + m * 16; const float* cx = ctx + (size_t)((row - 32768) >> 3) * 2 * 2816 + col;
                    c0[m] = *(const f32x4*)cx; c1[m] = *(const f32x4*)(cx + 2816); }
#pragma unroll
                for (int m = mh; m < mh + 2; ++m) { const int row = row0 + m * 16; const u32x2 cur = gq[m];
                    const u32x2 q1 = shf(cur, lane - 1), q2 = shf(cur, lane - 2);
                    float g0[4], g1[4], g2[4]; unpk4(cur, g0); unpk4(q1, g1); unpk4(q2, g2);
#pragma unroll
                    for (int j = 0; j < 4; ++j) { const float x1 = c1[m][j], x0 = c0[m][j];
                        if (i < 1) g1[j] = x1;
                        if (i < 2) g2[j] = (i == 1) ? x1 : x0; }
                    finish(g0, g1, g2, w0, w1, w2, bb, acc[0][bj][m][hv], rsqrtf(ssv[m] * (1.f / 1024.f) + 1e-6f), H + (size_t)row * 2816 + col); }
                }
            }
        }
    }
};

template <class Epi, class Sched, bool ALIGN_EPI = false, bool SP2 = false>
__device__ __forceinline__ void gemm_phase(PG8_LAS unsigned char* lds, const Gemm g, const Sched& S, const Epi& E, int wave0) {
    int tid_ = threadIdx.x; (void)wave0; asm volatile("" : "+v"(tid_));
    const int tid = tid_, wid = __builtin_amdgcn_readfirstlane(tid >> 6), lane = tid & 63, wr = wid >> 2, wc = wid & 3, fr = lane & 15, fq = lane >> 4;
    const int K = g.K, nt = K / BK;
    unsigned voffA[2], voffB[2];
#pragma unroll
    for (int i = 0; i < 2; ++i) { int R, C; stage_rc(tid * 16 + i * 8192, R, C); const int Rb = Epi::PERM ? ((R & ~31) + perm32(R & 31)) : R;
        voffA[i] = (unsigned)(R * K + C) * 2u; voffB[i] = (unsigned)(Rb * K + C) * 2u; }
    const size_t kstep = (size_t)(BK * 2);
    const size_t hstep = (size_t)HALF * K * 2;
    const size_t tstep = 2 * hstep;
    const unsigned ldsw = (unsigned)wid * 1024u;
    const int aoff = lds_byte(wr * 64 + fr, fq * 8), boff = lds_byte(wc * 32 + fr, fq * 8);
#define PG8_SA(b, h) (((b) * 2 + (h)) * HTB)
#define PG8_SB(b, h) ((4 + (b) * 2 + (h)) * HTB)
#define PG8_STAGE(bufoff, gbase, voff) do { _Pragma("unroll") for (int _i = 0; _i < 2; ++_i) \
        __builtin_amdgcn_global_load_lds((const unsigned*)((const char*)(gbase) + (voff)[_i]), (PG8_LAS unsigned*)(lds + (bufoff) + ldsw + _i * 8192), 16, 0, 0); } while (0)
#define PG8_LDA(dst, b, h) do { _Pragma("unroll") for (int m = 0; m < 4; ++m) _Pragma("unroll") for (int k = 0; k < 2; ++k) dst[m][k] = *(const PG8_LAS bf16x8*)(lds + PG8_SA(b, h) + aoff + m * 2048 + k * 1024); } while (0)
#define PG8_LDB(dst, b, h) do { _Pragma("unroll") for (int n = 0; n < 2; ++n) _Pragma("unroll") for (int k = 0; k < 2; ++k) dst[n][k] = *(const PG8_LAS bf16x8*)(lds + PG8_SB(b, h) + boff + n * 2048 + k * 1024); } while (0)
#define PG8_MMA(ai, bj, At, Bt) do { __builtin_amdgcn_s_setprio(1); _Pragma("unroll") for (int m = 0; m < 4; ++m) _Pragma("unroll") for (int n = 0; n < 2; ++n) _Pragma("unroll") for (int k = 0; k < 2; ++k) \
        acc[ai][bj][m][n] = __builtin_amdgcn_mfma_f32_16x16x32_bf16(Bt[n][k], At[m][k], acc[ai][bj][m][n], 0, 0, 0); __builtin_amdgcn_s_setprio(0); } while (0)
#define PG8_WAIT_V(n) asm volatile("s_waitcnt vmcnt(" #n ")" ::: "memory")
#define PG8_WAIT_L(n) asm volatile("s_waitcnt lgkmcnt(" #n ")" ::: "memory")
#define PG8_BAR __builtin_amdgcn_s_barrier()
#define PG8_SCHED __builtin_amdgcn_sched_barrier(0)
    Unit cur, nxt; int ui = 0;
    if (!S.next(0, cur)) return;
    f32x4 acc[2][2][4][2];
#pragma unroll
    for (int a = 0; a < 2; ++a)
#pragma unroll
        for (int b = 0; b < 2; ++b)
#pragma unroll
            for (int m = 0; m < 4; ++m)
#pragma unroll
                for (int n = 0; n < 2; ++n) acc[a][b][m][n] = (f32x4){0.f, 0.f, 0.f, 0.f};
    bf16x8 At[4][2], B0[2][2], B1[2][2];
    const char* cA = (const char*)g.A + (size_t)cur.rb * K * 2; const char* cB = (const char*)g.Bt + (size_t)cur.pn * tstep;
    S.a_ready(cur);
    if constexpr (SP2) {
        PG8_STAGE(PG8_SB(0, 0), cB, voffB); PG8_STAGE(PG8_SB(0, 1), cB + hstep, voffB); PG8_STAGE(PG8_SA(0, 0), cA, voffA); PG8_STAGE(PG8_SA(0, 1), cA + hstep, voffA);
        if (wr == 1) PG8_BAR;
        PG8_WAIT_V(2); PG8_BAR;
        PG8_STAGE(PG8_SB(1, 0), cB + kstep, voffB); PG8_STAGE(PG8_SA(1, 0), cA + kstep, voffA); PG8_STAGE(PG8_SB(1, 1), cB + hstep + kstep, voffB);
        PG8_WAIT_V(6); PG8_BAR;
    } else {
        PG8_STAGE(PG8_SB(0, 0), cB, voffB); PG8_STAGE(PG8_SA(0, 0), cA, voffA); PG8_STAGE(PG8_SB(0, 1), cB + hstep, voffB); PG8_STAGE(PG8_SA(0, 1), cA + hstep, voffA);
        if (wr == 1) PG8_BAR;
        PG8_WAIT_V(4); PG8_BAR;
        PG8_STAGE(PG8_SB(1, 0), cB + kstep, voffB); PG8_STAGE(PG8_SA(1, 0), cA + kstep, voffA); PG8_STAGE(PG8_SB(1, 1), cB + hstep + kstep, voffB);
        PG8_WAIT_V(6); PG8_BAR;
    }
    for (;;) {
        const bool has_next = S.next(ui + 1, nxt);
        const char* nA = has_next ? (const char*)g.A + (size_t)nxt.rb * K * 2 : cA; const char* nB = has_next ? (const char*)g.Bt + (size_t)nxt.pn * tstep : cB;
        for (int t = 0; t < nt; t += 2) {
            const bool last = (t == nt - 2);
            const char* a1 = cA + (size_t)(t + 1) * kstep;
            const char* a2 = last ? nA : cA + (size_t)(t + 2) * kstep; const char* b2 = last ? nB : cB + (size_t)(t + 2) * kstep;
            const char* a3 = a2 + kstep; const char* b3 = b2 + kstep;
            if (last && has_next) S.a_ready(nxt);
            if constexpr (SP2) {
            PG8_LDB(B0, 0, 0); PG8_LDB(B1, 0, 1); PG8_SCHED; PG8_LDA(At, 0, 0); PG8_STAGE(PG8_SA(1, 1), a1 + hstep, voffA);
            PG8_WAIT_V(8); PG8_WAIT_L(0); PG8_BAR; PG8_MMA(0, 0, At, B0); PG8_MMA(0, 1, At, B1); PG8_BAR; PG8_SCHED;
            PG8_LDA(At, 0, 1); PG8_STAGE(PG8_SB(0, 0), b2, voffB); PG8_STAGE(PG8_SB(0, 1), b2 + hstep, voffB); PG8_STAGE(PG8_SA(0, 0), a2, voffA);
            PG8_WAIT_V(8); PG8_WAIT_L(0); PG8_BAR; if (!cur.half) { PG8_MMA(1, 0, At, B0); PG8_MMA(1, 1, At, B1); } PG8_BAR; PG8_SCHED;
            PG8_LDB(B0, 1, 0); PG8_LDB(B1, 1, 1); PG8_SCHED; PG8_LDA(At, 1, 0); PG8_STAGE(PG8_SA(0, 1), a2 + hstep, voffA);
            PG8_WAIT_V(8); PG8_WAIT_L(0); PG8_BAR; PG8_MMA(0, 0, At, B0); PG8_MMA(0, 1, At, B1); PG8_BAR; PG8_SCHED;
            PG8_LDA(At, 1, 1); PG8_STAGE(PG8_SB(1, 0), b3, voffB); PG8_STAGE(PG8_SB(1, 1), b3 + hstep, voffB); PG8_STAGE(PG8_SA(1, 0), a3, voffA);
            PG8_WAIT_V(8); PG8_WAIT_L(0); PG8_BAR; if (!cur.half) { PG8_MMA(1, 0, At, B0); PG8_MMA(1, 1, At, B1); } PG8_BAR; PG8_SCHED;
            } else {
            PG8_LDB(B0, 0, 0); PG8_SCHED; PG8_LDA(At, 0, 0); PG8_STAGE(PG8_SA(1, 1), a1 + hstep, voffA);
            PG8_WAIT_L(8); PG8_BAR; PG8_WAIT_L(0); PG8_MMA(0, 0, At, B0); PG8_BAR; PG8_SCHED;
            PG8_LDB(B1, 0, 1); PG8_STAGE(PG8_SB(0, 0), b2, voffB);
            PG8_BAR; PG8_WAIT_L(0); PG8_MMA(0, 1, At, B1); PG8_BAR;
            PG8_LDA(At, 0, 1); PG8_STAGE(PG8_SA(0, 0), a2, voffA);
            PG8_BAR; PG8_WAIT_L(0); if (!cur.half) PG8_MMA(1, 0, At, B0); PG8_BAR; PG8_SCHED;
            PG8_STAGE(PG8_SB(0, 1), b2 + hstep, voffB);
            PG8_WAIT_V(6); PG8_BAR; if (!cur.half) PG8_MMA(1, 1, At, B1); PG8_BAR;
            PG8_LDB(B0, 1, 0); PG8_SCHED; PG8_LDA(At, 1, 0); PG8_STAGE(PG8_SA(0, 1), a2 + hstep, voffA);
            PG8_WAIT_L(8); PG8_BAR; PG8_WAIT_L(0); PG8_MMA(0, 0, At, B0); PG8_BAR; PG8_SCHED;
            PG8_LDB(B1, 1, 1); PG8_STAGE(PG8_SB(1, 0), b3, voffB);
            PG8_BAR; PG8_WAIT_L(0); PG8_MMA(0, 1, At, B1); PG8_BAR;
            PG8_LDA(At, 1, 1); PG8_STAGE(PG8_SA(1, 0), a3, voffA);
            PG8_BAR; PG8_WAIT_L(0); if (!cur.half) PG8_MMA(1, 0, At, B0); PG8_BAR; PG8_SCHED;
            PG8_STAGE(PG8_SB(1, 1), b3 + hstep, voffB);
            PG8_WAIT_V(6); PG8_BAR; if (!cur.half) PG8_MMA(1, 1, At, B1); PG8_BAR;
            }
        }
        if constexpr (ALIGN_EPI) { if (wr == 0) PG8_BAR; }
        if constexpr (!Epi::AFTER_DRAIN) { E(acc, cur, wr, wc, fr, fq); S.done(cur); }
        if (!has_next) break;
#pragma unroll
        for (int a = 0; a < 2; ++a)
#pragma unroll
            for (int b = 0; b < 2; ++b)
#pragma unroll
                for (int m = 0; m < 4; ++m)
#pragma unroll
                    for (int n = 0; n < 2; ++n) acc[a][b][m][n] = (f32x4){0.f, 0.f, 0.f, 0.f};
        cur = nxt; cA = nA; cB = nB; ++ui;
        if constexpr (ALIGN_EPI) { if (wr == 1) PG8_BAR; }
    }
    PG8_WAIT_V(0);
    if constexpr (!ALIGN_EPI) { if (wr == 0) PG8_BAR; }
    PG8_BAR;
    if constexpr (Epi::AFTER_DRAIN) { E.fused(acc, cur, wr, wc, fr, fq, lds, wid, lane); S.done(cur); }
#undef PG8_SA
#undef PG8_SB
#undef PG8_STAGE
#undef PG8_LDA
#undef PG8_LDB
#undef PG8_MMA
#undef PG8_WAIT_V
#undef PG8_WAIT_L
#undef PG8_BAR
#undef PG8_SCHED
}

template <class Epi>
__device__ __forceinline__ void mini_gemm(PG8_LAS unsigned char* lds, const bf16_t* A, const bf16_t* Bt, int K, int ntn, const Epi& E, int c, int G, int wave0, int row_base = 32768) {
    int tid_ = threadIdx.x; (void)wave0; asm volatile("" : "+v"(tid_));
    const int tid = tid_, wid = __builtin_amdgcn_readfirstlane(tid >> 6), lane = tid & 63, wr = wid >> 2, wc = wid & 3, fr = lane & 15, fq = lane >> 4;
    constexpr int LS = 136, BUFB = 2 * 128 * LS * 2;
    const int lr = tid >> 2, lp = (tid & 3) * 4;
    const int nst = K / 128;
#pragma unroll 1
    for (int t = c; t < 8 * ntn; t += G) {
        const int tm = t & 7, tn = t >> 3;
        const bf16_t* ga = A + ((size_t)row_base + 128 * tm + lr) * K + lp * 8;
        const bf16_t* gb = Bt + ((size_t)128 * tn + lr) * K + lp * 8;
        u32x4 ra[2][4], rb[2][4];
#pragma unroll
        for (int s2 = 0; s2 < 2; ++s2)
#pragma unroll
            for (int j = 0; j < 4; ++j) { ra[s2][j] = *(const u32x4*)(ga + 128 * s2 + 8 * j); rb[s2][j] = *(const u32x4*)(gb + 128 * s2 + 8 * j); }
        f32x4 acc[4][2];
#pragma unroll
        for (int m = 0; m < 4; ++m)
#pragma unroll
            for (int n = 0; n < 2; ++n) acc[m][n] = (f32x4){0.f, 0.f, 0.f, 0.f};
#pragma unroll 1
        for (int st = 0; st < nst; st += 2) {
#pragma unroll
          for (int s2 = 0; s2 < 2; ++s2) {
            PG8_LAS bf16_t* As = (PG8_LAS bf16_t*)(lds + s2 * BUFB); PG8_LAS bf16_t* Bs = As + 128 * LS;
#pragma unroll
            for (int j = 0; j < 4; ++j) { *(PG8_LAS u32x4*)(As + lr * LS + (lp + j) * 8) = ra[s2][j]; *(PG8_LAS u32x4*)(Bs + lr * LS + (lp + j) * 8) = rb[s2][j]; }
            __syncthreads();
            if (st + 2 < nst) {
#pragma unroll
                for (int j = 0; j < 4; ++j) { ra[s2][j] = *(const u32x4*)(ga + 128 * (st + 2 + s2) + 8 * j); rb[s2][j] = *(const u32x4*)(gb + 128 * (st + 2 + s2) + 8 * j); } }
#pragma unroll
            for (int kc = 0; kc < 4; ++kc) {
                bf16x8 af[4], bfr[2];
#pragma unroll
                for (int m = 0; m < 4; ++m) af[m] = *(const PG8_LAS bf16x8*)(As + (64 * wr + 16 * m + fr) * LS + 32 * kc + 8 * fq);
#pragma unroll
                for (int n = 0; n < 2; ++n) bfr[n] = *(const PG8_LAS bf16x8*)(Bs + (32 * wc + 8 * (fr >> 2) + 4 * n + (fr & 3)) * LS + 32 * kc + 8 * fq);
#pragma unroll
                for (int m = 0; m < 4; ++m)
#pragma unroll
                    for (int n = 0; n < 2; ++n) acc[m][n] = __builtin_amdgcn_mfma_f32_16x16x32_bf16(bfr[n], af[m], acc[m][n], 0, 0, 0);
            }
          }
        }
        f32x4 accf[2][2][4][2];
#pragma unroll
        for (int a = 0; a < 2; ++a)
#pragma unroll
            for (int bq = 0; bq < 2; ++bq)
#pragma unroll
                for (int m = 0; m < 4; ++m)
#pragma unroll
                    for (int n = 0; n < 2; ++n) accf[a][bq][m][n] = (a == 0 && bq == 0) ? acc[m][n] : (f32x4){0.f, 0.f, 0.f, 0.f};
        Unit u; u.pm = 128 + (tm >> 1); u.pn = tn >> 1; u.rb = row_base + 128 * tm; u.half = 1; u.q = 1; u.cb = 128 * tn;
        E(accf, u, wr, wc, fr, fq);
        __syncthreads();
    }
}
}

#define LAS __attribute__((address_space(3)))
typedef unsigned short bf16;
typedef unsigned v4u __attribute__((ext_vector_type(4)));
typedef unsigned v2u __attribute__((ext_vector_type(2)));
typedef float f32x4 __attribute__((ext_vector_type(4)));
typedef short bf16x8 __attribute__((ext_vector_type(8)));

constexpr int NTHR = 512, NWAVES = 8;
constexpr int MP = 32768, MS = 1024, MT = MP + MS;
constexpr int D = 1024, DFF = 2816;
constexpr int LDS_BYTES = 147456;
constexpr float EPS = 1e-6f;

enum { I_XP = 0, I_XS, I_CPOOL, I_CSK, I_CSV, I_CMK, I_CMV, I_CFC, I_MEMP, I_LNMIX, I_LNMEM, I_LNMEMKV, I_LNFFN, I_ABWIN, I_ABVG, I_ABWS, I_ABBS, I_ABPW, I_ABPS, I_ABWOUT,
       I_CWQKV, I_CQG, I_CKG, I_CSINK, I_CWO, I_MWQ, I_MWKV, I_MQG, I_MKG, I_MWO, I_FWUP, I_FCW, I_FCB, I_FWDN, N_IN };
constexpr size_t O_YP = 0, O_YS = O_YP + (size_t)MP * D, O_POOLP = O_YS + (size_t)MS * D, O_POOLS = O_POOLP + 4 * 15 * 512, O_CHV = O_POOLS + 128 * 15 * 512,
                 O_SKP = O_CHV + 128 * 8 * 512, O_SVP = O_SKP + 4 * 128 * 256, O_SKS = O_SVP + 4 * 128 * 256, O_SVS = O_SKS + (size_t)128 * 128 * 256,
                 O_MKP = O_SVS + (size_t)128 * 128 * 256, O_MVP = O_MKP + 2 * 4 * 256 * 512, O_FCP = O_MVP + 2 * 4 * 256 * 512, O_FCS = O_FCP + 2 * 4 * 2 * DFF,
                 O_END = O_FCS + (size_t)2 * 128 * 2 * DFF;
constexpr size_t MiB = 1u << 20;
constexpr size_t W_WIN = 0, W_WOUT = W_WIN + 1536 * 1024 * 2, W_WQKV = W_WOUT + 1024 * 1024 * 2, W_CWO = W_WQKV + 1536 * 1024 * 2, W_LAYER = W_CWO + 1024 * 1024 * 2;
constexpr size_t WL_WQ = 0, WL_WKV = WL_WQ + 512 * 1024 * 2, WL_WO = WL_WKV + 1024 * 1024 * 2, WL_WUP = WL_WO + 1024 * 512 * 2, WL_WDN = WL_WUP + (size_t)2 * DFF * 1024 * 2,
                 WL_SIZE = WL_WDN + (size_t)1024 * DFF * 2;
constexpr size_t W_MN = W_LAYER + 2 * WL_SIZE;
constexpr size_t W_MKV = W_MN + 2 * 1024 * 1024 * 2;
constexpr size_t W_SS = W_MKV + 2 * 1024 * 1024 * 4;
constexpr size_t W_SMALL_END = W_SS + (size_t)6 * MT * 4;
static_assert(W_SMALL_END <= 72 * MiB, "weights region");
constexpr size_t W_XN = 72 * MiB;
constexpr size_t W_G = 138 * MiB;
constexpr size_t W_PROJ = W_G;
constexpr size_t W_AO = W_PROJ + 99 * MiB;
constexpr size_t W_H = 320 * MiB;
constexpr size_t W_KV32 = W_H;
constexpr size_t W_MQ = W_KV32 + 66 * MiB;
constexpr size_t W_MO = W_MQ + 33 * MiB;
constexpr size_t W_END = 502 * MiB;
constexpr size_t W_CTL = 504 * MiB, CTL_BYTES = 65536, W_NEED = W_CTL + CTL_BYTES;
constexpr int LDS_CTL_OFF = LDS_BYTES - 64;
static_assert(W_XN + (size_t)MT * 1024 * 2 <= W_G && W_PROJ + (size_t)MT * 1536 * 2 <= W_AO && W_AO + (size_t)MT * 1024 * 2 <= W_H && W_G + (size_t)MT * DFF * 2 <= W_H, "ws map 1");
static_assert(W_KV32 + (size_t)MT * 512 * 4 <= W_MQ && W_MQ + (size_t)MT * 512 * 2 <= W_MO && W_MO + (size_t)MT * 512 * 2 <= W_END && W_H + (size_t)MT * DFF * 2 <= W_END, "ws map 2");

struct Params { const float* in[N_IN]; float* out; unsigned char* ws; };

__device__ __forceinline__ unsigned pk2(float lo, float hi) { return pg8::cvt_pk_bf16(lo, hi); }
__device__ __forceinline__ unsigned f2bf(float f) { return pg8::cvt_pk_bf16(f, 0.f) & 0xffffu; }
__device__ __forceinline__ float bflo(unsigned w) { return __builtin_bit_cast(float, w << 16); }
__device__ __forceinline__ float bfhi(unsigned w) { return __builtin_bit_cast(float, w & 0xffff0000u); }
__device__ __forceinline__ float bf1(bf16 h) { return __builtin_bit_cast(float, (unsigned)h << 16); }
__device__ __forceinline__ void unpack8(const v4u w, float (&o)[8]) { o[0] = bflo(w.x); o[1] = bfhi(w.x); o[2] = bflo(w.y); o[3] = bfhi(w.y); o[4] = bflo(w.z); o[5] = bfhi(w.z); o[6] = bflo(w.w); o[7] = bfhi(w.w); }
__device__ __forceinline__ bf16x8 pack8(const float (&o)[8]) { v4u w; w.x = pk2(o[0], o[1]); w.y = pk2(o[2], o[3]); w.z = pk2(o[4], o[5]); w.w = pk2(o[6], o[7]); return __builtin_bit_cast(bf16x8, w); }
typedef short v4i16_t __attribute__((ext_vector_type(4)));
__device__ __forceinline__ v2u vtr(const LAS bf16* p) { return __builtin_bit_cast(v2u, __builtin_amdgcn_ds_read_tr16_b64_v4i16((LAS v4i16_t*)p)); }
__device__ __forceinline__ float wave_sum(float v) {
#pragma unroll
    for (int o = 1; o < 64; o <<= 1) v += __shfl_xor(v, o);
    return v;
}
__device__ __forceinline__ float gelu1(float v) { const pg8::f32x2 r = pg8::gelu_pk((pg8::f32x2){v, 0.f}); return r.x; }
__device__ __forceinline__ void rope_cs(float pos, int e, float& c, float& s) {
    const float inv = exp2f(-(float)e * (0.125f * 18.931568569324174f));
    const float ang = pos * inv;
    const float k = rintf(ang * 0.15915494309189535f);
    float r = fmaf(-k, 6.28125f, ang);
    r = fmaf(-k, 0.0019353071795864769f, r);
    s = __sinf(r); c = __cosf(r);
}

#define XB_TMO      128
#define XB_XCNT(j)  (256  + 64 * (j))
#define XB_XSUB(j)  (1280 + 64 * (j))
#define XB_XGEN(j)  (2304 + 64 * (j))
#define XB_TOP      3328
#define XB_TOPGEN   3392
#define XCD_BAR_WORDS 3456
#define XB_SPIN_CAP (1u << 18)

__device__ __forceinline__ unsigned xb_ld(unsigned* p)              { return __hip_atomic_load(p, __ATOMIC_RELAXED, __HIP_MEMORY_SCOPE_AGENT); }
__device__ __forceinline__ unsigned xb_add(unsigned* p, unsigned v) { return __hip_atomic_fetch_add(p, v, __ATOMIC_RELAXED, __HIP_MEMORY_SCOPE_AGENT); }
__device__ __forceinline__ unsigned xb_xcc_id() { return (unsigned)__builtin_amdgcn_s_getreg((3 << 11) | 20) & 0xFu; }
#define XB_SPIN(cond, bar) do { unsigned _sp = 0; while (cond) { __builtin_amdgcn_s_sleep(1); \
    if ((++_sp & 255u) == 0u) { if (xb_ld(&(bar)[XB_TMO])) break; if (_sp > XB_SPIN_CAP) { atomicAdd(&(bar)[XB_TMO], 1u); break; } } } } while (0)

struct XcdBarrier {
    unsigned* bar; unsigned x; int w0;
    volatile LAS unsigned* st;
};

__device__ __forceinline__ XcdBarrier xcd_barrier_post(unsigned* bar, volatile LAS unsigned* st) {
    XcdBarrier b; b.bar = bar; b.x = xb_xcc_id(); b.st = st; b.w0 = __builtin_amdgcn_readfirstlane((int)threadIdx.x >> 6);
    if (threadIdx.x == 0) (void)xb_add(&bar[XB_XCNT(b.x)], 1u);
    return b;
}
__device__ __forceinline__ void xcd_barrier_complete(unsigned* bar, unsigned x, unsigned& nloc, unsigned& nx) {
    const unsigned G = gridDim.x * gridDim.y * gridDim.z;
    unsigned sum, cnt, mine, sp = 0u;
    for (;;) {
        sum = 0u; cnt = 0u; mine = 0u;
#pragma unroll
        for (unsigned j = 0; j < 16; ++j) { const unsigned c = xb_ld(&bar[XB_XCNT(j)]); sum += c; cnt += (c > 0u) ? 1u : 0u; mine = (j == x) ? c : mine; }
        if (sum == G) break;
        __builtin_amdgcn_s_sleep(1);
        if ((++sp & 255u) == 0u) { if (xb_ld(&bar[XB_TMO])) break; if (sp > XB_SPIN_CAP) { atomicAdd(&bar[XB_TMO], 1u); break; } }
    }
    nloc = mine > 0u ? mine : 1u; nx = cnt > 0u ? cnt : 1u;
}

__device__ __forceinline__ void xcd_barrier(const XcdBarrier& b) {
    asm volatile("s_waitcnt vmcnt(0)" ::: "memory");
    __syncthreads();
    if (threadIdx.x == 0) {
        unsigned* bar = b.bar;
        __builtin_amdgcn_s_waitcnt(0);
        unsigned nloc = b.st[0], nx = b.st[1];
        if (nloc == 0u) { xcd_barrier_complete(bar, b.x, nloc, nx); b.st[0] = nloc; b.st[1] = nx; }
        const unsigned old = xb_add(&bar[XB_XSUB(b.x)], 1u);
        const unsigned gen = old / nloc;
        if (old + 1u == (gen + 1u) * nloc) {
            __builtin_amdgcn_fence(__ATOMIC_RELEASE, "agent");
            asm volatile("s_waitcnt vmcnt(0)" ::: "memory");
            const unsigned og = xb_add(&bar[XB_TOP], 1u);
            const unsigned tg = og / nx;
            if (og + 1u == (tg + 1u) * nx) xb_add(&bar[XB_TOPGEN], 1u);
            else XB_SPIN(xb_ld(&bar[XB_TOPGEN]) == tg, bar);
            __builtin_amdgcn_fence(__ATOMIC_ACQUIRE, "agent");
            xb_add(&bar[XB_XGEN(b.x)], 1u);
            asm volatile("s_waitcnt vmcnt(0)" ::: "memory");
        } else {
            XB_SPIN(xb_ld(&bar[XB_XGEN(b.x)]) == gen, bar);
            __builtin_amdgcn_fence(__ATOMIC_ACQUIRE, "agent");
            asm volatile("s_waitcnt vmcnt(0)" ::: "memory");
        }
    }
    __syncthreads();
}

__device__ __forceinline__ void transpose_item(const float* W, const float* gain, int ldn, int nblk, bf16* WT, int ldk, int koff, LAS float* scr, int item, int lane) {
    const int kb = item / nblk, nb = item % nblk, k0 = 64 * kb, n0 = 32 * nb;
    float wv[32];
#pragma unroll
    for (int i = 0; i < 32; ++i) wv[i] = W[(size_t)(k0 + 2 * i + (lane >> 5)) * ldn + n0 + (lane & 31)];
    if (gain) {
#pragma unroll
        for (int i = 0; i < 32; ++i) wv[i] *= gain[k0 + 2 * i + (lane >> 5)]; }
#pragma unroll
    for (int i = 0; i < 32; ++i) scr[(2 * i + (lane >> 5)) * 33 + (lane & 31)] = wv[i];
    asm volatile("s_waitcnt lgkmcnt(0)" ::: "memory");
    const int c = lane & 7;
#pragma unroll
    for (int j = 0; j < 4; ++j) { const int n = (lane >> 3) + 8 * j; const LAS float* s = scr + (8 * c) * 33 + n;
        v4u o; o.x = pk2(s[0 * 33], s[1 * 33]); o.y = pk2(s[2 * 33], s[3 * 33]); o.z = pk2(s[4 * 33], s[5 * 33]); o.w = pk2(s[6 * 33], s[7 * 33]);
        *(v4u*)(WT + (size_t)(n0 + n) * ldk + koff + k0 + 8 * c) = o; }
    asm volatile("s_waitcnt lgkmcnt(0)" ::: "memory");
}
__device__ __forceinline__ void rms_row(const float* xrow, const float* g, bf16* orow, int lane) {
    const f32x4* xr = (const f32x4*)xrow + lane; const f32x4* gr = (const f32x4*)g + lane;
    f32x4 v[4]; float s = 0.f;
#pragma unroll
    for (int j = 0; j < 4; ++j) { v[j] = xr[64 * j]; s += (v[j].x * v[j].x + v[j].y * v[j].y) + (v[j].z * v[j].z + v[j].w * v[j].w); }
    const float rs = rsqrtf(wave_sum(s) * (1.f / 1024.f) + EPS);
    unsigned long long* o8 = (unsigned long long*)orow + lane;
#pragma unroll
    for (int j = 0; j < 4; ++j) { const f32x4 gg = gr[64 * j];
        o8[64 * j] = (unsigned long long)pk2(v[j].x * rs * gg.x, v[j].y * rs * gg.y) | ((unsigned long long)pk2(v[j].z * rs * gg.z, v[j].w * rs * gg.w) << 32); }
}
__device__ __forceinline__ void xb_row(const float* xrow, bf16* orow, float* ss, int lane) {
    const f32x4* xr = (const f32x4*)xrow + lane;
    f32x4 v[4]; float s = 0.f;
#pragma unroll
    for (int j = 0; j < 4; ++j) { v[j] = xr[64 * j]; s += (v[j].x * v[j].x + v[j].y * v[j].y) + (v[j].z * v[j].z + v[j].w * v[j].w); }
    s = wave_sum(s);
    unsigned long long* o8 = (unsigned long long*)orow + lane;
#pragma unroll
    for (int j = 0; j < 4; ++j) o8[64 * j] = (unsigned long long)pk2(v[j].x, v[j].y) | ((unsigned long long)pk2(v[j].z, v[j].w) << 32);
    if (lane == 0) *ss = s;
}

struct TItem { const float* W; int ldn, nblk, nitems; bf16* WT; int ldk, koff; };

__device__ __forceinline__ void prologue(const Params& p, LAS unsigned char* lds, int gw, int ngw, int wave, int lane) {
    unsigned char* ws = p.ws;
    LAS float* scr = (LAS float*)(lds + wave * 16384);
#define TR(Wp, gn_, K_, N_, ldn_, dst_, ldk_, koff_) do { const int nblk_ = (N_) / 32, nit_ = ((K_) / 64) * nblk_; \
        for (int it = gw; it < nit_; it += ngw) transpose_item((Wp), (gn_), (ldn_), nblk_, (bf16*)(dst_), (ldk_), (koff_), scr, it, lane); } while (0)
    const float* nog = nullptr;
    TR(p.in[I_ABWIN], p.in[I_LNMIX], 1024, 1536, 1536, ws + W_WIN, 1024, 0);
    TR(p.in[I_ABWOUT], nog, 512, 1024, 1024, ws + W_WOUT, 1024, 0);
    TR(p.in[I_CWQKV], p.in[I_LNMIX] + D, 1024, 1536, 1536, ws + W_WQKV, 1024, 0);
    TR(p.in[I_CWO], nog, 1024, 1024, 1024, ws + W_CWO, 1024, 0);
#pragma unroll 1
    for (int l = 0; l < 2; ++l) {
        unsigned char* wl = ws + W_LAYER + l * WL_SIZE;
        TR(p.in[I_MWQ] + (size_t)l * 1024 * 512, p.in[I_LNMEM] + l * D, 1024, 512, 512, wl + WL_WQ, 1024, 0);
        TR(p.in[I_MWKV] + (size_t)l * 1024 * 1024, nog, 1024, 1024, 1024, wl + WL_WKV, 1024, 0);
        TR(p.in[I_MWO] + (size_t)l * 512 * 1024, nog, 512, 1024, 1024, wl + WL_WO, 512, 0);
        TR(p.in[I_FWUP] + (size_t)l * 1024 * 2 * DFF, p.in[I_LNFFN] + l * D, 1024, 2 * DFF, 2 * DFF, wl + WL_WUP, 1024, 0);
        TR(p.in[I_FWDN] + (size_t)l * DFF * 1024, nog, DFF, 1024, 1024, wl + WL_WDN, DFF, 0);
    }
#undef TR
    {
        const float* pw = p.in[I_ABPW]; const float* ps = p.in[I_ABPS]; const float* wo = p.in[I_ABWOUT] + (size_t)512 * 1024;
        bf16* WT = (bf16*)(ws + W_WOUT);
        const int gt = gw * 64 + lane, ngt = ngw * 64;
        for (int o = gt; o < 128 * 1024; o += ngt) {
            const int n = o & 1023, d = o >> 10;
            float a[4] = {0.f, 0.f, 0.f, 0.f};
#pragma unroll 4
            for (int e = 0; e < 128; ++e) {
#pragma unroll
                for (int g = 0; g < 4; ++g) a[g] += pw[((size_t)g * 128 + d) * 128 + e] * ps[g * 128 + e] * wo[((size_t)g * 128 + e) * 1024 + n]; }
#pragma unroll
            for (int g = 0; g < 4; ++g) WT[(size_t)n * 1024 + 512 + g * 128 + d] = (bf16)f2bf(a[g]); }
    }
    for (int m0 = gw * 4; m0 < MT; m0 += ngw * 4) {
        f32x4 v[4][4];
#pragma unroll
        for (int r = 0; r < 4; ++r) { const int m = m0 + r; const f32x4* xr = (const f32x4*)(m < MP ? p.in[I_XP] + (size_t)m * D : p.in[I_XS] + (size_t)(m - MP) * D) + lane;
#pragma unroll
            for (int j = 0; j < 4; ++j) v[r][j] = xr[64 * j]; }
#pragma unroll
        for (int r = 0; r < 4; ++r) { const int m = m0 + r; float sq = 0.f;
#pragma unroll
            for (int j = 0; j < 4; ++j) sq += (v[r][j].x * v[r][j].x + v[r][j].y * v[r][j].y) + (v[r][j].z * v[r][j].z + v[r][j].w * v[r][j].w);
            sq = wave_sum(sq);
            unsigned long long* o8 = (unsigned long long*)((bf16*)(ws + W_XN) + (size_t)m * D) + lane;
#pragma unroll
            for (int j = 0; j < 4; ++j) o8[64 * j] = (unsigned long long)pk2(v[r][j].x, v[r][j].y) | ((unsigned long long)pk2(v[r][j].z, v[r][j].w) << 32);
            if (lane == 0) ((float*)(ws + W_SS))[m] = sq; }
    }
    for (int o = gw * 64 + lane; o < 5 * MT; o += ngw * 64) ((float*)(ws + W_SS))[MT + o] = 0.f;
    for (int m = gw; m < 2048; m += ngw) { const int l = m >> 10, r = m & 1023;
        rms_row(p.in[I_MEMP] + (size_t)r * D, p.in[I_LNMEMKV] + l * D, (bf16*)(ws + W_MN) + (size_t)m * D, lane); }
}

constexpr int SG_VS = 520;
template <int W> __device__ __forceinline__ void pool_block(const float (&prev)[16], const float (&cur)[16], float (&o)[16], int t0, bool clampcnt) {
#pragma unroll
    for (int k = 0; k < 16; ++k) { float s = 0.f;
#pragma unroll
        for (int kk = 0; kk < W; ++kk) s += (k - kk >= 0) ? cur[(k - kk) & 15] : prev[(16 + k - kk) & 15];
        float inv = 1.f / (float)W;
        if (clampcnt) { const int t1 = t0 + k + 1; if (t1 < W) inv = __builtin_amdgcn_rcpf((float)t1); }
        o[k] = s * inv - cur[k]; }
}
__device__ __forceinline__ void pool_dispatch(int gi, const float (&prev)[16], const float (&cur)[16], float (&o)[16], int t0, bool clampcnt) {
    if (gi == 0) pool_block<2>(prev, cur, o, t0, clampcnt); else if (gi == 1) pool_block<4>(prev, cur, o, t0, clampcnt);
    else if (gi == 2) pool_block<8>(prev, cur, o, t0, clampcnt); else pool_block<16>(prev, cur, o, t0, clampcnt);
}

__device__ __forceinline__ void sgu_prompt_unit(const Params& p, LAS unsigned char* lds, int unit, int tid, int wave, int lane) {
    const bf16* PROJ = (const bf16*)(p.ws + W_PROJ); bf16* AO = (bf16*)(p.ws + W_AO);
    LAS bf16* Vn = (LAS bf16*)lds;
    const int b = unit >> 6, ch = unit & 63; const size_t r0 = (size_t)b * 8192 + ch * 128;
    {
        float gn[8]; pg8::ld8f(p.in[I_ABVG] + 8 * lane, gn);
        v4u raw[16];
#pragma unroll
        for (int jj = 0; jj < 16; ++jj) raw[jj] = *(const v4u*)(PROJ + (r0 + wave + 8 * jj) * 1536 + 512 + 8 * lane);
#pragma unroll
        for (int jj = 0; jj < 16; ++jj) { const int j = wave + 8 * jj;
            float x[8]; unpack8(raw[jj], x);
            float s = 0.f;
#pragma unroll
            for (int e = 0; e < 8; ++e) s += x[e];
            const float mean = wave_sum(s) * (1.f / 512.f); float q = 0.f;
#pragma unroll
            for (int e = 0; e < 8; ++e) { x[e] -= mean; q += x[e] * x[e]; }
            const float rstd = rsqrtf(wave_sum(q) * (1.f / 512.f) + EPS);
#pragma unroll
            for (int e = 0; e < 8; ++e) x[e] *= rstd * gn[e];
            *(LAS bf16x8*)(Vn + j * SG_VS + 8 * lane) = pack8(x); }
    }
    __syncthreads();
    {
        const int q16 = lane & 15, kq = lane >> 4, nch = (wave >> 1) + 1; int i = 16 * wave + q16;
#pragma unroll 1
        for (int g = 0; g < 4; ++g) {
            asm volatile("" : "+v"(i));
            f32x4 acc[8];
#pragma unroll
            for (int dt = 0; dt < 8; ++dt) acc[dt] = (f32x4){0.f, 0.f, 0.f, 0.f};
            const float* wsr = p.in[I_ABWS] + ((size_t)g * 128 + i) * 128;
            float wva[4][8]; v2u uu8[8];
#pragma unroll
            for (int c = 0; c < 4; ++c) pg8::ld8f(wsr + 32 * c + 8 * kq, wva[c]);
#pragma unroll
            for (int dt = 0; dt < 8; ++dt) uu8[dt] = *(const v2u*)(PROJ + (r0 + i) * 1536 + g * 128 + 16 * dt + 4 * kq);
#pragma unroll
            for (int c = 0; c < 4; ++c) if (c < nch) {
                float (&wv)[8] = wva[c];
#pragma unroll
                for (int e = 0; e < 8; ++e) if (32 * c + 8 * kq + e > i) wv[e] = 0.f;
                const bf16x8 bfrag = pack8(wv);
#pragma unroll
                for (int dt = 0; dt < 8; ++dt) { const LAS bf16* vp = Vn + (32 * c + 8 * kq + (q16 >> 2)) * SG_VS + g * 128 + 16 * dt + 4 * (q16 & 3);
                    const v2u lo = vtr(vp), hi = vtr(vp + 4 * SG_VS);
                    v4u av; av.x = lo.x; av.y = lo.y; av.z = hi.x; av.w = hi.y;
                    acc[dt] = __builtin_amdgcn_mfma_f32_16x16x32_bf16(__builtin_bit_cast(bf16x8, av), bfrag, acc[dt], 0, 0, 0); }
            }
            const float bs = p.in[I_ABBS][g * 128 + i];
#pragma unroll
            for (int dt = 0; dt < 8; ++dt) { const v2u uu = uu8[dt];
                const float o0 = bflo(uu.x) * (acc[dt][0] + bs), o1 = bfhi(uu.x) * (acc[dt][1] + bs), o2 = bflo(uu.y) * (acc[dt][2] + bs), o3 = bfhi(uu.y) * (acc[dt][3] + bs);
                v2u w; w.x = pk2(o0, o1); w.y = pk2(o2, o3);
                *(v2u*)(AO + (r0 + i) * 1024 + g * 128 + 16 * dt + 4 * kq) = w; }
        }
    }
    {
        const int c = tid, gi = c >> 7;
        const bf16* pp = PROJ + 1024 + c;
        float prev[16], cur[16], o[16];
#pragma unroll
        for (int k = 0; k < 16; ++k) prev[k] = (ch > 0) ? bf1(pp[(r0 - 16 + k) * 1536]) : 0.f;
        bf16 nxt[16];
#pragma unroll
        for (int k = 0; k < 16; ++k) nxt[k] = pp[(r0 + k) * 1536];
#pragma unroll 1
        for (int blk = 0; blk < 8; ++blk) {
#pragma unroll
            for (int k = 0; k < 16; ++k) cur[k] = bf1(nxt[k]);
            if (blk < 7) {
#pragma unroll
                for (int k = 0; k < 16; ++k) nxt[k] = pp[(r0 + 16 * (blk + 1) + k) * 1536]; }
            pool_dispatch(gi, prev, cur, o, ch * 128 + 16 * blk, ch == 0 && blk == 0);
#pragma unroll
            for (int k = 0; k < 16; ++k) AO[(r0 + 16 * blk + k) * 1024 + 512 + c] = (bf16)f2bf(o[k]);
            if (ch == 63 && blk == 7) {
#pragma unroll
                for (int k = 1; k < 16; ++k) p.out[O_POOLP + ((size_t)b * 15 + (k - 1)) * 512 + c] = cur[k]; }
#pragma unroll
            for (int k = 0; k < 16; ++k) prev[k] = cur[k];
        }
    }
    __syncthreads();
}

__device__ __forceinline__ void sgu_sample_unit(const Params& p, LAS unsigned char* lds, int b, int tid, int wave, int lane) {
    const bf16* PROJ = (const bf16*)(p.ws + W_PROJ); bf16* AO = (bf16*)(p.ws + W_AO);
    LAS float* red = (LAS float*)lds;
    const int c = tid, g = c >> 7; const size_t rs = (size_t)MP + 8 * b;
    float x[8], st[16];
#pragma unroll
    for (int j = 0; j < 8; ++j) { x[j] = bf1(PROJ[(rs + j) * 1536 + 512 + c]); st[j] = wave_sum(x[j]); st[8 + j] = wave_sum(x[j] * x[j]); }
    if (lane == 0) {
#pragma unroll
        for (int j = 0; j < 16; ++j) red[wave * 16 + j] = st[j]; }
    __syncthreads();
    float v[8]; const float gn = p.in[I_ABVG][c];
#pragma unroll
    for (int j = 0; j < 8; ++j) { float s = 0.f, q = 0.f;
#pragma unroll
        for (int w = 0; w < 8; ++w) { s += red[w * 16 + j]; q += red[w * 16 + 8 + j]; }
        const float mean = s * (1.f / 512.f), var = fmaxf(q * (1.f / 512.f) - mean * mean, 0.f);
        v[j] = (x[j] - mean) * rsqrtf(var + EPS) * gn;
        p.out[O_CHV + ((size_t)b * 8 + j) * 512 + c] = v[j]; }
    const float* wsg = p.in[I_ABWS] + (size_t)g * 128 * 128;
#pragma unroll
    for (int i = 0; i < 8; ++i) { float sg = p.in[I_ABBS][g * 128 + i];
#pragma unroll
        for (int j = 0; j < 8; ++j) if (j <= i) sg += wsg[i * 128 + j] * v[j];
        AO[(rs + i) * 1024 + c] = (bf16)f2bf(bf1(PROJ[(rs + i) * 1536 + c]) * sg); }
    float pe[24];
    pe[0] = 0.f;
#pragma unroll
    for (int k = 0; k < 15; ++k) pe[1 + k] = p.in[I_CPOOL][((size_t)b * 15 + k) * 512 + c];
#pragma unroll
    for (int i = 0; i < 8; ++i) pe[16 + i] = bf1(PROJ[(rs + i) * 1536 + 1024 + c]);
    const int W = 2 << g; const float invW = __builtin_amdgcn_rcpf((float)W);
#pragma unroll
    for (int i = 0; i < 8; ++i) { float s = 0.f;
#pragma unroll
        for (int kk = 0; kk < 16; ++kk) if (kk < W) s += pe[16 + i - kk];
        AO[(rs + i) * 1024 + 512 + c] = (bf16)f2bf(s * invW - pe[16 + i]); }
#pragma unroll
    for (int k = 0; k < 15; ++k) p.out[O_POOLS + ((size_t)b * 15 + k) * 512 + c] = pe[9 + k];
    __syncthreads();
}

constexpr int SWA_KS = 72, SWA_VS = 72, SWA_VOFF = 256 * SWA_KS * 2;
template <bool SAMPLE>
__device__ __forceinline__ void swa_unit(const Params& p, LAS unsigned char* lds, int unit, int tid, int wave, int lane) {
    const bf16* Q = (const bf16*)(p.ws + W_PROJ); const float* KV = (const float*)(p.ws + W_KV32); bf16* AO = (bf16*)(p.ws + W_AO);
    LAS bf16* Kl = (LAS bf16*)lds; LAS bf16* Vt = (LAS bf16*)(lds + SWA_VOFF);
    int b, kvh, nb;
    if (!SAMPLE) { nb = unit & 63; kvh = (unit >> 6) & 3; b = unit >> 8; } else { kvh = unit & 3; b = unit >> 2; nb = 0; }
    constexpr int NKEY = SAMPLE ? 160 : 256;
    {
        const int sub = tid & 7;
        float kg[8]; pg8::ld8f(p.in[I_CKG] + 8 * sub, kg);
        constexpr int NIT = SAMPLE ? 3 : 4;
        float kk[NIT][8], vv[NIT][8];
#pragma unroll
        for (int it = 0; it < NIT; ++it) { const int s = (tid >> 3) + 64 * it;
            const float* kp = nullptr; const float* vp = nullptr;
            if (!SAMPLE) { const int trel = (nb - 1) * 128 + s;
                if (trel >= 0) { kp = KV + ((size_t)b * 8192 + trel) * 512 + kvh * 64 + sub * 8; vp = kp + 256; } }
            else { if (s < 128) { const size_t o = (((size_t)b * 128 + s) * 4 + kvh) * 64 + sub * 8; kp = p.in[I_CSK] + o; vp = p.in[I_CSV] + o; }
                else if (s < 136) { kp = KV + ((size_t)MP + 8 * b + (s - 128)) * 512 + kvh * 64 + sub * 8; vp = kp + 256; } }
            if (kp) { pg8::ld8f(kp, kk[it]); pg8::ld8f(vp, vv[it]); } else { pg8::zero8(kk[it]); pg8::zero8(vv[it]); } }
#pragma unroll
        for (int it = 0; it < NIT; ++it) { const int s = (tid >> 3) + 64 * it;
            __builtin_amdgcn_sched_barrier(0);
            if (s < NKEY) {
            bool norm; float pos;
            if (!SAMPLE) { const int trel = (nb - 1) * 128 + s; norm = trel >= 0; pos = (float)trel; }
            else { norm = (s >= 128 && s < 136); pos = (float)(16384 + s - 128); }
            float (&k)[8] = kk[it]; float (&v)[8] = vv[it];
            asm volatile("" : "+v"(pos));
            if (norm) { float ss = 0.f;
#pragma unroll
                for (int e = 0; e < 8; ++e) ss += k[e] * k[e];
                ss += __shfl_xor(ss, 1); ss += __shfl_xor(ss, 2); ss += __shfl_xor(ss, 4);
                const float rs = rsqrtf(ss * (1.f / 64.f) + EPS);
#pragma unroll
                for (int e = 0; e < 8; ++e) k[e] *= rs * kg[e];
#pragma unroll
                for (int e = 0; e < 8; ++e) { const float pk = __shfl_xor(k[e], 1); float cs, sn; rope_cs(pos, e, cs, sn);
                    if (sub == 0) k[e] = k[e] * cs - pk * sn; else if (sub == 1) k[e] = k[e] * cs + pk * sn; }
            }
            *(LAS bf16x8*)(Kl + s * SWA_KS + sub * 8) = pack8(k);
            *(LAS bf16x8*)(Vt + s * SWA_VS + sub * 8) = pack8(v);
            if (!SAMPLE) { if (nb == 63 && s >= 128) { const size_t o = (((size_t)b * 128 + (s - 128)) * 4 + kvh) * 64 + sub * 8;
                    *(f32x4*)(p.out + O_SKP + o) = (f32x4){k[0], k[1], k[2], k[3]}; *(f32x4*)(p.out + O_SKP + o + 4) = (f32x4){k[4], k[5], k[6], k[7]};
                    *(f32x4*)(p.out + O_SVP + o) = (f32x4){v[0], v[1], v[2], v[3]}; *(f32x4*)(p.out + O_SVP + o + 4) = (f32x4){v[4], v[5], v[6], v[7]}; } }
            else { if (s >= 8 && s < 136) { const size_t o = (((size_t)b * 128 + (s - 8)) * 4 + kvh) * 64 + sub * 8;
                    *(f32x4*)(p.out + O_SKS + o) = (f32x4){k[0], k[1], k[2], k[3]}; *(f32x4*)(p.out + O_SKS + o + 4) = (f32x4){k[4], k[5], k[6], k[7]};
                    *(f32x4*)(p.out + O_SVS + o) = (f32x4){v[0], v[1], v[2], v[3]}; *(f32x4*)(p.out + O_SVS + o + 4) = (f32x4){v[4], v[5], v[6], v[7]}; } }
            }
        }
    }
    __syncthreads();
    constexpr int NPASS = SAMPLE ? 1 : 4;
    if (!SAMPLE || wave < 2) {
        asm volatile("" : "+v"(lane));
        float rc[8], rsn[8];
        { const int q16 = lane & 15; const float pos0 = SAMPLE ? (float)(16384 + (q16 & 7)) : (float)(nb * 128 + 16 * wave + q16);
#pragma unroll
          for (int e = 0; e < 8; ++e) rope_cs(pos0, e, rc[e], rsn[e]); }
        float qgs[2][8];
        {
#pragma unroll
          for (int dc = 0; dc < 2; ++dc) { pg8::ld8f(p.in[I_CQG] + 32 * dc + 8 * (lane >> 4), qgs[dc]);
#pragma unroll
            for (int e = 0; e < 8; ++e) qgs[dc][e] *= 0.125f; } }
        v4u qraw[2];
        { const int q16 = lane & 15, kq = lane >> 4;
          const size_t row0 = SAMPLE ? (size_t)MP + 8 * b + (q16 & 7) : (size_t)b * 8192 + nb * 128 + 16 * wave + q16;
          const int h0 = kvh * 4 + (SAMPLE ? 2 * wave + (q16 >> 3) : 0);
#pragma unroll
          for (int dc = 0; dc < 2; ++dc) qraw[dc] = *(const v4u*)(Q + row0 * 1024 + h0 * 64 + 32 * dc + 8 * kq); }
#pragma unroll 1
        for (int ps = 0; ps < NPASS; ++ps) {
            int q16 = lane & 15, kq = lane >> 4; asm volatile("" : "+v"(q16), "+v"(kq));
            int g, i, c0; size_t row; float pos;
            if (!SAMPLE) { g = ps; i = 16 * wave + q16; row = (size_t)b * 8192 + nb * 128 + i; pos = (float)(nb * 128 + i); c0 = wave >> 1; }
            else { g = 2 * wave + (q16 >> 3); i = q16 & 7; row = (size_t)MP + 8 * b + i; pos = (float)(16384 + i); c0 = 0; }
            const int h = kvh * 4 + g;
            float qv[2][8];
#pragma unroll
            for (int dc = 0; dc < 2; ++dc) unpack8(qraw[dc], qv[dc]);
            if (!SAMPLE && ps + 1 < NPASS) {
#pragma unroll
                for (int dc = 0; dc < 2; ++dc) qraw[dc] = *(const v4u*)(Q + row * 1024 + (h + 1) * 64 + 32 * dc + 8 * kq); }
            float ss = 0.f;
#pragma unroll
            for (int dc = 0; dc < 2; ++dc)
#pragma unroll
                for (int e = 0; e < 8; ++e) ss += qv[dc][e] * qv[dc][e];
            ss += __shfl_xor(ss, 16); ss += __shfl_xor(ss, 32);
            const float rs = rsqrtf(ss * (1.f / 64.f) + EPS);
#pragma unroll
            for (int dc = 0; dc < 2; ++dc) {
#pragma unroll
                for (int e = 0; e < 8; ++e) qv[dc][e] *= rs * qgs[dc][e]; }
#pragma unroll
            for (int e = 0; e < 8; ++e) { const float pk = __shfl_xor(qv[0][e], 16); const float cs = rc[e], sn = rsn[e];
                if (kq == 0) qv[0][e] = qv[0][e] * cs - pk * sn; else if (kq == 1) qv[0][e] = qv[0][e] * cs + pk * sn; }
            bf16x8 qf[2];
#pragma unroll
            for (int dc = 0; dc < 2; ++dc) qf[dc] = pack8(qv[dc]);
            f32x4 S[5][2];
            const float sink = p.in[I_CSINK][h];
            float mx = sink;
#pragma unroll
            for (int cc = 0; cc < 5; ++cc)
#pragma unroll
                for (int tt = 0; tt < 2; ++tt) { const int kb = 32 * (c0 + cc) + 16 * tt; f32x4 a = (f32x4){0.f, 0.f, 0.f, 0.f};
#pragma unroll
                    for (int dc = 0; dc < 2; ++dc) { const bf16x8 kf = *(const LAS bf16x8*)(Kl + (kb + q16) * SWA_KS + 32 * dc + 8 * kq);
                        a = __builtin_amdgcn_mfma_f32_16x16x32_bf16(kf, qf[dc], a, 0, 0, 0); }
                    const int rel = (kb >> 4) - wave;
                    const bool full = !SAMPLE && rel >= 1 && rel <= 7 && (nb > 0 || kb >= 128);
                    if (!full) {
#pragma unroll
                        for (int e = 0; e < 4; ++e) { const int s = kb + 4 * kq + e; const bool ok = (s > i) && (s <= i + 128) && (SAMPLE || nb > 0 || s >= 128);
                            a[e] = ok ? a[e] : -INFINITY; } }
#pragma unroll
                    for (int e = 0; e < 4; ++e) mx = fmaxf(mx, a[e]);
                    S[cc][tt] = a; }
            mx = fmaxf(mx, __shfl_xor(mx, 16)); mx = fmaxf(mx, __shfl_xor(mx, 32));
            float den = 0.f;
#pragma unroll
            for (int cc = 0; cc < 5; ++cc)
#pragma unroll
                for (int tt = 0; tt < 2; ++tt)
#pragma unroll
                    for (int e = 0; e < 4; ++e) { const float pe = __expf(S[cc][tt][e] - mx); S[cc][tt][e] = pe; den += pe; }
            den += __shfl_xor(den, 16); den += __shfl_xor(den, 32);
            den += __expf(sink - mx);
            const float rden = 1.f / den;
            bf16x8 pf[5];
#pragma unroll
            for (int cc = 0; cc < 5; ++cc) { float t8[8];
#pragma unroll
                for (int e = 0; e < 4; ++e) { t8[e] = S[cc][0][e]; t8[4 + e] = S[cc][1][e]; }
                pf[cc] = pack8(t8); }
#pragma unroll
            for (int dt = 0; dt < 4; ++dt) { f32x4 o = (f32x4){0.f, 0.f, 0.f, 0.f};
#pragma unroll
                for (int cc = 0; cc < 5; ++cc) { const LAS bf16* vp = Vt + (32 * (c0 + cc) + 4 * kq + (q16 >> 2)) * SWA_VS + 16 * dt + 4 * (q16 & 3);
                    const v2u lo = vtr(vp), hi = vtr(vp + 16 * SWA_VS);
                    v4u av; av.x = lo.x; av.y = lo.y; av.z = hi.x; av.w = hi.y;
                    o = __builtin_amdgcn_mfma_f32_16x16x32_bf16(__builtin_bit_cast(bf16x8, av), pf[cc], o, 0, 0, 0); }
                v2u w; w.x = pk2(o[0] * rden, o[1] * rden); w.y = pk2(o[2] * rden, o[3] * rden);
                *(v2u*)(AO + row * 1024 + h * 64 + 16 * dt + 4 * kq) = w; }
        }
    }
    __syncthreads();
}

constexpr int MEM_KS = 136, MEM_VS = 136, MEM_VOFF = 256 * MEM_KS * 2;
static_assert(MEM_VOFF + 256 * MEM_VS * 2 <= LDS_CTL_OFF && 128 * SG_VS * 2 <= LDS_CTL_OFF, "LDS");
template <bool SAMPLE>
__device__ __forceinline__ void mem_unit(const Params& p, int l, LAS unsigned char* lds, int unit, int tid, int wave, int lane) {
    const bf16* MQ = (const bf16*)(p.ws + W_MQ); bf16* MO = (bf16*)(p.ws + W_MO);
    LAS bf16* Kl = (LAS bf16*)lds; LAS bf16* Vt = (LAS bf16*)(lds + MEM_VOFF);
    int b, h, qt;
    if (!SAMPLE) { qt = unit & 15; h = (unit >> 4) & 3; b = unit >> 6; } else { h = unit & 3; b = unit >> 2; qt = 0; }
    {
        const int sub = tid & 15;
        float kg[8]; pg8::ld8f(p.in[I_MKG] + l * 128 + 8 * sub, kg);
#pragma unroll 1
        for (int hb = 0; hb < 2; ++hb) {
            float kk[4][8], vv[4][8];
#pragma unroll
            for (int it = 0; it < 4; ++it) { const int s = (tid >> 4) + 32 * (4 * hb + it);
                const float* kp; const float* vp;
                if (!SAMPLE) { kp = (const float*)(p.ws + W_MKV) + ((size_t)l * 1024 + b * 256 + s) * 1024 + h * 128 + sub * 8; vp = kp + 512; }
                else { const size_t o = ((((size_t)l * 128 + b) * 256 + s) * 4 + h) * 128 + sub * 8; kp = p.in[I_CMK] + o; vp = p.in[I_CMV] + o; }
                pg8::ld8f(kp, kk[it]); pg8::ld8f(vp, vv[it]); }
#pragma unroll
            for (int it = 0; it < 4; ++it) { const int s = (tid >> 4) + 32 * (4 * hb + it);
                float (&k)[8] = kk[it]; float (&v)[8] = vv[it];
                if (!SAMPLE) { float ss = 0.f;
#pragma unroll
                    for (int e = 0; e < 8; ++e) ss += k[e] * k[e];
                    ss += __shfl_xor(ss, 1); ss += __shfl_xor(ss, 2); ss += __shfl_xor(ss, 4); ss += __shfl_xor(ss, 8);
                    const float rs = rsqrtf(ss * (1.f / 128.f) + EPS);
#pragma unroll
                    for (int e = 0; e < 8; ++e) k[e] *= rs * kg[e];
                    if (qt == 0) { const size_t o = ((((size_t)l * 4 + b) * 256 + s) * 4 + h) * 128 + sub * 8;
                        *(f32x4*)(p.out + O_MKP + o) = (f32x4){k[0], k[1], k[2], k[3]}; *(f32x4*)(p.out + O_MKP + o + 4) = (f32x4){k[4], k[5], k[6], k[7]};
                        *(f32x4*)(p.out + O_MVP + o) = (f32x4){v[0], v[1], v[2], v[3]}; *(f32x4*)(p.out + O_MVP + o + 4) = (f32x4){v[4], v[5], v[6], v[7]}; }
                }
                *(LAS bf16x8*)(Kl + s * MEM_KS + sub * 8) = pack8(k);
                *(LAS bf16x8*)(Vt + s * MEM_VS + sub * 8) = pack8(v);
            }
        }
    }
    __syncthreads();
    if (!SAMPLE || wave == 0) {
#pragma unroll 1
      for (int qq = 0; qq < (SAMPLE ? 1 : 4); ++qq) {
        int q16 = lane & 15, kq = lane >> 4; asm volatile("" : "+v"(q16), "+v"(kq));
        size_t row; bool st;
        if (!SAMPLE) { row = (size_t)b * 8192 + (qt * 4 + qq) * 128 + 16 * wave + q16; st = true; } else { row = (size_t)MP + 8 * b + (q16 & 7); st = q16 < 8; }
        bf16x8 qf[4];
        {
            float qv[4][8]; float ss = 0.f;
#pragma unroll
            for (int dc = 0; dc < 4; ++dc) { unpack8(*(const v4u*)(MQ + row * 512 + h * 128 + 32 * dc + 8 * kq), qv[dc]);
#pragma unroll
                for (int e = 0; e < 8; ++e) ss += qv[dc][e] * qv[dc][e]; }
            ss += __shfl_xor(ss, 16); ss += __shfl_xor(ss, 32);
            const float rs = rsqrtf(ss * (1.f / 128.f) + EPS) * 0.08838834764831845f;
#pragma unroll
            for (int dc = 0; dc < 4; ++dc) { float qg[8]; pg8::ld8f(p.in[I_MQG] + l * 128 + 32 * dc + 8 * kq, qg);
#pragma unroll
                for (int e = 0; e < 8; ++e) qv[dc][e] *= rs * qg[e];
                qf[dc] = pack8(qv[dc]); }
        }
        f32x4 S[8][2]; float mx = -INFINITY;
#pragma unroll
        for (int cc = 0; cc < 8; ++cc)
#pragma unroll
            for (int tt = 0; tt < 2; ++tt) { const int kb = 32 * cc + 16 * tt; f32x4 a = (f32x4){0.f, 0.f, 0.f, 0.f};
#pragma unroll
                for (int dc = 0; dc < 4; ++dc) { const bf16x8 kf = *(const LAS bf16x8*)(Kl + (kb + q16) * MEM_KS + 32 * dc + 8 * kq);
                    a = __builtin_amdgcn_mfma_f32_16x16x32_bf16(kf, qf[dc], a, 0, 0, 0); }
#pragma unroll
                for (int e = 0; e < 4; ++e) mx = fmaxf(mx, a[e]);
                S[cc][tt] = a; }
        mx = fmaxf(mx, __shfl_xor(mx, 16)); mx = fmaxf(mx, __shfl_xor(mx, 32));
        float den = 0.f;
#pragma unroll
        for (int cc = 0; cc < 8; ++cc)
#pragma unroll
            for (int tt = 0; tt < 2; ++tt)
#pragma unroll
                for (int e = 0; e < 4; ++e) { const float pe = __expf(S[cc][tt][e] - mx); S[cc][tt][e] = pe; den += pe; }
        den += __shfl_xor(den, 16); den += __shfl_xor(den, 32);
        const float rden = 1.f / den;
        bf16x8 pf[8];
#pragma unroll
        for (int cc = 0; cc < 8; ++cc) { float t8[8];
#pragma unroll
            for (int e = 0; e < 4; ++e) { t8[e] = S[cc][0][e]; t8[4 + e] = S[cc][1][e]; }
            pf[cc] = pack8(t8); }
#pragma unroll
        for (int dt = 0; dt < 8; ++dt) { f32x4 o = (f32x4){0.f, 0.f, 0.f, 0.f};
#pragma unroll
            for (int cc = 0; cc < 8; ++cc) { const LAS bf16* vp = Vt + (32 * cc + 4 * kq + (q16 >> 2)) * MEM_VS + 16 * dt + 4 * (q16 & 3);
                const v2u lo = vtr(vp), hi = vtr(vp + 16 * MEM_VS);
                v4u av; av.x = lo.x; av.y = lo.y; av.z = hi.x; av.w = hi.y;
                o = __builtin_amdgcn_mfma_f32_16x16x32_bf16(__builtin_bit_cast(bf16x8, av), pf[cc], o, 0, 0, 0); }
            if (st) { v2u w; w.x = pk2(o[0] * rden, o[1] * rden); w.y = pk2(o[2] * rden, o[3] * rden);
                *(v2u*)(MO + row * 512 + h * 128 + 16 * dt + 4 * kq) = w; } }
      }
    }
    __syncthreads();
}

#ifndef REP_LIGHT
#define REP_LIGHT 1
#endif
#ifndef REP_G9
#define REP_G9 1
#endif
#ifndef REP_G10
#define REP_G10 1
#endif
#ifndef REP_PRO
#define REP_PRO 1
#endif
#ifndef REP_MEM
#define REP_MEM 1
#endif
#ifndef REP_P15
#define REP_P15 1
#endif
#ifndef REP_SYNC
#define REP_SYNC 1
#endif
#define GSYNC() do { for (int r_ = 0; r_ < REP_SYNC; ++r_) xcd_barrier(xbar); } while (0)
#define PHASE_IDS int t_ = threadIdx.x; asm volatile("" : "+v"(t_)); const int tid = t_, lane = tid & 63, wave = __builtin_amdgcn_readfirstlane(tid >> 6); const int gw = bx * NWAVES + wave; (void)gw; (void)lane; (void)tid;
__global__ void __launch_bounds__(NTHR, 2) fwd_megakernel(Params p) {
    extern __shared__ __attribute__((aligned(16))) unsigned char lds_raw[];
    LAS unsigned char* lds = (LAS unsigned char*)lds_raw;
    cg::grid_group grid = cg::this_grid();
    const int G = gridDim.x, bx = blockIdx.x;
    const int wave0 = __builtin_amdgcn_readfirstlane((int)threadIdx.x >> 6);
    const int ngw = G * NWAVES;
    unsigned char* ws = p.ws;
    bf16* XN = (bf16*)(ws + W_XN);
    float* SSb = (float*)(ws + W_SS);
    float* X = p.out;
    typedef pg8::bf16_t pb;

    if (threadIdx.x < 16) ((LAS unsigned*)(lds + LDS_CTL_OFF))[threadIdx.x] = 0u;
    __syncthreads();
    const XcdBarrier xbar = xcd_barrier_post((unsigned*)(ws + W_CTL), (volatile LAS unsigned*)(lds + LDS_CTL_OFF));
    for (int rep = 0; rep < REP_LIGHT * REP_PRO; ++rep) { PHASE_IDS prologue(p, lds, gw, ngw, wave, lane); }
    grid.sync();

    auto layer_body = [&](auto LC) __attribute__((always_inline)) {
        constexpr int l = decltype(LC)::value;
        unsigned char* wl = ws + W_LAYER + (size_t)l * WL_SIZE;
        if (l == 0) {
            { pg8::Gemm g{(const pb*)XN, (const pb*)(ws + W_WIN), MT, 1536, 1024}; pg8::StaticOrder S; S.init(MP, 1536, G, bx);
              pg8::EpiAct E{(pb*)(ws + W_PROJ), 1536, 4, SSb};
              pg8::gemm_phase<pg8::EpiAct, pg8::StaticOrder, true, true>(lds, g, S, E, wave0);
              pg8::mini_gemm(lds, g.A, g.Bt, 1024, 12, E, bx, G, wave0); }
#pragma unroll 1
            for (int ll = 0; ll < 2; ++ll) {
              pg8::EpiRes E{(float*)(ws + W_MKV) + (size_t)ll * 1024 * 1024, nullptr, nullptr, 0, nullptr, nullptr, 0};
              pg8::mini_gemm(lds, (const pb*)(ws + W_MN) + (size_t)ll * 1024 * 1024, (const pb*)(ws + W_LAYER + (size_t)ll * WL_SIZE + WL_WKV), 1024, 8, E, (bx + G - 96 - 64 * ll) % G, G, wave0, 0); }
        } else {
            pg8::Gemm g{(const pb*)XN, (const pb*)(ws + W_WQKV), MT, 1536, 1024}; pg8::StaticOrder S; S.init(MP, 1536, G, bx);
            pg8::EpiQKV E{(pb*)(ws + W_PROJ), (float*)(ws + W_KV32), SSb + (size_t)3 * MT};
            pg8::gemm_phase<pg8::EpiQKV, pg8::StaticOrder, true, true>(lds, g, S, E, wave0);
            pg8::mini_gemm(lds, g.A, g.Bt, 1024, 12, E, bx, G, wave0);
        }
        GSYNC();
        if (l == 0) {
#ifndef NO_SGU
            PHASE_IDS
            for (int rep = 0; rep < REP_LIGHT; ++rep)
            for (int u = bx; u < 256 + 128; u += G) { if (u < 256) sgu_prompt_unit(p, lds, u, tid, wave, lane); else sgu_sample_unit(p, lds, u - 256, tid, wave, lane); }
#endif
        } else {
#ifndef NO_SWA
            PHASE_IDS
            for (int rep = 0; rep < REP_LIGHT; ++rep)
            for (int u = bx; u < 1024 + 512; u += G) { if (u < 1024) swa_unit<false>(p, lds, u, tid, wave, lane); else swa_unit<true>(p, lds, u - 1024, tid, wave, lane); }
#endif
        }
        GSYNC();
        {
            pg8::Gemm g{(const pb*)(ws + W_AO), (const pb*)(ws + (l == 0 ? W_WOUT : W_CWO)), MT, 1024, 1024}; pg8::StaticOrder S; S.init(MP, 1024, G, bx);
            pg8::EpiRes E{nullptr, nullptr, nullptr, 1, (pb*)XN, SSb + (size_t)(1 + 3 * l) * MT, 1};
            pg8::gemm_phase<pg8::EpiRes, pg8::StaticOrder, true, true>(lds, g, S, E, wave0);
            pg8::mini_gemm(lds, g.A, g.Bt, 1024, 8, E, bx, G, wave0);
        }
        GSYNC();
        {
            pg8::Gemm g{(const pb*)XN, (const pb*)(wl + WL_WQ), MT, 512, 1024}; pg8::StaticOrder S; S.init(MP, 512, G, bx);
            pg8::EpiAct E{(pb*)(ws + W_MQ), 512, 0, SSb + (size_t)(1 + 3 * l) * MT};
            pg8::gemm_phase<pg8::EpiAct, pg8::StaticOrder, true, true>(lds, g, S, E, wave0);
            pg8::mini_gemm(lds, g.A, g.Bt, 1024, 4, E, bx, G, wave0);
        }
        GSYNC();
#ifndef NO_MEM
        { PHASE_IDS
        for (int rep = 0; rep < REP_LIGHT * REP_MEM; ++rep)
        for (int u = bx; u < 256 + 512; u += G) { if (u < 256) mem_unit<false>(p, l, lds, u, tid, wave, lane); else mem_unit<true>(p, l, lds, u - 256, tid, wave, lane); } }
#endif
        GSYNC();
        {
            pg8::Gemm g{(const pb*)(ws + W_MO), (const pb*)(wl + WL_WO), MT, 1024, 512}; pg8::StaticOrder S; S.init(MP, 1024, G, bx);
            pg8::EpiRes E{nullptr, nullptr, nullptr, 1, (pb*)XN, SSb + (size_t)(2 + 3 * l) * MT, 1};
            pg8::gemm_phase<pg8::EpiRes, pg8::StaticOrder, true, true>(lds, g, S, E, wave0);
            pg8::mini_gemm(lds, g.A, g.Bt, 512, 8, E, bx, G, wave0);
        }
        GSYNC();
        {
            pg8::Gemm g{(const pb*)XN, (const pb*)(wl + WL_WUP), MT, DFF, 1024}; pg8::SplitOrder S; S.init(DFF, G, bx);
            pg8::EpiG E{(pb*)(ws + W_G), p.out + O_FCP + (size_t)l * 4 * 2 * DFF, p.out + O_FCS + (size_t)l * 128 * 2 * DFF, SSb + (size_t)(2 + 3 * l) * MT};
            for (int rep = 0; rep < REP_G9; ++rep) pg8::gemm_phase<pg8::EpiG, pg8::SplitOrder, true, true>(lds, g, S, E, wave0);
        }
        GSYNC();
        {
            pg8::Gemm g{(const pb*)XN, (const pb*)(wl + WL_WUP) + (size_t)DFF * 1024, MT, DFF, 1024}; pg8::SplitOrder S; S.init(DFF, G, bx);
            pg8::EpiH E{(const pb*)(ws + W_G), (pb*)(ws + W_H), p.in[I_FCW] + (size_t)l * 3 * DFF, p.in[I_FCB] + (size_t)l * DFF, p.in[I_CFC] + (size_t)l * 128 * 2 * DFF, SSb + (size_t)(2 + 3 * l) * MT};
            for (int rep = 0; rep < REP_G10; ++rep) pg8::gemm_phase<pg8::EpiH, pg8::SplitOrder, true, true>(lds, g, S, E, wave0);
        }
        GSYNC();
        {
            pg8::Gemm g{(const pb*)(ws + W_H), (const pb*)(wl + WL_WDN), MT, 1024, DFF}; pg8::StaticOrder S; S.init(MP, 1024, G, bx);
            pg8::EpiRes E{l == 0 ? nullptr : X, nullptr, nullptr, 1, (pb*)XN, SSb + (size_t)3 * MT, l == 0};
            pg8::gemm_phase<pg8::EpiRes, pg8::StaticOrder, true, true>(lds, g, S, E, wave0);
            pg8::mini_gemm(lds, g.A, g.Bt, DFF, 8, E, bx, G, wave0);
        }
        GSYNC();
    };
    layer_body(std::integral_constant<int, 0>{});
    layer_body(std::integral_constant<int, 1>{});
}

extern "C" void kernel_launch(void* const* d_in, const int* in_sizes, int n_in, void* d_out, int out_size, void* d_ws, size_t ws_size, hipStream_t stream) {
    static int grid_blocks = 0;
    if (grid_blocks == 0) {
        if (n_in != N_IN || (size_t)out_size != O_END || ws_size < W_NEED) { fprintf(stderr, "kernel_launch: unexpected shapes: n_in %d out %d ws %zu (need %zu)\n", n_in, out_size, ws_size, (size_t)W_NEED); grid_blocks = -1; return; }
        int dev = 0, cus = 0, per_cu = 0;
        hipGetDevice(&dev);
        hipDeviceGetAttribute(&cus, hipDeviceAttributeMultiprocessorCount, dev);
        if (hipFuncSetAttribute((const void*)fwd_megakernel, hipFuncAttributeMaxDynamicSharedMemorySize, LDS_BYTES) != hipSuccess) { fprintf(stderr, "kernel_launch: hipFuncSetAttribute failed\n"); grid_blocks = -1; return; }
        if (hipOccupancyMaxActiveBlocksPerMultiprocessor(&per_cu, (const void*)fwd_megakernel, NTHR, LDS_BYTES) != hipSuccess || per_cu < 1) { fprintf(stderr, "kernel_launch: occupancy query failed (%d)\n", per_cu); (void)hipGetLastError(); grid_blocks = -1; return; }
        grid_blocks = cus * per_cu;
    }
    if (grid_blocks < 0) return;
    if (hipMemsetAsync((char*)d_ws + W_CTL, 0, CTL_BYTES, stream) != hipSuccess) { fprintf(stderr, "kernel_launch: memset failed\n"); return; }
    Params p{};
    for (int i = 0; i < N_IN; ++i) p.in[i] = (const float*)d_in[i];
    p.out = (float*)d_out; p.ws = (unsigned char*)d_ws;
    void* args[] = {&p};
    hipError_t e = hipLaunchCooperativeKernel((const void*)fwd_megakernel, dim3(grid_blocks), dim3(NTHR), args, LDS_BYTES, stream);
    if (e != hipSuccess) fprintf(stderr, "cooperative launch failed: %s (grid %d)\n", hipGetErrorString(e), grid_blocks);
}
```

```cpp
#include <hip/hip_runtime.h>
#include <hip/hip_cooperative_groups.h>
#include <cstdio>
#include <cstdint>
#include <type_traits>
namespace cg = cooperative_groups;
namespace pg8 {
#define PG8_LAS __attribute__((address_space(3)))
typedef unsigned short bf16_t;
typedef short bf16x8 __attribute__((ext_vector_type(8)));
typedef float f32x4 __attribute__((ext_vector_type(4)));
typedef unsigned u32x4 __attribute__((ext_vector_type(4)));
constexpr int BM = 256, BK = 64, HALF = 128, HTB = HALF * BK * 2  , STAGE_BYTES = 8 * HTB, NXCD = 8, WGM = 8;

__host__ __device__ __forceinline__ int lds_byte(int r, int c) { const int st = (r >> 4) * 2 + (c >> 5), rr = r & 15, cc = c & 31, ob = rr * 64 + cc * 2; return st * 1024 + (ob ^ (((ob >> 9) & 1) << 5)); }
__host__ __device__ __forceinline__ void stage_rc(int b, int& R, int& C) { const int st = b / 1024, sb = b % 1024, swz = sb ^ (((sb >> 9) & 1) << 5); R = (st >> 1) * 16 + swz / 64; C = (st & 1) * 32 + (swz % 64) / 2; }
__host__ __device__ __forceinline__ int perm32(int rho) { const int n = rho >> 4, i = rho & 15; return 8 * (i >> 2) + 4 * n + (i & 3); }

struct Unit { int pm, pn; int rb; int half; int q; int cb; };
struct Gemm { const bf16_t* A; const bf16_t* Bt; int M, N, K; };

struct StaticOrder {
    int nM, nN, nwg, G, c;
    __host__ __device__ void init(int M, int N, int G_, int c_) { nM = M / BM; nN = N / BM; nwg = nM * nN; G = G_; c = c_; }
    __host__ __device__ bool next(int i, Unit& u) const {
        const long L = (long)i * G + c; if (L >= nwg) return false;
        int wgid = (int)L; { const int q = nwg / NXCD, r = nwg % NXCD, xcd = wgid % NXCD, off = wgid / NXCD; wgid = (xcd < r ? xcd * (q + 1) : r * (q + 1) + (xcd - r) * q) + off; }
        const int nig = WGM * nN, gid = wgid / nig, fm = gid * WGM, gsz = (nM - fm) < WGM ? (nM - fm) : WGM;
        u.pm = fm + ((wgid % nig) % gsz); u.pn = (wgid % nig) / gsz; u.rb = u.pm * BM; u.half = 0; u.q = 0; u.cb = u.pn * BM; return true;
    }
    __device__ __forceinline__ void a_ready(const Unit&) const {}
    __device__ __forceinline__ void done(const Unit&) const {}
};
struct SplitOrder {
    StaticOrder P; int nP, nS, nN, G, c;
    __host__ __device__ void init(int N, int G_, int c_) { P.init(32768, N, G_, c_); nP = P.nwg; nN = N / BM; nS = 8 * nN; G = G_; c = c_; }
    __host__ __device__ bool next(int i, Unit& u) const {
        const long L = (long)i * G + c;
        if (L < nP) return P.next(i, u);
        const int j = (int)(L - nP); if (j >= nS) return false;
        const int hm = j & 7; u.pn = j >> 3; u.pm = 128 + (hm >> 1); u.rb = 32768 + 128 * hm; u.half = 1; u.q = 0; u.cb = u.pn * BM; return true;
    }
    __device__ __forceinline__ void a_ready(const Unit&) const {}
    __device__ __forceinline__ void done(const Unit&) const {}
};


__device__ __forceinline__ unsigned cvt_pk_bf16(float lo, float hi) { unsigned r; asm volatile("v_cvt_pk_bf16_f32 %0, %1, %2" : "=v"(r) : "v"(lo), "v"(hi)); return r; }
typedef float f32x2 __attribute__((ext_vector_type(2)));
__device__ __forceinline__ f32x2 gelu_pk(f32x2 v) {
    f32x2 x = v * 0.70710678118f;
    x.x = __builtin_amdgcn_fmed3f(x.x, -2.9f, 2.9f); x.y = __builtin_amdgcn_fmed3f(x.y, -2.9f, 2.9f);
    const f32x2 t = x * x;
    f32x2 p = t * (-4.953124630e-07f) + 1.987094038e-05f;
    p = p * t + (-3.472001117e-04f); p = p * t + 3.517547622e-03f; p = p * t + (-2.333305031e-02f); p = p * t + 1.087993085e-01f; p = p * t + (-3.740358949e-01f); p = p * t + 1.128076553e+00f;
    const f32x2 hv = v * 0.5f;
    return hv * (x * p) + hv;
}

__device__ __forceinline__ float bf_lo(unsigned w) { return __builtin_bit_cast(float, w << 16); }
__device__ __forceinline__ float bf_hi(unsigned w) { return __builtin_bit_cast(float, w & 0xffff0000u); }
__device__ __forceinline__ void ld8bf(const bf16_t* p, float (&o)[8]) { const u32x4 w = *(const u32x4*)p;
    o[0] = bf_lo(w.x); o[1] = bf_hi(w.x); o[2] = bf_lo(w.y); o[3] = bf_hi(w.y); o[4] = bf_lo(w.z); o[5] = bf_hi(w.z); o[6] = bf_lo(w.w); o[7] = bf_hi(w.w); }
__device__ __forceinline__ void ld8f(const float* p, float (&o)[8]) { const f32x4 a = *(const f32x4*)p, b = *(const f32x4*)(p + 4);
    o[0] = a[0]; o[1] = a[1]; o[2] = a[2]; o[3] = a[3]; o[4] = b[0]; o[5] = b[1]; o[6] = b[2]; o[7] = b[3]; }
__device__ __forceinline__ void ld8f_nt(const float* p, float (&o)[8]) { const f32x4 a = __builtin_nontemporal_load((const f32x4*)p), b = __builtin_nontemporal_load((const f32x4*)(p + 4));
    o[0] = a[0]; o[1] = a[1]; o[2] = a[2]; o[3] = a[3]; o[4] = b[0]; o[5] = b[1]; o[6] = b[2]; o[7] = b[3]; }
__device__ __forceinline__ void zero8(float (&o)[8]) {
#pragma unroll
    for (int j = 0; j < 8; ++j) o[j] = 0.f; }

struct EpiAct {
    static constexpr bool PERM = true, AFTER_DRAIN = false;
    bf16_t* O; int ldc; int gelu_tiles; const float* SS;
    __device__ __forceinline__ void operator()(const f32x4 (&acc)[2][2][4][2], const Unit& u, int wr, int wc, int fr, int fq) const {
        asm volatile("" : "+v"(fr), "+v"(fq));
        const int row0 = u.rb + wr * 64 + fr, col0 = u.cb + wc * 32 + 8 * fq;
        const bool act = u.pn < gelu_tiles;
        float rsv[2][4];
#pragma unroll
        for (int ai = 0; ai < 2; ++ai)
#pragma unroll
            for (int m = 0; m < 4; ++m) rsv[ai][m] = SS[row0 + (u.half ? 0 : ai * HALF) + m * 16];
#pragma unroll
        for (int ai = 0; ai < 2; ++ai) if (ai == 0 || !u.half)
#pragma unroll
            for (int m = 0; m < 4; ++m) { bf16_t* rowp = O + (size_t)(row0 + ai * HALF + m * 16) * ldc + col0;
                const float rs = rsqrtf(rsv[ai][m] * (1.f / 1024.f) + 1e-6f);
#pragma unroll
                for (int bj = 0; bj < 2; ++bj) if (bj == 0 || !u.q) { f32x4 v0 = acc[ai][bj][m][0] * rs, v1 = acc[ai][bj][m][1] * rs;
                    if (act) { f32x2 a = gelu_pk((f32x2){v0[0], v0[1]}), b = gelu_pk((f32x2){v0[2], v0[3]}), c = gelu_pk((f32x2){v1[0], v1[1]}), d = gelu_pk((f32x2){v1[2], v1[3]});
                        v0 = (f32x4){a.x, a.y, b.x, b.y}; v1 = (f32x4){c.x, c.y, d.x, d.y}; }
                    u32x4 w; w.x = cvt_pk_bf16(v0[0], v0[1]); w.y = cvt_pk_bf16(v0[2], v0[3]); w.z = cvt_pk_bf16(v1[0], v1[1]); w.w = cvt_pk_bf16(v1[2], v1[3]);
                    *(u32x4*)(rowp + bj * HALF) = w; } }
    }
};

struct EpiQKV {
    static constexpr bool PERM = true, AFTER_DRAIN = false;
    bf16_t* Q; float* KV; const float* SS;
    __device__ __forceinline__ void operator()(const f32x4 (&acc)[2][2][4][2], const Unit& u, int wr, int wc, int fr, int fq) const {
        asm volatile("" : "+v"(fr), "+v"(fq));
        const int row0 = u.rb + wr * 64 + fr;
        float rs[2][4];
#pragma unroll
        for (int ai = 0; ai < 2; ++ai) if (ai == 0 || !u.half)
#pragma unroll
            for (int m = 0; m < 4; ++m) rs[ai][m] = rsqrtf(SS[row0 + (u.half ? 0 : ai * HALF) + m * 16] * (1.f / 1024.f) + 1e-6f);
        if (u.pn < 4) {
            const int col0 = u.cb + wc * 32 + 8 * fq;
#pragma unroll
            for (int ai = 0; ai < 2; ++ai) if (ai == 0 || !u.half)
#pragma unroll
                for (int m = 0; m < 4; ++m) { bf16_t* rowp = Q + (size_t)(row0 + ai * HALF + m * 16) * 1024 + col0;
#pragma unroll
                    for (int bj = 0; bj < 2; ++bj) if (bj == 0 || !u.q) { const f32x4 v0 = acc[ai][bj][m][0] * rs[ai][m], v1 = acc[ai][bj][m][1] * rs[ai][m];
                        u32x4 w; w.x = cvt_pk_bf16(v0[0], v0[1]); w.y = cvt_pk_bf16(v0[2], v0[3]); w.z = cvt_pk_bf16(v1[0], v1[1]); w.w = cvt_pk_bf16(v1[2], v1[3]);
                        *(u32x4*)(rowp + bj * HALF) = w; } }
        } else {
            const int col0 = (u.cb - 1024) + wc * 32 + 8 * fq;
#pragma unroll
            for (int ai = 0; ai < 2; ++ai) if (ai == 0 || !u.half)
#pragma unroll
                for (int m = 0; m < 4; ++m) { float* rowp = KV + (size_t)(row0 + ai * HALF + m * 16) * 512 + col0;
#pragma unroll
                    for (int bj = 0; bj < 2; ++bj) if (bj == 0 || !u.q) { *(f32x4*)(rowp + bj * HALF) = acc[ai][bj][m][0] * rs[ai][m]; *(f32x4*)(rowp + bj * HALF + 4) = acc[ai][bj][m][1] * rs[ai][m]; } }
        }
    }
};

struct EpiRes {
    static constexpr bool PERM = true, AFTER_DRAIN = false;
    float* C; const float* resP; const float* resS; int inplace; bf16_t* XB0; float* SS; int wxb;
    static constexpr int ldc = 1024, split = 32768;
    __device__ __forceinline__ void row_out(const f32x4 v0, const f32x4 v1, int row, int col, float& ss) const {
        if (C) { float* rowp = C + (size_t)row * ldc + col; __builtin_nontemporal_store(v0, (f32x4*)rowp); __builtin_nontemporal_store(v1, (f32x4*)(rowp + 4)); }
        if (wxb) { u32x4 w; w.x = cvt_pk_bf16(v0[0], v0[1]); w.y = cvt_pk_bf16(v0[2], v0[3]); w.z = cvt_pk_bf16(v1[0], v1[1]); w.w = cvt_pk_bf16(v1[2], v1[3]);
            *(u32x4*)(XB0 + (size_t)row * ldc + col) = w;
            ss += (v0[0] * v0[0] + v0[1] * v0[1]) + (v0[2] * v0[2] + v0[3] * v0[3]) + (v1[0] * v1[0] + v1[1] * v1[1]) + (v1[2] * v1[2] + v1[3] * v1[3]); }
    }
    __device__ __forceinline__ void operator()(const f32x4 (&acc)[2][2][4][2], const Unit& u, int wr, int wc, int fr, int fq) const {
        asm volatile("" : "+v"(fr), "+v"(fq));
        const int row0 = u.rb + wr * 64 + fr, col0 = u.cb + wc * 32 + 8 * fq;
        if (inplace) {
#pragma unroll
            for (int ai = 0; ai < 2; ++ai) if (ai == 0 || !u.half)
#pragma unroll
              for (int mh = 0; mh < 4; mh += 2) {
                u32x4 rw[2][2];
#pragma unroll
                for (int mm = 0; mm < 2; ++mm) { const int row = row0 + ai * HALF + (mh + mm) * 16;
#pragma unroll
                    for (int bj = 0; bj < 2; ++bj) if (bj == 0 || !u.q) rw[mm][bj] = *(const u32x4*)(XB0 + (size_t)row * ldc + col0 + bj * HALF); }
#pragma unroll
                for (int mm = 0; mm < 2; ++mm) { const int m = mh + mm, row = row0 + ai * HALF + m * 16; float ss = 0.f;
#pragma unroll
                    for (int bj = 0; bj < 2; ++bj) if (bj == 0 || !u.q) { const u32x4 w = rw[mm][bj];
                        const f32x4 v0 = acc[ai][bj][m][0] + (f32x4){bf_lo(w.x), bf_hi(w.x), bf_lo(w.y), bf_hi(w.y)}, v1 = acc[ai][bj][m][1] + (f32x4){bf_lo(w.z), bf_hi(w.z), bf_lo(w.w), bf_hi(w.w)};
                        row_out(v0, v1, row, col0 + bj * HALF, ss); }
                    if (wxb) { ss += __shfl_xor(ss, 16); ss += __shfl_xor(ss, 32); if (fq == 0) unsafeAtomicAdd(SS + row, ss); } }
              }
        } else {
#pragma unroll
            for (int ai = 0; ai < 2; ++ai) if (ai == 0 || !u.half)
#pragma unroll
                for (int m = 0; m < 4; ++m) { const int row = row0 + ai * HALF + m * 16; float ss = 0.f;
                    const float* rp = resP ? ((row < split ? resP + (size_t)row * ldc : resS + (size_t)(row - split) * ldc) + col0) : nullptr;
                    f32x4 rv[2][2];
#pragma unroll
                    for (int bj = 0; bj < 2; ++bj) if (bj == 0 || !u.q) { rv[bj][0] = rp ? *(const f32x4*)(rp + bj * HALF) : (f32x4){0.f, 0.f, 0.f, 0.f}; rv[bj][1] = rp ? *(const f32x4*)(rp + bj * HALF + 4) : (f32x4){0.f, 0.f, 0.f, 0.f}; }
#pragma unroll
                    for (int bj = 0; bj < 2; ++bj) if (bj == 0 || !u.q) row_out(acc[ai][bj][m][0] + rv[bj][0], acc[ai][bj][m][1] + rv[bj][1], row, col0 + bj * HALF, ss);
                    if (wxb) { ss += __shfl_xor(ss, 16); ss += __shfl_xor(ss, 32); if (fq == 0) unsafeAtomicAdd(SS + row, ss); } }
        }
    }
};

struct EpiG {
    static constexpr bool PERM = true, AFTER_DRAIN = false;
    bf16_t* G; float* outP; float* outS; const float* SS;
    __device__ __forceinline__ void operator()(const f32x4 (&acc)[2][2][4][2], const Unit& u, int wr, int wc, int fr, int fq) const {
        asm volatile("" : "+v"(fr), "+v"(fq));
        const int row0 = u.rb + wr * 64 + fr, col0 = u.pn * BM + wc * 32 + 8 * fq;
        float rsv[2][4];
#pragma unroll
        for (int ai = 0; ai < 2; ++ai)
#pragma unroll
            for (int m = 0; m < 4; ++m) rsv[ai][m] = SS[row0 + (u.half ? 0 : ai * HALF) + m * 16];
#pragma unroll
        for (int ai = 0; ai < 2; ++ai) if (ai == 0 || !u.half)
#pragma unroll
            for (int m = 0; m < 4; ++m) { const int row = row0 + ai * HALF + m * 16; bf16_t* rowp = G + (size_t)row * 2816 + col0;
                float* co = nullptr;
                if (row < 32768) { const int t = row & 8191; if (t >= 8190) co = outP + ((size_t)(row >> 13) * 2 + (t - 8190)) * 2816 + col0; }
                else { const int i = row & 7; if (i >= 6) co = outS + ((size_t)((row - 32768) >> 3) * 2 + (i - 6)) * 2816 + col0; }
                const float rs = rsqrtf(rsv[ai][m] * (1.f / 1024.f) + 1e-6f);
#pragma unroll
                for (int bj = 0; bj < 2; ++bj) { const f32x4 v0 = acc[ai][bj][m][0] * rs, v1 = acc[ai][bj][m][1] * rs;
                    u32x4 w; w.x = cvt_pk_bf16(v0[0], v0[1]); w.y = cvt_pk_bf16(v0[2], v0[3]); w.z = cvt_pk_bf16(v1[0], v1[1]); w.w = cvt_pk_bf16(v1[2], v1[3]);
                    *(u32x4*)(rowp + bj * HALF) = w;
                    if (co) { *(f32x4*)(co + bj * HALF) = v0; *(f32x4*)(co + bj * HALF + 4) = v1; } } }
    }
};

typedef unsigned u32x2 __attribute__((ext_vector_type(2)));
struct EpiH {
    static constexpr bool PERM = true, AFTER_DRAIN = false;
    const bf16_t* G; bf16_t* H; const float* cw; const float* cb; const float* ctx; const float* SS;
    static __device__ __forceinline__ void unpk4(const u32x2 w, float (&o)[4]) { o[0] = bf_lo(w.x); o[1] = bf_hi(w.x); o[2] = bf_lo(w.y); o[3] = bf_hi(w.y); }
    static __device__ __forceinline__ void ld4f(const float* p, float (&o)[4]) { const f32x4 a = *(const f32x4*)p; o[0] = a[0]; o[1] = a[1]; o[2] = a[2]; o[3] = a[3]; }
    static __device__ __forceinline__ u32x2 shf(const u32x2 w, int src) { u32x2 r; r.x = (unsigned)__shfl((int)w.x, src); r.y = (unsigned)__shfl((int)w.y, src); return r; }
    static __device__ __forceinline__ void finish(const float (&g0)[4], const float (&g1)[4], const float (&g2)[4], const float (&w0)[4], const float (&w1)[4], const float (&w2)[4], const float (&bb)[4],
                                                  const f32x4 v, float rs, bf16_t* dst) {
        float h[4];
#pragma unroll
        for (int j = 0; j < 4; j += 2) {
            const f32x2 gc = (f32x2){bb[j] + w0[j] * g2[j] + w1[j] * g1[j] + w2[j] * g0[j], bb[j + 1] + w0[j + 1] * g2[j + 1] + w1[j + 1] * g1[j + 1] + w2[j + 1] * g0[j + 1]};
            const f32x2 ge = gelu_pk(gc); h[j] = ge.x * v[j] * rs; h[j + 1] = ge.y * v[j + 1] * rs; }
        u32x2 w; w.x = cvt_pk_bf16(h[0], h[1]); w.y = cvt_pk_bf16(h[2], h[3]);
        *(u32x2*)dst = w;
    }
    __device__ __forceinline__ void operator()(const f32x4 (&acc)[2][2][4][2], const Unit& u, int wr, int wc, int fr, int fq) const {
        asm volatile("" : "+v"(fr), "+v"(fq));
        const int row0 = u.rb + wr * 64 + fr;
        const int lane = fq * 16 + fr;
        const int s1 = fr >= 1 ? lane - 1 : lane + 15, s2 = fr >= 2 ? lane - 2 : lane + 14;
#pragma unroll
        for (int bj = 0; bj < 2; ++bj)
#pragma unroll
          for (int hv = 0; hv < 2; ++hv) {
            const int col = u.pn * BM + bj * HALF + wc * 32 + 8 * fq + 4 * hv;
            float w0[4], w1[4], w2[4], bb[4];
            ld4f(cw + col, w0); ld4f(cw + 2816 + col, w1); ld4f(cw + 2 * 2816 + col, w2); ld4f(cb + col, bb);
            if (u.pm < 128) {
#pragma unroll
                for (int ai = 0; ai < 2; ++ai) {
                    const int R0 = u.rb + ai * HALF + wr * 64;
                    const bf16_t* gp = G + (size_t)(R0 + fr) * 2816 + col;
                    u32x2 gq[4];
#pragma unroll
                    for (int m = 0; m < 4; ++m) gq[m] = *(const u32x2*)(gp + (size_t)m * 16 * 2816);
                    u32x2 prv = (u32x2){0u, 0u};
                    if ((R0 & 8191) != 0) prv = *(const u32x2*)(gp - (size_t)16 * 2816);
#pragma unroll
                    for (int m = 0; m < 4; ++m) {
                        const u32x2 q1 = shf(fr == 15 ? prv : gq[m], s1), q2 = shf(fr >= 14 ? prv : gq[m], s2);
                        float g0[4], g1[4], g2[4]; unpk4(gq[m], g0); unpk4(q1, g1); unpk4(q2, g2);
                        finish(g0, g1, g2, w0, w1, w2, bb, acc[ai][bj][m][hv], rsqrtf(SS[R0 + fr + 16 * m] * (1.f / 1024.f) + 1e-6f), H + (size_t)(R0 + fr + 16 * m) * 2816 + col);
                        prv = gq[m];
                    }
                }
            } else {
                const int i = fr & 7;
                u32x2 gq[4]; float ssv[4];
#pragma unroll
                for (int m = 0; m < 4; ++m) { const int row = row0 + m * 16; gq[m] = *(const u32x2*)(G + (size_t)row * 2816 + col); ssv[m] = SS[row]; }
#pragma unroll
                for (int mh = 0; mh < 4; mh += 2) {
                f32x4 c0[4], c1[4];
#pragma unroll
                for (int m = mh; m < mh + 2; ++m) { const int row = row0 + m * 16; const float* cx = ctx + (size_t)((row - 32768) >> 3) * 2 * 2816 + col;
                    c0[m] = *(const f32x4*)cx; c1[m] = *(const f32x4*)(cx + 2816); }
#pragma unroll
                for (int m = mh; m < mh + 2; ++m) { const int row = row0 + m * 16; const u32x2 cur = gq[m];
                    const u32x2 q1 = shf(cur, lane - 1), q2 = shf(cur, lane - 2);
                    float g0[4], g1[4], g2[4]; unpk4(cur, g0); unpk4(q1, g1); unpk4(q2, g2);
#pragma unroll
                    for (int j = 0; j < 4; ++j) { const float x1 = c1[m][j], x0 = c0[m][j];
                        if (i < 1) g1[j] = x1;
                        if (i < 2) g2[j] = (i == 1) ? x1 : x0; }
                    finish(g0, g1, g2, w0, w1, w2, bb, acc[0][bj][m][hv], rsqrtf(ssv[m] * (1.f / 1024.f) + 1e-6f), H + (size_t)row * 2816 + col); }
                }
            }
        }
    }
};

template <class Epi, class Sched, bool ALIGN_EPI = false, bool SP2 = false>
__device__ __forceinline__ void gemm_phase(PG8_LAS unsigned char* lds, const Gemm g, const Sched& S, const Epi& E, int wave0) {
    int tid_ = threadIdx.x; (void)wave0; asm volatile("" : "+v"(tid_));
    const int tid = tid_, wid = __builtin_amdgcn_readfirstlane(tid >> 6), lane = tid & 63, wr = wid >> 2, wc = wid & 3, fr = lane & 15, fq = lane >> 4;
    const int K = g.K, nt = K / BK;
    unsigned voffA[2], voffB[2];
#pragma unroll
    for (int i = 0; i < 2; ++i) { int R, C; stage_rc(tid * 16 + i * 8192, R, C); const int Rb = Epi::PERM ? ((R & ~31) + perm32(R & 31)) : R;
        voffA[i] = (unsigned)(R * K + C) * 2u; voffB[i] = (unsigned)(Rb * K + C) * 2u; }
    const size_t kstep = (size_t)(BK * 2);
    const size_t hstep = (size_t)HALF * K * 2;
    const size_t tstep = 2 * hstep;
    const unsigned ldsw = (unsigned)wid * 1024u;
    const int aoff = lds_byte(wr * 64 + fr, fq * 8), boff = lds_byte(wc * 32 + fr, fq * 8);
#define PG8_SA(b, h) (((b) * 2 + (h)) * HTB)
#define PG8_SB(b, h) ((4 + (b) * 2 + (h)) * HTB)
#define PG8_STAGE(bufoff, gbase, voff) do { _Pragma("unroll") for (int _i = 0; _i < 2; ++_i) \
        __builtin_amdgcn_global_load_lds((const unsigned*)((const char*)(gbase) + (voff)[_i]), (PG8_LAS unsigned*)(lds + (bufoff) + ldsw + _i * 8192), 16, 0, 0); } while (0)
#define PG8_LDA(dst, b, h) do { _Pragma("unroll") for (int m = 0; m < 4; ++m) _Pragma("unroll") for (int k = 0; k < 2; ++k) dst[m][k] = *(const PG8_LAS bf16x8*)(lds + PG8_SA(b, h) + aoff + m * 2048 + k * 1024); } while (0)
#define PG8_LDB(dst, b, h) do { _Pragma("unroll") for (int n = 0; n < 2; ++n) _Pragma("unroll") for (int k = 0; k < 2; ++k) dst[n][k] = *(const PG8_LAS bf16x8*)(lds + PG8_SB(b, h) + boff + n * 2048 + k * 1024); } while (0)
#define PG8_MMA(ai, bj, At, Bt) do { __builtin_amdgcn_s_setprio(1); _Pragma("unroll") for (int m = 0; m < 4; ++m) _Pragma("unroll") for (int n = 0; n < 2; ++n) _Pragma("unroll") for (int k = 0; k < 2; ++k) \
        acc[ai][bj][m][n] = __builtin_amdgcn_mfma_f32_16x16x32_bf16(Bt[n][k], At[m][k], acc[ai][bj][m][n], 0, 0, 0); __builtin_amdgcn_s_setprio(0); } while (0)
#define PG8_WAIT_V(n) asm volatile("s_waitcnt vmcnt(" #n ")" ::: "memory")
#define PG8_WAIT_L(n) asm volatile("s_waitcnt lgkmcnt(" #n ")" ::: "memory")
#define PG8_BAR __builtin_amdgcn_s_barrier()
#define PG8_SCHED __builtin_amdgcn_sched_barrier(0)
    Unit cur, nxt; int ui = 0;
    if (!S.next(0, cur)) return;
    f32x4 acc[2][2][4][2];
#pragma unroll
    for (int a = 0; a < 2; ++a)
#pragma unroll
        for (int b = 0; b < 2; ++b)
#pragma unroll
            for (int m = 0; m < 4; ++m)
#pragma unroll
                for (int n = 0; n < 2; ++n) acc[a][b][m][n] = (f32x4){0.f, 0.f, 0.f, 0.f};
    bf16x8 At[4][2], B0[2][2], B1[2][2];
    const char* cA = (const char*)g.A + (size_t)cur.rb * K * 2; const char* cB = (const char*)g.Bt + (size_t)cur.pn * tstep;
    S.a_ready(cur);
    if constexpr (SP2) {
        PG8_STAGE(PG8_SB(0, 0), cB, voffB); PG8_STAGE(PG8_SB(0, 1), cB + hstep, voffB); PG8_STAGE(PG8_SA(0, 0), cA, voffA); PG8_STAGE(PG8_SA(0, 1), cA + hstep, voffA);
        if (wr == 1) PG8_BAR;
        PG8_WAIT_V(2); PG8_BAR;
        PG8_STAGE(PG8_SB(1, 0), cB + kstep, voffB); PG8_STAGE(PG8_SA(1, 0), cA + kstep, voffA); PG8_STAGE(PG8_SB(1, 1), cB + hstep + kstep, voffB);
        PG8_WAIT_V(6); PG8_BAR;
    } else {
        PG8_STAGE(PG8_SB(0, 0), cB, voffB); PG8_STAGE(PG8_SA(0, 0), cA, voffA); PG8_STAGE(PG8_SB(0, 1), cB + hstep, voffB); PG8_STAGE(PG8_SA(0, 1), cA + hstep, voffA);
        if (wr == 1) PG8_BAR;
        PG8_WAIT_V(4); PG8_BAR;
        PG8_STAGE(PG8_SB(1, 0), cB + kstep, voffB); PG8_STAGE(PG8_SA(1, 0), cA + kstep, voffA); PG8_STAGE(PG8_SB(1, 1), cB + hstep + kstep, voffB);
        PG8_WAIT_V(6); PG8_BAR;
    }
    for (;;) {
        const bool has_next = S.next(ui + 1, nxt);
        const char* nA = has_next ? (const char*)g.A + (size_t)nxt.rb * K * 2 : cA; const char* nB = has_next ? (const char*)g.Bt + (size_t)nxt.pn * tstep : cB;
        for (int t = 0; t < nt; t += 2) {
            const bool last = (t == nt - 2);
            const char* a1 = cA + (size_t)(t + 1) * kstep;
            const char* a2 = last ? nA : cA + (size_t)(t + 2) * kstep; const char* b2 = last ? nB : cB + (size_t)(t + 2) * kstep;
            const char* a3 = a2 + kstep; const char* b3 = b2 + kstep;
            if (last && has_next) S.a_ready(nxt);
            if constexpr (SP2) {
            PG8_LDB(B0, 0, 0); PG8_LDB(B1, 0, 1); PG8_SCHED; PG8_LDA(At, 0, 0); PG8_STAGE(PG8_SA(1, 1), a1 + hstep, voffA);
            PG8_WAIT_V(8); PG8_WAIT_L(0); PG8_BAR; PG8_MMA(0, 0, At, B0); PG8_MMA(0, 1, At, B1); PG8_BAR; PG8_SCHED;
            PG8_LDA(At, 0, 1); PG8_STAGE(PG8_SB(0, 0), b2, voffB); PG8_STAGE(PG8_SB(0, 1), b2 + hstep, voffB); PG8_STAGE(PG8_SA(0, 0), a2, voffA);
            PG8_WAIT_V(8); PG8_WAIT_L(0); PG8_BAR; if (!cur.half) { PG8_MMA(1, 0, At, B0); PG8_MMA(1, 1, At, B1); } PG8_BAR; PG8_SCHED;
            PG8_LDB(B0, 1, 0); PG8_LDB(B1, 1, 1); PG8_SCHED; PG8_LDA(At, 1, 0); PG8_STAGE(PG8_SA(0, 1), a2 + hstep, voffA);
            PG8_WAIT_V(8); PG8_WAIT_L(0); PG8_BAR; PG8_MMA(0, 0, At, B0); PG8_MMA(0, 1, At, B1); PG8_BAR; PG8_SCHED;
            PG8_LDA(At, 1, 1); PG8_STAGE(PG8_SB(1, 0), b3, voffB); PG8_STAGE(PG8_SB(1, 1), b3 + hstep, voffB); PG8_STAGE(PG8_SA(1, 0), a3, voffA);
            PG8_WAIT_V(8); PG8_WAIT_L(0); PG8_BAR; if (!cur.half) { PG8_MMA(1, 0, At, B0); PG8_MMA(1, 1, At, B1); } PG8_BAR; PG8_SCHED;
            } else {
            PG8_LDB(B0, 0, 0); PG8_SCHED; PG8_LDA(At, 0, 0); PG8_STAGE(PG8_SA(1, 1), a1 + hstep, voffA);
            PG8_WAIT_L(8); PG8_BAR; PG8_WAIT_L(0); PG8_MMA(0, 0, At, B0); PG8_BAR; PG8_SCHED;
            PG8_LDB(B1, 0, 1); PG8_STAGE(PG8_SB(0, 0), b2, voffB);
            PG8_BAR; PG8_WAIT_L(0); PG8_MMA(0, 1, At, B1); PG8_BAR;
            PG8_LDA(At, 0, 1); PG8_STAGE(PG8_SA(0, 0), a2, voffA);
            PG8_BAR; PG8_WAIT_L(0); if (!cur.half) PG8_MMA(1, 0, At, B0); PG8_BAR; PG8_SCHED;
            PG8_STAGE(PG8_SB(0, 1), b2 + hstep, voffB);
            PG8_WAIT_V(6); PG8_BAR; if (!cur.half) PG8_MMA(1, 1, At, B1); PG8_BAR;
            PG8_LDB(B0, 1, 0); PG8_SCHED; PG8_LDA(At, 1, 0); PG8_STAGE(PG8_SA(0, 1), a2 + hstep, voffA);
            PG8_WAIT_L(8); PG8_BAR; PG8_WAIT_L(0); PG8_MMA(0, 0, At, B0); PG8_BAR; PG8_SCHED;
            PG8_LDB(B1, 1, 1); PG8_STAGE(PG8_SB(1, 0), b3, voffB);
            PG8_BAR; PG8_WAIT_L(0); PG8_MMA(0, 1, At, B1); PG8_BAR;
            PG8_LDA(At, 1, 1); PG8_STAGE(PG8_SA(1, 0), a3, voffA);
            PG8_BAR; PG8_WAIT_L(0); if (!cur.half) PG8_MMA(1, 0, At, B0); PG8_BAR; PG8_SCHED;
            PG8_STAGE(PG8_SB(1, 1), b3 + hstep, voffB);
            PG8_WAIT_V(6); PG8_BAR; if (!cur.half) PG8_MMA(1, 1, At, B1); PG8_BAR;
            }
        }
        if constexpr (ALIGN_EPI) { if (wr == 0) PG8_BAR; }
        if constexpr (!Epi::AFTER_DRAIN) { E(acc, cur, wr, wc, fr, fq); S.done(cur); }
        if (!has_next) break;
#pragma unroll
        for (int a = 0; a < 2; ++a)
#pragma unroll
            for (int b = 0; b < 2; ++b)
#pragma unroll
                for (int m = 0; m < 4; ++m)
#pragma unroll
                    for (int n = 0; n < 2; ++n) acc[a][b][m][n] = (f32x4){0.f, 0.f, 0.f, 0.f};
        cur = nxt; cA = nA; cB = nB; ++ui;
        if constexpr (ALIGN_EPI) { if (wr == 1) PG8_BAR; }
    }
    PG8_WAIT_V(0);
    if constexpr (!ALIGN_EPI) { if (wr == 0) PG8_BAR; }
    PG8_BAR;
    if constexpr (Epi::AFTER_DRAIN) { E.fused(acc, cur, wr, wc, fr, fq, lds, wid, lane); S.done(cur); }
#undef PG8_SA
#undef PG8_SB
#undef PG8_STAGE
#undef PG8_LDA
#undef PG8_LDB
#undef PG8_MMA
#undef PG8_WAIT_V
#undef PG8_WAIT_L
#undef PG8_BAR
#undef PG8_SCHED
}

template <class Epi>
__device__ __forceinline__ void mini_gemm(PG8_LAS unsigned char* lds, const bf16_t* A, const bf16_t* Bt, int K, int ntn, const Epi& E, int c, int G, int wave0, int row_base = 32768) {
    int tid_ = threadIdx.x; (void)wave0; asm volatile("" : "+v"(tid_));
    const int tid = tid_, wid = __builtin_amdgcn_readfirstlane(tid >> 6), lane = tid & 63, wr = wid >> 2, wc = wid & 3, fr = lane & 15, fq = lane >> 4;
    constexpr int LS = 136, BUFB = 2 * 128 * LS * 2;
    const int lr = tid >> 2, lp = (tid & 3) * 4;
    const int nst = K / 128;
#pragma unroll 1
    for (int t = c; t < 8 * ntn; t += G) {
        const int tm = t & 7, tn = t >> 3;
        const bf16_t* ga = A + ((size_t)row_base + 128 * tm + lr) * K + lp * 8;
        const bf16_t* gb = Bt + ((size_t)128 * tn + lr) * K + lp * 8;
        u32x4 ra[2][4], rb[2][4];
#pragma unroll
        for (int s2 = 0; s2 < 2; ++s2)
#pragma unroll
            for (int j = 0; j < 4; ++j) { ra[s2][j] = *(const u32x4*)(ga + 128 * s2 + 8 * j); rb[s2][j] = *(const u32x4*)(gb + 128 * s2 + 8 * j); }
        f32x4 acc[4][2];
#pragma unroll
        for (int m = 0; m < 4; ++m)
#pragma unroll
            for (int n = 0; n < 2; ++n) acc[m][n] = (f32x4){0.f, 0.f, 0.f, 0.f};
#pragma unroll 1
        for (int st = 0; st < nst; st += 2) {
#pragma unroll
          for (int s2 = 0; s2 < 2; ++s2) {
            PG8_LAS bf16_t* As = (PG8_LAS bf16_t*)(lds + s2 * BUFB); PG8_LAS bf16_t* Bs = As + 128 * LS;
#pragma unroll
            for (int j = 0; j < 4; ++j) { *(PG8_LAS u32x4*)(As + lr * LS + (lp + j) * 8) = ra[s2][j]; *(PG8_LAS u32x4*)(Bs + lr * LS + (lp + j) * 8) = rb[s2][j]; }
            __syncthreads();
            if (st + 2 < nst) {
#pragma unroll
                for (int j = 0; j < 4; ++j) { ra[s2][j] = *(const u32x4*)(ga + 128 * (st + 2 + s2) + 8 * j); rb[s2][j] = *(const u32x4*)(gb + 128 * (st + 2 + s2) + 8 * j); } }
#pragma unroll
            for (int kc = 0; kc < 4; ++kc) {
                bf16x8 af[4], bfr[2];
#pragma unroll
                for (int m = 0; m < 4; ++m) af[m] = *(const PG8_LAS bf16x8*)(As + (64 * wr + 16 * m + fr) * LS + 32 * kc + 8 * fq);
#pragma unroll
                for (int n = 0; n < 2; ++n) bfr[n] = *(const PG8_LAS bf16x8*)(Bs + (32 * wc + 8 * (fr >> 2) + 4 * n + (fr & 3)) * LS + 32 * kc + 8 * fq);
#pragma unroll
                for (int m = 0; m < 4; ++m)
#pragma unroll
                    for (int n = 0; n < 2; ++n) acc[m][n] = __builtin_amdgcn_mfma_f32_16x16x32_bf16(bfr[n], af[m], acc[m][n], 0, 0, 0);
            }
          }
        }
        f32x4 accf[2][2][4][2];
#pragma unroll
        for (int a = 0; a < 2; ++a)
#pragma unroll
            for (int bq = 0; bq < 2; ++bq)
#pragma unroll
                for (int m = 0; m < 4; ++m)
#pragma unroll
                    for (int n = 0; n < 2; ++n) accf[a][bq][m][n] = (a == 0 && bq == 0) ? acc[m][n] : (f32x4){0.f, 0.f, 0.f, 0.f};
        Unit u; u.pm = 128 + (tm >> 1); u.pn = tn >> 1; u.rb = row_base + 128 * tm; u.half = 1; u.q = 1; u.cb = 128 * tn;
        E(accf, u, wr, wc, fr, fq);
        __syncthreads();
    }
}
}

#define LAS __attribute__((address_space(3)))
typedef unsigned short bf16;
typedef unsigned v4u __attribute__((ext_vector_type(4)));
typedef unsigned v2u __attribute__((ext_vector_type(2)));
typedef float f32x4 __attribute__((ext_vector_type(4)));
typedef short bf16x8 __attribute__((ext_vector_type(8)));

constexpr int NTHR = 512, NWAVES = 8;
constexpr int MP = 32768, MS = 1024, MT = MP + MS;
constexpr int D = 1024, DFF = 2816;
constexpr int LDS_BYTES = 147456;
constexpr float EPS = 1e-6f;

enum { I_XP = 0, I_XS, I_CPOOL, I_CSK, I_CSV, I_CMK, I_CMV, I_CFC, I_MEMP, I_LNMIX, I_LNMEM, I_LNMEMKV, I_LNFFN, I_ABWIN, I_ABVG, I_ABWS, I_ABBS, I_ABPW, I_ABPS, I_ABWOUT,
       I_CWQKV, I_CQG, I_CKG, I_CSINK, I_CWO, I_MWQ, I_MWKV, I_MQG, I_MKG, I_MWO, I_FWUP, I_FCW, I_FCB, I_FWDN, N_IN };
constexpr size_t O_YP = 0, O_YS = O_YP + (size_t)MP * D, O_POOLP = O_YS + (size_t)MS * D, O_POOLS = O_POOLP + 4 * 15 * 512, O_CHV = O_POOLS + 128 * 15 * 512,
                 O_SKP = O_CHV + 128 * 8 * 512, O_SVP = O_SKP + 4 * 128 * 256, O_SKS = O_SVP + 4 * 128 * 256, O_SVS = O_SKS + (size_t)128 * 128 * 256,
                 O_MKP = O_SVS + (size_t)128 * 128 * 256, O_MVP = O_MKP + 2 * 4 * 256 * 512, O_FCP = O_MVP + 2 * 4 * 256 * 512, O_FCS = O_FCP + 2 * 4 * 2 * DFF,
                 O_END = O_FCS + (size_t)2 * 128 * 2 * DFF;
constexpr size_t MiB = 1u << 20;
constexpr size_t W_WIN = 0, W_WOUT = W_WIN + 1536 * 1024 * 2, W_WQKV = W_WOUT + 1024 * 1024 * 2, W_CWO = W_WQKV + 1536 * 1024 * 2, W_LAYER = W_CWO + 1024 * 1024 * 2;
constexpr size_t WL_WQ = 0, WL_WKV = WL_WQ + 512 * 1024 * 2, WL_WO = WL_WKV + 1024 * 1024 * 2, WL_WUP = WL_WO + 1024 * 512 * 2, WL_WDN = WL_WUP + (size_t)2 * DFF * 1024 * 2,
                 WL_SIZE = WL_WDN + (size_t)1024 * DFF * 2;
constexpr size_t W_MN = W_LAYER + 2 * WL_SIZE;
constexpr size_t W_MKV = W_MN + 2 * 1024 * 1024 * 2;
constexpr size_t W_SS = W_MKV + 2 * 1024 * 1024 * 4;
constexpr size_t W_SMALL_END = W_SS + (size_t)6 * MT * 4;
static_assert(W_SMALL_END <= 72 * MiB, "weights region");
constexpr size_t W_XN = 72 * MiB;
constexpr size_t W_G = 138 * MiB;
constexpr size_t W_PROJ = W_G;
constexpr size_t W_AO = W_PROJ + 99 * MiB;
constexpr size_t W_H = 320 * MiB;
constexpr size_t W_KV32 = W_H;
constexpr size_t W_MQ = W_KV32 + 66 * MiB;
constexpr size_t W_MO = W_MQ + 33 * MiB;
constexpr size_t W_END = 502 * MiB;
constexpr size_t W_CTL = 504 * MiB, CTL_BYTES = 65536, W_NEED = W_CTL + CTL_BYTES;
constexpr int LDS_CTL_OFF = LDS_BYTES - 64;
static_assert(W_XN + (size_t)MT * 1024 * 2 <= W_G && W_PROJ + (size_t)MT * 1536 * 2 <= W_AO && W_AO + (size_t)MT * 1024 * 2 <= W_H && W_G + (size_t)MT * DFF * 2 <= W_H, "ws map 1");
static_assert(W_KV32 + (size_t)MT * 512 * 4 <= W_MQ && W_MQ + (size_t)MT * 512 * 2 <= W_MO && W_MO + (size_t)MT * 512 * 2 <= W_END && W_H + (size_t)MT * DFF * 2 <= W_END, "ws map 2");

struct Params { const float* in[N_IN]; float* out; unsigned char* ws; };

__device__ __forceinline__ unsigned pk2(float lo, float hi) { return pg8::cvt_pk_bf16(lo, hi); }
__device__ __forceinline__ unsigned f2bf(float f) { return pg8::cvt_pk_bf16(f, 0.f) & 0xffffu; }
__device__ __forceinline__ float bflo(unsigned w) { return __builtin_bit_cast(float, w << 16); }
__device__ __forceinline__ float bfhi(unsigned w) { return __builtin_bit_cast(float, w & 0xffff0000u); }
__device__ __forceinline__ float bf1(bf16 h) { return __builtin_bit_cast(float, (unsigned)h << 16); }
__device__ __forceinline__ void unpack8(const v4u w, float (&o)[8]) { o[0] = bflo(w.x); o[1] = bfhi(w.x); o[2] = bflo(w.y); o[3] = bfhi(w.y); o[4] = bflo(w.z); o[5] = bfhi(w.z); o[6] = bflo(w.w); o[7] = bfhi(w.w); }
__device__ __forceinline__ bf16x8 pack8(const float (&o)[8]) { v4u w; w.x = pk2(o[0], o[1]); w.y = pk2(o[2], o[3]); w.z = pk2(o[4], o[5]); w.w = pk2(o[6], o[7]); return __builtin_bit_cast(bf16x8, w); }
typedef short v4i16_t __attribute__((ext_vector_type(4)));
__device__ __forceinline__ v2u vtr(const LAS bf16* p) { return __builtin_bit_cast(v2u, __builtin_amdgcn_ds_read_tr16_b64_v4i16((LAS v4i16_t*)p)); }
__device__ __forceinline__ float wave_sum(float v) {
#pragma unroll
    for (int o = 1; o < 64; o <<= 1) v += __shfl_xor(v, o);
    return v;
}
__device__ __forceinline__ float gelu1(float v) { const pg8::f32x2 r = pg8::gelu_pk((pg8::f32x2){v, 0.f}); return r.x; }
__device__ __forceinline__ void rope_cs(float pos, int e, float& c, float& s) {
    const float inv = exp2f(-(float)e * (0.125f * 18.931568569324174f));
    const float ang = pos * inv;
    const float k = rintf(ang * 0.15915494309189535f);
    float r = fmaf(-k, 6.28125f, ang);
    r = fmaf(-k, 0.0019353071795864769f, r);
    s = __sinf(r); c = __cosf(r);
}

#define XB_TMO      128
#define XB_XCNT(j)  (256  + 64 * (j))
#define XB_XSUB(j)  (1280 + 64 * (j))
#define XB_XGEN(j)  (2304 + 64 * (j))
#define XB_TOP      3328
#define XB_TOPGEN   3392
#define XCD_BAR_WORDS 3456
#define XB_SPIN_CAP (1u << 18)

__device__ __forceinline__ unsigned xb_ld(unsigned* p)              { return __hip_atomic_load(p, __ATOMIC_RELAXED, __HIP_MEMORY_SCOPE_AGENT); }
__device__ __forceinline__ unsigned xb_add(unsigned* p, unsigned v) { return __hip_atomic_fetch_add(p, v, __ATOMIC_RELAXED, __HIP_MEMORY_SCOPE_AGENT); }
__device__ __forceinline__ unsigned xb_xcc_id() { return (unsigned)__builtin_amdgcn_s_getreg((3 << 11) | 20) & 0xFu; }
#define XB_SPIN(cond, bar) do { unsigned _sp = 0; while (cond) { __builtin_amdgcn_s_sleep(1); \
    if ((++_sp & 255u) == 0u) { if (xb_ld(&(bar)[XB_TMO])) break; if (_sp > XB_SPIN_CAP) { atomicAdd(&(bar)[XB_TMO], 1u); break; } } } } while (0)

struct XcdBarrier {
    unsigned* bar; unsigned x; int w0;
    volatile LAS unsigned* st;
};

__device__ __forceinline__ XcdBarrier xcd_barrier_post(unsigned* bar, volatile LAS unsigned* st) {
    XcdBarrier b; b.bar = bar; b.x = xb_xcc_id(); b.st = st; b.w0 = __builtin_amdgcn_readfirstlane((int)threadIdx.x >> 6);
    if (threadIdx.x == 0) (void)xb_add(&bar[XB_XCNT(b.x)], 1u);
    return b;
}
__device__ __forceinline__ void xcd_barrier_complete(unsigned* bar, unsigned x, unsigned& nloc, unsigned& nx) {
    const unsigned G = gridDim.x * gridDim.y * gridDim.z;
    unsigned sum, cnt, mine, sp = 0u;
    for (;;) {
        sum = 0u; cnt = 0u; mine = 0u;
#pragma unroll
        for (unsigned j = 0; j < 16; ++j) { const unsigned c = xb_ld(&bar[XB_XCNT(j)]); sum += c; cnt += (c > 0u) ? 1u : 0u; mine = (j == x) ? c : mine; }
        if (sum == G) break;
        __builtin_amdgcn_s_sleep(1);
        if ((++sp & 255u) == 0u) { if (xb_ld(&bar[XB_TMO])) break; if (sp > XB_SPIN_CAP) { atomicAdd(&bar[XB_TMO], 1u); break; } }
    }
    nloc = mine > 0u ? mine : 1u; nx = cnt > 0u ? cnt : 1u;
}

__device__ __forceinline__ void xcd_barrier(const XcdBarrier& b) {
    asm volatile("s_waitcnt vmcnt(0)" ::: "memory");
    __syncthreads();
    if (threadIdx.x == 0) {
        unsigned* bar = b.bar;
        __builtin_amdgcn_s_waitcnt(0);
        unsigned nloc = b.st[0], nx = b.st[1];
        if (nloc == 0u) { xcd_barrier_complete(bar, b.x, nloc, nx); b.st[0] = nloc; b.st[1] = nx; }
        const unsigned old = xb_add(&bar[XB_XSUB(b.x)], 1u);
        const unsigned gen = old / nloc;
        if (old + 1u == (gen + 1u) * nloc) {
            __builtin_amdgcn_fence(__ATOMIC_RELEASE, "agent");
            asm volatile("s_waitcnt vmcnt(0)" ::: "memory");
            const unsigned og = xb_add(&bar[XB_TOP], 1u);
            const unsigned tg = og / nx;
            if (og + 1u == (tg + 1u) * nx) xb_add(&bar[XB_TOPGEN], 1u);
            else XB_SPIN(xb_ld(&bar[XB_TOPGEN]) == tg, bar);
            __builtin_amdgcn_fence(__ATOMIC_ACQUIRE, "agent");
            xb_add(&bar[XB_XGEN(b.x)], 1u);
            asm volatile("s_waitcnt vmcnt(0)" ::: "memory");
        } else {
            XB_SPIN(xb_ld(&bar[XB_XGEN(b.x)]) == gen, bar);
            __builtin_amdgcn_fence(__ATOMIC_ACQUIRE, "agent");
            asm volatile("s_waitcnt vmcnt(0)" ::: "memory");
        }
    }
    __syncthreads();
}

__device__ __forceinline__ void transpose_item(const float* W, const float* gain, int ldn, int nblk, bf16* WT, int ldk, int koff, LAS float* scr, int item, int lane) {
    const int kb = item / nblk, nb = item % nblk, k0 = 64 * kb, n0 = 32 * nb;
    float wv[32];
#pragma unroll
    for (int i = 0; i < 32; ++i) wv[i] = __builtin_nontemporal_load(W + (size_t)(k0 + 2 * i + (lane >> 5)) * ldn + n0 + (lane & 31));
    if (gain) {
#pragma unroll
        for (int i = 0; i < 32; ++i) wv[i] *= gain[k0 + 2 * i + (lane >> 5)]; }
#pragma unroll
    for (int i = 0; i < 32; ++i) scr[(2 * i + (lane >> 5)) * 33 + (lane & 31)] = wv[i];
    asm volatile("s_waitcnt lgkmcnt(0)" ::: "memory");
    const int c = lane & 7;
#pragma unroll
    for (int j = 0; j < 4; ++j) { const int n = (lane >> 3) + 8 * j; const LAS float* s = scr + (8 * c) * 33 + n;
        v4u o; o.x = pk2(s[0 * 33], s[1 * 33]); o.y = pk2(s[2 * 33], s[3 * 33]); o.z = pk2(s[4 * 33], s[5 * 33]); o.w = pk2(s[6 * 33], s[7 * 33]);
        *(v4u*)(WT + (size_t)(n0 + n) * ldk + koff + k0 + 8 * c) = o; }
    asm volatile("s_waitcnt lgkmcnt(0)" ::: "memory");
}
__device__ __forceinline__ void rms_row(const float* xrow, const float* g, bf16* orow, int lane) {
    const f32x4* xr = (const f32x4*)xrow + lane; const f32x4* gr = (const f32x4*)g + lane;
    f32x4 v[4]; float s = 0.f;
#pragma unroll
    for (int j = 0; j < 4; ++j) { v[j] = xr[64 * j]; s += (v[j].x * v[j].x + v[j].y * v[j].y) + (v[j].z * v[j].z + v[j].w * v[j].w); }
    const float rs = rsqrtf(wave_sum(s) * (1.f / 1024.f) + EPS);
    unsigned long long* o8 = (unsigned long long*)orow + lane;
#pragma unroll
    for (int j = 0; j < 4; ++j) { const f32x4 gg = gr[64 * j];
        o8[64 * j] = (unsigned long long)pk2(v[j].x * rs * gg.x, v[j].y * rs * gg.y) | ((unsigned long long)pk2(v[j].z * rs * gg.z, v[j].w * rs * gg.w) << 32); }
}
__device__ __forceinline__ void xb_row(const float* xrow, bf16* orow, float* ss, int lane) {
    const f32x4* xr = (const f32x4*)xrow + lane;
    f32x4 v[4]; float s = 0.f;
#pragma unroll
    for (int j = 0; j < 4; ++j) { v[j] = xr[64 * j]; s += (v[j].x * v[j].x + v[j].y * v[j].y) + (v[j].z * v[j].z + v[j].w * v[j].w); }
    s = wave_sum(s);
    unsigned long long* o8 = (unsigned long long*)orow + lane;
#pragma unroll
    for (int j = 0; j < 4; ++j) o8[64 * j] = (unsigned long long)pk2(v[j].x, v[j].y) | ((unsigned long long)pk2(v[j].z, v[j].w) << 32);
    if (lane == 0) *ss = s;
}

struct TItem { const float* W; int ldn, nblk, nitems; bf16* WT; int ldk, koff; };

__device__ __forceinline__ void prologue(const Params& p, LAS unsigned char* lds, int gw, int ngw, int wave, int lane) {
    unsigned char* ws = p.ws;
    LAS float* scr = (LAS float*)(lds + wave * 16384);
#define TR(Wp, gn_, K_, N_, ldn_, dst_, ldk_, koff_) do { const int nblk_ = (N_) / 32, nit_ = ((K_) / 64) * nblk_; \
        for (int it = gw; it < nit_; it += ngw) transpose_item((Wp), (gn_), (ldn_), nblk_, (bf16*)(dst_), (ldk_), (koff_), scr, it, lane); } while (0)
    const float* nog = nullptr;
    TR(p.in[I_ABWIN], p.in[I_LNMIX], 1024, 1536, 1536, ws + W_WIN, 1024, 0);
    TR(p.in[I_ABWOUT], nog, 512, 1024, 1024, ws + W_WOUT, 1024, 0);
    TR(p.in[I_CWQKV], p.in[I_LNMIX] + D, 1024, 1536, 1536, ws + W_WQKV, 1024, 0);
    TR(p.in[I_CWO], nog, 1024, 1024, 1024, ws + W_CWO, 1024, 0);
#pragma unroll 1
    for (int l = 0; l < 2; ++l) {
        unsigned char* wl = ws + W_LAYER + l * WL_SIZE;
        TR(p.in[I_MWQ] + (size_t)l * 1024 * 512, p.in[I_LNMEM] + l * D, 1024, 512, 512, wl + WL_WQ, 1024, 0);
        TR(p.in[I_MWKV] + (size_t)l * 1024 * 1024, nog, 1024, 1024, 1024, wl + WL_WKV, 1024, 0);
        TR(p.in[I_MWO] + (size_t)l * 512 * 1024, nog, 512, 1024, 1024, wl + WL_WO, 512, 0);
        TR(p.in[I_FWUP] + (size_t)l * 1024 * 2 * DFF, p.in[I_LNFFN] + l * D, 1024, 2 * DFF, 2 * DFF, wl + WL_WUP, 1024, 0);
        TR(p.in[I_FWDN] + (size_t)l * DFF * 1024, nog, DFF, 1024, 1024, wl + WL_WDN, DFF, 0);
    }
#undef TR
    {
        const float* pw = p.in[I_ABPW]; const float* ps = p.in[I_ABPS]; const float* wo = p.in[I_ABWOUT] + (size_t)512 * 1024;
        bf16* WT = (bf16*)(ws + W_WOUT);
        const int gt = gw * 64 + lane, ngt = ngw * 64;
        for (int o = gt; o < 128 * 1024; o += ngt) {
            const int n = o & 1023, d = o >> 10;
            float a[4] = {0.f, 0.f, 0.f, 0.f};
#pragma unroll 4
            for (int e = 0; e < 128; ++e) {
#pragma unroll
                for (int g = 0; g < 4; ++g) a[g] += pw[((size_t)g * 128 + d) * 128 + e] * ps[g * 128 + e] * wo[((size_t)g * 128 + e) * 1024 + n]; }
#pragma unroll
            for (int g = 0; g < 4; ++g) WT[(size_t)n * 1024 + 512 + g * 128 + d] = (bf16)f2bf(a[g]); }
    }
    for (int m0 = gw * 4; m0 < MT; m0 += ngw * 4) {
        f32x4 v[4][4];
#pragma unroll
        for (int r = 0; r < 4; ++r) { const int m = m0 + r; const f32x4* xr = (const f32x4*)(m < MP ? p.in[I_XP] + (size_t)m * D : p.in[I_XS] + (size_t)(m - MP) * D) + lane;
#pragma unroll
            for (int j = 0; j < 4; ++j) v[r][j] = __builtin_nontemporal_load(xr + 64 * j); }
#pragma unroll
        for (int r = 0; r < 4; ++r) { const int m = m0 + r; float sq = 0.f;
#pragma unroll
            for (int j = 0; j < 4; ++j) sq += (v[r][j].x * v[r][j].x + v[r][j].y * v[r][j].y) + (v[r][j].z * v[r][j].z + v[r][j].w * v[r][j].w);
            sq = wave_sum(sq);
            unsigned long long* o8 = (unsigned long long*)((bf16*)(ws + W_XN) + (size_t)m * D) + lane;
#pragma unroll
            for (int j = 0; j < 4; ++j) o8[64 * j] = (unsigned long long)pk2(v[r][j].x, v[r][j].y) | ((unsigned long long)pk2(v[r][j].z, v[r][j].w) << 32);
            if (lane == 0) ((float*)(ws + W_SS))[m] = sq; }
    }
    for (int o = gw * 64 + lane; o < 5 * MT; o += ngw * 64) ((float*)(ws + W_SS))[MT + o] = 0.f;
    for (int m = gw; m < 2048; m += ngw) { const int l = m >> 10, r = m & 1023;
        rms_row(p.in[I_MEMP] + (size_t)r * D, p.in[I_LNMEMKV] + l * D, (bf16*)(ws + W_MN) + (size_t)m * D, lane); }
}

constexpr int SG_VS = 520;
template <int W> __device__ __forceinline__ void pool_block(const float (&prev)[16], const float (&cur)[16], float (&o)[16], int t0, bool clampcnt) {
#pragma unroll
    for (int k = 0; k < 16; ++k) { float s = 0.f;
#pragma unroll
        for (int kk = 0; kk < W; ++kk) s += (k - kk >= 0) ? cur[(k - kk) & 15] : prev[(16 + k - kk) & 15];
        float inv = 1.f / (float)W;
        if (clampcnt) { const int t1 = t0 + k + 1; if (t1 < W) inv = __builtin_amdgcn_rcpf((float)t1); }
        o[k] = s * inv - cur[k]; }
}
__device__ __forceinline__ void pool_dispatch(int gi, const float (&prev)[16], const float (&cur)[16], float (&o)[16], int t0, bool clampcnt) {
    if (gi == 0) pool_block<2>(prev, cur, o, t0, clampcnt); else if (gi == 1) pool_block<4>(prev, cur, o, t0, clampcnt);
    else if (gi == 2) pool_block<8>(prev, cur, o, t0, clampcnt); else pool_block<16>(prev, cur, o, t0, clampcnt);
}

__device__ __forceinline__ void sgu_prompt_unit(const Params& p, LAS unsigned char* lds, int unit, int tid, int wave, int lane) {
    const bf16* PROJ = (const bf16*)(p.ws + W_PROJ); bf16* AO = (bf16*)(p.ws + W_AO);
    LAS bf16* Vn = (LAS bf16*)lds;
    const int b = unit >> 6, ch = unit & 63; const size_t r0 = (size_t)b * 8192 + ch * 128;
    {
        float gn[8]; pg8::ld8f(p.in[I_ABVG] + 8 * lane, gn);
        v4u raw[16];
#pragma unroll
        for (int jj = 0; jj < 16; ++jj) raw[jj] = *(const v4u*)(PROJ + (r0 + wave + 8 * jj) * 1536 + 512 + 8 * lane);
#pragma unroll
        for (int jj = 0; jj < 16; ++jj) { const int j = wave + 8 * jj;
            float x[8]; unpack8(raw[jj], x);
            float s = 0.f;
#pragma unroll
            for (int e = 0; e < 8; ++e) s += x[e];
            const float mean = wave_sum(s) * (1.f / 512.f); float q = 0.f;
#pragma unroll
            for (int e = 0; e < 8; ++e) { x[e] -= mean; q += x[e] * x[e]; }
            const float rstd = rsqrtf(wave_sum(q) * (1.f / 512.f) + EPS);
#pragma unroll
            for (int e = 0; e < 8; ++e) x[e] *= rstd * gn[e];
            *(LAS bf16x8*)(Vn + j * SG_VS + 8 * lane) = pack8(x); }
    }
    __syncthreads();
    {
        const int q16 = lane & 15, kq = lane >> 4, nch = (wave >> 1) + 1; int i = 16 * wave + q16;
#pragma unroll 1
        for (int g = 0; g < 4; ++g) {
            asm volatile("" : "+v"(i));
            f32x4 acc[8];
#pragma unroll
            for (int dt = 0; dt < 8; ++dt) acc[dt] = (f32x4){0.f, 0.f, 0.f, 0.f};
            const float* wsr = p.in[I_ABWS] + ((size_t)g * 128 + i) * 128;
            float wva[4][8]; v2u uu8[8];
#pragma unroll
            for (int c = 0; c < 4; ++c) pg8::ld8f(wsr + 32 * c + 8 * kq, wva[c]);
#pragma unroll
            for (int dt = 0; dt < 8; ++dt) uu8[dt] = *(const v2u*)(PROJ + (r0 + i) * 1536 + g * 128 + 16 * dt + 4 * kq);
#pragma unroll
            for (int c = 0; c < 4; ++c) if (c < nch) {
                float (&wv)[8] = wva[c];
#pragma unroll
                for (int e = 0; e < 8; ++e) if (32 * c + 8 * kq + e > i) wv[e] = 0.f;
                const bf16x8 bfrag = pack8(wv);
#pragma unroll
                for (int dt = 0; dt < 8; ++dt) { const LAS bf16* vp = Vn + (32 * c + 8 * kq + (q16 >> 2)) * SG_VS + g * 128 + 16 * dt + 4 * (q16 & 3);
                    const v2u lo = vtr(vp), hi = vtr(vp + 4 * SG_VS);
                    v4u av; av.x = lo.x; av.y = lo.y; av.z = hi.x; av.w = hi.y;
                    acc[dt] = __builtin_amdgcn_mfma_f32_16x16x32_bf16(__builtin_bit_cast(bf16x8, av), bfrag, acc[dt], 0, 0, 0); }
            }
            const float bs = p.in[I_ABBS][g * 128 + i];
#pragma unroll
            for (int dt = 0; dt < 8; ++dt) { const v2u uu = uu8[dt];
                const float o0 = bflo(uu.x) * (acc[dt][0] + bs), o1 = bfhi(uu.x) * (acc[dt][1] + bs), o2 = bflo(uu.y) * (acc[dt][2] + bs), o3 = bfhi(uu.y) * (acc[dt][3] + bs);
                v2u w; w.x = pk2(o0, o1); w.y = pk2(o2, o3);
                *(v2u*)(AO + (r0 + i) * 1024 + g * 128 + 16 * dt + 4 * kq) = w; }
        }
    }
    {
        const int c = tid, gi = c >> 7;
        const bf16* pp = PROJ + 1024 + c;
        float prev[16], cur[16], o[16];
#pragma unroll
        for (int k = 0; k < 16; ++k) prev[k] = (ch > 0) ? bf1(pp[(r0 - 16 + k) * 1536]) : 0.f;
        bf16 nxt[16];
#pragma unroll
        for (int k = 0; k < 16; ++k) nxt[k] = pp[(r0 + k) * 1536];
#pragma unroll 1
        for (int blk = 0; blk < 8; ++blk) {
#pragma unroll
            for (int k = 0; k < 16; ++k) cur[k] = bf1(nxt[k]);
            if (blk < 7) {
#pragma unroll
                for (int k = 0; k < 16; ++k) nxt[k] = pp[(r0 + 16 * (blk + 1) + k) * 1536]; }
            pool_dispatch(gi, prev, cur, o, ch * 128 + 16 * blk, ch == 0 && blk == 0);
#pragma unroll
            for (int k = 0; k < 16; ++k) AO[(r0 + 16 * blk + k) * 1024 + 512 + c] = (bf16)f2bf(o[k]);
            if (ch == 63 && blk == 7) {
#pragma unroll
                for (int k = 1; k < 16; ++k) p.out[O_POOLP + ((size_t)b * 15 + (k - 1)) * 512 + c] = cur[k]; }
#pragma unroll
            for (int k = 0; k < 16; ++k) prev[k] = cur[k];
        }
    }
    __syncthreads();
}

__device__ __forceinline__ void sgu_sample_unit(const Params& p, LAS unsigned char* lds, int b, int tid, int wave, int lane) {
    const bf16* PROJ = (const bf16*)(p.ws + W_PROJ); bf16* AO = (bf16*)(p.ws + W_AO);
    LAS float* red = (LAS float*)lds;
    const int c = tid, g = c >> 7; const size_t rs = (size_t)MP + 8 * b;
    float x[8], st[16];
#pragma unroll
    for (int j = 0; j < 8; ++j) { x[j] = bf1(PROJ[(rs + j) * 1536 + 512 + c]); st[j] = wave_sum(x[j]); st[8 + j] = wave_sum(x[j] * x[j]); }
    if (lane == 0) {
#pragma unroll
        for (int j = 0; j < 16; ++j) red[wave * 16 + j] = st[j]; }
    __syncthreads();
    float v[8]; const float gn = p.in[I_ABVG][c];
#pragma unroll
    for (int j = 0; j < 8; ++j) { float s = 0.f, q = 0.f;
#pragma unroll
        for (int w = 0; w < 8; ++w) { s += red[w * 16 + j]; q += red[w * 16 + 8 + j]; }
        const float mean = s * (1.f / 512.f), var = fmaxf(q * (1.f / 512.f) - mean * mean, 0.f);
        v[j] = (x[j] - mean) * rsqrtf(var + EPS) * gn;
        p.out[O_CHV + ((size_t)b * 8 + j) * 512 + c] = v[j]; }
    const float* wsg = p.in[I_ABWS] + (size_t)g * 128 * 128;
#pragma unroll
    for (int i = 0; i < 8; ++i) { float sg = p.in[I_ABBS][g * 128 + i];
#pragma unroll
        for (int j = 0; j < 8; ++j) if (j <= i) sg += wsg[i * 128 + j] * v[j];
        AO[(rs + i) * 1024 + c] = (bf16)f2bf(bf1(PROJ[(rs + i) * 1536 + c]) * sg); }
    float pe[24];
    pe[0] = 0.f;
#pragma unroll
    for (int k = 0; k < 15; ++k) pe[1 + k] = p.in[I_CPOOL][((size_t)b * 15 + k) * 512 + c];
#pragma unroll
    for (int i = 0; i < 8; ++i) pe[16 + i] = bf1(PROJ[(rs + i) * 1536 + 1024 + c]);
    const int W = 2 << g; const float invW = __builtin_amdgcn_rcpf((float)W);
#pragma unroll
    for (int i = 0; i < 8; ++i) { float s = 0.f;
#pragma unroll
        for (int kk = 0; kk < 16; ++kk) if (kk < W) s += pe[16 + i - kk];
        AO[(rs + i) * 1024 + 512 + c] = (bf16)f2bf(s * invW - pe[16 + i]); }
#pragma unroll
    for (int k = 0; k < 15; ++k) p.out[O_POOLS + ((size_t)b * 15 + k) * 512 + c] = pe[9 + k];
    __syncthreads();
}

constexpr int SWA_KS = 72, SWA_VS = 72, SWA_VOFF = 256 * SWA_KS * 2;
template <bool SAMPLE>
__device__ __forceinline__ void swa_unit(const Params& p, LAS unsigned char* lds, int unit, int tid, int wave, int lane) {
    const bf16* Q = (const bf16*)(p.ws + W_PROJ); const float* KV = (const float*)(p.ws + W_KV32); bf16* AO = (bf16*)(p.ws + W_AO);
    LAS bf16* Kl = (LAS bf16*)lds; LAS bf16* Vt = (LAS bf16*)(lds + SWA_VOFF);
    int b, kvh, nb;
    if (!SAMPLE) { nb = unit & 63; kvh = (unit >> 6) & 3; b = unit >> 8; } else { kvh = unit & 3; b = unit >> 2; nb = 0; }
    constexpr int NKEY = SAMPLE ? 160 : 256;
    {
        const int sub = tid & 7;
        float kg[8]; pg8::ld8f(p.in[I_CKG] + 8 * sub, kg);
        constexpr int NIT = SAMPLE ? 3 : 4;
        float kk[NIT][8], vv[NIT][8];
#pragma unroll
        for (int it = 0; it < NIT; ++it) { const int s = (tid >> 3) + 64 * it;
            const float* kp = nullptr; const float* vp = nullptr;
            if (!SAMPLE) { const int trel = (nb - 1) * 128 + s;
                if (trel >= 0) { kp = KV + ((size_t)b * 8192 + trel) * 512 + kvh * 64 + sub * 8; vp = kp + 256; } }
            else { if (s < 128) { const size_t o = (((size_t)b * 128 + s) * 4 + kvh) * 64 + sub * 8; kp = p.in[I_CSK] + o; vp = p.in[I_CSV] + o; }
                else if (s < 136) { kp = KV + ((size_t)MP + 8 * b + (s - 128)) * 512 + kvh * 64 + sub * 8; vp = kp + 256; } }
            if (kp) { if (SAMPLE) { pg8::ld8f_nt(kp, kk[it]); pg8::ld8f_nt(vp, vv[it]); } else { pg8::ld8f(kp, kk[it]); pg8::ld8f(vp, vv[it]); } } else { pg8::zero8(kk[it]); pg8::zero8(vv[it]); } }
#pragma unroll
        for (int it = 0; it < NIT; ++it) { const int s = (tid >> 3) + 64 * it;
            __builtin_amdgcn_sched_barrier(0);
            if (s < NKEY) {
            bool norm; float pos;
            if (!SAMPLE) { const int trel = (nb - 1) * 128 + s; norm = trel >= 0; pos = (float)trel; }
            else { norm = (s >= 128 && s < 136); pos = (float)(16384 + s - 128); }
            float (&k)[8] = kk[it]; float (&v)[8] = vv[it];
            asm volatile("" : "+v"(pos));
            if (norm) { float ss = 0.f;
#pragma unroll
                for (int e = 0; e < 8; ++e) ss += k[e] * k[e];
                ss += __shfl_xor(ss, 1); ss += __shfl_xor(ss, 2); ss += __shfl_xor(ss, 4);
                const float rs = rsqrtf(ss * (1.f / 64.f) + EPS);
#pragma unroll
                for (int e = 0; e < 8; ++e) k[e] *= rs * kg[e];
#pragma unroll
                for (int e = 0; e < 8; ++e) { const float pk = __shfl_xor(k[e], 1); float cs, sn; rope_cs(pos, e, cs, sn);
                    if (sub == 0) k[e] = k[e] * cs - pk * sn; else if (sub == 1) k[e] = k[e] * cs + pk * sn; }
            }
            *(LAS bf16x8*)(Kl + s * SWA_KS + sub * 8) = pack8(k);
            *(LAS bf16x8*)(Vt + s * SWA_VS + sub * 8) = pack8(v);
            if (!SAMPLE) { if (nb == 63 && s >= 128) { const size_t o = (((size_t)b * 128 + (s - 128)) * 4 + kvh) * 64 + sub * 8;
                    *(f32x4*)(p.out + O_SKP + o) = (f32x4){k[0], k[1], k[2], k[3]}; *(f32x4*)(p.out + O_SKP + o + 4) = (f32x4){k[4], k[5], k[6], k[7]};
                    *(f32x4*)(p.out + O_SVP + o) = (f32x4){v[0], v[1], v[2], v[3]}; *(f32x4*)(p.out + O_SVP + o + 4) = (f32x4){v[4], v[5], v[6], v[7]}; } }
            else { if (s >= 8 && s < 136) { const size_t o = (((size_t)b * 128 + (s - 8)) * 4 + kvh) * 64 + sub * 8;
                    *(f32x4*)(p.out + O_SKS + o) = (f32x4){k[0], k[1], k[2], k[3]}; *(f32x4*)(p.out + O_SKS + o + 4) = (f32x4){k[4], k[5], k[6], k[7]};
                    *(f32x4*)(p.out + O_SVS + o) = (f32x4){v[0], v[1], v[2], v[3]}; *(f32x4*)(p.out + O_SVS + o + 4) = (f32x4){v[4], v[5], v[6], v[7]}; } }
            }
        }
    }
    __syncthreads();
    constexpr int NPASS = SAMPLE ? 1 : 4;
    if (!SAMPLE || wave < 2) {
        asm volatile("" : "+v"(lane));
        float rc[8], rsn[8];
        { const int q16 = lane & 15; const float pos0 = SAMPLE ? (float)(16384 + (q16 & 7)) : (float)(nb * 128 + 16 * wave + q16);
#pragma unroll
          for (int e = 0; e < 8; ++e) rope_cs(pos0, e, rc[e], rsn[e]); }
        float qgs[2][8];
        {
#pragma unroll
          for (int dc = 0; dc < 2; ++dc) { pg8::ld8f(p.in[I_CQG] + 32 * dc + 8 * (lane >> 4), qgs[dc]);
#pragma unroll
            for (int e = 0; e < 8; ++e) qgs[dc][e] *= 0.125f; } }
        v4u qraw[2];
        { const int q16 = lane & 15, kq = lane >> 4;
          const size_t row0 = SAMPLE ? (size_t)MP + 8 * b + (q16 & 7) : (size_t)b * 8192 + nb * 128 + 16 * wave + q16;
          const int h0 = kvh * 4 + (SAMPLE ? 2 * wave + (q16 >> 3) : 0);
#pragma unroll
          for (int dc = 0; dc < 2; ++dc) qraw[dc] = *(const v4u*)(Q + row0 * 1024 + h0 * 64 + 32 * dc + 8 * kq); }
#pragma unroll 1
        for (int ps = 0; ps < NPASS; ++ps) {
            int q16 = lane & 15, kq = lane >> 4; asm volatile("" : "+v"(q16), "+v"(kq));
            int g, i, c0; size_t row; float pos;
            if (!SAMPLE) { g = ps; i = 16 * wave + q16; row = (size_t)b * 8192 + nb * 128 + i; pos = (float)(nb * 128 + i); c0 = wave >> 1; }
            else { g = 2 * wave + (q16 >> 3); i = q16 & 7; row = (size_t)MP + 8 * b + i; pos = (float)(16384 + i); c0 = 0; }
            const int h = kvh * 4 + g;
            float qv[2][8];
#pragma unroll
            for (int dc = 0; dc < 2; ++dc) unpack8(qraw[dc], qv[dc]);
            if (!SAMPLE && ps + 1 < NPASS) {
#pragma unroll
                for (int dc = 0; dc < 2; ++dc) qraw[dc] = *(const v4u*)(Q + row * 1024 + (h + 1) * 64 + 32 * dc + 8 * kq); }
            float ss = 0.f;
#pragma unroll
            for (int dc = 0; dc < 2; ++dc)
#pragma unroll
                for (int e = 0; e < 8; ++e) ss += qv[dc][e] * qv[dc][e];
            ss += __shfl_xor(ss, 16); ss += __shfl_xor(ss, 32);
            const float rs = rsqrtf(ss * (1.f / 64.f) + EPS);
#pragma unroll
            for (int dc = 0; dc < 2; ++dc) {
#pragma unroll
                for (int e = 0; e < 8; ++e) qv[dc][e] *= rs * qgs[dc][e]; }
#pragma unroll
            for (int e = 0; e < 8; ++e) { const float pk = __shfl_xor(qv[0][e], 16); const float cs = rc[e], sn = rsn[e];
                if (kq == 0) qv[0][e] = qv[0][e] * cs - pk * sn; else if (kq == 1) qv[0][e] = qv[0][e] * cs + pk * sn; }
            bf16x8 qf[2];
#pragma unroll
            for (int dc = 0; dc < 2; ++dc) qf[dc] = pack8(qv[dc]);
            f32x4 S[5][2];
            const float sink = p.in[I_CSINK][h];
            float mx = sink;
#pragma unroll
            for (int cc = 0; cc < 5; ++cc)
#pragma unroll
                for (int tt = 0; tt < 2; ++tt) { const int kb = 32 * (c0 + cc) + 16 * tt; f32x4 a = (f32x4){0.f, 0.f, 0.f, 0.f};
#pragma unroll
                    for (int dc = 0; dc < 2; ++dc) { const bf16x8 kf = *(const LAS bf16x8*)(Kl + (kb + q16) * SWA_KS + 32 * dc + 8 * kq);
                        a = __builtin_amdgcn_mfma_f32_16x16x32_bf16(kf, qf[dc], a, 0, 0, 0); }
                    const int rel = (kb >> 4) - wave;
                    const bool full = !SAMPLE && rel >= 1 && rel <= 7 && (nb > 0 || kb >= 128);
                    if (!full) {
#pragma unroll
                        for (int e = 0; e < 4; ++e) { const int s = kb + 4 * kq + e; const bool ok = (s > i) && (s <= i + 128) && (SAMPLE || nb > 0 || s >= 128);
                            a[e] = ok ? a[e] : -INFINITY; } }
#pragma unroll
                    for (int e = 0; e < 4; ++e) mx = fmaxf(mx, a[e]);
                    S[cc][tt] = a; }
            mx = fmaxf(mx, __shfl_xor(mx, 16)); mx = fmaxf(mx, __shfl_xor(mx, 32));
            float den = 0.f;
#pragma unroll
            for (int cc = 0; cc < 5; ++cc)
#pragma unroll
                for (int tt = 0; tt < 2; ++tt)
#pragma unroll
                    for (int e = 0; e < 4; ++e) { const float pe = __expf(S[cc][tt][e] - mx); S[cc][tt][e] = pe; den += pe; }
            den += __shfl_xor(den, 16); den += __shfl_xor(den, 32);
            den += __expf(sink - mx);
            const float rden = 1.f / den;
            bf16x8 pf[5];
#pragma unroll
            for (int cc = 0; cc < 5; ++cc) { float t8[8];
#pragma unroll
                for (int e = 0; e < 4; ++e) { t8[e] = S[cc][0][e]; t8[4 + e] = S[cc][1][e]; }
                pf[cc] = pack8(t8); }
#pragma unroll
            for (int dt = 0; dt < 4; ++dt) { f32x4 o = (f32x4){0.f, 0.f, 0.f, 0.f};
#pragma unroll
                for (int cc = 0; cc < 5; ++cc) { const LAS bf16* vp = Vt + (32 * (c0 + cc) + 4 * kq + (q16 >> 2)) * SWA_VS + 16 * dt + 4 * (q16 & 3);
                    const v2u lo = vtr(vp), hi = vtr(vp + 16 * SWA_VS);
                    v4u av; av.x = lo.x; av.y = lo.y; av.z = hi.x; av.w = hi.y;
                    o = __builtin_amdgcn_mfma_f32_16x16x32_bf16(__builtin_bit_cast(bf16x8, av), pf[cc], o, 0, 0, 0); }
                v2u w; w.x = pk2(o[0] * rden, o[1] * rden); w.y = pk2(o[2] * rden, o[3] * rden);
                *(v2u*)(AO + row * 1024 + h * 64 + 16 * dt + 4 * kq) = w; }
        }
    }
    __syncthreads();
}

constexpr int MEM_KS = 136, MEM_VS = 136, MEM_VOFF = 256 * MEM_KS * 2;
static_assert(MEM_VOFF + 256 * MEM_VS * 2 <= LDS_CTL_OFF && 128 * SG_VS * 2 <= LDS_CTL_OFF, "LDS");
template <bool SAMPLE>
__device__ __forceinline__ void mem_unit(const Params& p, int l, LAS unsigned char* lds, int unit, int tid, int wave, int lane) {
    const bf16* MQ = (const bf16*)(p.ws + W_MQ); bf16* MO = (bf16*)(p.ws + W_MO);
    LAS bf16* Kl = (LAS bf16*)lds; LAS bf16* Vt = (LAS bf16*)(lds + MEM_VOFF);
    int b, h, qt;
    if (!SAMPLE) { qt = unit & 15; h = (unit >> 4) & 3; b = unit >> 6; } else { h = unit & 3; b = unit >> 2; qt = 0; }
    {
        const int sub = tid & 15;
        float kg[8]; pg8::ld8f(p.in[I_MKG] + l * 128 + 8 * sub, kg);
#pragma unroll 1
        for (int hb = 0; hb < 2; ++hb) {
            float kk[4][8], vv[4][8];
#pragma unroll
            for (int it = 0; it < 4; ++it) { const int s = (tid >> 4) + 32 * (4 * hb + it);
                const float* kp; const float* vp;
                if (!SAMPLE) { kp = (const float*)(p.ws + W_MKV) + ((size_t)l * 1024 + b * 256 + s) * 1024 + h * 128 + sub * 8; vp = kp + 512; }
                else { const size_t o = ((((size_t)l * 128 + b) * 256 + s) * 4 + h) * 128 + sub * 8; kp = p.in[I_CMK] + o; vp = p.in[I_CMV] + o; }
                if (SAMPLE) { pg8::ld8f_nt(kp, kk[it]); pg8::ld8f_nt(vp, vv[it]); } else { pg8::ld8f(kp, kk[it]); pg8::ld8f(vp, vv[it]); } }
#pragma unroll
            for (int it = 0; it < 4; ++it) { const int s = (tid >> 4) + 32 * (4 * hb + it);
                float (&k)[8] = kk[it]; float (&v)[8] = vv[it];
                if (!SAMPLE) { float ss = 0.f;
#pragma unroll
                    for (int e = 0; e < 8; ++e) ss += k[e] * k[e];
                    ss += __shfl_xor(ss, 1); ss += __shfl_xor(ss, 2); ss += __shfl_xor(ss, 4); ss += __shfl_xor(ss, 8);
                    const float rs = rsqrtf(ss * (1.f / 128.f) + EPS);
#pragma unroll
                    for (int e = 0; e < 8; ++e) k[e] *= rs * kg[e];
                    if (qt == 0) { const size_t o = ((((size_t)l * 4 + b) * 256 + s) * 4 + h) * 128 + sub * 8;
                        *(f32x4*)(p.out + O_MKP + o) = (f32x4){k[0], k[1], k[2], k[3]}; *(f32x4*)(p.out + O_MKP + o + 4) = (f32x4){k[4], k[5], k[6], k[7]};
                        *(f32x4*)(p.out + O_MVP + o) = (f32x4){v[0], v[1], v[2], v[3]}; *(f32x4*)(p.out + O_MVP + o + 4) = (f32x4){v[4], v[5], v[6], v[7]}; }
                }
                *(LAS bf16x8*)(Kl + s * MEM_KS + sub * 8) = pack8(k);
                *(LAS bf16x8*)(Vt + s * MEM_VS + sub * 8) = pack8(v);
            }
        }
    }
    __syncthreads();
    if (!SAMPLE || wave == 0) {
#pragma unroll 1
      for (int qq = 0; qq < (SAMPLE ? 1 : 4); ++qq) {
        int q16 = lane & 15, kq = lane >> 4; asm volatile("" : "+v"(q16), "+v"(kq));
        size_t row; bool st;
        if (!SAMPLE) { row = (size_t)b * 8192 + (qt * 4 + qq) * 128 + 16 * wave + q16; st = true; } else { row = (size_t)MP + 8 * b + (q16 & 7); st = q16 < 8; }
        bf16x8 qf[4];
        {
            float qv[4][8]; float ss = 0.f;
#pragma unroll
            for (int dc = 0; dc < 4; ++dc) { unpack8(*(const v4u*)(MQ + row * 512 + h * 128 + 32 * dc + 8 * kq), qv[dc]);
#pragma unroll
                for (int e = 0; e < 8; ++e) ss += qv[dc][e] * qv[dc][e]; }
            ss += __shfl_xor(ss, 16); ss += __shfl_xor(ss, 32);
            const float rs = rsqrtf(ss * (1.f / 128.f) + EPS) * 0.08838834764831845f;
#pragma unroll
            for (int dc = 0; dc < 4; ++dc) { float qg[8]; pg8::ld8f(p.in[I_MQG] + l * 128 + 32 * dc + 8 * kq, qg);
#pragma unroll
                for (int e = 0; e < 8; ++e) qv[dc][e] *= rs * qg[e];
                qf[dc] = pack8(qv[dc]); }
        }
        f32x4 S[8][2]; float mx = -INFINITY;
#pragma unroll
        for (int cc = 0; cc < 8; ++cc)
#pragma unroll
            for (int tt = 0; tt < 2; ++tt) { const int kb = 32 * cc + 16 * tt; f32x4 a = (f32x4){0.f, 0.f, 0.f, 0.f};
#pragma unroll
                for (int dc = 0; dc < 4; ++dc) { const bf16x8 kf = *(const LAS bf16x8*)(Kl + (kb + q16) * MEM_KS + 32 * dc + 8 * kq);
                    a = __builtin_amdgcn_mfma_f32_16x16x32_bf16(kf, qf[dc], a, 0, 0, 0); }
#pragma unroll
                for (int e = 0; e < 4; ++e) mx = fmaxf(mx, a[e]);
                S[cc][tt] = a; }
        mx = fmaxf(mx, __shfl_xor(mx, 16)); mx = fmaxf(mx, __shfl_xor(mx, 32));
        float den = 0.f;
#pragma unroll
        for (int cc = 0; cc < 8; ++cc)
#pragma unroll
            for (int tt = 0; tt < 2; ++tt)
#pragma unroll
                for (int e = 0; e < 4; ++e) { const float pe = __expf(S[cc][tt][e] - mx); S[cc][tt][e] = pe; den += pe; }
        den += __shfl_xor(den, 16); den += __shfl_xor(den, 32);
        const float rden = 1.f / den;
        bf16x8 pf[8];
#pragma unroll
        for (int cc = 0; cc < 8; ++cc) { float t8[8];
#pragma unroll
            for (int e = 0; e < 4; ++e) { t8[e] = S[cc][0][e]; t8[4 + e] = S[cc][1][e]; }
            pf[cc] = pack8(t8); }
#pragma unroll
        for (int dt = 0; dt < 8; ++dt) { f32x4 o = (f32x4){0.f, 0.f, 0.f, 0.f};
#pragma unroll
            for (int cc = 0; cc < 8; ++cc) { const LAS bf16* vp = Vt + (32 * cc + 4 * kq + (q16 >> 2)) * MEM_VS + 16 * dt + 4 * (q16 & 3);
                const v2u lo = vtr(vp), hi = vtr(vp + 16 * MEM_VS);
                v4u av; av.x = lo.x; av.y = lo.y; av.z = hi.x; av.w = hi.y;
                o = __builtin_amdgcn_mfma_f32_16x16x32_bf16(__builtin_bit_cast(bf16x8, av), pf[cc], o, 0, 0, 0); }
            if (st) { v2u w; w.x = pk2(o[0] * rden, o[1] * rden); w.y = pk2(o[2] * rden, o[3] * rden);
                *(v2u*)(MO + row * 512 + h * 128 + 16 * dt + 4 * kq) = w; } }
      }
    }
    __syncthreads();
}

#ifndef REP_LIGHT
#define REP_LIGHT 1
#endif
#ifndef REP_G9
#define REP_G9 1
#endif
#ifndef REP_G10
#define REP_G10 1
#endif
#ifndef REP_PRO
#define REP_PRO 1
#endif
#ifndef REP_MEM
#define REP_MEM 1
#endif
#ifndef REP_P15
#define REP_P15 1
#endif
#ifndef REP_SYNC
#define REP_SYNC 1
#endif
#define GSYNC() do { for (int r_ = 0; r_ < REP_SYNC; ++r_) xcd_barrier(xbar); } while (0)
#define PHASE_IDS int t_ = threadIdx.x; asm volatile("" : "+v"(t_)); const int tid = t_, lane = tid & 63, wave = __builtin_amdgcn_readfirstlane(tid >> 6); const int gw = bx * NWAVES + wave; (void)gw; (void)lane; (void)tid;
__global__ void __launch_bounds__(NTHR, 2) fwd_megakernel(Params p) {
    extern __shared__ __attribute__((aligned(16))) unsigned char lds_raw[];
    LAS unsigned char* lds = (LAS unsigned char*)lds_raw;
    cg::grid_group grid = cg::this_grid();
    const int G = gridDim.x, bx = blockIdx.x;
    const int wave0 = __builtin_amdgcn_readfirstlane((int)threadIdx.x >> 6);
    const int ngw = G * NWAVES;
    unsigned char* ws = p.ws;
    bf16* XN = (bf16*)(ws + W_XN);
    float* SSb = (float*)(ws + W_SS);
    float* X = p.out;
    typedef pg8::bf16_t pb;

    if (threadIdx.x < 16) ((LAS unsigned*)(lds + LDS_CTL_OFF))[threadIdx.x] = 0u;
    __syncthreads();
    const XcdBarrier xbar = xcd_barrier_post((unsigned*)(ws + W_CTL), (volatile LAS unsigned*)(lds + LDS_CTL_OFF));
    for (int rep = 0; rep < REP_LIGHT * REP_PRO; ++rep) { PHASE_IDS prologue(p, lds, gw, ngw, wave, lane); }
    grid.sync();

    auto layer_body = [&](auto LC) __attribute__((always_inline)) {
        constexpr int l = decltype(LC)::value;
        unsigned char* wl = ws + W_LAYER + (size_t)l * WL_SIZE;
        if (l == 0) {
            { pg8::Gemm g{(const pb*)XN, (const pb*)(ws + W_WIN), MT, 1536, 1024}; pg8::StaticOrder S; S.init(MP, 1536, G, bx);
              pg8::EpiAct E{(pb*)(ws + W_PROJ), 1536, 4, SSb};
              pg8::gemm_phase<pg8::EpiAct, pg8::StaticOrder, true, true>(lds, g, S, E, wave0);
              pg8::mini_gemm(lds, g.A, g.Bt, 1024, 12, E, bx, G, wave0); }
#pragma unroll 1
            for (int ll = 0; ll < 2; ++ll) {
              pg8::EpiRes E{(float*)(ws + W_MKV) + (size_t)ll * 1024 * 1024, nullptr, nullptr, 0, nullptr, nullptr, 0};
              pg8::mini_gemm(lds, (const pb*)(ws + W_MN) + (size_t)ll * 1024 * 1024, (const pb*)(ws + W_LAYER + (size_t)ll * WL_SIZE + WL_WKV), 1024, 8, E, (bx + G - 96 - 64 * ll) % G, G, wave0, 0); }
        } else {
            pg8::Gemm g{(const pb*)XN, (const pb*)(ws + W_WQKV), MT, 1536, 1024}; pg8::StaticOrder S; S.init(MP, 1536, G, bx);
            pg8::EpiQKV E{(pb*)(ws + W_PROJ), (float*)(ws + W_KV32), SSb + (size_t)3 * MT};
            pg8::gemm_phase<pg8::EpiQKV, pg8::StaticOrder, true, true>(lds, g, S, E, wave0);
            pg8::mini_gemm(lds, g.A, g.Bt, 1024, 12, E, bx, G, wave0);
        }
        GSYNC();
        if (l == 0) {
#ifndef NO_SGU
            PHASE_IDS
            for (int rep = 0; rep < REP_LIGHT; ++rep)
            for (int u = bx; u < 256 + 128; u += G) { if (u < 256) sgu_prompt_unit(p, lds, u, tid, wave, lane); else sgu_sample_unit(p, lds, u - 256, tid, wave, lane); }
#endif
        } else {
#ifndef NO_SWA
            PHASE_IDS
            for (int rep = 0; rep < REP_LIGHT; ++rep)
            for (int u = bx; u < 1024 + 512; u += G) { if (u < 1024) swa_unit<false>(p, lds, u, tid, wave, lane); else swa_unit<true>(p, lds, u - 1024, tid, wave, lane); }
#endif
        }
        GSYNC();
        {
            pg8::Gemm g{(const pb*)(ws + W_AO), (const pb*)(ws + (l == 0 ? W_WOUT : W_CWO)), MT, 1024, 1024}; pg8::StaticOrder S; S.init(MP, 1024, G, bx);
            pg8::EpiRes E{nullptr, nullptr, nullptr, 1, (pb*)XN, SSb + (size_t)(1 + 3 * l) * MT, 1};
            pg8::gemm_phase<pg8::EpiRes, pg8::StaticOrder, true, true>(lds, g, S, E, wave0);
            pg8::mini_gemm(lds, g.A, g.Bt, 1024, 8, E, bx, G, wave0);
        }
        GSYNC();
        {
            pg8::Gemm g{(const pb*)XN, (const pb*)(wl + WL_WQ), MT, 512, 1024}; pg8::StaticOrder S; S.init(MP, 512, G, bx);
            pg8::EpiAct E{(pb*)(ws + W_MQ), 512, 0, SSb + (size_t)(1 + 3 * l) * MT};
            pg8::gemm_phase<pg8::EpiAct, pg8::StaticOrder, true, true>(lds, g, S, E, wave0);
            pg8::mini_gemm(lds, g.A, g.Bt, 1024, 4, E, bx, G, wave0);
        }
        GSYNC();
#ifndef NO_MEM
        { PHASE_IDS
        for (int rep = 0; rep < REP_LIGHT * REP_MEM; ++rep)
        for (int u = bx; u < 256 + 512; u += G) { if (u < 256) mem_unit<false>(p, l, lds, u, tid, wave, lane); else mem_unit<true>(p, l, lds, u - 256, tid, wave, lane); } }
#endif
        GSYNC();
        {
            pg8::Gemm g{(const pb*)(ws + W_MO), (const pb*)(wl + WL_WO), MT, 1024, 512}; pg8::StaticOrder S; S.init(MP, 1024, G, bx);
            pg8::EpiRes E{nullptr, nullptr, nullptr, 1, (pb*)XN, SSb + (size_t)(2 + 3 * l) * MT, 1};
            pg8::gemm_phase<pg8::EpiRes, pg8::StaticOrder, true, true>(lds, g, S, E, wave0);
            pg8::mini_gemm(lds, g.A, g.Bt, 512, 8, E, bx, G, wave0);
        }
        GSYNC();
        {
            pg8::Gemm g{(const pb*)XN, (const pb*)(wl + WL_WUP), MT, DFF, 1024}; pg8::SplitOrder S; S.init(DFF, G, bx);
            pg8::EpiG E{(pb*)(ws + W_G), p.out + O_FCP + (size_t)l * 4 * 2 * DFF, p.out + O_FCS + (size_t)l * 128 * 2 * DFF, SSb + (size_t)(2 + 3 * l) * MT};
            for (int rep = 0; rep < REP_G9; ++rep) pg8::gemm_phase<pg8::EpiG, pg8::SplitOrder, true, true>(lds, g, S, E, wave0);
        }
        GSYNC();
        {
            pg8::Gemm g{(const pb*)XN, (const pb*)(wl + WL_WUP) + (size_t)DFF * 1024, MT, DFF, 1024}; pg8::SplitOrder S; S.init(DFF, G, bx);
            pg8::EpiH E{(const pb*)(ws + W_G), (pb*)(ws + W_H), p.in[I_FCW] + (size_t)l * 3 * DFF, p.in[I_FCB] + (size_t)l * DFF, p.in[I_CFC] + (size_t)l * 128 * 2 * DFF, SSb + (size_t)(2 + 3 * l) * MT};
            for (int rep = 0; rep < REP_G10; ++rep) pg8::gemm_phase<pg8::EpiH, pg8::SplitOrder, true, true>(lds, g, S, E, wave0);
        }
        GSYNC();
        {
            pg8::Gemm g{(const pb*)(ws + W_H), (const pb*)(wl + WL_WDN), MT, 1024, DFF}; pg8::StaticOrder S; S.init(MP, 1024, G, bx);
            pg8::EpiRes E{l == 0 ? nullptr : X, nullptr, nullptr, 1, (pb*)XN, SSb + (size_t)3 * MT, l == 0};
            pg8::gemm_phase<pg8::EpiRes, pg8::StaticOrder, true, true>(lds, g, S, E, wave0);
            pg8::mini_gemm(lds, g.A, g.Bt, DFF, 8, E, bx, G, wave0);
        }
        GSYNC();
    };
    layer_body(std::integral_constant<int, 0>{});
    layer_body(std::integral_constant<int, 1>{});
}

extern "C" void kernel_launch(void* const* d_in, const int* in_sizes, int n_in, void* d_out, int out_size, void* d_ws, size_t ws_size, hipStream_t stream) {
    static int grid_blocks = 0;
    if (grid_blocks == 0) {
        if (n_in != N_IN || (size_t)out_size != O_END || ws_size < W_NEED) { fprintf(stderr, "kernel_launch: unexpected shapes: n_in %d out %d ws %zu (need %zu)\n", n_in, out_size, ws_size, (size_t)W_NEED); grid_blocks = -1; return; }
        int dev = 0, cus = 0, per_cu = 0;
        hipGetDevice(&dev);
        hipDeviceGetAttribute(&cus, hipDeviceAttributeMultiprocessorCount, dev);
        if (hipFuncSetAttribute((const void*)fwd_megakernel, hipFuncAttributeMaxDynamicSharedMemorySize, LDS_BYTES) != hipSuccess) { fprintf(stderr, "kernel_launch: hipFuncSetAttribute failed\n"); grid_blocks = -1; return; }
        if (hipOccupancyMaxActiveBlocksPerMultiprocessor(&per_cu, (const void*)fwd_megakernel, NTHR, LDS_BYTES) != hipSuccess || per_cu < 1) { fprintf(stderr, "kernel_launch: occupancy query failed (%d)\n", per_cu); (void)hipGetLastError(); grid_blocks = -1; return; }
        grid_blocks = cus * per_cu;
    }
    if (grid_blocks < 0) return;
    if (hipMemsetAsync((char*)d_ws + W_CTL, 0, CTL_BYTES, stream) != hipSuccess) { fprintf(stderr, "kernel_launch: memset failed\n"); return; }
    Params p{};
    for (int i = 0; i < N_IN; ++i) p.in[i] = (const float*)d_in[i];
    p.out = (float*)d_out; p.ws = (unsigned char*)d_ws;
    void* args[] = {&p};
    hipError_t e = hipLaunchCooperativeKernel((const void*)fwd_megakernel, dim3(grid_blocks), dim3(NTHR), args, LDS_BYTES, stream);
    if (e != hipSuccess) fprintf(stderr, "cooperative launch failed: %s (grid %d)\n", hipGetErrorString(e), grid_blocks);
}
```

```cpp
#include <hip/hip_runtime.h>
#include <hip/hip_cooperative_groups.h>
#include <cstdio>
#include <cstdint>
#include <type_traits>
namespace cg = cooperative_groups;
namespace pg8 {
#define PG8_LAS __attribute__((address_space(3)))
typedef unsigned short bf16_t;
typedef short bf16x8 __attribute__((ext_vector_type(8)));
typedef float f32x4 __attribute__((ext_vector_type(4)));
typedef unsigned u32x4 __attribute__((ext_vector_type(4)));
constexpr int BM = 256, BK = 64, HALF = 128, HTB = HALF * BK * 2  , STAGE_BYTES = 8 * HTB, NXCD = 8, WGM = 8;

__host__ __device__ __forceinline__ int lds_byte(int r, int c) { const int st = (r >> 4) * 2 + (c >> 5), rr = r & 15, cc = c & 31, ob = rr * 64 + cc * 2; return st * 1024 + (ob ^ (((ob >> 9) & 1) << 5)); }
__host__ __device__ __forceinline__ void stage_rc(int b, int& R, int& C) { const int st = b / 1024, sb = b % 1024, swz = sb ^ (((sb >> 9) & 1) << 5); R = (st >> 1) * 16 + swz / 64; C = (st & 1) * 32 + (swz % 64) / 2; }
__host__ __device__ __forceinline__ int perm32(int rho) { const int n = rho >> 4, i = rho & 15; return 8 * (i >> 2) + 4 * n + (i & 3); }

struct Unit { int pm, pn; int rb; int half; int q; int cb; };
struct Gemm { const bf16_t* A; const bf16_t* Bt; int M, N, K; };

struct StaticOrder {
    int nM, nN, nwg, G, c;
    __host__ __device__ void init(int M, int N, int G_, int c_) { nM = M / BM; nN = N / BM; nwg = nM * nN; G = G_; c = c_; }
    __host__ __device__ bool next(int i, Unit& u) const {
        const long L = (long)i * G + c; if (L >= nwg) return false;
        int wgid = (int)L; { const int q = nwg / NXCD, r = nwg % NXCD, xcd = wgid % NXCD, off = wgid / NXCD; wgid = (xcd < r ? xcd * (q + 1) : r * (q + 1) + (xcd - r) * q) + off; }
        const int nig = WGM * nN, gid = wgid / nig, fm = gid * WGM, gsz = (nM - fm) < WGM ? (nM - fm) : WGM;
        u.pm = fm + ((wgid % nig) % gsz); u.pn = (wgid % nig) / gsz; u.rb = u.pm * BM; u.half = 0; u.q = 0; u.cb = u.pn * BM; return true;
    }
    __device__ __forceinline__ void a_ready(const Unit&) const {}
    __device__ __forceinline__ void done(const Unit&) const {}
};
struct SplitOrder {
    StaticOrder P; int nP, nS, nN, G, c;
    __host__ __device__ void init(int N, int G_, int c_) { P.init(32768, N, G_, c_); nP = P.nwg; nN = N / BM; nS = 8 * nN; G = G_; c = c_; }
    __host__ __device__ bool next(int i, Unit& u) const {
        const long L = (long)i * G + c;
        if (L < nP) return P.next(i, u);
        const int j = (int)(L - nP); if (j >= nS) return false;
        const int hm = j & 7; u.pn = j >> 3; u.pm = 128 + (hm >> 1); u.rb = 32768 + 128 * hm; u.half = 1; u.q = 0; u.cb = u.pn * BM; return true;
    }
    __device__ __forceinline__ void a_ready(const Unit&) const {}
    __device__ __forceinline__ void done(const Unit&) const {}
};


__device__ __forceinline__ unsigned cvt_pk_bf16(float lo, float hi) { unsigned r; asm volatile("v_cvt_pk_bf16_f32 %0, %1, %2" : "=v"(r) : "v"(lo), "v"(hi)); return r; }
typedef float f32x2 __attribute__((ext_vector_type(2)));
__device__ __forceinline__ f32x2 gelu_pk(f32x2 v) {
    f32x2 x = v * 0.70710678118f;
    x.x = __builtin_amdgcn_fmed3f(x.x, -2.9f, 2.9f); x.y = __builtin_amdgcn_fmed3f(x.y, -2.9f, 2.9f);
    const f32x2 t = x * x;
    f32x2 p = t * (-4.953124630e-07f) + 1.987094038e-05f;
    p = p * t + (-3.472001117e-04f); p = p * t + 3.517547622e-03f; p = p * t + (-2.333305031e-02f); p = p * t + 1.087993085e-01f; p = p * t + (-3.740358949e-01f); p = p * t + 1.128076553e+00f;
    const f32x2 hv = v * 0.5f;
    return hv * (x * p) + hv;
}

__device__ __forceinline__ float bf_lo(unsigned w) { return __builtin_bit_cast(float, w << 16); }
__device__ __forceinline__ float bf_hi(unsigned w) { return __builtin_bit_cast(float, w & 0xffff0000u); }
__device__ __forceinline__ void ld8bf(const bf16_t* p, float (&o)[8]) { const u32x4 w = *(const u32x4*)p;
    o[0] = bf_lo(w.x); o[1] = bf_hi(w.x); o[2] = bf_lo(w.y); o[3] = bf_hi(w.y); o[4] = bf_lo(w.z); o[5] = bf_hi(w.z); o[6] = bf_lo(w.w); o[7] = bf_hi(w.w); }
__device__ __forceinline__ void ld8f(const float* p, float (&o)[8]) { const f32x4 a = *(const f32x4*)p, b = *(const f32x4*)(p + 4);
    o[0] = a[0]; o[1] = a[1]; o[2] = a[2]; o[3] = a[3]; o[4] = b[0]; o[5] = b[1]; o[6] = b[2]; o[7] = b[3]; }
__device__ __forceinline__ void ld8f_nt(const float* p, float (&o)[8]) { const f32x4 a = __builtin_nontemporal_load((const f32x4*)p), b = __builtin_nontemporal_load((const f32x4*)(p + 4));
    o[0] = a[0]; o[1] = a[1]; o[2] = a[2]; o[3] = a[3]; o[4] = b[0]; o[5] = b[1]; o[6] = b[2]; o[7] = b[3]; }
__device__ __forceinline__ void zero8(float (&o)[8]) {
#pragma unroll
    for (int j = 0; j < 8; ++j) o[j] = 0.f; }

struct EpiAct {
    static constexpr bool PERM = true, AFTER_DRAIN = false;
    bf16_t* O; int ldc; int gelu_tiles; const float* SS;
    __device__ __forceinline__ void operator()(const f32x4 (&acc)[2][2][4][2], const Unit& u, int wr, int wc, int fr, int fq) const {
        asm volatile("" : "+v"(fr), "+v"(fq));
        const int row0 = u.rb + wr * 64 + fr, col0 = u.cb + wc * 32 + 8 * fq;
        const bool act = u.pn < gelu_tiles;
        float rsv[2][4];
#pragma unroll
        for (int ai = 0; ai < 2; ++ai)
#pragma unroll
            for (int m = 0; m < 4; ++m) rsv[ai][m] = SS[row0 + (u.half ? 0 : ai * HALF) + m * 16];
#pragma unroll
        for (int ai = 0; ai < 2; ++ai) if (ai == 0 || !u.half)
#pragma unroll
            for (int m = 0; m < 4; ++m) { bf16_t* rowp = O + (size_t)(row0 + ai * HALF + m * 16) * ldc + col0;
                const float rs = rsqrtf(rsv[ai][m] * (1.f / 1024.f) + 1e-6f);
#pragma unroll
                for (int bj = 0; bj < 2; ++bj) if (bj == 0 || !u.q) { f32x4 v0 = acc[ai][bj][m][0] * rs, v1 = acc[ai][bj][m][1] * rs;
                    if (act) { f32x2 a = gelu_pk((f32x2){v0[0], v0[1]}), b = gelu_pk((f32x2){v0[2], v0[3]}), c = gelu_pk((f32x2){v1[0], v1[1]}), d = gelu_pk((f32x2){v1[2], v1[3]});
                        v0 = (f32x4){a.x, a.y, b.x, b.y}; v1 = (f32x4){c.x, c.y, d.x, d.y}; }
                    u32x4 w; w.x = cvt_pk_bf16(v0[0], v0[1]); w.y = cvt_pk_bf16(v0[2], v0[3]); w.z = cvt_pk_bf16(v1[0], v1[1]); w.w = cvt_pk_bf16(v1[2], v1[3]);
                    *(u32x4*)(rowp + bj * HALF) = w; } }
    }
};

struct EpiQKV {
    static constexpr bool PERM = true, AFTER_DRAIN = false;
    bf16_t* Q; float* KV; const float* SS;
    __device__ __forceinline__ void operator()(const f32x4 (&acc)[2][2][4][2], const Unit& u, int wr, int wc, int fr, int fq) const {
        asm volatile("" : "+v"(fr), "+v"(fq));
        const int row0 = u.rb + wr * 64 + fr;
        float rs[2][4];
#pragma unroll
        for (int ai = 0; ai < 2; ++ai) if (ai == 0 || !u.half)
#pragma unroll
            for (int m = 0; m < 4; ++m) rs[ai][m] = rsqrtf(SS[row0 + (u.half ? 0 : ai * HALF) + m * 16] * (1.f / 1024.f) + 1e-6f);
        if (u.pn < 4) {
            const int col0 = u.cb + wc * 32 + 8 * fq;
#pragma unroll
            for (int ai = 0; ai < 2; ++ai) if (ai == 0 || !u.half)
#pragma unroll
                for (int m = 0; m < 4; ++m) { bf16_t* rowp = Q + (size_t)(row0 + ai * HALF + m * 16) * 1024 + col0;
#pragma unroll
                    for (int bj = 0; bj < 2; ++bj) if (bj == 0 || !u.q) { const f32x4 v0 = acc[ai][bj][m][0] * rs[ai][m], v1 = acc[ai][bj][m][1] * rs[ai][m];
                        u32x4 w; w.x = cvt_pk_bf16(v0[0], v0[1]); w.y = cvt_pk_bf16(v0[2], v0[3]); w.z = cvt_pk_bf16(v1[0], v1[1]); w.w = cvt_pk_bf16(v1[2], v1[3]);
                        *(u32x4*)(rowp + bj * HALF) = w; } }
        } else {
            const int col0 = (u.cb - 1024) + wc * 32 + 8 * fq;
#pragma unroll
            for (int ai = 0; ai < 2; ++ai) if (ai == 0 || !u.half)
#pragma unroll
                for (int m = 0; m < 4; ++m) { float* rowp = KV + (size_t)(row0 + ai * HALF + m * 16) * 512 + col0;
#pragma unroll
                    for (int bj = 0; bj < 2; ++bj) if (bj == 0 || !u.q) { *(f32x4*)(rowp + bj * HALF) = acc[ai][bj][m][0] * rs[ai][m]; *(f32x4*)(rowp + bj * HALF + 4) = acc[ai][bj][m][1] * rs[ai][m]; } }
        }
    }
};

struct EpiRes {
    static constexpr bool PERM = true, AFTER_DRAIN = false;
    float* C; const float* resP; const float* resS; int inplace; bf16_t* XB0; float* SS; int wxb;
    static constexpr int ldc = 1024, split = 32768;
    __device__ __forceinline__ void row_out(const f32x4 v0, const f32x4 v1, int row, int col, float& ss) const {
        if (C) { float* rowp = C + (size_t)row * ldc + col; __builtin_nontemporal_store(v0, (f32x4*)rowp); __builtin_nontemporal_store(v1, (f32x4*)(rowp + 4)); }
        if (wxb) { u32x4 w; w.x = cvt_pk_bf16(v0[0], v0[1]); w.y = cvt_pk_bf16(v0[2], v0[3]); w.z = cvt_pk_bf16(v1[0], v1[1]); w.w = cvt_pk_bf16(v1[2], v1[3]);
            *(u32x4*)(XB0 + (size_t)row * ldc + col) = w;
            ss += (v0[0] * v0[0] + v0[1] * v0[1]) + (v0[2] * v0[2] + v0[3] * v0[3]) + (v1[0] * v1[0] + v1[1] * v1[1]) + (v1[2] * v1[2] + v1[3] * v1[3]); }
    }
    __device__ __forceinline__ void operator()(const f32x4 (&acc)[2][2][4][2], const Unit& u, int wr, int wc, int fr, int fq) const {
        asm volatile("" : "+v"(fr), "+v"(fq));
        const int row0 = u.rb + wr * 64 + fr, col0 = u.cb + wc * 32 + 8 * fq;
        if (inplace) {
#pragma unroll
            for (int ai = 0; ai < 2; ++ai) if (ai == 0 || !u.half)
#pragma unroll
              for (int mh = 0; mh < 4; mh += 2) {
                u32x4 rw[2][2];
#pragma unroll
                for (int mm = 0; mm < 2; ++mm) { const int row = row0 + ai * HALF + (mh + mm) * 16;
#pragma unroll
                    for (int bj = 0; bj < 2; ++bj) if (bj == 0 || !u.q) rw[mm][bj] = *(const u32x4*)(XB0 + (size_t)row * ldc + col0 + bj * HALF); }
#pragma unroll
                for (int mm = 0; mm < 2; ++mm) { const int m = mh + mm, row = row0 + ai * HALF + m * 16; float ss = 0.f;
#pragma unroll
                    for (int bj = 0; bj < 2; ++bj) if (bj == 0 || !u.q) { const u32x4 w = rw[mm][bj];
                        const f32x4 v0 = acc[ai][bj][m][0] + (f32x4){bf_lo(w.x), bf_hi(w.x), bf_lo(w.y), bf_hi(w.y)}, v1 = acc[ai][bj][m][1] + (f32x4){bf_lo(w.z), bf_hi(w.z), bf_lo(w.w), bf_hi(w.w)};
                        row_out(v0, v1, row, col0 + bj * HALF, ss); }
                    if (wxb) { ss += __shfl_xor(ss, 16); ss += __shfl_xor(ss, 32); if (fq == 0) unsafeAtomicAdd(SS + row, ss); } }
              }
        } else {
#pragma unroll
            for (int ai = 0; ai < 2; ++ai) if (ai == 0 || !u.half)
#pragma unroll
                for (int m = 0; m < 4; ++m) { const int row = row0 + ai * HALF + m * 16; float ss = 0.f;
                    const float* rp = resP ? ((row < split ? resP + (size_t)row * ldc : resS + (size_t)(row - split) * ldc) + col0) : nullptr;
                    f32x4 rv[2][2];
#pragma unroll
                    for (int bj = 0; bj < 2; ++bj) if (bj == 0 || !u.q) { rv[bj][0] = rp ? *(const f32x4*)(rp + bj * HALF) : (f32x4){0.f, 0.f, 0.f, 0.f}; rv[bj][1] = rp ? *(const f32x4*)(rp + bj * HALF + 4) : (f32x4){0.f, 0.f, 0.f, 0.f}; }
#pragma unroll
                    for (int bj = 0; bj < 2; ++bj) if (bj == 0 || !u.q) row_out(acc[ai][bj][m][0] + rv[bj][0], acc[ai][bj][m][1] + rv[bj][1], row, col0 + bj * HALF, ss);
                    if (wxb) { ss += __shfl_xor(ss, 16); ss += __shfl_xor(ss, 32); if (fq == 0) unsafeAtomicAdd(SS + row, ss); } }
        }
    }
};

struct EpiG {
    static constexpr bool PERM = true, AFTER_DRAIN = false;
    bf16_t* G; float* outP; float* outS; const float* SS;
    __device__ __forceinline__ void operator()(const f32x4 (&acc)[2][2][4][2], const Unit& u, int wr, int wc, int fr, int fq) const {
        asm volatile("" : "+v"(fr), "+v"(fq));
        const int row0 = u.rb + wr * 64 + fr, col0 = u.pn * BM + wc * 32 + 8 * fq;
        float rsv[2][4];
#pragma unroll
        for (int ai = 0; ai < 2; ++ai)
#pragma unroll
            for (int m = 0; m < 4; ++m) rsv[ai][m] = SS[row0 + (u.half ? 0 : ai * HALF) + m * 16];
#pragma unroll
        for (int ai = 0; ai < 2; ++ai) if (ai == 0 || !u.half)
#pragma unroll
            for (int m = 0; m < 4; ++m) { const int row = row0 + ai * HALF + m * 16; bf16_t* rowp = G + (size_t)row * 2816 + col0;
                float* co = nullptr;
                if (row < 32768) { const int t = row & 8191; if (t >= 8190) co = outP + ((size_t)(row >> 13) * 2 + (t - 8190)) * 2816 + col0; }
                else { const int i = row & 7; if (i >= 6) co = outS + ((size_t)((row - 32768) >> 3) * 2 + (i - 6)) * 2816 + col0; }
                const float rs = rsqrtf(rsv[ai][m] * (1.f / 1024.f) + 1e-6f);
#pragma unroll
                for (int bj = 0; bj < 2; ++bj) { const f32x4 v0 = acc[ai][bj][m][0] * rs, v1 = acc[ai][bj][m][1] * rs;
                    u32x4 w; w.x = cvt_pk_bf16(v0[0], v0[1]); w.y = cvt_pk_bf16(v0[2], v0[3]); w.z = cvt_pk_bf16(v1[0], v1[1]); w.w = cvt_pk_bf16(v1[2], v1[3]);
                    *(u32x4*)(rowp + bj * HALF) = w;
                    if (co) { *(f32x4*)(co + bj * HALF) = v0; *(f32x4*)(co + bj * HALF + 4) = v1; } } }
    }
};

typedef unsigned u32x2 __attribute__((ext_vector_type(2)));
struct EpiH {
    static constexpr bool PERM = true, AFTER_DRAIN = false;
    const bf16_t* G; bf16_t* H; const float* cw; const float* cb; const float* ctx; const float* SS;
    static __device__ __forceinline__ void unpk4(const u32x2 w, float (&o)[4]) { o[0] = bf_lo(w.x); o[1] = bf_hi(w.x); o[2] = bf_lo(w.y); o[3] = bf_hi(w.y); }
    static __device__ __forceinline__ void ld4f(const float* p, float (&o)[4]) { const f32x4 a = *(const f32x4*)p; o[0] = a[0]; o[1] = a[1]; o[2] = a[2]; o[3] = a[3]; }
    static __device__ __forceinline__ u32x2 shf(const u32x2 w, int src) { u32x2 r; r.x = (unsigned)__shfl((int)w.x, src); r.y = (unsigned)__shfl((int)w.y, src); return r; }
    static __device__ __forceinline__ void finish(const float (&g0)[4], const float (&g1)[4], const float (&g2)[4], const float (&w0)[4], const float (&w1)[4], const float (&w2)[4], const float (&bb)[4],
                                                  const f32x4 v, float rs, bf16_t* dst) {
        float h[4];
#pragma unroll
        for (int j = 0; j < 4; j += 2) {
            const f32x2 gc = (f32x2){bb[j] + w0[j] * g2[j] + w1[j] * g1[j] + w2[j] * g0[j], bb[j + 1] + w0[j + 1] * g2[j + 1] + w1[j + 1] * g1[j + 1] + w2[j + 1] * g0[j + 1]};
            const f32x2 ge = gelu_pk(gc); h[j] = ge.x * v[j] * rs; h[j + 1] = ge.y * v[j + 1] * rs; }
        u32x2 w; w.x = cvt_pk_bf16(h[0], h[1]); w.y = cvt_pk_bf16(h[2], h[3]);
        *(u32x2*)dst = w;
    }
    __device__ __forceinline__ void operator()(const f32x4 (&acc)[2][2][4][2], const Unit& u, int wr, int wc, int fr, int fq) const {
        asm volatile("" : "+v"(fr), "+v"(fq));
        const int row0 = u.rb + wr * 64 + fr;
        const int lane = fq * 16 + fr;
        const int s1 = fr >= 1 ? lane - 1 : lane + 15, s2 = fr >= 2 ? lane - 2 : lane + 14;
#pragma unroll
        for (int bj = 0; bj < 2; ++bj)
#pragma unroll
          for (int hv = 0; hv < 2; ++hv) {
            const int col = u.pn * BM + bj * HALF + wc * 32 + 8 * fq + 4 * hv;
            float w0[4], w1[4], w2[4], bb[4];
            ld4f(cw + col, w0); ld4f(cw + 2816 + col, w1); ld4f(cw + 2 * 2816 + col, w2); ld4f(cb + col, bb);
            if (u.pm < 128) {
#pragma unroll
                for (int ai = 0; ai < 2; ++ai) {
                    const int R0 = u.rb + ai * HALF + wr * 64;
                    const bf16_t* gp = G + (size_t)(R0 + fr) * 2816 + col;
                    u32x2 gq[4];
#pragma unroll
                    for (int m = 0; m < 4; ++m) gq[m] = *(const u32x2*)(gp + (size_t)m * 16 * 2816);
                    u32x2 prv = (u32x2){0u, 0u};
                    if ((R0 & 8191) != 0) prv = *(const u32x2*)(gp - (size_t)16 * 2816);
#pragma unroll
                    for (int m = 0; m < 4; ++m) {
                        const u32x2 q1 = shf(fr == 15 ? prv : gq[m], s1), q2 = shf(fr >= 14 ? prv : gq[m], s2);
                        float g0[4], g1[4], g2[4]; unpk4(gq[m], g0); unpk4(q1, g1); unpk4(q2, g2);
                        finish(g0, g1, g2, w0, w1, w2, bb, acc[ai][bj][m][hv], rsqrtf(SS[R0 + fr + 16 * m] * (1.f / 1024.f) + 1e-6f), H + (size_t)(R0 + fr + 16 * m) * 2816 + col);
                        prv = gq[m];
                    }
                }
            } else {
                const int i = fr & 7;
                u32x2 gq[4]; float ssv[4];
#pragma unroll
                for (int m = 0; m < 4; ++m) { const int row = row0 + m * 16; gq[m] = *(const u32x2*)(G + (size_t)row * 2816 + col); ssv[m] = SS[row]; }
#pragma unroll
                for (int mh = 0; mh < 4; mh += 2) {
                f32x4 c0[4], c1[4];
#pragma unroll
                for (int m = mh; m < mh + 2; ++m) { const int row = row0 + m * 16; const float* cx = ctx + (size_t)((row - 32768) >> 3) * 2 * 2816 + col;
                    c0[m] = *(const f32x4*)cx; c1[m] = *(const f32x4*)(cx + 2816); }
#pragma unroll
                for (int m = mh; m < mh + 2; ++m) { const int row = row0 + m * 16; const u32x2 cur = gq[m];
                    const u32x2 q1 = shf(cur, lane - 1), q2 = shf(cur, lane - 2);
                    float g0[4], g1[4], g2[4]; unpk4(cur, g0); unpk4(q1, g1); unpk4(q2, g2);
#pragma unroll
                    for (int j = 0; j < 4; ++j) { const float x1 = c1[m][j], x0 = c0[m][j];
                        if (i < 1) g1[j] = x1;
                        if (i < 2) g2[j] = (i == 1) ? x1 : x0; }
                    finish(g0, g1, g2, w0, w1, w2, bb, acc[0][bj][m][hv], rsqrtf(ssv[m] * (1.f / 1024.f) + 1e-6f), H + (size_t)row * 2816 + col); }
                }
            }
        }
    }
};

template <class Epi, class Sched, bool ALIGN_EPI = false, bool SP2 = false>
__device__ __forceinline__ void gemm_phase(PG8_LAS unsigned char* lds, const Gemm g, const Sched& S, const Epi& E, int wave0) {
    int tid_ = threadIdx.x; (void)wave0; asm volatile("" : "+v"(tid_));
    const int tid = tid_, wid = __builtin_amdgcn_readfirstlane(tid >> 6), lane = tid & 63, wr = wid >> 2, wc = wid & 3, fr = lane & 15, fq = lane >> 4;
    const int K = g.K, nt = K / BK;
    unsigned voffA[2], voffB[2];
#pragma unroll
    for (int i = 0; i < 2; ++i) { int R, C; stage_rc(tid * 16 + i * 8192, R, C); const int Rb = Epi::PERM ? ((R & ~31) + perm32(R & 31)) : R;
        voffA[i] = (unsigned)(R * K + C) * 2u; voffB[i] = (unsigned)(Rb * K + C) * 2u; }
    const size_t kstep = (size_t)(BK * 2);
    const size_t hstep = (size_t)HALF * K * 2;
    const size_t tstep = 2 * hstep;
    const unsigned ldsw = (unsigned)wid * 1024u;
    const int aoff = lds_byte(wr * 64 + fr, fq * 8), boff = lds_byte(wc * 32 + fr, fq * 8);
#define PG8_SA(b, h) (((b) * 2 + (h)) * HTB)
#define PG8_SB(b, h) ((4 + (b) * 2 + (h)) * HTB)
#define PG8_STAGE(bufoff, gbase, voff) do { _Pragma("unroll") for (int _i = 0; _i < 2; ++_i) \
        __builtin_amdgcn_global_load_lds((const unsigned*)((const char*)(gbase) + (voff)[_i]), (PG8_LAS unsigned*)(lds + (bufoff) + ldsw + _i * 8192), 16, 0, 0); } while (0)
#define PG8_LDA(dst, b, h) do { _Pragma("unroll") for (int m = 0; m < 4; ++m) _Pragma("unroll") for (int k = 0; k < 2; ++k) dst[m][k] = *(const PG8_LAS bf16x8*)(lds + PG8_SA(b, h) + aoff + m * 2048 + k * 1024); } while (0)
#define PG8_LDB(dst, b, h) do { _Pragma("unroll") for (int n = 0; n < 2; ++n) _Pragma("unroll") for (int k = 0; k < 2; ++k) dst[n][k] = *(const PG8_LAS bf16x8*)(lds + PG8_SB(b, h) + boff + n * 2048 + k * 1024); } while (0)
#define PG8_MMA(ai, bj, At, Bt) do { __builtin_amdgcn_s_setprio(1); _Pragma("unroll") for (int m = 0; m < 4; ++m) _Pragma("unroll") for (int n = 0; n < 2; ++n) _Pragma("unroll") for (int k = 0; k < 2; ++k) \
        acc[ai][bj][m][n] = __builtin_amdgcn_mfma_f32_16x16x32_bf16(Bt[n][k], At[m][k], acc[ai][bj][m][n], 0, 0, 0); __builtin_amdgcn_s_setprio(0); } while (0)
#define PG8_WAIT_V(n) asm volatile("s_waitcnt vmcnt(" #n ")" ::: "memory")
#define PG8_WAIT_L(n) asm volatile("s_waitcnt lgkmcnt(" #n ")" ::: "memory")
#define PG8_BAR __builtin_amdgcn_s_barrier()
#define PG8_SCHED __builtin_amdgcn_sched_barrier(0)
    Unit cur, nxt; int ui = 0;
    if (!S.next(0, cur)) return;
    f32x4 acc[2][2][4][2];
#pragma unroll
    for (int a = 0; a < 2; ++a)
#pragma unroll
        for (int b = 0; b < 2; ++b)
#pragma unroll
            for (int m = 0; m < 4; ++m)
#pragma unroll
                for (int n = 0; n < 2; ++n) acc[a][b][m][n] = (f32x4){0.f, 0.f, 0.f, 0.f};
    bf16x8 At[4][2], B0[2][2], B1[2][2];
    const char* cA = (const char*)g.A + (size_t)cur.rb * K * 2; const char* cB = (const char*)g.Bt + (size_t)cur.pn * tstep;
    S.a_ready(cur);
    if constexpr (SP2) {
        PG8_STAGE(PG8_SB(0, 0), cB, voffB); PG8_STAGE(PG8_SB(0, 1), cB + hstep, voffB); PG8_STAGE(PG8_SA(0, 0), cA, voffA); PG8_STAGE(PG8_SA(0, 1), cA + hstep, voffA);
        if (wr == 1) PG8_BAR;
        PG8_WAIT_V(2); PG8_BAR;
        PG8_STAGE(PG8_SB(1, 0), cB + kstep, voffB); PG8_STAGE(PG8_SA(1, 0), cA + kstep, voffA); PG8_STAGE(PG8_SB(1, 1), cB + hstep + kstep, voffB);
        PG8_WAIT_V(6); PG8_BAR;
    } else {
        PG8_STAGE(PG8_SB(0, 0), cB, voffB); PG8_STAGE(PG8_SA(0, 0), cA, voffA); PG8_STAGE(PG8_SB(0, 1), cB + hstep, voffB); PG8_STAGE(PG8_SA(0, 1), cA + hstep, voffA);
        if (wr == 1) PG8_BAR;
        PG8_WAIT_V(4); PG8_BAR;
        PG8_STAGE(PG8_SB(1, 0), cB + kstep, voffB); PG8_STAGE(PG8_SA(1, 0), cA + kstep, voffA); PG8_STAGE(PG8_SB(1, 1), cB + hstep + kstep, voffB);
        PG8_WAIT_V(6); PG8_BAR;
    }
    for (;;) {
        const bool has_next = S.next(ui + 1, nxt);
        const char* nA = has_next ? (const char*)g.A + (size_t)nxt.rb * K * 2 : cA; const char* nB = has_next ? (const char*)g.Bt + (size_t)nxt.pn * tstep : cB;
        for (int t = 0; t < nt; t += 2) {
            const bool last = (t == nt - 2);
            const char* a1 = cA + (size_t)(t + 1) * kstep;
            const char* a2 = last ? nA : cA + (size_t)(t + 2) * kstep; const char* b2 = last ? nB : cB + (size_t)(t + 2) * kstep;
            const char* a3 = a2 + kstep; const char* b3 = b2 + kstep;
            if (last && has_next) S.a_ready(nxt);
            if constexpr (SP2) {
            PG8_LDB(B0, 0, 0); PG8_LDB(B1, 0, 1); PG8_SCHED; PG8_LDA(At, 0, 0); PG8_STAGE(PG8_SA(1, 1), a1 + hstep, voffA);
            PG8_WAIT_V(8); PG8_WAIT_L(0); PG8_BAR; PG8_MMA(0, 0, At, B0); PG8_MMA(0, 1, At, B1); PG8_BAR; PG8_SCHED;
            PG8_LDA(At, 0, 1); PG8_STAGE(PG8_SB(0, 0), b2, voffB); PG8_STAGE(PG8_SB(0, 1), b2 + hstep, voffB); PG8_STAGE(PG8_SA(0, 0), a2, voffA);
            PG8_WAIT_V(8); PG8_WAIT_L(0); PG8_BAR; if (!cur.half) { PG8_MMA(1, 0, At, B0); PG8_MMA(1, 1, At, B1); } PG8_BAR; PG8_SCHED;
            PG8_LDB(B0, 1, 0); PG8_LDB(B1, 1, 1); PG8_SCHED; PG8_LDA(At, 1, 0); PG8_STAGE(PG8_SA(0, 1), a2 + hstep, voffA);
            PG8_WAIT_V(8); PG8_WAIT_L(0); PG8_BAR; PG8_MMA(0, 0, At, B0); PG8_MMA(0, 1, At, B1); PG8_BAR; PG8_SCHED;
            PG8_LDA(At, 1, 1); PG8_STAGE(PG8_SB(1, 0), b3, voffB); PG8_STAGE(PG8_SB(1, 1), b3 + hstep, voffB); PG8_STAGE(PG8_SA(1, 0), a3, voffA);
            PG8_WAIT_V(8); PG8_WAIT_L(0); PG8_BAR; if (!cur.half) { PG8_MMA(1, 0, At, B0); PG8_MMA(1, 1, At, B1); } PG8_BAR; PG8_SCHED;
            } else {
            PG8_LDB(B0, 0, 0); PG8_SCHED; PG8_LDA(At, 0, 0); PG8_STAGE(PG8_SA(1, 1), a1 + hstep, voffA);
            PG8_WAIT_L(8); PG8_BAR; PG8_WAIT_L(0); PG8_MMA(0, 0, At, B0); PG8_BAR; PG8_SCHED;
            PG8_LDB(B1, 0, 1); PG8_STAGE(PG8_SB(0, 0), b2, voffB);
            PG8_BAR; PG8_WAIT_L(0); PG8_MMA(0, 1, At, B1); PG8_BAR;
            PG8_LDA(At, 0, 1); PG8_STAGE(PG8_SA(0, 0), a2, voffA);
            PG8_BAR; PG8_WAIT_L(0); if (!cur.half) PG8_MMA(1, 0, At, B0); PG8_BAR; PG8_SCHED;
            PG8_STAGE(PG8_SB(0, 1), b2 + hstep, voffB);
            PG8_WAIT_V(6); PG8_BAR; if (!cur.half) PG8_MMA(1, 1, At, B1); PG8_BAR;
            PG8_LDB(B0, 1, 0); PG8_SCHED; PG8_LDA(At, 1, 0); PG8_STAGE(PG8_SA(0, 1), a2 + hstep, voffA);
            PG8_WAIT_L(8); PG8_BAR; PG8_WAIT_L(0); PG8_MMA(0, 0, At, B0); PG8_BAR; PG8_SCHED;
            PG8_LDB(B1, 1, 1); PG8_STAGE(PG8_SB(1, 0), b3, voffB);
            PG8_BAR; PG8_WAIT_L(0); PG8_MMA(0, 1, At, B1); PG8_BAR;
            PG8_LDA(At, 1, 1); PG8_STAGE(PG8_SA(1, 0), a3, voffA);
            PG8_BAR; PG8_WAIT_L(0); if (!cur.half) PG8_MMA(1, 0, At, B0); PG8_BAR; PG8_SCHED;
            PG8_STAGE(PG8_SB(1, 1), b3 + hstep, voffB);
            PG8_WAIT_V(6); PG8_BAR; if (!cur.half) PG8_MMA(1, 1, At, B1); PG8_BAR;
            }
        }
        if constexpr (ALIGN_EPI) { if (wr == 0) PG8_BAR; }
        if constexpr (!Epi::AFTER_DRAIN) { E(acc, cur, wr, wc, fr, fq); S.done(cur); }
        if (!has_next) break;
#pragma unroll
        for (int a = 0; a < 2; ++a)
#pragma unroll
            for (int b = 0; b < 2; ++b)
#pragma unroll
                for (int m = 0; m < 4; ++m)
#pragma unroll
                    for (int n = 0; n < 2; ++n) acc[a][b][m][n] = (f32x4){0.f, 0.f, 0.f, 0.f};
        cur = nxt; cA = nA; cB = nB; ++ui;
        if constexpr (ALIGN_EPI) { if (wr == 1) PG8_BAR; }
    }
    PG8_WAIT_V(0);
    if constexpr (!ALIGN_EPI) { if (wr == 0) PG8_BAR; }
    PG8_BAR;
    if constexpr (Epi::AFTER_DRAIN) { E.fused(acc, cur, wr, wc, fr, fq, lds, wid, lane); S.done(cur); }
#undef PG8_SA
#undef PG8_SB
#undef PG8_STAGE
#undef PG8_LDA
#undef PG8_LDB
#undef PG8_MMA
#undef PG8_WAIT_V
#undef PG8_WAIT_L
#undef PG8_BAR
#undef PG8_SCHED
}

template <class Epi, bool NARROW = false>
__device__ __forceinline__ void mini_gemm(PG8_LAS unsigned char* lds, const bf16_t* A, const bf16_t* Bt, int K, int ntn, const Epi& E, int c, int G, int wave0, int row_base = 32768) {
    int tid_ = threadIdx.x; (void)wave0; asm volatile("" : "+v"(tid_));
    const int tid = tid_, wid = __builtin_amdgcn_readfirstlane(tid >> 6), lane = tid & 63, wr = wid >> 2, wc = wid & 3, fr = lane & 15, fq = lane >> 4;
    constexpr int LS = 136, BUFB = 2 * 128 * LS * 2;
    constexpr int NB = NARROW ? 2 : 4, TW = NARROW ? 64 : 128;
    const int lr = tid >> 2, lp = (tid & 3) * 4;
    const int lrb = NARROW ? (tid >> 3) : lr, lpb = NARROW ? (tid & 7) * 2 : lp;
    const bool active = !NARROW || wc < 2;
    const int nst = K / 128;
#pragma unroll 1
    for (int t = c; t < 8 * ntn; t += G) {
        const int tm = t & 7, tn = t >> 3;
        const bf16_t* ga = A + ((size_t)row_base + 128 * tm + lr) * K + lp * 8;
        const bf16_t* gb = Bt + ((size_t)TW * tn + lrb) * K + lpb * 8;
        u32x4 ra[2][4], rb[2][NB];
#pragma unroll
        for (int s2 = 0; s2 < 2; ++s2) {
#pragma unroll
            for (int j = 0; j < 4; ++j) ra[s2][j] = *(const u32x4*)(ga + 128 * s2 + 8 * j);
#pragma unroll
            for (int j = 0; j < NB; ++j) rb[s2][j] = *(const u32x4*)(gb + 128 * s2 + 8 * j); }
        f32x4 acc[4][2];
#pragma unroll
        for (int m = 0; m < 4; ++m)
#pragma unroll
            for (int n = 0; n < 2; ++n) acc[m][n] = (f32x4){0.f, 0.f, 0.f, 0.f};
#pragma unroll 1
        for (int st = 0; st < nst; st += 2) {
#pragma unroll
          for (int s2 = 0; s2 < 2; ++s2) {
            PG8_LAS bf16_t* As = (PG8_LAS bf16_t*)(lds + s2 * BUFB); PG8_LAS bf16_t* Bs = As + 128 * LS;
#pragma unroll
            for (int j = 0; j < 4; ++j) *(PG8_LAS u32x4*)(As + lr * LS + (lp + j) * 8) = ra[s2][j];
#pragma unroll
            for (int j = 0; j < NB; ++j) *(PG8_LAS u32x4*)(Bs + lrb * LS + (lpb + j) * 8) = rb[s2][j];
            __syncthreads();
            if (st + 2 < nst) {
#pragma unroll
                for (int j = 0; j < 4; ++j) ra[s2][j] = *(const u32x4*)(ga + 128 * (st + 2 + s2) + 8 * j);
#pragma unroll
                for (int j = 0; j < NB; ++j) rb[s2][j] = *(const u32x4*)(gb + 128 * (st + 2 + s2) + 8 * j); }
            if (active) {
#pragma unroll
            for (int kc = 0; kc < 4; ++kc) {
                bf16x8 af[4], bfr[2];
#pragma unroll
                for (int m = 0; m < 4; ++m) af[m] = *(const PG8_LAS bf16x8*)(As + (64 * wr + 16 * m + fr) * LS + 32 * kc + 8 * fq);
#pragma unroll
                for (int n = 0; n < 2; ++n) bfr[n] = *(const PG8_LAS bf16x8*)(Bs + (32 * wc + 8 * (fr >> 2) + 4 * n + (fr & 3)) * LS + 32 * kc + 8 * fq);
#pragma unroll
                for (int m = 0; m < 4; ++m)
#pragma unroll
                    for (int n = 0; n < 2; ++n) acc[m][n] = __builtin_amdgcn_mfma_f32_16x16x32_bf16(bfr[n], af[m], acc[m][n], 0, 0, 0);
            } }
          }
        }
        if (active) {
        f32x4 accf[2][2][4][2];
#pragma unroll
        for (int a = 0; a < 2; ++a)
#pragma unroll
            for (int bq = 0; bq < 2; ++bq)
#pragma unroll
                for (int m = 0; m < 4; ++m)
#pragma unroll
                    for (int n = 0; n < 2; ++n) accf[a][bq][m][n] = (a == 0 && bq == 0) ? acc[m][n] : (f32x4){0.f, 0.f, 0.f, 0.f};
        Unit u; u.pm = 128 + (tm >> 1); u.cb = TW * tn; u.pn = u.cb >> 8; u.rb = row_base + 128 * tm; u.half = 1; u.q = 1;
        E(accf, u, wr, wc, fr, fq);
        }
        __syncthreads();
    }
}
}

#define LAS __attribute__((address_space(3)))
typedef unsigned short bf16;
typedef unsigned v4u __attribute__((ext_vector_type(4)));
typedef unsigned v2u __attribute__((ext_vector_type(2)));
typedef float f32x4 __attribute__((ext_vector_type(4)));
typedef short bf16x8 __attribute__((ext_vector_type(8)));

constexpr int NTHR = 512, NWAVES = 8;
constexpr int MP = 32768, MS = 1024, MT = MP + MS;
constexpr int D = 1024, DFF = 2816;
constexpr int LDS_BYTES = 147456;
constexpr float EPS = 1e-6f;

enum { I_XP = 0, I_XS, I_CPOOL, I_CSK, I_CSV, I_CMK, I_CMV, I_CFC, I_MEMP, I_LNMIX, I_LNMEM, I_LNMEMKV, I_LNFFN, I_ABWIN, I_ABVG, I_ABWS, I_ABBS, I_ABPW, I_ABPS, I_ABWOUT,
       I_CWQKV, I_CQG, I_CKG, I_CSINK, I_CWO, I_MWQ, I_MWKV, I_MQG, I_MKG, I_MWO, I_FWUP, I_FCW, I_FCB, I_FWDN, N_IN };
constexpr size_t O_YP = 0, O_YS = O_YP + (size_t)MP * D, O_POOLP = O_YS + (size_t)MS * D, O_POOLS = O_POOLP + 4 * 15 * 512, O_CHV = O_POOLS + 128 * 15 * 512,
                 O_SKP = O_CHV + 128 * 8 * 512, O_SVP = O_SKP + 4 * 128 * 256, O_SKS = O_SVP + 4 * 128 * 256, O_SVS = O_SKS + (size_t)128 * 128 * 256,
                 O_MKP = O_SVS + (size_t)128 * 128 * 256, O_MVP = O_MKP + 2 * 4 * 256 * 512, O_FCP = O_MVP + 2 * 4 * 256 * 512, O_FCS = O_FCP + 2 * 4 * 2 * DFF,
                 O_END = O_FCS + (size_t)2 * 128 * 2 * DFF;
constexpr size_t MiB = 1u << 20;
constexpr size_t W_WIN = 0, W_WOUT = W_WIN + 1536 * 1024 * 2, W_WQKV = W_WOUT + 1024 * 1024 * 2, W_CWO = W_WQKV + 1536 * 1024 * 2, W_LAYER = W_CWO + 1024 * 1024 * 2;
constexpr size_t WL_WQ = 0, WL_WKV = WL_WQ + 512 * 1024 * 2, WL_WO = WL_WKV + 1024 * 1024 * 2, WL_WUP = WL_WO + 1024 * 512 * 2, WL_WDN = WL_WUP + (size_t)2 * DFF * 1024 * 2,
                 WL_SIZE = WL_WDN + (size_t)1024 * DFF * 2;
constexpr size_t W_MN = W_LAYER + 2 * WL_SIZE;
constexpr size_t W_MKV = W_MN + 2 * 1024 * 1024 * 2;
constexpr size_t W_SS = W_MKV + 2 * 1024 * 1024 * 4;
constexpr size_t W_SMALL_END = W_SS + (size_t)6 * MT * 4;
static_assert(W_SMALL_END <= 72 * MiB, "weights region");
constexpr size_t W_XN = 72 * MiB;
constexpr size_t W_G = 138 * MiB;
constexpr size_t W_PROJ = W_G;
constexpr size_t W_AO = W_PROJ + 99 * MiB;
constexpr size_t W_H = 320 * MiB;
constexpr size_t W_KV32 = W_H;
constexpr size_t W_MQ = W_KV32 + 66 * MiB;
constexpr size_t W_MO = W_MQ + 33 * MiB;
constexpr size_t W_END = 502 * MiB;
constexpr size_t W_CTL = 504 * MiB, CTL_BYTES = 65536, W_NEED = W_CTL + CTL_BYTES;
constexpr int LDS_CTL_OFF = LDS_BYTES - 64;
static_assert(W_XN + (size_t)MT * 1024 * 2 <= W_G && W_PROJ + (size_t)MT * 1536 * 2 <= W_AO && W_AO + (size_t)MT * 1024 * 2 <= W_H && W_G + (size_t)MT * DFF * 2 <= W_H, "ws map 1");
static_assert(W_KV32 + (size_t)MT * 512 * 4 <= W_MQ && W_MQ + (size_t)MT * 512 * 2 <= W_MO && W_MO + (size_t)MT * 512 * 2 <= W_END && W_H + (size_t)MT * DFF * 2 <= W_END, "ws map 2");

struct Params { const float* in[N_IN]; float* out; unsigned char* ws; };

__device__ __forceinline__ unsigned pk2(float lo, float hi) { return pg8::cvt_pk_bf16(lo, hi); }
__device__ __forceinline__ unsigned f2bf(float f) { return pg8::cvt_pk_bf16(f, 0.f) & 0xffffu; }
__device__ __forceinline__ float bflo(unsigned w) { return __builtin_bit_cast(float, w << 16); }
__device__ __forceinline__ float bfhi(unsigned w) { return __builtin_bit_cast(float, w & 0xffff0000u); }
__device__ __forceinline__ float bf1(bf16 h) { return __builtin_bit_cast(float, (unsigned)h << 16); }
__device__ __forceinline__ void unpack8(const v4u w, float (&o)[8]) { o[0] = bflo(w.x); o[1] = bfhi(w.x); o[2] = bflo(w.y); o[3] = bfhi(w.y); o[4] = bflo(w.z); o[5] = bfhi(w.z); o[6] = bflo(w.w); o[7] = bfhi(w.w); }
__device__ __forceinline__ bf16x8 pack8(const float (&o)[8]) { v4u w; w.x = pk2(o[0], o[1]); w.y = pk2(o[2], o[3]); w.z = pk2(o[4], o[5]); w.w = pk2(o[6], o[7]); return __builtin_bit_cast(bf16x8, w); }
typedef short v4i16_t __attribute__((ext_vector_type(4)));
__device__ __forceinline__ v2u vtr(const LAS bf16* p) { return __builtin_bit_cast(v2u, __builtin_amdgcn_ds_read_tr16_b64_v4i16((LAS v4i16_t*)p)); }
__device__ __forceinline__ float wave_sum(float v) {
#pragma unroll
    for (int o = 1; o < 64; o <<= 1) v += __shfl_xor(v, o);
    return v;
}
__device__ __forceinline__ float gelu1(float v) { const pg8::f32x2 r = pg8::gelu_pk((pg8::f32x2){v, 0.f}); return r.x; }
__device__ __forceinline__ void rope_cs(float pos, int e, float& c, float& s) {
    const float inv = exp2f(-(float)e * (0.125f * 18.931568569324174f));
    const float ang = pos * inv;
    const float k = rintf(ang * 0.15915494309189535f);
    float r = fmaf(-k, 6.28125f, ang);
    r = fmaf(-k, 0.0019353071795864769f, r);
    s = __sinf(r); c = __cosf(r);
}

#define XB_TMO      128
#define XB_XCNT(j)  (256  + 64 * (j))
#define XB_XSUB(j)  (1280 + 64 * (j))
#define XB_XGEN(j)  (2304 + 64 * (j))
#define XB_TOP      3328
#define XB_TOPGEN   3392
#define XCD_BAR_WORDS 3456
#define XB_SPIN_CAP (1u << 18)

__device__ __forceinline__ unsigned xb_ld(unsigned* p)              { return __hip_atomic_load(p, __ATOMIC_RELAXED, __HIP_MEMORY_SCOPE_AGENT); }
__device__ __forceinline__ unsigned xb_add(unsigned* p, unsigned v) { return __hip_atomic_fetch_add(p, v, __ATOMIC_RELAXED, __HIP_MEMORY_SCOPE_AGENT); }
__device__ __forceinline__ unsigned xb_xcc_id() { return (unsigned)__builtin_amdgcn_s_getreg((3 << 11) | 20) & 0xFu; }
#define XB_SPIN(cond, bar) do { unsigned _sp = 0; while (cond) { __builtin_amdgcn_s_sleep(1); \
    if ((++_sp & 255u) == 0u) { if (xb_ld(&(bar)[XB_TMO])) break; if (_sp > XB_SPIN_CAP) { atomicAdd(&(bar)[XB_TMO], 1u); break; } } } } while (0)

struct XcdBarrier {
    unsigned* bar; unsigned x; int w0;
    volatile LAS unsigned* st;
};

__device__ __forceinline__ XcdBarrier xcd_barrier_post(unsigned* bar, volatile LAS unsigned* st) {
    XcdBarrier b; b.bar = bar; b.x = xb_xcc_id(); b.st = st; b.w0 = __builtin_amdgcn_readfirstlane((int)threadIdx.x >> 6);
    if (threadIdx.x == 0) (void)xb_add(&bar[XB_XCNT(b.x)], 1u);
    return b;
}
__device__ __forceinline__ void xcd_barrier_complete(unsigned* bar, unsigned x, unsigned& nloc, unsigned& nx) {
    const unsigned G = gridDim.x * gridDim.y * gridDim.z;
    unsigned sum, cnt, mine, sp = 0u;
    for (;;) {
        sum = 0u; cnt = 0u; mine = 0u;
#pragma unroll
        for (unsigned j = 0; j < 16; ++j) { const unsigned c = xb_ld(&bar[XB_XCNT(j)]); sum += c; cnt += (c > 0u) ? 1u : 0u; mine = (j == x) ? c : mine; }
        if (sum == G) break;
        __builtin_amdgcn_s_sleep(1);
        if ((++sp & 255u) == 0u) { if (xb_ld(&bar[XB_TMO])) break; if (sp > XB_SPIN_CAP) { atomicAdd(&bar[XB_TMO], 1u); break; } }
    }
    nloc = mine > 0u ? mine : 1u; nx = cnt > 0u ? cnt : 1u;
}

__device__ __forceinline__ void xcd_barrier(const XcdBarrier& b) {
    asm volatile("s_waitcnt vmcnt(0)" ::: "memory");
    __syncthreads();
    if (threadIdx.x == 0) {
        unsigned* bar = b.bar;
        __builtin_amdgcn_s_waitcnt(0);
        unsigned nloc = b.st[0], nx = b.st[1];
        if (nloc == 0u) { xcd_barrier_complete(bar, b.x, nloc, nx); b.st[0] = nloc; b.st[1] = nx; }
        const unsigned old = xb_add(&bar[XB_XSUB(b.x)], 1u);
        const unsigned gen = old / nloc;
        if (old + 1u == (gen + 1u) * nloc) {
            __builtin_amdgcn_fence(__ATOMIC_RELEASE, "agent");
            asm volatile("s_waitcnt vmcnt(0)" ::: "memory");
            const unsigned og = xb_add(&bar[XB_TOP], 1u);
            const unsigned tg = og / nx;
            if (og + 1u == (tg + 1u) * nx) xb_add(&bar[XB_TOPGEN], 1u);
            else XB_SPIN(xb_ld(&bar[XB_TOPGEN]) == tg, bar);
            __builtin_amdgcn_fence(__ATOMIC_ACQUIRE, "agent");
            xb_add(&bar[XB_XGEN(b.x)], 1u);
            asm volatile("s_waitcnt vmcnt(0)" ::: "memory");
        } else {
            XB_SPIN(xb_ld(&bar[XB_XGEN(b.x)]) == gen, bar);
            __builtin_amdgcn_fence(__ATOMIC_ACQUIRE, "agent");
            asm volatile("s_waitcnt vmcnt(0)" ::: "memory");
        }
    }
    __syncthreads();
}

__device__ __forceinline__ void transpose_item(const float* W, const float* gain, int ldn, int nblk, bf16* WT, int ldk, int koff, LAS float* scr, int item, int lane) {
    const int kb = item / nblk, nb = item % nblk, k0 = 64 * kb, n0 = 32 * nb;
    float wv[32];
#pragma unroll
    for (int i = 0; i < 32; ++i) wv[i] = __builtin_nontemporal_load(W + (size_t)(k0 + 2 * i + (lane >> 5)) * ldn + n0 + (lane & 31));
    if (gain) {
#pragma unroll
        for (int i = 0; i < 32; ++i) wv[i] *= gain[k0 + 2 * i + (lane >> 5)]; }
#pragma unroll
    for (int i = 0; i < 32; ++i) scr[(2 * i + (lane >> 5)) * 33 + (lane & 31)] = wv[i];
    asm volatile("s_waitcnt lgkmcnt(0)" ::: "memory");
    const int c = lane & 7;
#pragma unroll
    for (int j = 0; j < 4; ++j) { const int n = (lane >> 3) + 8 * j; const LAS float* s = scr + (8 * c) * 33 + n;
        v4u o; o.x = pk2(s[0 * 33], s[1 * 33]); o.y = pk2(s[2 * 33], s[3 * 33]); o.z = pk2(s[4 * 33], s[5 * 33]); o.w = pk2(s[6 * 33], s[7 * 33]);
        *(v4u*)(WT + (size_t)(n0 + n) * ldk + koff + k0 + 8 * c) = o; }
    asm volatile("s_waitcnt lgkmcnt(0)" ::: "memory");
}
__device__ __forceinline__ void rms_row(const float* xrow, const float* g, bf16* orow, int lane) {
    const f32x4* xr = (const f32x4*)xrow + lane; const f32x4* gr = (const f32x4*)g + lane;
    f32x4 v[4]; float s = 0.f;
#pragma unroll
    for (int j = 0; j < 4; ++j) { v[j] = xr[64 * j]; s += (v[j].x * v[j].x + v[j].y * v[j].y) + (v[j].z * v[j].z + v[j].w * v[j].w); }
    const float rs = rsqrtf(wave_sum(s) * (1.f / 1024.f) + EPS);
    unsigned long long* o8 = (unsigned long long*)orow + lane;
#pragma unroll
    for (int j = 0; j < 4; ++j) { const f32x4 gg = gr[64 * j];
        o8[64 * j] = (unsigned long long)pk2(v[j].x * rs * gg.x, v[j].y * rs * gg.y) | ((unsigned long long)pk2(v[j].z * rs * gg.z, v[j].w * rs * gg.w) << 32); }
}
__device__ __forceinline__ void xb_row(const float* xrow, bf16* orow, float* ss, int lane) {
    const f32x4* xr = (const f32x4*)xrow + lane;
    f32x4 v[4]; float s = 0.f;
#pragma unroll
    for (int j = 0; j < 4; ++j) { v[j] = xr[64 * j]; s += (v[j].x * v[j].x + v[j].y * v[j].y) + (v[j].z * v[j].z + v[j].w * v[j].w); }
    s = wave_sum(s);
    unsigned long long* o8 = (unsigned long long*)orow + lane;
#pragma unroll
    for (int j = 0; j < 4; ++j) o8[64 * j] = (unsigned long long)pk2(v[j].x, v[j].y) | ((unsigned long long)pk2(v[j].z, v[j].w) << 32);
    if (lane == 0) *ss = s;
}

struct TItem { const float* W; int ldn, nblk, nitems; bf16* WT; int ldk, koff; };

__device__ __forceinline__ void prologue(const Params& p, LAS unsigned char* lds, int gw, int ngw, int wave, int lane) {
    unsigned char* ws = p.ws;
    LAS float* scr = (LAS float*)(lds + wave * 16384);
#define TR(Wp, gn_, K_, N_, ldn_, dst_, ldk_, koff_) do { const int nblk_ = (N_) / 32, nit_ = ((K_) / 64) * nblk_; \
        for (int it = gw; it < nit_; it += ngw) transpose_item((Wp), (gn_), (ldn_), nblk_, (bf16*)(dst_), (ldk_), (koff_), scr, it, lane); } while (0)
    const float* nog = nullptr;
    TR(p.in[I_ABWIN], p.in[I_LNMIX], 1024, 1536, 1536, ws + W_WIN, 1024, 0);
    TR(p.in[I_ABWOUT], nog, 512, 1024, 1024, ws + W_WOUT, 1024, 0);
    TR(p.in[I_CWQKV], p.in[I_LNMIX] + D, 1024, 1536, 1536, ws + W_WQKV, 1024, 0);
    TR(p.in[I_CWO], nog, 1024, 1024, 1024, ws + W_CWO, 1024, 0);
#pragma unroll 1
    for (int l = 0; l < 2; ++l) {
        unsigned char* wl = ws + W_LAYER + l * WL_SIZE;
        TR(p.in[I_MWQ] + (size_t)l * 1024 * 512, p.in[I_LNMEM] + l * D, 1024, 512, 512, wl + WL_WQ, 1024, 0);
        TR(p.in[I_MWKV] + (size_t)l * 1024 * 1024, nog, 1024, 1024, 1024, wl + WL_WKV, 1024, 0);
        TR(p.in[I_MWO] + (size_t)l * 512 * 1024, nog, 512, 1024, 1024, wl + WL_WO, 512, 0);
        TR(p.in[I_FWUP] + (size_t)l * 1024 * 2 * DFF, p.in[I_LNFFN] + l * D, 1024, 2 * DFF, 2 * DFF, wl + WL_WUP, 1024, 0);
        TR(p.in[I_FWDN] + (size_t)l * DFF * 1024, nog, DFF, 1024, 1024, wl + WL_WDN, DFF, 0);
    }
#undef TR
    {
        const float* pw = p.in[I_ABPW]; const float* ps = p.in[I_ABPS]; const float* wo = p.in[I_ABWOUT] + (size_t)512 * 1024;
        bf16* WT = (bf16*)(ws + W_WOUT);
        const int gt = gw * 64 + lane, ngt = ngw * 64;
        for (int o = gt; o < 128 * 1024; o += ngt) {
            const int n = o & 1023, d = o >> 10;
            float a[4] = {0.f, 0.f, 0.f, 0.f};
#pragma unroll 4
            for (int e = 0; e < 128; ++e) {
#pragma unroll
                for (int g = 0; g < 4; ++g) a[g] += pw[((size_t)g * 128 + d) * 128 + e] * ps[g * 128 + e] * wo[((size_t)g * 128 + e) * 1024 + n]; }
#pragma unroll
            for (int g = 0; g < 4; ++g) WT[(size_t)n * 1024 + 512 + g * 128 + d] = (bf16)f2bf(a[g]); }
    }
    for (int m0 = gw * 4; m0 < MT; m0 += ngw * 4) {
        f32x4 v[4][4];
#pragma unroll
        for (int r = 0; r < 4; ++r) { const int m = m0 + r; const f32x4* xr = (const f32x4*)(m < MP ? p.in[I_XP] + (size_t)m * D : p.in[I_XS] + (size_t)(m - MP) * D) + lane;
#pragma unroll
            for (int j = 0; j < 4; ++j) v[r][j] = __builtin_nontemporal_load(xr + 64 * j); }
#pragma unroll
        for (int r = 0; r < 4; ++r) { const int m = m0 + r; float sq = 0.f;
#pragma unroll
            for (int j = 0; j < 4; ++j) sq += (v[r][j].x * v[r][j].x + v[r][j].y * v[r][j].y) + (v[r][j].z * v[r][j].z + v[r][j].w * v[r][j].w);
            sq = wave_sum(sq);
            unsigned long long* o8 = (unsigned long long*)((bf16*)(ws + W_XN) + (size_t)m * D) + lane;
#pragma unroll
            for (int j = 0; j < 4; ++j) o8[64 * j] = (unsigned long long)pk2(v[r][j].x, v[r][j].y) | ((unsigned long long)pk2(v[r][j].z, v[r][j].w) << 32);
            if (lane == 0) ((float*)(ws + W_SS))[m] = sq; }
    }
    for (int o = gw * 64 + lane; o < 5 * MT; o += ngw * 64) ((float*)(ws + W_SS))[MT + o] = 0.f;
    for (int m = gw; m < 2048; m += ngw) { const int l = m >> 10, r = m & 1023;
        rms_row(p.in[I_MEMP] + (size_t)r * D, p.in[I_LNMEMKV] + l * D, (bf16*)(ws + W_MN) + (size_t)m * D, lane); }
}

constexpr int SG_VS = 520;
template <int W> __device__ __forceinline__ void pool_block(const float (&prev)[16], const float (&cur)[16], float (&o)[16], int t0, bool clampcnt) {
#pragma unroll
    for (int k = 0; k < 16; ++k) { float s = 0.f;
#pragma unroll
        for (int kk = 0; kk < W; ++kk) s += (k - kk >= 0) ? cur[(k - kk) & 15] : prev[(16 + k - kk) & 15];
        float inv = 1.f / (float)W;
        if (clampcnt) { const int t1 = t0 + k + 1; if (t1 < W) inv = __builtin_amdgcn_rcpf((float)t1); }
        o[k] = s * inv - cur[k]; }
}
__device__ __forceinline__ void pool_dispatch(int gi, const float (&prev)[16], const float (&cur)[16], float (&o)[16], int t0, bool clampcnt) {
    if (gi == 0) pool_block<2>(prev, cur, o, t0, clampcnt); else if (gi == 1) pool_block<4>(prev, cur, o, t0, clampcnt);
    else if (gi == 2) pool_block<8>(prev, cur, o, t0, clampcnt); else pool_block<16>(prev, cur, o, t0, clampcnt);
}

__device__ __forceinline__ void sgu_prompt_unit(const Params& p, LAS unsigned char* lds, int unit, int tid, int wave, int lane) {
    const bf16* PROJ = (const bf16*)(p.ws + W_PROJ); bf16* AO = (bf16*)(p.ws + W_AO);
    LAS bf16* Vn = (LAS bf16*)lds;
    const int b = unit >> 6, ch = unit & 63; const size_t r0 = (size_t)b * 8192 + ch * 128;
    {
        float gn[8]; pg8::ld8f(p.in[I_ABVG] + 8 * lane, gn);
        v4u raw[16];
#pragma unroll
        for (int jj = 0; jj < 16; ++jj) raw[jj] = *(const v4u*)(PROJ + (r0 + wave + 8 * jj) * 1536 + 512 + 8 * lane);
#pragma unroll
        for (int jj = 0; jj < 16; ++jj) { const int j = wave + 8 * jj;
            float x[8]; unpack8(raw[jj], x);
            float s = 0.f;
#pragma unroll
            for (int e = 0; e < 8; ++e) s += x[e];
            const float mean = wave_sum(s) * (1.f / 512.f); float q = 0.f;
#pragma unroll
            for (int e = 0; e < 8; ++e) { x[e] -= mean; q += x[e] * x[e]; }
            const float rstd = rsqrtf(wave_sum(q) * (1.f / 512.f) + EPS);
#pragma unroll
            for (int e = 0; e < 8; ++e) x[e] *= rstd * gn[e];
            *(LAS bf16x8*)(Vn + j * SG_VS + 8 * lane) = pack8(x); }
    }
    __syncthreads();
    {
        const int q16 = lane & 15, kq = lane >> 4, nch = (wave >> 1) + 1; int i = 16 * wave + q16;
#pragma unroll 1
        for (int g = 0; g < 4; ++g) {
            asm volatile("" : "+v"(i));
            f32x4 acc[8];
#pragma unroll
            for (int dt = 0; dt < 8; ++dt) acc[dt] = (f32x4){0.f, 0.f, 0.f, 0.f};
            const float* wsr = p.in[I_ABWS] + ((size_t)g * 128 + i) * 128;
            float wva[4][8]; v2u uu8[8];
#pragma unroll
            for (int c = 0; c < 4; ++c) pg8::ld8f(wsr + 32 * c + 8 * kq, wva[c]);
#pragma unroll
            for (int dt = 0; dt < 8; ++dt) uu8[dt] = *(const v2u*)(PROJ + (r0 + i) * 1536 + g * 128 + 16 * dt + 4 * kq);
#pragma unroll
            for (int c = 0; c < 4; ++c) if (c < nch) {
                float (&wv)[8] = wva[c];
#pragma unroll
                for (int e = 0; e < 8; ++e) if (32 * c + 8 * kq + e > i) wv[e] = 0.f;
                const bf16x8 bfrag = pack8(wv);
#pragma unroll
                for (int dt = 0; dt < 8; ++dt) { const LAS bf16* vp = Vn + (32 * c + 8 * kq + (q16 >> 2)) * SG_VS + g * 128 + 16 * dt + 4 * (q16 & 3);
                    const v2u lo = vtr(vp), hi = vtr(vp + 4 * SG_VS);
                    v4u av; av.x = lo.x; av.y = lo.y; av.z = hi.x; av.w = hi.y;
                    acc[dt] = __builtin_amdgcn_mfma_f32_16x16x32_bf16(__builtin_bit_cast(bf16x8, av), bfrag, acc[dt], 0, 0, 0); }
            }
            const float bs = p.in[I_ABBS][g * 128 + i];
#pragma unroll
            for (int dt = 0; dt < 8; ++dt) { const v2u uu = uu8[dt];
                const float o0 = bflo(uu.x) * (acc[dt][0] + bs), o1 = bfhi(uu.x) * (acc[dt][1] + bs), o2 = bflo(uu.y) * (acc[dt][2] + bs), o3 = bfhi(uu.y) * (acc[dt][3] + bs);
                v2u w; w.x = pk2(o0, o1); w.y = pk2(o2, o3);
                *(v2u*)(AO + (r0 + i) * 1024 + g * 128 + 16 * dt + 4 * kq) = w; }
        }
    }
    {
        const int c = tid, gi = c >> 7;
        const bf16* pp = PROJ + 1024 + c;
        float prev[16], cur[16], o[16];
#pragma unroll
        for (int k = 0; k < 16; ++k) prev[k] = (ch > 0) ? bf1(pp[(r0 - 16 + k) * 1536]) : 0.f;
        bf16 nxt[16];
#pragma unroll
        for (int k = 0; k < 16; ++k) nxt[k] = pp[(r0 + k) * 1536];
#pragma unroll 1
        for (int blk = 0; blk < 8; ++blk) {
#pragma unroll
            for (int k = 0; k < 16; ++k) cur[k] = bf1(nxt[k]);
            if (blk < 7) {
#pragma unroll
                for (int k = 0; k < 16; ++k) nxt[k] = pp[(r0 + 16 * (blk + 1) + k) * 1536]; }
            pool_dispatch(gi, prev, cur, o, ch * 128 + 16 * blk, ch == 0 && blk == 0);
#pragma unroll
            for (int k = 0; k < 16; ++k) AO[(r0 + 16 * blk + k) * 1024 + 512 + c] = (bf16)f2bf(o[k]);
            if (ch == 63 && blk == 7) {
#pragma unroll
                for (int k = 1; k < 16; ++k) p.out[O_POOLP + ((size_t)b * 15 + (k - 1)) * 512 + c] = cur[k]; }
#pragma unroll
            for (int k = 0; k < 16; ++k) prev[k] = cur[k];
        }
    }
    __syncthreads();
}

__device__ __forceinline__ void sgu_sample_unit(const Params& p, LAS unsigned char* lds, int b, int tid, int wave, int lane) {
    const bf16* PROJ = (const bf16*)(p.ws + W_PROJ); bf16* AO = (bf16*)(p.ws + W_AO);
    LAS float* red = (LAS float*)lds;
    const int c = tid, g = c >> 7; const size_t rs = (size_t)MP + 8 * b;
    float x[8], st[16];
#pragma unroll
    for (int j = 0; j < 8; ++j) { x[j] = bf1(PROJ[(rs + j) * 1536 + 512 + c]); st[j] = wave_sum(x[j]); st[8 + j] = wave_sum(x[j] * x[j]); }
    if (lane == 0) {
#pragma unroll
        for (int j = 0; j < 16; ++j) red[wave * 16 + j] = st[j]; }
    __syncthreads();
    float v[8]; const float gn = p.in[I_ABVG][c];
#pragma unroll
    for (int j = 0; j < 8; ++j) { float s = 0.f, q = 0.f;
#pragma unroll
        for (int w = 0; w < 8; ++w) { s += red[w * 16 + j]; q += red[w * 16 + 8 + j]; }
        const float mean = s * (1.f / 512.f), var = fmaxf(q * (1.f / 512.f) - mean * mean, 0.f);
        v[j] = (x[j] - mean) * rsqrtf(var + EPS) * gn;
        p.out[O_CHV + ((size_t)b * 8 + j) * 512 + c] = v[j]; }
    const float* wsg = p.in[I_ABWS] + (size_t)g * 128 * 128;
#pragma unroll
    for (int i = 0; i < 8; ++i) { float sg = p.in[I_ABBS][g * 128 + i];
#pragma unroll
        for (int j = 0; j < 8; ++j) if (j <= i) sg += wsg[i * 128 + j] * v[j];
        AO[(rs + i) * 1024 + c] = (bf16)f2bf(bf1(PROJ[(rs + i) * 1536 + c]) * sg); }
    float pe[24];
    pe[0] = 0.f;
#pragma unroll
    for (int k = 0; k < 15; ++k) pe[1 + k] = p.in[I_CPOOL][((size_t)b * 15 + k) * 512 + c];
#pragma unroll
    for (int i = 0; i < 8; ++i) pe[16 + i] = bf1(PROJ[(rs + i) * 1536 + 1024 + c]);
    const int W = 2 << g; const float invW = __builtin_amdgcn_rcpf((float)W);
#pragma unroll
    for (int i = 0; i < 8; ++i) { float s = 0.f;
#pragma unroll
        for (int kk = 0; kk < 16; ++kk) if (kk < W) s += pe[16 + i - kk];
        AO[(rs + i) * 1024 + 512 + c] = (bf16)f2bf(s * invW - pe[16 + i]); }
#pragma unroll
    for (int k = 0; k < 15; ++k) p.out[O_POOLS + ((size_t)b * 15 + k) * 512 + c] = pe[9 + k];
    __syncthreads();
}

constexpr int SWA_KS = 72, SWA_VS = 72, SWA_VOFF = 256 * SWA_KS * 2;
template <bool SAMPLE>
__device__ __forceinline__ void swa_unit(const Params& p, LAS unsigned char* lds, int unit, int tid, int wave, int lane) {
    const bf16* Q = (const bf16*)(p.ws + W_PROJ); const float* KV = (const float*)(p.ws + W_KV32); bf16* AO = (bf16*)(p.ws + W_AO);
    LAS bf16* Kl = (LAS bf16*)lds; LAS bf16* Vt = (LAS bf16*)(lds + SWA_VOFF);
    int b, kvh, nb;
    if (!SAMPLE) { nb = unit & 63; kvh = (unit >> 6) & 3; b = unit >> 8; } else { kvh = unit & 3; b = unit >> 2; nb = 0; }
    constexpr int NKEY = SAMPLE ? 160 : 256;
    {
        const int sub = tid & 7;
        float kg[8]; pg8::ld8f(p.in[I_CKG] + 8 * sub, kg);
        constexpr int NIT = SAMPLE ? 3 : 4;
        float kk[NIT][8], vv[NIT][8];
#pragma unroll
        for (int it = 0; it < NIT; ++it) { const int s = (tid >> 3) + 64 * it;
            const float* kp = nullptr; const float* vp = nullptr;
            if (!SAMPLE) { const int trel = (nb - 1) * 128 + s;
                if (trel >= 0) { kp = KV + ((size_t)b * 8192 + trel) * 512 + kvh * 64 + sub * 8; vp = kp + 256; } }
            else { if (s < 128) { const size_t o = (((size_t)b * 128 + s) * 4 + kvh) * 64 + sub * 8; kp = p.in[I_CSK] + o; vp = p.in[I_CSV] + o; }
                else if (s < 136) { kp = KV + ((size_t)MP + 8 * b + (s - 128)) * 512 + kvh * 64 + sub * 8; vp = kp + 256; } }
            if (kp) { if (SAMPLE) { pg8::ld8f_nt(kp, kk[it]); pg8::ld8f_nt(vp, vv[it]); } else { pg8::ld8f(kp, kk[it]); pg8::ld8f(vp, vv[it]); } } else { pg8::zero8(kk[it]); pg8::zero8(vv[it]); } }
#pragma unroll
        for (int it = 0; it < NIT; ++it) { const int s = (tid >> 3) + 64 * it;
            __builtin_amdgcn_sched_barrier(0);
            if (s < NKEY) {
            bool norm; float pos;
            if (!SAMPLE) { const int trel = (nb - 1) * 128 + s; norm = trel >= 0; pos = (float)trel; }
            else { norm = (s >= 128 && s < 136); pos = (float)(16384 + s - 128); }
            float (&k)[8] = kk[it]; float (&v)[8] = vv[it];
            asm volatile("" : "+v"(pos));
            if (norm) { float ss = 0.f;
#pragma unroll
                for (int e = 0; e < 8; ++e) ss += k[e] * k[e];
                ss += __shfl_xor(ss, 1); ss += __shfl_xor(ss, 2); ss += __shfl_xor(ss, 4);
                const float rs = rsqrtf(ss * (1.f / 64.f) + EPS);
#pragma unroll
                for (int e = 0; e < 8; ++e) k[e] *= rs * kg[e];
#pragma unroll
                for (int e = 0; e < 8; ++e) { const float pk = __shfl_xor(k[e], 1); float cs, sn; rope_cs(pos, e, cs, sn);
                    if (sub == 0) k[e] = k[e] * cs - pk * sn; else if (sub == 1) k[e] = k[e] * cs + pk * sn; }
            }
            *(LAS bf16x8*)(Kl + s * SWA_KS + sub * 8) = pack8(k);
            *(LAS bf16x8*)(Vt + s * SWA_VS + sub * 8) = pack8(v);
            if (!SAMPLE) { if (nb == 63 && s >= 128) { const size_t o = (((size_t)b * 128 + (s - 128)) * 4 + kvh) * 64 + sub * 8;
                    *(f32x4*)(p.out + O_SKP + o) = (f32x4){k[0], k[1], k[2], k[3]}; *(f32x4*)(p.out + O_SKP + o + 4) = (f32x4){k[4], k[5], k[6], k[7]};
                    *(f32x4*)(p.out + O_SVP + o) = (f32x4){v[0], v[1], v[2], v[3]}; *(f32x4*)(p.out + O_SVP + o + 4) = (f32x4){v[4], v[5], v[6], v[7]}; } }
            else { if (s >= 8 && s < 136) { const size_t o = (((size_t)b * 128 + (s - 8)) * 4 + kvh) * 64 + sub * 8;
                    __builtin_nontemporal_store((f32x4){k[0], k[1], k[2], k[3]}, (f32x4*)(p.out + O_SKS + o)); __builtin_nontemporal_store((f32x4){k[4], k[5], k[6], k[7]}, (f32x4*)(p.out + O_SKS + o + 4));
                    __builtin_nontemporal_store((f32x4){v[0], v[1], v[2], v[3]}, (f32x4*)(p.out + O_SVS + o)); __builtin_nontemporal_store((f32x4){v[4], v[5], v[6], v[7]}, (f32x4*)(p.out + O_SVS + o + 4)); } }
            }
        }
    }
    __syncthreads();
    constexpr int NPASS = SAMPLE ? 1 : 4;
    if (!SAMPLE || wave < 2) {
        asm volatile("" : "+v"(lane));
        float rc[8], rsn[8];
        { const int q16 = lane & 15; const float pos0 = SAMPLE ? (float)(16384 + (q16 & 7)) : (float)(nb * 128 + 16 * wave + q16);
#pragma unroll
          for (int e = 0; e < 8; ++e) rope_cs(pos0, e, rc[e], rsn[e]); }
        float qgs[2][8];
        {
#pragma unroll
          for (int dc = 0; dc < 2; ++dc) { pg8::ld8f(p.in[I_CQG] + 32 * dc + 8 * (lane >> 4), qgs[dc]);
#pragma unroll
            for (int e = 0; e < 8; ++e) qgs[dc][e] *= 0.125f; } }
        v4u qraw[2];
        { const int q16 = lane & 15, kq = lane >> 4;
          const size_t row0 = SAMPLE ? (size_t)MP + 8 * b + (q16 & 7) : (size_t)b * 8192 + nb * 128 + 16 * wave + q16;
          const int h0 = kvh * 4 + (SAMPLE ? 2 * wave + (q16 >> 3) : 0);
#pragma unroll
          for (int dc = 0; dc < 2; ++dc) qraw[dc] = *(const v4u*)(Q + row0 * 1024 + h0 * 64 + 32 * dc + 8 * kq); }
#pragma unroll 1
        for (int ps = 0; ps < NPASS; ++ps) {
            int q16 = lane & 15, kq = lane >> 4; asm volatile("" : "+v"(q16), "+v"(kq));
            int g, i, c0; size_t row; float pos;
            if (!SAMPLE) { g = ps; i = 16 * wave + q16; row = (size_t)b * 8192 + nb * 128 + i; pos = (float)(nb * 128 + i); c0 = wave >> 1; }
            else { g = 2 * wave + (q16 >> 3); i = q16 & 7; row = (size_t)MP + 8 * b + i; pos = (float)(16384 + i); c0 = 0; }
            const int h = kvh * 4 + g;
            float qv[2][8];
#pragma unroll
            for (int dc = 0; dc < 2; ++dc) unpack8(qraw[dc], qv[dc]);
            if (!SAMPLE && ps + 1 < NPASS) {
#pragma unroll
                for (int dc = 0; dc < 2; ++dc) qraw[dc] = *(const v4u*)(Q + row * 1024 + (h + 1) * 64 + 32 * dc + 8 * kq); }
            float ss = 0.f;
#pragma unroll
            for (int dc = 0; dc < 2; ++dc)
#pragma unroll
                for (int e = 0; e < 8; ++e) ss += qv[dc][e] * qv[dc][e];
            ss += __shfl_xor(ss, 16); ss += __shfl_xor(ss, 32);
            const float rs = rsqrtf(ss * (1.f / 64.f) + EPS);
#pragma unroll
            for (int dc = 0; dc < 2; ++dc) {
#pragma unroll
                for (int e = 0; e < 8; ++e) qv[dc][e] *= rs * qgs[dc][e]; }
#pragma unroll
            for (int e = 0; e < 8; ++e) { const float pk = __shfl_xor(qv[0][e], 16); const float cs = rc[e], sn = rsn[e];
                if (kq == 0) qv[0][e] = qv[0][e] * cs - pk * sn; else if (kq == 1) qv[0][e] = qv[0][e] * cs + pk * sn; }
            bf16x8 qf[2];
#pragma unroll
            for (int dc = 0; dc < 2; ++dc) qf[dc] = pack8(qv[dc]);
            f32x4 S[5][2];
            const float sink = p.in[I_CSINK][h];
            float mx = sink;
#pragma unroll
            for (int cc = 0; cc < 5; ++cc)
#pragma unroll
                for (int tt = 0; tt < 2; ++tt) { const int kb = 32 * (c0 + cc) + 16 * tt; f32x4 a = (f32x4){0.f, 0.f, 0.f, 0.f};
#pragma unroll
                    for (int dc = 0; dc < 2; ++dc) { const bf16x8 kf = *(const LAS bf16x8*)(Kl + (kb + q16) * SWA_KS + 32 * dc + 8 * kq);
                        a = __builtin_amdgcn_mfma_f32_16x16x32_bf16(kf, qf[dc], a, 0, 0, 0); }
                    const int rel = (kb >> 4) - wave;
                    const bool full = !SAMPLE && rel >= 1 && rel <= 7 && (nb > 0 || kb >= 128);
                    if (!full) {
#pragma unroll
                        for (int e = 0; e < 4; ++e) { const int s = kb + 4 * kq + e; const bool ok = (s > i) && (s <= i + 128) && (SAMPLE || nb > 0 || s >= 128);
                            a[e] = ok ? a[e] : -INFINITY; } }
#pragma unroll
                    for (int e = 0; e < 4; ++e) mx = fmaxf(mx, a[e]);
                    S[cc][tt] = a; }
            mx = fmaxf(mx, __shfl_xor(mx, 16)); mx = fmaxf(mx, __shfl_xor(mx, 32));
            float den = 0.f;
#pragma unroll
            for (int cc = 0; cc < 5; ++cc)
#pragma unroll
                for (int tt = 0; tt < 2; ++tt)
#pragma unroll
                    for (int e = 0; e < 4; ++e) { const float pe = __expf(S[cc][tt][e] - mx); S[cc][tt][e] = pe; den += pe; }
            den += __shfl_xor(den, 16); den += __shfl_xor(den, 32);
            den += __expf(sink - mx);
            const float rden = 1.f / den;
            bf16x8 pf[5];
#pragma unroll
            for (int cc = 0; cc < 5; ++cc) { float t8[8];
#pragma unroll
                for (int e = 0; e < 4; ++e) { t8[e] = S[cc][0][e]; t8[4 + e] = S[cc][1][e]; }
                pf[cc] = pack8(t8); }
#pragma unroll
            for (int dt = 0; dt < 4; ++dt) { f32x4 o = (f32x4){0.f, 0.f, 0.f, 0.f};
#pragma unroll
                for (int cc = 0; cc < 5; ++cc) { const LAS bf16* vp = Vt + (32 * (c0 + cc) + 4 * kq + (q16 >> 2)) * SWA_VS + 16 * dt + 4 * (q16 & 3);
                    const v2u lo = vtr(vp), hi = vtr(vp + 16 * SWA_VS);
                    v4u av; av.x = lo.x; av.y = lo.y; av.z = hi.x; av.w = hi.y;
                    o = __builtin_amdgcn_mfma_f32_16x16x32_bf16(__builtin_bit_cast(bf16x8, av), pf[cc], o, 0, 0, 0); }
                v2u w; w.x = pk2(o[0] * rden, o[1] * rden); w.y = pk2(o[2] * rden, o[3] * rden);
                *(v2u*)(AO + row * 1024 + h * 64 + 16 * dt + 4 * kq) = w; }
        }
    }
    __syncthreads();
}

constexpr int MEM_KS = 136, MEM_VS = 136, MEM_VOFF = 256 * MEM_KS * 2;
static_assert(MEM_VOFF + 256 * MEM_VS * 2 <= LDS_CTL_OFF && 128 * SG_VS * 2 <= LDS_CTL_OFF, "LDS");
template <bool SAMPLE>
__device__ __forceinline__ void mem_unit(const Params& p, int l, LAS unsigned char* lds, int unit, int tid, int wave, int lane) {
    const bf16* MQ = (const bf16*)(p.ws + W_MQ); bf16* MO = (bf16*)(p.ws + W_MO);
    LAS bf16* Kl = (LAS bf16*)lds; LAS bf16* Vt = (LAS bf16*)(lds + MEM_VOFF);
    int b, h, qt;
    if (!SAMPLE) { qt = unit & 15; h = (unit >> 4) & 3; b = unit >> 6; } else { h = unit & 3; b = unit >> 2; qt = 0; }
    {
        const int sub = tid & 15;
        float kg[8]; pg8::ld8f(p.in[I_MKG] + l * 128 + 8 * sub, kg);
#pragma unroll 1
        for (int hb = 0; hb < 2; ++hb) {
            float kk[4][8], vv[4][8];
#pragma unroll
            for (int it = 0; it < 4; ++it) { const int s = (tid >> 4) + 32 * (4 * hb + it);
                const float* kp; const float* vp;
                if (!SAMPLE) { kp = (const float*)(p.ws + W_MKV) + ((size_t)l * 1024 + b * 256 + s) * 1024 + h * 128 + sub * 8; vp = kp + 512; }
                else { const size_t o = ((((size_t)l * 128 + b) * 256 + s) * 4 + h) * 128 + sub * 8; kp = p.in[I_CMK] + o; vp = p.in[I_CMV] + o; }
                if (SAMPLE) { pg8::ld8f_nt(kp, kk[it]); pg8::ld8f_nt(vp, vv[it]); } else { pg8::ld8f(kp, kk[it]); pg8::ld8f(vp, vv[it]); } }
#pragma unroll
            for (int it = 0; it < 4; ++it) { const int s = (tid >> 4) + 32 * (4 * hb + it);
                float (&k)[8] = kk[it]; float (&v)[8] = vv[it];
                if (!SAMPLE) { float ss = 0.f;
#pragma unroll
                    for (int e = 0; e < 8; ++e) ss += k[e] * k[e];
                    ss += __shfl_xor(ss, 1); ss += __shfl_xor(ss, 2); ss += __shfl_xor(ss, 4); ss += __shfl_xor(ss, 8);
                    const float rs = rsqrtf(ss * (1.f / 128.f) + EPS);
#pragma unroll
                    for (int e = 0; e < 8; ++e) k[e] *= rs * kg[e];
                    if (qt == 0) { const size_t o = ((((size_t)l * 4 + b) * 256 + s) * 4 + h) * 128 + sub * 8;
                        *(f32x4*)(p.out + O_MKP + o) = (f32x4){k[0], k[1], k[2], k[3]}; *(f32x4*)(p.out + O_MKP + o + 4) = (f32x4){k[4], k[5], k[6], k[7]};
                        *(f32x4*)(p.out + O_MVP + o) = (f32x4){v[0], v[1], v[2], v[3]}; *(f32x4*)(p.out + O_MVP + o + 4) = (f32x4){v[4], v[5], v[6], v[7]}; }
                }
                *(LAS bf16x8*)(Kl + s * MEM_KS + sub * 8) = pack8(k);
                *(LAS bf16x8*)(Vt + s * MEM_VS + sub * 8) = pack8(v);
            }
        }
    }
    __syncthreads();
    if (!SAMPLE || wave == 0) {
#pragma unroll 1
      for (int qq = 0; qq < (SAMPLE ? 1 : 4); ++qq) {
        int q16 = lane & 15, kq = lane >> 4; asm volatile("" : "+v"(q16), "+v"(kq));
        size_t row; bool st;
        if (!SAMPLE) { row = (size_t)b * 8192 + (qt * 4 + qq) * 128 + 16 * wave + q16; st = true; } else { row = (size_t)MP + 8 * b + (q16 & 7); st = q16 < 8; }
        bf16x8 qf[4];
        {
            float qv[4][8]; float ss = 0.f;
#pragma unroll
            for (int dc = 0; dc < 4; ++dc) { unpack8(*(const v4u*)(MQ + row * 512 + h * 128 + 32 * dc + 8 * kq), qv[dc]);
#pragma unroll
                for (int e = 0; e < 8; ++e) ss += qv[dc][e] * qv[dc][e]; }
            ss += __shfl_xor(ss, 16); ss += __shfl_xor(ss, 32);
            const float rs = rsqrtf(ss * (1.f / 128.f) + EPS) * 0.08838834764831845f;
#pragma unroll
            for (int dc = 0; dc < 4; ++dc) { float qg[8]; pg8::ld8f(p.in[I_MQG] + l * 128 + 32 * dc + 8 * kq, qg);
#pragma unroll
                for (int e = 0; e < 8; ++e) qv[dc][e] *= rs * qg[e];
                qf[dc] = pack8(qv[dc]); }
        }
        f32x4 S[8][2]; float mx = -INFINITY;
#pragma unroll
        for (int cc = 0; cc < 8; ++cc)
#pragma unroll
            for (int tt = 0; tt < 2; ++tt) { const int kb = 32 * cc + 16 * tt; f32x4 a = (f32x4){0.f, 0.f, 0.f, 0.f};
#pragma unroll
                for (int dc = 0; dc < 4; ++dc) { const bf16x8 kf = *(const LAS bf16x8*)(Kl + (kb + q16) * MEM_KS + 32 * dc + 8 * kq);
                    a = __builtin_amdgcn_mfma_f32_16x16x32_bf16(kf, qf[dc], a, 0, 0, 0); }
#pragma unroll
                for (int e = 0; e < 4; ++e) mx = fmaxf(mx, a[e]);
                S[cc][tt] = a; }
        mx = fmaxf(mx, __shfl_xor(mx, 16)); mx = fmaxf(mx, __shfl_xor(mx, 32));
        float den = 0.f;
#pragma unroll
        for (int cc = 0; cc < 8; ++cc)
#pragma unroll
            for (int tt = 0; tt < 2; ++tt)
#pragma unroll
                for (int e = 0; e < 4; ++e) { const float pe = __expf(S[cc][tt][e] - mx); S[cc][tt][e] = pe; den += pe; }
        den += __shfl_xor(den, 16); den += __shfl_xor(den, 32);
        const float rden = 1.f / den;
        bf16x8 pf[8];
#pragma unroll
        for (int cc = 0; cc < 8; ++cc) { float t8[8];
#pragma unroll
            for (int e = 0; e < 4; ++e) { t8[e] = S[cc][0][e]; t8[4 + e] = S[cc][1][e]; }
            pf[cc] = pack8(t8); }
#pragma unroll
        for (int dt = 0; dt < 8; ++dt) { f32x4 o = (f32x4){0.f, 0.f, 0.f, 0.f};
#pragma unroll
            for (int cc = 0; cc < 8; ++cc) { const LAS bf16* vp = Vt + (32 * cc + 4 * kq + (q16 >> 2)) * MEM_VS + 16 * dt + 4 * (q16 & 3);
                const v2u lo = vtr(vp), hi = vtr(vp + 16 * MEM_VS);
                v4u av; av.x = lo.x; av.y = lo.y; av.z = hi.x; av.w = hi.y;
                o = __builtin_amdgcn_mfma_f32_16x16x32_bf16(__builtin_bit_cast(bf16x8, av), pf[cc], o, 0, 0, 0); }
            if (st) { v2u w; w.x = pk2(o[0] * rden, o[1] * rden); w.y = pk2(o[2] * rden, o[3] * rden);
                *(v2u*)(MO + row * 512 + h * 128 + 16 * dt + 4 * kq) = w; } }
      }
    }
    __syncthreads();
}

#ifndef REP_LIGHT
#define REP_LIGHT 1
#endif
#ifndef REP_G9
#define REP_G9 1
#endif
#ifndef REP_G10
#define REP_G10 1
#endif
#ifndef REP_PRO
#define REP_PRO 1
#endif
#ifndef REP_MEM
#define REP_MEM 1
#endif
#ifndef REP_P15
#define REP_P15 1
#endif
#ifndef REP_SYNC
#define REP_SYNC 1
#endif
#define GSYNC() do { for (int r_ = 0; r_ < REP_SYNC; ++r_) xcd_barrier(xbar); } while (0)
#define PHASE_IDS int t_ = threadIdx.x; asm volatile("" : "+v"(t_)); const int tid = t_, lane = tid & 63, wave = __builtin_amdgcn_readfirstlane(tid >> 6); const int gw = bx * NWAVES + wave; (void)gw; (void)lane; (void)tid;
__global__ void __launch_bounds__(NTHR, 2) fwd_megakernel(Params p) {
    extern __shared__ __attribute__((aligned(16))) unsigned char lds_raw[];
    LAS unsigned char* lds = (LAS unsigned char*)lds_raw;
    cg::grid_group grid = cg::this_grid();
    const int G = gridDim.x, bx = blockIdx.x;
    const int wave0 = __builtin_amdgcn_readfirstlane((int)threadIdx.x >> 6);
    const int ngw = G * NWAVES;
    unsigned char* ws = p.ws;
    bf16* XN = (bf16*)(ws + W_XN);
    float* SSb = (float*)(ws + W_SS);
    float* X = p.out;
    typedef pg8::bf16_t pb;

    if (threadIdx.x < 16) ((LAS unsigned*)(lds + LDS_CTL_OFF))[threadIdx.x] = 0u;
    __syncthreads();
    const XcdBarrier xbar = xcd_barrier_post((unsigned*)(ws + W_CTL), (volatile LAS unsigned*)(lds + LDS_CTL_OFF));
    for (int rep = 0; rep < REP_LIGHT * REP_PRO; ++rep) { PHASE_IDS prologue(p, lds, gw, ngw, wave, lane); }
    grid.sync();

    auto layer_body = [&](auto LC) __attribute__((always_inline)) {
        constexpr int l = decltype(LC)::value;
        unsigned char* wl = ws + W_LAYER + (size_t)l * WL_SIZE;
        if (l == 0) {
            { pg8::Gemm g{(const pb*)XN, (const pb*)(ws + W_WIN), MT, 1536, 1024}; pg8::StaticOrder S; S.init(MP, 1536, G, bx);
              pg8::EpiAct E{(pb*)(ws + W_PROJ), 1536, 4, SSb};
              pg8::gemm_phase<pg8::EpiAct, pg8::StaticOrder, true, true>(lds, g, S, E, wave0);
              pg8::mini_gemm(lds, g.A, g.Bt, 1024, 12, E, bx, G, wave0); }
#pragma unroll 1
            for (int ll = 0; ll < 2; ++ll) {
              pg8::EpiRes E{(float*)(ws + W_MKV) + (size_t)ll * 1024 * 1024, nullptr, nullptr, 0, nullptr, nullptr, 0};
              pg8::mini_gemm(lds, (const pb*)(ws + W_MN) + (size_t)ll * 1024 * 1024, (const pb*)(ws + W_LAYER + (size_t)ll * WL_SIZE + WL_WKV), 1024, 8, E, (bx + G - 96 - 64 * ll) % G, G, wave0, 0); }
        } else {
            pg8::Gemm g{(const pb*)XN, (const pb*)(ws + W_WQKV), MT, 1536, 1024}; pg8::StaticOrder S; S.init(MP, 1536, G, bx);
            pg8::EpiQKV E{(pb*)(ws + W_PROJ), (float*)(ws + W_KV32), SSb + (size_t)3 * MT};
            pg8::gemm_phase<pg8::EpiQKV, pg8::StaticOrder, true, true>(lds, g, S, E, wave0);
            pg8::mini_gemm(lds, g.A, g.Bt, 1024, 12, E, bx, G, wave0);
        }
        GSYNC();
        if (l == 0) {
#ifndef NO_SGU
            PHASE_IDS
            for (int rep = 0; rep < REP_LIGHT; ++rep)
            for (int u = bx; u < 256 + 128; u += G) { if (u < 256) sgu_prompt_unit(p, lds, u, tid, wave, lane); else sgu_sample_unit(p, lds, u - 256, tid, wave, lane); }
#endif
        } else {
#ifndef NO_SWA
            PHASE_IDS
            for (int rep = 0; rep < REP_LIGHT; ++rep)
            for (int u = bx; u < 1024 + 512; u += G) { if (u < 1024) swa_unit<false>(p, lds, u, tid, wave, lane); else swa_unit<true>(p, lds, u - 1024, tid, wave, lane); }
#endif
        }
        GSYNC();
        {
            pg8::Gemm g{(const pb*)(ws + W_AO), (const pb*)(ws + (l == 0 ? W_WOUT : W_CWO)), MT, 1024, 1024}; pg8::StaticOrder S; S.init(MP, 1024, G, bx);
            pg8::EpiRes E{nullptr, nullptr, nullptr, 1, (pb*)XN, SSb + (size_t)(1 + 3 * l) * MT, 1};
            pg8::gemm_phase<pg8::EpiRes, pg8::StaticOrder, true, true>(lds, g, S, E, wave0);
            pg8::mini_gemm<pg8::EpiRes, true>(lds, g.A, g.Bt, 1024, 16, E, bx, G, wave0);
        }
        GSYNC();
        {
            pg8::Gemm g{(const pb*)XN, (const pb*)(wl + WL_WQ), MT, 512, 1024}; pg8::StaticOrder S; S.init(MP, 512, G, bx);
            pg8::EpiAct E{(pb*)(ws + W_MQ), 512, 0, SSb + (size_t)(1 + 3 * l) * MT};
            pg8::gemm_phase<pg8::EpiAct, pg8::StaticOrder, true, true>(lds, g, S, E, wave0);
            pg8::mini_gemm<pg8::EpiAct, true>(lds, g.A, g.Bt, 1024, 8, E, bx, G, wave0);
        }
        GSYNC();
#ifndef NO_MEM
        { PHASE_IDS
        for (int rep = 0; rep < REP_LIGHT * REP_MEM; ++rep)
        for (int u = bx; u < 256 + 512; u += G) { if (u < 256) mem_unit<false>(p, l, lds, u, tid, wave, lane); else mem_unit<true>(p, l, lds, u - 256, tid, wave, lane); } }
#endif
        GSYNC();
        {
            pg8::Gemm g{(const pb*)(ws + W_MO), (const pb*)(wl + WL_WO), MT, 1024, 512}; pg8::StaticOrder S; S.init(MP, 1024, G, bx);
            pg8::EpiRes E{nullptr, nullptr, nullptr, 1, (pb*)XN, SSb + (size_t)(2 + 3 * l) * MT, 1};
            pg8::gemm_phase<pg8::EpiRes, pg8::StaticOrder, true, true>(lds, g, S, E, wave0);
            pg8::mini_gemm<pg8::EpiRes, true>(lds, g.A, g.Bt, 512, 16, E, bx, G, wave0);
        }
        GSYNC();
        {
            pg8::Gemm g{(const pb*)XN, (const pb*)(wl + WL_WUP), MT, DFF, 1024}; pg8::SplitOrder S; S.init(DFF, G, bx);
            pg8::EpiG E{(pb*)(ws + W_G), p.out + O_FCP + (size_t)l * 4 * 2 * DFF, p.out + O_FCS + (size_t)l * 128 * 2 * DFF, SSb + (size_t)(2 + 3 * l) * MT};
            for (int rep = 0; rep < REP_G9; ++rep) pg8::gemm_phase<pg8::EpiG, pg8::SplitOrder, true, true>(lds, g, S, E, wave0);
        }
        GSYNC();
        {
            pg8::Gemm g{(const pb*)XN, (const pb*)(wl + WL_WUP) + (size_t)DFF * 1024, MT, DFF, 1024}; pg8::SplitOrder S; S.init(DFF, G, bx);
            pg8::EpiH E{(const pb*)(ws + W_G), (pb*)(ws + W_H), p.in[I_FCW] + (size_t)l * 3 * DFF, p.in[I_FCB] + (size_t)l * DFF, p.in[I_CFC] + (size_t)l * 128 * 2 * DFF, SSb + (size_t)(2 + 3 * l) * MT};
            for (int rep = 0; rep < REP_G10; ++rep) pg8::gemm_phase<pg8::EpiH, pg8::SplitOrder, true, true>(lds, g, S, E, wave0);
        }
        GSYNC();
        {
            pg8::Gemm g{(const pb*)(ws + W_H), (const pb*)(wl + WL_WDN), MT, 1024, DFF}; pg8::StaticOrder S; S.init(MP, 1024, G, bx);
            pg8::EpiRes E{l == 0 ? nullptr : X, nullptr, nullptr, 1, (pb*)XN, SSb + (size_t)3 * MT, l == 0};
            pg8::gemm_phase<pg8::EpiRes, pg8::StaticOrder, true, true>(lds, g, S, E, wave0);
            pg8::mini_gemm<pg8::EpiRes, true>(lds, g.A, g.Bt, DFF, 16, E, bx, G, wave0);
        }
        GSYNC();
    };
    layer_body(std::integral_constant<int, 0>{});
    layer_body(std::integral_constant<int, 1>{});
}

extern "C" void kernel_launch(void* const* d_in, const int* in_sizes, int n_in, void* d_out, int out_size, void* d_ws, size_t ws_size, hipStream_t stream) {
    static int grid_blocks = 0;
    if (grid_blocks == 0) {
        if (n_in != N_IN || (size_t)out_size != O_END || ws_size < W_NEED) { fprintf(stderr, "kernel_launch: unexpected shapes: n_in %d out %d ws %zu (need %zu)\n", n_in, out_size, ws_size, (size_t)W_NEED); grid_blocks = -1; return; }
        int dev = 0, cus = 0, per_cu = 0;
        hipGetDevice(&dev);
        hipDeviceGetAttribute(&cus, hipDeviceAttributeMultiprocessorCount, dev);
        if (hipFuncSetAttribute((const void*)fwd_megakernel, hipFuncAttributeMaxDynamicSharedMemorySize, LDS_BYTES) != hipSuccess) { fprintf(stderr, "kernel_launch: hipFuncSetAttribute failed\n"); grid_blocks = -1; return; }
        if (hipOccupancyMaxActiveBlocksPerMultiprocessor(&per_cu, (const void*)fwd_megakernel, NTHR, LDS_BYTES) != hipSuccess || per_cu < 1) { fprintf(stderr, "kernel_launch: occupancy query failed (%d)\n", per_cu); (void)hipGetLastError(); grid_blocks = -1; return; }
        grid_blocks = cus * per_cu;
    }
    if (grid_blocks < 0) return;
    if (hipMemsetAsync((char*)d_ws + W_CTL, 0, CTL_BYTES, stream) != hipSuccess) { fprintf(stderr, "kernel_launch: memset failed\n"); return; }
    Params p{};
    for (int i = 0; i < N_IN; ++i) p.in[i] = (const float*)d_in[i];
    p.out = (float*)d_out; p.ws = (unsigned char*)d_ws;
    void* args[] = {&p};
    hipError_t e = hipLaunchCooperativeKernel((const void*)fwd_megakernel, dim3(grid_blocks), dim3(NTHR), args, LDS_BYTES, stream);
    if (e != hipSuccess) fprintf(stderr, "cooperative launch failed: %s (grid %d)\n", hipGetErrorString(e), grid_blocks);
}
```

```cpp
#include <hip/hip_runtime.h>
#include <hip/hip_cooperative_groups.h>
#include <cstdio>
#include <cstdint>
#include <type_traits>
namespace cg = cooperative_groups;
namespace pg8 {
#define PG8_LAS __attribute__((address_space(3)))
typedef unsigned short bf16_t;
typedef short bf16x8 __attribute__((ext_vector_type(8)));
typedef float f32x4 __attribute__((ext_vector_type(4)));
typedef unsigned u32x4 __attribute__((ext_vector_type(4)));
constexpr int BM = 256, BK = 64, HALF = 128, HTB = HALF * BK * 2  , STAGE_BYTES = 8 * HTB, NXCD = 8, WGM = 8;

__host__ __device__ __forceinline__ int lds_byte(int r, int c) { const int st = (r >> 4) * 2 + (c >> 5), rr = r & 15, cc = c & 31, ob = rr * 64 + cc * 2; return st * 1024 + (ob ^ (((ob >> 9) & 1) << 5)); }
__host__ __device__ __forceinline__ void stage_rc(int b, int& R, int& C) { const int st = b / 1024, sb = b % 1024, swz = sb ^ (((sb >> 9) & 1) << 5); R = (st >> 1) * 16 + swz / 64; C = (st & 1) * 32 + (swz % 64) / 2; }
__host__ __device__ __forceinline__ int perm32(int rho) { const int n = rho >> 4, i = rho & 15; return 8 * (i >> 2) + 4 * n + (i & 3); }

struct Unit { int pm, pn; int rb; int half; int q; int cb; };
struct Gemm { const bf16_t* A; const bf16_t* Bt; int M, N, K; };

struct StaticOrder {
    int nM, nN, nwg, G, c;
    __host__ __device__ void init(int M, int N, int G_, int c_) { nM = M / BM; nN = N / BM; nwg = nM * nN; G = G_; c = c_; }
    __host__ __device__ bool next(int i, Unit& u) const {
        const long L = (long)i * G + c; if (L >= nwg) return false;
        int wgid = (int)L; { const int q = nwg / NXCD, r = nwg % NXCD, xcd = wgid % NXCD, off = wgid / NXCD; wgid = (xcd < r ? xcd * (q + 1) : r * (q + 1) + (xcd - r) * q) + off; }
        const int nig = WGM * nN, gid = wgid / nig, fm = gid * WGM, gsz = (nM - fm) < WGM ? (nM - fm) : WGM;
        u.pm = fm + ((wgid % nig) % gsz); u.pn = (wgid % nig) / gsz; u.rb = u.pm * BM; u.half = 0; u.q = 0; u.cb = u.pn * BM; return true;
    }
    __device__ __forceinline__ void a_ready(const Unit&) const {}
    __device__ __forceinline__ void done(const Unit&) const {}
};
struct SplitOrder {
    StaticOrder P; int nP, nS, nN, G, c;
    __host__ __device__ void init(int N, int G_, int c_) { P.init(32768, N, G_, c_); nP = P.nwg; nN = N / BM; nS = 8 * nN; G = G_; c = c_; }
    __host__ __device__ bool next(int i, Unit& u) const {
        const long L = (long)i * G + c;
        if (L < nP) return P.next(i, u);
        const int j = (int)(L - nP); if (j >= nS) return false;
        const int hm = j & 7; u.pn = j >> 3; u.pm = 128 + (hm >> 1); u.rb = 32768 + 128 * hm; u.half = 1; u.q = 0; u.cb = u.pn * BM; return true;
    }
    __device__ __forceinline__ void a_ready(const Unit&) const {}
    __device__ __forceinline__ void done(const Unit&) const {}
};


__device__ __forceinline__ unsigned cvt_pk_bf16(float lo, float hi) { unsigned r; asm volatile("v_cvt_pk_bf16_f32 %0, %1, %2" : "=v"(r) : "v"(lo), "v"(hi)); return r; }
typedef float f32x2 __attribute__((ext_vector_type(2)));
__device__ __forceinline__ f32x2 gelu_pk(f32x2 v) {
    f32x2 x = v * 0.70710678118f;
    x.x = __builtin_amdgcn_fmed3f(x.x, -2.9f, 2.9f); x.y = __builtin_amdgcn_fmed3f(x.y, -2.9f, 2.9f);
    const f32x2 t = x * x;
    f32x2 p = t * (-4.953124630e-07f) + 1.987094038e-05f;
    p = p * t + (-3.472001117e-04f); p = p * t + 3.517547622e-03f; p = p * t + (-2.333305031e-02f); p = p * t + 1.087993085e-01f; p = p * t + (-3.740358949e-01f); p = p * t + 1.128076553e+00f;
    const f32x2 hv = v * 0.5f;
    return hv * (x * p) + hv;
}

__device__ __forceinline__ float bf_lo(unsigned w) { return __builtin_bit_cast(float, w << 16); }
__device__ __forceinline__ float bf_hi(unsigned w) { return __builtin_bit_cast(float, w & 0xffff0000u); }
__device__ __forceinline__ void ld8bf(const bf16_t* p, float (&o)[8]) { const u32x4 w = *(const u32x4*)p;
    o[0] = bf_lo(w.x); o[1] = bf_hi(w.x); o[2] = bf_lo(w.y); o[3] = bf_hi(w.y); o[4] = bf_lo(w.z); o[5] = bf_hi(w.z); o[6] = bf_lo(w.w); o[7] = bf_hi(w.w); }
__device__ __forceinline__ void ld8f(const float* p, float (&o)[8]) { const f32x4 a = *(const f32x4*)p, b = *(const f32x4*)(p + 4);
    o[0] = a[0]; o[1] = a[1]; o[2] = a[2]; o[3] = a[3]; o[4] = b[0]; o[5] = b[1]; o[6] = b[2]; o[7] = b[3]; }
__device__ __forceinline__ void ld8f_nt(const float* p, float (&o)[8]) { const f32x4 a = __builtin_nontemporal_load((const f32x4*)p), b = __builtin_nontemporal_load((const f32x4*)(p + 4));
    o[0] = a[0]; o[1] = a[1]; o[2] = a[2]; o[3] = a[3]; o[4] = b[0]; o[5] = b[1]; o[6] = b[2]; o[7] = b[3]; }
__device__ __forceinline__ void zero8(float (&o)[8]) {
#pragma unroll
    for (int j = 0; j < 8; ++j) o[j] = 0.f; }

struct EpiAct {
    static constexpr bool PERM = true, AFTER_DRAIN = false;
    bf16_t* O; int ldc; int gelu_tiles; const float* SS;
    __device__ __forceinline__ void operator()(const f32x4 (&acc)[2][2][4][2], const Unit& u, int wr, int wc, int fr, int fq) const {
        asm volatile("" : "+v"(fr), "+v"(fq));
        const int row0 = u.rb + wr * 64 + fr, col0 = u.cb + wc * 32 + 8 * fq;
        const bool act = u.pn < gelu_tiles;
        float rsv[2][4];
#pragma unroll
        for (int ai = 0; ai < 2; ++ai)
#pragma unroll
            for (int m = 0; m < 4; ++m) rsv[ai][m] = SS[row0 + (u.half ? 0 : ai * HALF) + m * 16];
#pragma unroll
        for (int ai = 0; ai < 2; ++ai) if (ai == 0 || !u.half)
#pragma unroll
            for (int m = 0; m < 4; ++m) { bf16_t* rowp = O + (size_t)(row0 + ai * HALF + m * 16) * ldc + col0;
                const float rs = rsqrtf(rsv[ai][m] * (1.f / 1024.f) + 1e-6f);
#pragma unroll
                for (int bj = 0; bj < 2; ++bj) if (bj == 0 || !u.q) { f32x4 v0 = acc[ai][bj][m][0] * rs, v1 = acc[ai][bj][m][1] * rs;
                    if (act) { f32x2 a = gelu_pk((f32x2){v0[0], v0[1]}), b = gelu_pk((f32x2){v0[2], v0[3]}), c = gelu_pk((f32x2){v1[0], v1[1]}), d = gelu_pk((f32x2){v1[2], v1[3]});
                        v0 = (f32x4){a.x, a.y, b.x, b.y}; v1 = (f32x4){c.x, c.y, d.x, d.y}; }
                    u32x4 w; w.x = cvt_pk_bf16(v0[0], v0[1]); w.y = cvt_pk_bf16(v0[2], v0[3]); w.z = cvt_pk_bf16(v1[0], v1[1]); w.w = cvt_pk_bf16(v1[2], v1[3]);
                    *(u32x4*)(rowp + bj * HALF) = w; } }
    }
};

struct EpiQKV {
    static constexpr bool PERM = true, AFTER_DRAIN = false;
    bf16_t* Q; float* KV; const float* SS;
    __device__ __forceinline__ void operator()(const f32x4 (&acc)[2][2][4][2], const Unit& u, int wr, int wc, int fr, int fq) const {
        asm volatile("" : "+v"(fr), "+v"(fq));
        const int row0 = u.rb + wr * 64 + fr;
        float rs[2][4];
#pragma unroll
        for (int ai = 0; ai < 2; ++ai) if (ai == 0 || !u.half)
#pragma unroll
            for (int m = 0; m < 4; ++m) rs[ai][m] = rsqrtf(SS[row0 + (u.half ? 0 : ai * HALF) + m * 16] * (1.f / 1024.f) + 1e-6f);
        if (u.pn < 4) {
            const int col0 = u.cb + wc * 32 + 8 * fq;
#pragma unroll
            for (int ai = 0; ai < 2; ++ai) if (ai == 0 || !u.half)
#pragma unroll
                for (int m = 0; m < 4; ++m) { bf16_t* rowp = Q + (size_t)(row0 + ai * HALF + m * 16) * 1024 + col0;
#pragma unroll
                    for (int bj = 0; bj < 2; ++bj) if (bj == 0 || !u.q) { const f32x4 v0 = acc[ai][bj][m][0] * rs[ai][m], v1 = acc[ai][bj][m][1] * rs[ai][m];
                        u32x4 w; w.x = cvt_pk_bf16(v0[0], v0[1]); w.y = cvt_pk_bf16(v0[2], v0[3]); w.z = cvt_pk_bf16(v1[0], v1[1]); w.w = cvt_pk_bf16(v1[2], v1[3]);
                        *(u32x4*)(rowp + bj * HALF) = w; } }
        } else {
            const int col0 = (u.cb - 1024) + wc * 32 + 8 * fq;
#pragma unroll
            for (int ai = 0; ai < 2; ++ai) if (ai == 0 || !u.half)
#pragma unroll
                for (int m = 0; m < 4; ++m) { float* rowp = KV + (size_t)(row0 + ai * HALF + m * 16) * 512 + col0;
#pragma unroll
                    for (int bj = 0; bj < 2; ++bj) if (bj == 0 || !u.q) { *(f32x4*)(rowp + bj * HALF) = acc[ai][bj][m][0] * rs[ai][m]; *(f32x4*)(rowp + bj * HALF + 4) = acc[ai][bj][m][1] * rs[ai][m]; } }
        }
    }
};

struct EpiRes {
    static constexpr bool PERM = true, AFTER_DRAIN = false;
    float* C; const float* resP; const float* resS; int inplace; bf16_t* XB0; float* SS; int wxb;
    static constexpr int ldc = 1024, split = 32768;
    __device__ __forceinline__ void row_out(const f32x4 v0, const f32x4 v1, int row, int col, float& ss) const {
        if (C) { float* rowp = C + (size_t)row * ldc + col; __builtin_nontemporal_store(v0, (f32x4*)rowp); __builtin_nontemporal_store(v1, (f32x4*)(rowp + 4)); }
        if (wxb) { u32x4 w; w.x = cvt_pk_bf16(v0[0], v0[1]); w.y = cvt_pk_bf16(v0[2], v0[3]); w.z = cvt_pk_bf16(v1[0], v1[1]); w.w = cvt_pk_bf16(v1[2], v1[3]);
            *(u32x4*)(XB0 + (size_t)row * ldc + col) = w;
            ss += (v0[0] * v0[0] + v0[1] * v0[1]) + (v0[2] * v0[2] + v0[3] * v0[3]) + (v1[0] * v1[0] + v1[1] * v1[1]) + (v1[2] * v1[2] + v1[3] * v1[3]); }
    }
    __device__ __forceinline__ void operator()(const f32x4 (&acc)[2][2][4][2], const Unit& u, int wr, int wc, int fr, int fq) const {
        asm volatile("" : "+v"(fr), "+v"(fq));
        const int row0 = u.rb + wr * 64 + fr, col0 = u.cb + wc * 32 + 8 * fq;
        if (inplace) {
#pragma unroll
            for (int ai = 0; ai < 2; ++ai) if (ai == 0 || !u.half)
#pragma unroll
              for (int mh = 0; mh < 4; mh += 2) {
                u32x4 rw[2][2];
#pragma unroll
                for (int mm = 0; mm < 2; ++mm) { const int row = row0 + ai * HALF + (mh + mm) * 16;
#pragma unroll
                    for (int bj = 0; bj < 2; ++bj) if (bj == 0 || !u.q) rw[mm][bj] = *(const u32x4*)(XB0 + (size_t)row * ldc + col0 + bj * HALF); }
#pragma unroll
                for (int mm = 0; mm < 2; ++mm) { const int m = mh + mm, row = row0 + ai * HALF + m * 16; float ss = 0.f;
#pragma unroll
                    for (int bj = 0; bj < 2; ++bj) if (bj == 0 || !u.q) { const u32x4 w = rw[mm][bj];
                        const f32x4 v0 = acc[ai][bj][m][0] + (f32x4){bf_lo(w.x), bf_hi(w.x), bf_lo(w.y), bf_hi(w.y)}, v1 = acc[ai][bj][m][1] + (f32x4){bf_lo(w.z), bf_hi(w.z), bf_lo(w.w), bf_hi(w.w)};
                        row_out(v0, v1, row, col0 + bj * HALF, ss); }
                    if (wxb) { ss += __shfl_xor(ss, 16); ss += __shfl_xor(ss, 32); if (fq == 0) unsafeAtomicAdd(SS + row, ss); } }
              }
        } else {
#pragma unroll
            for (int ai = 0; ai < 2; ++ai) if (ai == 0 || !u.half)
#pragma unroll
                for (int m = 0; m < 4; ++m) { const int row = row0 + ai * HALF + m * 16; float ss = 0.f;
                    const float* rp = resP ? ((row < split ? resP + (size_t)row * ldc : resS + (size_t)(row - split) * ldc) + col0) : nullptr;
                    f32x4 rv[2][2];
#pragma unroll
                    for (int bj = 0; bj < 2; ++bj) if (bj == 0 || !u.q) { rv[bj][0] = rp ? *(const f32x4*)(rp + bj * HALF) : (f32x4){0.f, 0.f, 0.f, 0.f}; rv[bj][1] = rp ? *(const f32x4*)(rp + bj * HALF + 4) : (f32x4){0.f, 0.f, 0.f, 0.f}; }
#pragma unroll
                    for (int bj = 0; bj < 2; ++bj) if (bj == 0 || !u.q) row_out(acc[ai][bj][m][0] + rv[bj][0], acc[ai][bj][m][1] + rv[bj][1], row, col0 + bj * HALF, ss);
                    if (wxb) { ss += __shfl_xor(ss, 16); ss += __shfl_xor(ss, 32); if (fq == 0) unsafeAtomicAdd(SS + row, ss); } }
        }
    }
};

struct EpiG {
    static constexpr bool PERM = true, AFTER_DRAIN = false;
    bf16_t* G; float* outP; float* outS; const float* SS;
    __device__ __forceinline__ void operator()(const f32x4 (&acc)[2][2][4][2], const Unit& u, int wr, int wc, int fr, int fq) const {
        asm volatile("" : "+v"(fr), "+v"(fq));
        const int row0 = u.rb + wr * 64 + fr, col0 = u.pn * BM + wc * 32 + 8 * fq;
        float rsv[2][4];
#pragma unroll
        for (int ai = 0; ai < 2; ++ai)
#pragma unroll
            for (int m = 0; m < 4; ++m) rsv[ai][m] = SS[row0 + (u.half ? 0 : ai * HALF) + m * 16];
#pragma unroll
        for (int ai = 0; ai < 2; ++ai) if (ai == 0 || !u.half)
#pragma unroll
            for (int m = 0; m < 4; ++m) { const int row = row0 + ai * HALF + m * 16; bf16_t* rowp = G + (size_t)row * 2816 + col0;
                float* co = nullptr;
                if (row < 32768) { const int t = row & 8191; if (t >= 8190) co = outP + ((size_t)(row >> 13) * 2 + (t - 8190)) * 2816 + col0; }
                else { const int i = row & 7; if (i >= 6) co = outS + ((size_t)((row - 32768) >> 3) * 2 + (i - 6)) * 2816 + col0; }
                const float rs = rsqrtf(rsv[ai][m] * (1.f / 1024.f) + 1e-6f);
#pragma unroll
                for (int bj = 0; bj < 2; ++bj) { const f32x4 v0 = acc[ai][bj][m][0] * rs, v1 = acc[ai][bj][m][1] * rs;
                    u32x4 w; w.x = cvt_pk_bf16(v0[0], v0[1]); w.y = cvt_pk_bf16(v0[2], v0[3]); w.z = cvt_pk_bf16(v1[0], v1[1]); w.w = cvt_pk_bf16(v1[2], v1[3]);
                    *(u32x4*)(rowp + bj * HALF) = w;
                    if (co) { *(f32x4*)(co + bj * HALF) = v0; *(f32x4*)(co + bj * HALF + 4) = v1; } } }
    }
};

typedef unsigned u32x2 __attribute__((ext_vector_type(2)));
struct EpiH {
    static constexpr bool PERM = true, AFTER_DRAIN = false;
    const bf16_t* G; bf16_t* H; const float* cw; const float* cb; const float* ctx; const float* SS;
    static __device__ __forceinline__ void unpk4(const u32x2 w, float (&o)[4]) { o[0] = bf_lo(w.x); o[1] = bf_hi(w.x); o[2] = bf_lo(w.y); o[3] = bf_hi(w.y); }
    static __device__ __forceinline__ void ld4f(const float* p, float (&o)[4]) { const f32x4 a = *(const f32x4*)p; o[0] = a[0]; o[1] = a[1]; o[2] = a[2]; o[3] = a[3]; }
    static __device__ __forceinline__ u32x2 shf(const u32x2 w, int src) { u32x2 r; r.x = (unsigned)__shfl((int)w.x, src); r.y = (unsigned)__shfl((int)w.y, src); return r; }
    static __device__ __forceinline__ void finish(const float (&g0)[4], const float (&g1)[4], const float (&g2)[4], const float (&w0)[4], const float (&w1)[4], const float (&w2)[4], const float (&bb)[4],
                                                  const f32x4 v, float rs, bf16_t* dst) {
        float h[4];
#pragma unroll
        for (int j = 0; j < 4; j += 2) {
            const f32x2 gc = (f32x2){bb[j] + w0[j] * g2[j] + w1[j] * g1[j] + w2[j] * g0[j], bb[j + 1] + w0[j + 1] * g2[j + 1] + w1[j + 1] * g1[j + 1] + w2[j + 1] * g0[j + 1]};
            const f32x2 ge = gelu_pk(gc); h[j] = ge.x * v[j] * rs; h[j + 1] = ge.y * v[j + 1] * rs; }
        u32x2 w; w.x = cvt_pk_bf16(h[0], h[1]); w.y = cvt_pk_bf16(h[2], h[3]);
        *(u32x2*)dst = w;
    }
    __device__ __forceinline__ void operator()(const f32x4 (&acc)[2][2][4][2], const Unit& u, int wr, int wc, int fr, int fq) const {
        asm volatile("" : "+v"(fr), "+v"(fq));
        const int row0 = u.rb + wr * 64 + fr;
        const int lane = fq * 16 + fr;
        const int s1 = fr >= 1 ? lane - 1 : lane + 15, s2 = fr >= 2 ? lane - 2 : lane + 14;
#pragma unroll
        for (int bj = 0; bj < 2; ++bj)
#pragma unroll
          for (int hv = 0; hv < 2; ++hv) {
            const int col = u.pn * BM + bj * HALF + wc * 32 + 8 * fq + 4 * hv;
            float w0[4], w1[4], w2[4], bb[4];
            ld4f(cw + col, w0); ld4f(cw + 2816 + col, w1); ld4f(cw + 2 * 2816 + col, w2); ld4f(cb + col, bb);
            if (u.pm < 128) {
#pragma unroll
                for (int ai = 0; ai < 2; ++ai) {
                    const int R0 = u.rb + ai * HALF + wr * 64;
                    const bf16_t* gp = G + (size_t)(R0 + fr) * 2816 + col;
                    u32x2 gq[4];
#pragma unroll
                    for (int m = 0; m < 4; ++m) gq[m] = *(const u32x2*)(gp + (size_t)m * 16 * 2816);
                    u32x2 prv = (u32x2){0u, 0u};
                    if ((R0 & 8191) != 0) prv = *(const u32x2*)(gp - (size_t)16 * 2816);
#pragma unroll
                    for (int m = 0; m < 4; ++m) {
                        const u32x2 q1 = shf(fr == 15 ? prv : gq[m], s1), q2 = shf(fr >= 14 ? prv : gq[m], s2);
                        float g0[4], g1[4], g2[4]; unpk4(gq[m], g0); unpk4(q1, g1); unpk4(q2, g2);
                        finish(g0, g1, g2, w0, w1, w2, bb, acc[ai][bj][m][hv], rsqrtf(SS[R0 + fr + 16 * m] * (1.f / 1024.f) + 1e-6f), H + (size_t)(R0 + fr + 16 * m) * 2816 + col);
                        prv = gq[m];
                    }
                }
            } else {
                const int i = fr & 7;
                u32x2 gq[4]; float ssv[4];
#pragma unroll
                for (int m = 0; m < 4; ++m) { const int row = row0 + m * 16; gq[m] = *(const u32x2*)(G + (size_t)row * 2816 + col); ssv[m] = SS[row]; }
#pragma unroll
                for (int mh = 0; mh < 4; mh += 2) {
                f32x4 c0[4], c1[4];
#pragma unroll
                for (int m = mh; m < mh + 2; ++m) { const int row = row0 + m * 16; const float* cx = ctx + (size_t)((row - 32768) >> 3) * 2 * 2816 + col;
                    c0[m] = *(const f32x4*)cx; c1[m] = *(const f32x4*)(cx + 2816); }
#pragma unroll
                for (int m = mh; m < mh + 2; ++m) { const int row = row0 + m * 16; const u32x2 cur = gq[m];
                    const u32x2 q1 = shf(cur, lane - 1), q2 = shf(cur, lane - 2);
                    float g0[4], g1[4], g2[4]; unpk4(cur, g0); unpk4(q1, g1); unpk4(q2, g2);
#pragma unroll
                    for (int j = 0; j < 4; ++j) { const float x1 = c1[m][j], x0 = c0[m][j];
                        if (i < 1) g1[j] = x1;
                        if (i < 2) g2[j] = (i == 1) ? x1 : x0; }
                    finish(g0, g1, g2, w0, w1, w2, bb, acc[0][bj][m][hv], rsqrtf(ssv[m] * (1.f / 1024.f) + 1e-6f), H + (size_t)row * 2816 + col); }
                }
            }
        }
    }
};

template <class Epi, class Sched, bool ALIGN_EPI = false, bool SP2 = false>
__device__ __forceinline__ void gemm_phase(PG8_LAS unsigned char* lds, const Gemm g, const Sched& S, const Epi& E, int wave0) {
    int tid_ = threadIdx.x; (void)wave0; asm volatile("" : "+v"(tid_));
    const int tid = tid_, wid = __builtin_amdgcn_readfirstlane(tid >> 6), lane = tid & 63, wr = wid >> 2, wc = wid & 3, fr = lane & 15, fq = lane >> 4;
    const int K = g.K, nt = K / BK;
    unsigned voffA[2], voffB[2];
#pragma unroll
    for (int i = 0; i < 2; ++i) { int R, C; stage_rc(tid * 16 + i * 8192, R, C); const int Rb = Epi::PERM ? ((R & ~31) + perm32(R & 31)) : R;
        voffA[i] = (unsigned)(R * K + C) * 2u; voffB[i] = (unsigned)(Rb * K + C) * 2u; }
    const size_t kstep = (size_t)(BK * 2);
    const size_t hstep = (size_t)HALF * K * 2;
    const size_t tstep = 2 * hstep;
    const unsigned ldsw = (unsigned)wid * 1024u;
    const int aoff = lds_byte(wr * 64 + fr, fq * 8), boff = lds_byte(wc * 32 + fr, fq * 8);
#define PG8_SA(b, h) (((b) * 2 + (h)) * HTB)
#define PG8_SB(b, h) ((4 + (b) * 2 + (h)) * HTB)
#define PG8_STAGE(bufoff, gbase, voff) do { _Pragma("unroll") for (int _i = 0; _i < 2; ++_i) \
        __builtin_amdgcn_global_load_lds((const unsigned*)((const char*)(gbase) + (voff)[_i]), (PG8_LAS unsigned*)(lds + (bufoff) + ldsw + _i * 8192), 16, 0, 0); } while (0)
#define PG8_LDA(dst, b, h) do { _Pragma("unroll") for (int m = 0; m < 4; ++m) _Pragma("unroll") for (int k = 0; k < 2; ++k) dst[m][k] = *(const PG8_LAS bf16x8*)(lds + PG8_SA(b, h) + aoff + m * 2048 + k * 1024); } while (0)
#define PG8_LDB(dst, b, h) do { _Pragma("unroll") for (int n = 0; n < 2; ++n) _Pragma("unroll") for (int k = 0; k < 2; ++k) dst[n][k] = *(const PG8_LAS bf16x8*)(lds + PG8_SB(b, h) + boff + n * 2048 + k * 1024); } while (0)
#define PG8_MMA(ai, bj, At, Bt) do { __builtin_amdgcn_s_setprio(1); _Pragma("unroll") for (int m = 0; m < 4; ++m) _Pragma("unroll") for (int n = 0; n < 2; ++n) _Pragma("unroll") for (int k = 0; k < 2; ++k) \
        acc[ai][bj][m][n] = __builtin_amdgcn_mfma_f32_16x16x32_bf16(Bt[n][k], At[m][k], acc[ai][bj][m][n], 0, 0, 0); __builtin_amdgcn_s_setprio(0); } while (0)
#define PG8_WAIT_V(n) asm volatile("s_waitcnt vmcnt(" #n ")" ::: "memory")
#define PG8_WAIT_L(n) asm volatile("s_waitcnt lgkmcnt(" #n ")" ::: "memory")
#define PG8_BAR __builtin_amdgcn_s_barrier()
#define PG8_SCHED __builtin_amdgcn_sched_barrier(0)
    Unit cur, nxt; int ui = 0;
    if (!S.next(0, cur)) return;
    f32x4 acc[2][2][4][2];
#pragma unroll
    for (int a = 0; a < 2; ++a)
#pragma unroll
        for (int b = 0; b < 2; ++b)
#pragma unroll
            for (int m = 0; m < 4; ++m)
#pragma unroll
                for (int n = 0; n < 2; ++n) acc[a][b][m][n] = (f32x4){0.f, 0.f, 0.f, 0.f};
    bf16x8 At[4][2], B0[2][2], B1[2][2];
    const char* cA = (const char*)g.A + (size_t)cur.rb * K * 2; const char* cB = (const char*)g.Bt + (size_t)cur.pn * tstep;
    S.a_ready(cur);
    if constexpr (SP2) {
        PG8_STAGE(PG8_SB(0, 0), cB, voffB); PG8_STAGE(PG8_SB(0, 1), cB + hstep, voffB); PG8_STAGE(PG8_SA(0, 0), cA, voffA); PG8_STAGE(PG8_SA(0, 1), cA + hstep, voffA);
        if (wr == 1) PG8_BAR;
        PG8_WAIT_V(2); PG8_BAR;
        PG8_STAGE(PG8_SB(1, 0), cB + kstep, voffB); PG8_STAGE(PG8_SA(1, 0), cA + kstep, voffA); PG8_STAGE(PG8_SB(1, 1), cB + hstep + kstep, voffB);
        PG8_WAIT_V(6); PG8_BAR;
    } else {
        PG8_STAGE(PG8_SB(0, 0), cB, voffB); PG8_STAGE(PG8_SA(0, 0), cA, voffA); PG8_STAGE(PG8_SB(0, 1), cB + hstep, voffB); PG8_STAGE(PG8_SA(0, 1), cA + hstep, voffA);
        if (wr == 1) PG8_BAR;
        PG8_WAIT_V(4); PG8_BAR;
        PG8_STAGE(PG8_SB(1, 0), cB + kstep, voffB); PG8_STAGE(PG8_SA(1, 0), cA + kstep, voffA); PG8_STAGE(PG8_SB(1, 1), cB + hstep + kstep, voffB);
        PG8_WAIT_V(6); PG8_BAR;
    }
    for (;;) {
        const bool has_next = S.next(ui + 1, nxt);
        const char* nA = has_next ? (const char*)g.A + (size_t)nxt.rb * K * 2 : cA; const char* nB = has_next ? (const char*)g.Bt + (size_t)nxt.pn * tstep : cB;
        for (int t = 0; t < nt; t += 2) {
            const bool last = (t == nt - 2);
            const char* a1 = cA + (size_t)(t + 1) * kstep;
            const char* a2 = last ? nA : cA + (size_t)(t + 2) * kstep; const char* b2 = last ? nB : cB + (size_t)(t + 2) * kstep;
            const char* a3 = a2 + kstep; const char* b3 = b2 + kstep;
            if (last && has_next) S.a_ready(nxt);
            if constexpr (SP2) {
            PG8_LDB(B0, 0, 0); PG8_LDB(B1, 0, 1); PG8_SCHED; PG8_LDA(At, 0, 0); PG8_STAGE(PG8_SA(1, 1), a1 + hstep, voffA);
            PG8_WAIT_V(8); PG8_WAIT_L(0); PG8_BAR; PG8_MMA(0, 0, At, B0); PG8_MMA(0, 1, At, B1); PG8_BAR; PG8_SCHED;
            PG8_LDA(At, 0, 1); PG8_STAGE(PG8_SB(0, 0), b2, voffB); PG8_STAGE(PG8_SB(0, 1), b2 + hstep, voffB); PG8_STAGE(PG8_SA(0, 0), a2, voffA);
            PG8_WAIT_V(8); PG8_WAIT_L(0); PG8_BAR; if (!cur.half) { PG8_MMA(1, 0, At, B0); PG8_MMA(1, 1, At, B1); } PG8_BAR; PG8_SCHED;
            PG8_LDB(B0, 1, 0); PG8_LDB(B1, 1, 1); PG8_SCHED; PG8_LDA(At, 1, 0); PG8_STAGE(PG8_SA(0, 1), a2 + hstep, voffA);
            PG8_WAIT_V(8); PG8_WAIT_L(0); PG8_BAR; PG8_MMA(0, 0, At, B0); PG8_MMA(0, 1, At, B1); PG8_BAR; PG8_SCHED;
            PG8_LDA(At, 1, 1); PG8_STAGE(PG8_SB(1, 0), b3, voffB); PG8_STAGE(PG8_SB(1, 1), b3 + hstep, voffB); PG8_STAGE(PG8_SA(1, 0), a3, voffA);
            PG8_WAIT_V(8); PG8_WAIT_L(0); PG8_BAR; if (!cur.half) { PG8_MMA(1, 0, At, B0); PG8_MMA(1, 1, At, B1); } PG8_BAR; PG8_SCHED;
            } else {
            PG8_LDB(B0, 0, 0); PG8_SCHED; PG8_LDA(At, 0, 0); PG8_STAGE(PG8_SA(1, 1), a1 + hstep, voffA);
            PG8_WAIT_L(8); PG8_BAR; PG8_WAIT_L(0); PG8_MMA(0, 0, At, B0); PG8_BAR; PG8_SCHED;
            PG8_LDB(B1, 0, 1); PG8_STAGE(PG8_SB(0, 0), b2, voffB);
            PG8_BAR; PG8_WAIT_L(0); PG8_MMA(0, 1, At, B1); PG8_BAR;
            PG8_LDA(At, 0, 1); PG8_STAGE(PG8_SA(0, 0), a2, voffA);
            PG8_BAR; PG8_WAIT_L(0); if (!cur.half) PG8_MMA(1, 0, At, B0); PG8_BAR; PG8_SCHED;
            PG8_STAGE(PG8_SB(0, 1), b2 + hstep, voffB);
            PG8_WAIT_V(6); PG8_BAR; if (!cur.half) PG8_MMA(1, 1, At, B1); PG8_BAR;
            PG8_LDB(B0, 1, 0); PG8_SCHED; PG8_LDA(At, 1, 0); PG8_STAGE(PG8_SA(0, 1), a2 + hstep, voffA);
            PG8_WAIT_L(8); PG8_BAR; PG8_WAIT_L(0); PG8_MMA(0, 0, At, B0); PG8_BAR; PG8_SCHED;
            PG8_LDB(B1, 1, 1); PG8_STAGE(PG8_SB(1, 0), b3, voffB);
            PG8_BAR; PG8_WAIT_L(0); PG8_MMA(0, 1, At, B1); PG8_BAR;
            PG8_LDA(At, 1, 1); PG8_STAGE(PG8_SA(1, 0), a3, voffA);
            PG8_BAR; PG8_WAIT_L(0); if (!cur.half) PG8_MMA(1, 0, At, B0); PG8_BAR; PG8_SCHED;
            PG8_STAGE(PG8_SB(1, 1), b3 + hstep, voffB);
            PG8_WAIT_V(6); PG8_BAR; if (!cur.half) PG8_MMA(1, 1, At, B1); PG8_BAR;
            }
        }
        if constexpr (ALIGN_EPI) { if (wr == 0) PG8_BAR; }
        if constexpr (!Epi::AFTER_DRAIN) { E(acc, cur, wr, wc, fr, fq); S.done(cur); }
        if (!has_next) break;
#pragma unroll
        for (int a = 0; a < 2; ++a)
#pragma unroll
            for (int b = 0; b < 2; ++b)
#pragma unroll
                for (int m = 0; m < 4; ++m)
#pragma unroll
                    for (int n = 0; n < 2; ++n) acc[a][b][m][n] = (f32x4){0.f, 0.f, 0.f, 0.f};
        cur = nxt; cA = nA; cB = nB; ++ui;
        if constexpr (ALIGN_EPI) { if (wr == 1) PG8_BAR; }
    }
    PG8_WAIT_V(0);
    if constexpr (!ALIGN_EPI) { if (wr == 0) PG8_BAR; }
    PG8_BAR;
    if constexpr (Epi::AFTER_DRAIN) { E.fused(acc, cur, wr, wc, fr, fq, lds, wid, lane); S.done(cur); }
#undef PG8_SA
#undef PG8_SB
#undef PG8_STAGE
#undef PG8_LDA
#undef PG8_LDB
#undef PG8_MMA
#undef PG8_WAIT_V
#undef PG8_WAIT_L
#undef PG8_BAR
#undef PG8_SCHED
}

template <class Epi, bool NARROW = false, bool SHORT = false>
__device__ __forceinline__ void mini_gemm(PG8_LAS unsigned char* lds, const bf16_t* A, const bf16_t* Bt, int K, int ntn, const Epi& E, int c, int G, int wave0, int row_base = 32768) {
    int tid_ = threadIdx.x; (void)wave0; asm volatile("" : "+v"(tid_));
    const int tid = tid_, wid = __builtin_amdgcn_readfirstlane(tid >> 6), lane = tid & 63, wr = wid >> 2, wc = wid & 3, fr = lane & 15, fq = lane >> 4;
    constexpr int LS = 136, BUFB = 2 * 128 * LS * 2;
    constexpr int NB = NARROW ? 2 : 4, TW = NARROW ? 64 : 128;
    constexpr int NA = SHORT ? 2 : 4, TH = SHORT ? 64 : 128, NTM = SHORT ? 16 : 8;
    const int lr = SHORT ? (tid >> 3) : (tid >> 2), lp = SHORT ? (tid & 7) * 2 : (tid & 3) * 4;
    const int lrb = NARROW ? (tid >> 3) : lr, lpb = NARROW ? (tid & 7) * 2 : lp;
    const bool active = (!NARROW || wc < 2) && (!SHORT || wr == 0);
    const int nst = K / 128;
#pragma unroll 1
    for (int t = c; t < NTM * ntn; t += G) {
        const int tm = t % NTM, tn = t / NTM;
        const bf16_t* ga = A + ((size_t)row_base + TH * tm + lr) * K + lp * 8;
        const bf16_t* gb = Bt + ((size_t)TW * tn + lrb) * K + lpb * 8;
        u32x4 ra[2][NA], rb[2][NB];
#pragma unroll
        for (int s2 = 0; s2 < 2; ++s2) {
#pragma unroll
            for (int j = 0; j < NA; ++j) ra[s2][j] = *(const u32x4*)(ga + 128 * s2 + 8 * j);
#pragma unroll
            for (int j = 0; j < NB; ++j) rb[s2][j] = *(const u32x4*)(gb + 128 * s2 + 8 * j); }
        f32x4 acc[4][2];
#pragma unroll
        for (int m = 0; m < 4; ++m)
#pragma unroll
            for (int n = 0; n < 2; ++n) acc[m][n] = (f32x4){0.f, 0.f, 0.f, 0.f};
#pragma unroll 1
        for (int st = 0; st < nst; st += 2) {
#pragma unroll
          for (int s2 = 0; s2 < 2; ++s2) {
            PG8_LAS bf16_t* As = (PG8_LAS bf16_t*)(lds + s2 * BUFB); PG8_LAS bf16_t* Bs = As + 128 * LS;
#pragma unroll
            for (int j = 0; j < NA; ++j) *(PG8_LAS u32x4*)(As + lr * LS + (lp + j) * 8) = ra[s2][j];
#pragma unroll
            for (int j = 0; j < NB; ++j) *(PG8_LAS u32x4*)(Bs + lrb * LS + (lpb + j) * 8) = rb[s2][j];
            __syncthreads();
            if (st + 2 < nst) {
#pragma unroll
                for (int j = 0; j < NA; ++j) ra[s2][j] = *(const u32x4*)(ga + 128 * (st + 2 + s2) + 8 * j);
#pragma unroll
                for (int j = 0; j < NB; ++j) rb[s2][j] = *(const u32x4*)(gb + 128 * (st + 2 + s2) + 8 * j); }
            if (active) {
#pragma unroll
            for (int kc = 0; kc < 4; ++kc) {
                bf16x8 af[4], bfr[2];
#pragma unroll
                for (int m = 0; m < 4; ++m) af[m] = *(const PG8_LAS bf16x8*)(As + (64 * wr + 16 * m + fr) * LS + 32 * kc + 8 * fq);
#pragma unroll
                for (int n = 0; n < 2; ++n) bfr[n] = *(const PG8_LAS bf16x8*)(Bs + (32 * wc + 8 * (fr >> 2) + 4 * n + (fr & 3)) * LS + 32 * kc + 8 * fq);
#pragma unroll
                for (int m = 0; m < 4; ++m)
#pragma unroll
                    for (int n = 0; n < 2; ++n) acc[m][n] = __builtin_amdgcn_mfma_f32_16x16x32_bf16(bfr[n], af[m], acc[m][n], 0, 0, 0);
            } }
          }
        }
        if (active) {
        f32x4 accf[2][2][4][2];
#pragma unroll
        for (int a = 0; a < 2; ++a)
#pragma unroll
            for (int bq = 0; bq < 2; ++bq)
#pragma unroll
                for (int m = 0; m < 4; ++m)
#pragma unroll
                    for (int n = 0; n < 2; ++n) accf[a][bq][m][n] = (a == 0 && bq == 0) ? acc[m][n] : (f32x4){0.f, 0.f, 0.f, 0.f};
        Unit u; u.pm = 128 + (TH * tm >> 8); u.cb = TW * tn; u.pn = u.cb >> 8; u.rb = row_base + TH * tm; u.half = 1; u.q = 1;
        E(accf, u, wr, wc, fr, fq);
        }
        __syncthreads();
    }
}
}

#define LAS __attribute__((address_space(3)))
typedef unsigned short bf16;
typedef unsigned v4u __attribute__((ext_vector_type(4)));
typedef unsigned v2u __attribute__((ext_vector_type(2)));
typedef float f32x4 __attribute__((ext_vector_type(4)));
typedef short bf16x8 __attribute__((ext_vector_type(8)));

constexpr int NTHR = 512, NWAVES = 8;
constexpr int MP = 32768, MS = 1024, MT = MP + MS;
constexpr int D = 1024, DFF = 2816;
constexpr int LDS_BYTES = 147456;
constexpr float EPS = 1e-6f;

enum { I_XP = 0, I_XS, I_CPOOL, I_CSK, I_CSV, I_CMK, I_CMV, I_CFC, I_MEMP, I_LNMIX, I_LNMEM, I_LNMEMKV, I_LNFFN, I_ABWIN, I_ABVG, I_ABWS, I_ABBS, I_ABPW, I_ABPS, I_ABWOUT,
       I_CWQKV, I_CQG, I_CKG, I_CSINK, I_CWO, I_MWQ, I_MWKV, I_MQG, I_MKG, I_MWO, I_FWUP, I_FCW, I_FCB, I_FWDN, N_IN };
constexpr size_t O_YP = 0, O_YS = O_YP + (size_t)MP * D, O_POOLP = O_YS + (size_t)MS * D, O_POOLS = O_POOLP + 4 * 15 * 512, O_CHV = O_POOLS + 128 * 15 * 512,
                 O_SKP = O_CHV + 128 * 8 * 512, O_SVP = O_SKP + 4 * 128 * 256, O_SKS = O_SVP + 4 * 128 * 256, O_SVS = O_SKS + (size_t)128 * 128 * 256,
                 O_MKP = O_SVS + (size_t)128 * 128 * 256, O_MVP = O_MKP + 2 * 4 * 256 * 512, O_FCP = O_MVP + 2 * 4 * 256 * 512, O_FCS = O_FCP + 2 * 4 * 2 * DFF,
                 O_END = O_FCS + (size_t)2 * 128 * 2 * DFF;
constexpr size_t MiB = 1u << 20;
constexpr size_t W_WIN = 0, W_WOUT = W_WIN + 1536 * 1024 * 2, W_WQKV = W_WOUT + 1024 * 1024 * 2, W_CWO = W_WQKV + 1536 * 1024 * 2, W_LAYER = W_CWO + 1024 * 1024 * 2;
constexpr size_t WL_WQ = 0, WL_WKV = WL_WQ + 512 * 1024 * 2, WL_WO = WL_WKV + 1024 * 1024 * 2, WL_WUP = WL_WO + 1024 * 512 * 2, WL_WDN = WL_WUP + (size_t)2 * DFF * 1024 * 2,
                 WL_SIZE = WL_WDN + (size_t)1024 * DFF * 2;
constexpr size_t W_MN = W_LAYER + 2 * WL_SIZE;
constexpr size_t W_MKV = W_MN + 2 * 1024 * 1024 * 2;
constexpr size_t W_SS = W_MKV + 2 * 1024 * 1024 * 4;
constexpr size_t W_SMALL_END = W_SS + (size_t)6 * MT * 4;
static_assert(W_SMALL_END <= 72 * MiB, "weights region");
constexpr size_t W_XN = 72 * MiB;
constexpr size_t W_G = 138 * MiB;
constexpr size_t W_PROJ = W_G;
constexpr size_t W_AO = W_PROJ + 99 * MiB;
constexpr size_t W_H = 320 * MiB;
constexpr size_t W_KV32 = W_H;
constexpr size_t W_MQ = W_KV32 + 66 * MiB;
constexpr size_t W_MO = W_MQ + 33 * MiB;
constexpr size_t W_END = 502 * MiB;
constexpr size_t W_CTL = 504 * MiB, CTL_BYTES = 65536, W_NEED = W_CTL + CTL_BYTES;
constexpr int LDS_CTL_OFF = LDS_BYTES - 64;
static_assert(W_XN + (size_t)MT * 1024 * 2 <= W_G && W_PROJ + (size_t)MT * 1536 * 2 <= W_AO && W_AO + (size_t)MT * 1024 * 2 <= W_H && W_G + (size_t)MT * DFF * 2 <= W_H, "ws map 1");
static_assert(W_KV32 + (size_t)MT * 512 * 4 <= W_MQ && W_MQ + (size_t)MT * 512 * 2 <= W_MO && W_MO + (size_t)MT * 512 * 2 <= W_END && W_H + (size_t)MT * DFF * 2 <= W_END, "ws map 2");

struct Params { const float* in[N_IN]; float* out; unsigned char* ws; };

__device__ __forceinline__ unsigned pk2(float lo, float hi) { return pg8::cvt_pk_bf16(lo, hi); }
__device__ __forceinline__ unsigned f2bf(float f) { return pg8::cvt_pk_bf16(f, 0.f) & 0xffffu; }
__device__ __forceinline__ float bflo(unsigned w) { return __builtin_bit_cast(float, w << 16); }
__device__ __forceinline__ float bfhi(unsigned w) { return __builtin_bit_cast(float, w & 0xffff0000u); }
__device__ __forceinline__ float bf1(bf16 h) { return __builtin_bit_cast(float, (unsigned)h << 16); }
__device__ __forceinline__ void unpack8(const v4u w, float (&o)[8]) { o[0] = bflo(w.x); o[1] = bfhi(w.x); o[2] = bflo(w.y); o[3] = bfhi(w.y); o[4] = bflo(w.z); o[5] = bfhi(w.z); o[6] = bflo(w.w); o[7] = bfhi(w.w); }
__device__ __forceinline__ bf16x8 pack8(const float (&o)[8]) { v4u w; w.x = pk2(o[0], o[1]); w.y = pk2(o[2], o[3]); w.z = pk2(o[4], o[5]); w.w = pk2(o[6], o[7]); return __builtin_bit_cast(bf16x8, w); }
typedef short v4i16_t __attribute__((ext_vector_type(4)));
__device__ __forceinline__ v2u vtr(const LAS bf16* p) { return __builtin_bit_cast(v2u, __builtin_amdgcn_ds_read_tr16_b64_v4i16((LAS v4i16_t*)p)); }
__device__ __forceinline__ float wave_sum(float v) {
#pragma unroll
    for (int o = 1; o < 64; o <<= 1) v += __shfl_xor(v, o);
    return v;
}
__device__ __forceinline__ float gelu1(float v) { const pg8::f32x2 r = pg8::gelu_pk((pg8::f32x2){v, 0.f}); return r.x; }
__device__ __forceinline__ void rope_cs(float pos, int e, float& c, float& s) {
    const float inv = exp2f(-(float)e * (0.125f * 18.931568569324174f));
    const float ang = pos * inv;
    const float k = rintf(ang * 0.15915494309189535f);
    float r = fmaf(-k, 6.28125f, ang);
    r = fmaf(-k, 0.0019353071795864769f, r);
    s = __sinf(r); c = __cosf(r);
}

#define XB_TMO      128
#define XB_XCNT(j)  (256  + 64 * (j))
#define XB_XSUB(j)  (1280 + 64 * (j))
#define XB_XGEN(j)  (2304 + 64 * (j))
#define XB_TOP      3328
#define XB_TOPGEN   3392
#define XCD_BAR_WORDS 3456
#define XB_SPIN_CAP (1u << 18)

__device__ __forceinline__ unsigned xb_ld(unsigned* p)              { return __hip_atomic_load(p, __ATOMIC_RELAXED, __HIP_MEMORY_SCOPE_AGENT); }
__device__ __forceinline__ unsigned xb_add(unsigned* p, unsigned v) { return __hip_atomic_fetch_add(p, v, __ATOMIC_RELAXED, __HIP_MEMORY_SCOPE_AGENT); }
__device__ __forceinline__ unsigned xb_xcc_id() { return (unsigned)__builtin_amdgcn_s_getreg((3 << 11) | 20) & 0xFu; }
#define XB_SPIN(cond, bar) do { unsigned _sp = 0; while (cond) { __builtin_amdgcn_s_sleep(1); \
    if ((++_sp & 255u) == 0u) { if (xb_ld(&(bar)[XB_TMO])) break; if (_sp > XB_SPIN_CAP) { atomicAdd(&(bar)[XB_TMO], 1u); break; } } } } while (0)

struct XcdBarrier {
    unsigned* bar; unsigned x; int w0;
    volatile LAS unsigned* st;
};

__device__ __forceinline__ XcdBarrier xcd_barrier_post(unsigned* bar, volatile LAS unsigned* st) {
    XcdBarrier b; b.bar = bar; b.x = xb_xcc_id(); b.st = st; b.w0 = __builtin_amdgcn_readfirstlane((int)threadIdx.x >> 6);
    if (threadIdx.x == 0) (void)xb_add(&bar[XB_XCNT(b.x)], 1u);
    return b;
}
__device__ __forceinline__ void xcd_barrier_complete(unsigned* bar, unsigned x, unsigned& nloc, unsigned& nx) {
    const unsigned G = gridDim.x * gridDim.y * gridDim.z;
    unsigned sum, cnt, mine, sp = 0u;
    for (;;) {
        sum = 0u; cnt = 0u; mine = 0u;
#pragma unroll
        for (unsigned j = 0; j < 16; ++j) { const unsigned c = xb_ld(&bar[XB_XCNT(j)]); sum += c; cnt += (c > 0u) ? 1u : 0u; mine = (j == x) ? c : mine; }
        if (sum == G) break;
        __builtin_amdgcn_s_sleep(1);
        if ((++sp & 255u) == 0u) { if (xb_ld(&bar[XB_TMO])) break; if (sp > XB_SPIN_CAP) { atomicAdd(&bar[XB_TMO], 1u); break; } }
    }
    nloc = mine > 0u ? mine : 1u; nx = cnt > 0u ? cnt : 1u;
}

__device__ __forceinline__ void xcd_barrier(const XcdBarrier& b) {
    asm volatile("s_waitcnt vmcnt(0)" ::: "memory");
    __syncthreads();
    if (threadIdx.x == 0) {
        unsigned* bar = b.bar;
        __builtin_amdgcn_s_waitcnt(0);
        unsigned nloc = b.st[0], nx = b.st[1];
        if (nloc == 0u) { xcd_barrier_complete(bar, b.x, nloc, nx); b.st[0] = nloc; b.st[1] = nx; }
        const unsigned old = xb_add(&bar[XB_XSUB(b.x)], 1u);
        const unsigned gen = old / nloc;
        if (old + 1u == (gen + 1u) * nloc) {
            __builtin_amdgcn_fence(__ATOMIC_RELEASE, "agent");
            asm volatile("s_waitcnt vmcnt(0)" ::: "memory");
            const unsigned og = xb_add(&bar[XB_TOP], 1u);
            const unsigned tg = og / nx;
            if (og + 1u == (tg + 1u) * nx) xb_add(&bar[XB_TOPGEN], 1u);
            else XB_SPIN(xb_ld(&bar[XB_TOPGEN]) == tg, bar);
            __builtin_amdgcn_fence(__ATOMIC_ACQUIRE, "agent");
            xb_add(&bar[XB_XGEN(b.x)], 1u);
            asm volatile("s_waitcnt vmcnt(0)" ::: "memory");
        } else {
            XB_SPIN(xb_ld(&bar[XB_XGEN(b.x)]) == gen, bar);
            __builtin_amdgcn_fence(__ATOMIC_ACQUIRE, "agent");
            asm volatile("s_waitcnt vmcnt(0)" ::: "memory");
        }
    }
    __syncthreads();
}

__device__ __forceinline__ void transpose_item(const float* W, const float* gain, int ldn, int nblk, bf16* WT, int ldk, int koff, LAS float* scr, int item, int lane) {
    const int kb = item / nblk, nb = item % nblk, k0 = 64 * kb, n0 = 32 * nb;
    float wv[32];
#pragma unroll
    for (int i = 0; i < 32; ++i) wv[i] = __builtin_nontemporal_load(W + (size_t)(k0 + 2 * i + (lane >> 5)) * ldn + n0 + (lane & 31));
    if (gain) {
#pragma unroll
        for (int i = 0; i < 32; ++i) wv[i] *= gain[k0 + 2 * i + (lane >> 5)]; }
#pragma unroll
    for (int i = 0; i < 32; ++i) scr[(2 * i + (lane >> 5)) * 33 + (lane & 31)] = wv[i];
    asm volatile("s_waitcnt lgkmcnt(0)" ::: "memory");
    const int c = lane & 7;
#pragma unroll
    for (int j = 0; j < 4; ++j) { const int n = (lane >> 3) + 8 * j; const LAS float* s = scr + (8 * c) * 33 + n;
        v4u o; o.x = pk2(s[0 * 33], s[1 * 33]); o.y = pk2(s[2 * 33], s[3 * 33]); o.z = pk2(s[4 * 33], s[5 * 33]); o.w = pk2(s[6 * 33], s[7 * 33]);
        *(v4u*)(WT + (size_t)(n0 + n) * ldk + koff + k0 + 8 * c) = o; }
    asm volatile("s_waitcnt lgkmcnt(0)" ::: "memory");
}
__device__ __forceinline__ void rms_row(const float* xrow, const float* g, bf16* orow, int lane) {
    const f32x4* xr = (const f32x4*)xrow + lane; const f32x4* gr = (const f32x4*)g + lane;
    f32x4 v[4]; float s = 0.f;
#pragma unroll
    for (int j = 0; j < 4; ++j) { v[j] = xr[64 * j]; s += (v[j].x * v[j].x + v[j].y * v[j].y) + (v[j].z * v[j].z + v[j].w * v[j].w); }
    const float rs = rsqrtf(wave_sum(s) * (1.f / 1024.f) + EPS);
    unsigned long long* o8 = (unsigned long long*)orow + lane;
#pragma unroll
    for (int j = 0; j < 4; ++j) { const f32x4 gg = gr[64 * j];
        o8[64 * j] = (unsigned long long)pk2(v[j].x * rs * gg.x, v[j].y * rs * gg.y) | ((unsigned long long)pk2(v[j].z * rs * gg.z, v[j].w * rs * gg.w) << 32); }
}
__device__ __forceinline__ void xb_row(const float* xrow, bf16* orow, float* ss, int lane) {
    const f32x4* xr = (const f32x4*)xrow + lane;
    f32x4 v[4]; float s = 0.f;
#pragma unroll
    for (int j = 0; j < 4; ++j) { v[j] = xr[64 * j]; s += (v[j].x * v[j].x + v[j].y * v[j].y) + (v[j].z * v[j].z + v[j].w * v[j].w); }
    s = wave_sum(s);
    unsigned long long* o8 = (unsigned long long*)orow + lane;
#pragma unroll
    for (int j = 0; j < 4; ++j) o8[64 * j] = (unsigned long long)pk2(v[j].x, v[j].y) | ((unsigned long long)pk2(v[j].z, v[j].w) << 32);
    if (lane == 0) *ss = s;
}

struct TItem { const float* W; int ldn, nblk, nitems; bf16* WT; int ldk, koff; };

__device__ __forceinline__ void prologue(const Params& p, LAS unsigned char* lds, int gw, int ngw, int wave, int lane) {
    unsigned char* ws = p.ws;
    LAS float* scr = (LAS float*)(lds + wave * 16384);
#define TR(Wp, gn_, K_, N_, ldn_, dst_, ldk_, koff_) do { const int nblk_ = (N_) / 32, nit_ = ((K_) / 64) * nblk_; \
        for (int it = gw; it < nit_; it += ngw) transpose_item((Wp), (gn_), (ldn_), nblk_, (bf16*)(dst_), (ldk_), (koff_), scr, it, lane); } while (0)
    const float* nog = nullptr;
    TR(p.in[I_ABWIN], p.in[I_LNMIX], 1024, 1536, 1536, ws + W_WIN, 1024, 0);
    TR(p.in[I_ABWOUT], nog, 512, 1024, 1024, ws + W_WOUT, 1024, 0);
    TR(p.in[I_CWQKV], p.in[I_LNMIX] + D, 1024, 1536, 1536, ws + W_WQKV, 1024, 0);
    TR(p.in[I_CWO], nog, 1024, 1024, 1024, ws + W_CWO, 1024, 0);
#pragma unroll 1
    for (int l = 0; l < 2; ++l) {
        unsigned char* wl = ws + W_LAYER + l * WL_SIZE;
        TR(p.in[I_MWQ] + (size_t)l * 1024 * 512, p.in[I_LNMEM] + l * D, 1024, 512, 512, wl + WL_WQ, 1024, 0);
        TR(p.in[I_MWKV] + (size_t)l * 1024 * 1024, nog, 1024, 1024, 1024, wl + WL_WKV, 1024, 0);
        TR(p.in[I_MWO] + (size_t)l * 512 * 1024, nog, 512, 1024, 1024, wl + WL_WO, 512, 0);
        TR(p.in[I_FWUP] + (size_t)l * 1024 * 2 * DFF, p.in[I_LNFFN] + l * D, 1024, 2 * DFF, 2 * DFF, wl + WL_WUP, 1024, 0);
        TR(p.in[I_FWDN] + (size_t)l * DFF * 1024, nog, DFF, 1024, 1024, wl + WL_WDN, DFF, 0);
    }
#undef TR
    {
        const float* pw = p.in[I_ABPW]; const float* ps = p.in[I_ABPS]; const float* wo = p.in[I_ABWOUT] + (size_t)512 * 1024;
        bf16* WT = (bf16*)(ws + W_WOUT);
        const int gt = gw * 64 + lane, ngt = ngw * 64;
        for (int o = gt; o < 128 * 1024; o += ngt) {
            const int n = o & 1023, d = o >> 10;
            float a[4] = {0.f, 0.f, 0.f, 0.f};
#pragma unroll 4
            for (int e = 0; e < 128; ++e) {
#pragma unroll
                for (int g = 0; g < 4; ++g) a[g] += pw[((size_t)g * 128 + d) * 128 + e] * ps[g * 128 + e] * wo[((size_t)g * 128 + e) * 1024 + n]; }
#pragma unroll
            for (int g = 0; g < 4; ++g) WT[(size_t)n * 1024 + 512 + g * 128 + d] = (bf16)f2bf(a[g]); }
    }
    for (int m0 = gw * 4; m0 < MT; m0 += ngw * 4) {
        f32x4 v[4][4];
#pragma unroll
        for (int r = 0; r < 4; ++r) { const int m = m0 + r; const f32x4* xr = (const f32x4*)(m < MP ? p.in[I_XP] + (size_t)m * D : p.in[I_XS] + (size_t)(m - MP) * D) + lane;
#pragma unroll
            for (int j = 0; j < 4; ++j) v[r][j] = __builtin_nontemporal_load(xr + 64 * j); }
#pragma unroll
        for (int r = 0; r < 4; ++r) { const int m = m0 + r; float sq = 0.f;
#pragma unroll
            for (int j = 0; j < 4; ++j) sq += (v[r][j].x * v[r][j].x + v[r][j].y * v[r][j].y) + (v[r][j].z * v[r][j].z + v[r][j].w * v[r][j].w);
            sq = wave_sum(sq);
            unsigned long long* o8 = (unsigned long long*)((bf16*)(ws + W_XN) + (size_t)m * D) + lane;
#pragma unroll
            for (int j = 0; j < 4; ++j) o8[64 * j] = (unsigned long long)pk2(v[r][j].x, v[r][j].y) | ((unsigned long long)pk2(v[r][j].z, v[r][j].w) << 32);
            if (lane == 0) ((float*)(ws + W_SS))[m] = sq; }
    }
    for (int o = gw * 64 + lane; o < 5 * MT; o += ngw * 64) ((float*)(ws + W_SS))[MT + o] = 0.f;
    for (int m = gw; m < 2048; m += ngw) { const int l = m >> 10, r = m & 1023;
        rms_row(p.in[I_MEMP] + (size_t)r * D, p.in[I_LNMEMKV] + l * D, (bf16*)(ws + W_MN) + (size_t)m * D, lane); }
}

constexpr int SG_VS = 520;
template <int W> __device__ __forceinline__ void pool_block(const float (&prev)[16], const float (&cur)[16], float (&o)[16], int t0, bool clampcnt) {
#pragma unroll
    for (int k = 0; k < 16; ++k) { float s = 0.f;
#pragma unroll
        for (int kk = 0; kk < W; ++kk) s += (k - kk >= 0) ? cur[(k - kk) & 15] : prev[(16 + k - kk) & 15];
        float inv = 1.f / (float)W;
        if (clampcnt) { const int t1 = t0 + k + 1; if (t1 < W) inv = __builtin_amdgcn_rcpf((float)t1); }
        o[k] = s * inv - cur[k]; }
}
__device__ __forceinline__ void pool_dispatch(int gi, const float (&prev)[16], const float (&cur)[16], float (&o)[16], int t0, bool clampcnt) {
    if (gi == 0) pool_block<2>(prev, cur, o, t0, clampcnt); else if (gi == 1) pool_block<4>(prev, cur, o, t0, clampcnt);
    else if (gi == 2) pool_block<8>(prev, cur, o, t0, clampcnt); else pool_block<16>(prev, cur, o, t0, clampcnt);
}

__device__ __forceinline__ void sgu_prompt_unit(const Params& p, LAS unsigned char* lds, int unit, int tid, int wave, int lane) {
    const bf16* PROJ = (const bf16*)(p.ws + W_PROJ); bf16* AO = (bf16*)(p.ws + W_AO);
    LAS bf16* Vn = (LAS bf16*)lds;
    const int b = unit >> 6, ch = unit & 63; const size_t r0 = (size_t)b * 8192 + ch * 128;
    {
        float gn[8]; pg8::ld8f(p.in[I_ABVG] + 8 * lane, gn);
        v4u raw[16];
#pragma unroll
        for (int jj = 0; jj < 16; ++jj) raw[jj] = *(const v4u*)(PROJ + (r0 + wave + 8 * jj) * 1536 + 512 + 8 * lane);
#pragma unroll
        for (int jj = 0; jj < 16; ++jj) { const int j = wave + 8 * jj;
            float x[8]; unpack8(raw[jj], x);
            float s = 0.f;
#pragma unroll
            for (int e = 0; e < 8; ++e) s += x[e];
            const float mean = wave_sum(s) * (1.f / 512.f); float q = 0.f;
#pragma unroll
            for (int e = 0; e < 8; ++e) { x[e] -= mean; q += x[e] * x[e]; }
            const float rstd = rsqrtf(wave_sum(q) * (1.f / 512.f) + EPS);
#pragma unroll
            for (int e = 0; e < 8; ++e) x[e] *= rstd * gn[e];
            *(LAS bf16x8*)(Vn + j * SG_VS + 8 * lane) = pack8(x); }
    }
    __syncthreads();
    {
        const int q16 = lane & 15, kq = lane >> 4, nch = (wave >> 1) + 1; int i = 16 * wave + q16;
#pragma unroll 1
        for (int g = 0; g < 4; ++g) {
            asm volatile("" : "+v"(i));
            f32x4 acc[8];
#pragma unroll
            for (int dt = 0; dt < 8; ++dt) acc[dt] = (f32x4){0.f, 0.f, 0.f, 0.f};
            const float* wsr = p.in[I_ABWS] + ((size_t)g * 128 + i) * 128;
            float wva[4][8]; v2u uu8[8];
#pragma unroll
            for (int c = 0; c < 4; ++c) pg8::ld8f(wsr + 32 * c + 8 * kq, wva[c]);
#pragma unroll
            for (int dt = 0; dt < 8; ++dt) uu8[dt] = *(const v2u*)(PROJ + (r0 + i) * 1536 + g * 128 + 16 * dt + 4 * kq);
#pragma unroll
            for (int c = 0; c < 4; ++c) if (c < nch) {
                float (&wv)[8] = wva[c];
#pragma unroll
                for (int e = 0; e < 8; ++e) if (32 * c + 8 * kq + e > i) wv[e] = 0.f;
                const bf16x8 bfrag = pack8(wv);
#pragma unroll
                for (int dt = 0; dt < 8; ++dt) { const LAS bf16* vp = Vn + (32 * c + 8 * kq + (q16 >> 2)) * SG_VS + g * 128 + 16 * dt + 4 * (q16 & 3);
                    const v2u lo = vtr(vp), hi = vtr(vp + 4 * SG_VS);
                    v4u av; av.x = lo.x; av.y = lo.y; av.z = hi.x; av.w = hi.y;
                    acc[dt] = __builtin_amdgcn_mfma_f32_16x16x32_bf16(__builtin_bit_cast(bf16x8, av), bfrag, acc[dt], 0, 0, 0); }
            }
            const float bs = p.in[I_ABBS][g * 128 + i];
#pragma unroll
            for (int dt = 0; dt < 8; ++dt) { const v2u uu = uu8[dt];
                const float o0 = bflo(uu.x) * (acc[dt][0] + bs), o1 = bfhi(uu.x) * (acc[dt][1] + bs), o2 = bflo(uu.y) * (acc[dt][2] + bs), o3 = bfhi(uu.y) * (acc[dt][3] + bs);
                v2u w; w.x = pk2(o0, o1); w.y = pk2(o2, o3);
                *(v2u*)(AO + (r0 + i) * 1024 + g * 128 + 16 * dt + 4 * kq) = w; }
        }
    }
    {
        const int c = tid, gi = c >> 7;
        const bf16* pp = PROJ + 1024 + c;
        float prev[16], cur[16], o[16];
#pragma unroll
        for (int k = 0; k < 16; ++k) prev[k] = (ch > 0) ? bf1(pp[(r0 - 16 + k) * 1536]) : 0.f;
        bf16 nxt[16];
#pragma unroll
        for (int k = 0; k < 16; ++k) nxt[k] = pp[(r0 + k) * 1536];
#pragma unroll 1
        for (int blk = 0; blk < 8; ++blk) {
#pragma unroll
            for (int k = 0; k < 16; ++k) cur[k] = bf1(nxt[k]);
            if (blk < 7) {
#pragma unroll
                for (int k = 0; k < 16; ++k) nxt[k] = pp[(r0 + 16 * (blk + 1) + k) * 1536]; }
            pool_dispatch(gi, prev, cur, o, ch * 128 + 16 * blk, ch == 0 && blk == 0);
#pragma unroll
            for (int k = 0; k < 16; ++k) AO[(r0 + 16 * blk + k) * 1024 + 512 + c] = (bf16)f2bf(o[k]);
            if (ch == 63 && blk == 7) {
#pragma unroll
                for (int k = 1; k < 16; ++k) p.out[O_POOLP + ((size_t)b * 15 + (k - 1)) * 512 + c] = cur[k]; }
#pragma unroll
            for (int k = 0; k < 16; ++k) prev[k] = cur[k];
        }
    }
    __syncthreads();
}

__device__ __forceinline__ void sgu_sample_unit(const Params& p, LAS unsigned char* lds, int b, int tid, int wave, int lane) {
    const bf16* PROJ = (const bf16*)(p.ws + W_PROJ); bf16* AO = (bf16*)(p.ws + W_AO);
    LAS float* red = (LAS float*)lds;
    const int c = tid, g = c >> 7; const size_t rs = (size_t)MP + 8 * b;
    float x[8], st[16];
#pragma unroll
    for (int j = 0; j < 8; ++j) { x[j] = bf1(PROJ[(rs + j) * 1536 + 512 + c]); st[j] = wave_sum(x[j]); st[8 + j] = wave_sum(x[j] * x[j]); }
    if (lane == 0) {
#pragma unroll
        for (int j = 0; j < 16; ++j) red[wave * 16 + j] = st[j]; }
    __syncthreads();
    float v[8]; const float gn = p.in[I_ABVG][c];
#pragma unroll
    for (int j = 0; j < 8; ++j) { float s = 0.f, q = 0.f;
#pragma unroll
        for (int w = 0; w < 8; ++w) { s += red[w * 16 + j]; q += red[w * 16 + 8 + j]; }
        const float mean = s * (1.f / 512.f), var = fmaxf(q * (1.f / 512.f) - mean * mean, 0.f);
        v[j] = (x[j] - mean) * rsqrtf(var + EPS) * gn;
        p.out[O_CHV + ((size_t)b * 8 + j) * 512 + c] = v[j]; }
    const float* wsg = p.in[I_ABWS] + (size_t)g * 128 * 128;
#pragma unroll
    for (int i = 0; i < 8; ++i) { float sg = p.in[I_ABBS][g * 128 + i];
#pragma unroll
        for (int j = 0; j < 8; ++j) if (j <= i) sg += wsg[i * 128 + j] * v[j];
        AO[(rs + i) * 1024 + c] = (bf16)f2bf(bf1(PROJ[(rs + i) * 1536 + c]) * sg); }
    float pe[24];
    pe[0] = 0.f;
#pragma unroll
    for (int k = 0; k < 15; ++k) pe[1 + k] = p.in[I_CPOOL][((size_t)b * 15 + k) * 512 + c];
#pragma unroll
    for (int i = 0; i < 8; ++i) pe[16 + i] = bf1(PROJ[(rs + i) * 1536 + 1024 + c]);
    const int W = 2 << g; const float invW = __builtin_amdgcn_rcpf((float)W);
#pragma unroll
    for (int i = 0; i < 8; ++i) { float s = 0.f;
#pragma unroll
        for (int kk = 0; kk < 16; ++kk) if (kk < W) s += pe[16 + i - kk];
        AO[(rs + i) * 1024 + 512 + c] = (bf16)f2bf(s * invW - pe[16 + i]); }
#pragma unroll
    for (int k = 0; k < 15; ++k) p.out[O_POOLS + ((size_t)b * 15 + k) * 512 + c] = pe[9 + k];
    __syncthreads();
}

constexpr int SWA_KS = 72, SWA_VS = 72, SWA_VOFF = 256 * SWA_KS * 2;
template <bool SAMPLE>
__device__ __forceinline__ void swa_unit(const Params& p, LAS unsigned char* lds, int unit, int tid, int wave, int lane) {
    const bf16* Q = (const bf16*)(p.ws + W_PROJ); const float* KV = (const float*)(p.ws + W_KV32); bf16* AO = (bf16*)(p.ws + W_AO);
    LAS bf16* Kl = (LAS bf16*)lds; LAS bf16* Vt = (LAS bf16*)(lds + SWA_VOFF);
    int b, kvh, nb;
    if (!SAMPLE) { nb = unit & 63; kvh = (unit >> 6) & 3; b = unit >> 8; } else { kvh = unit & 3; b = unit >> 2; nb = 0; }
    constexpr int NKEY = SAMPLE ? 160 : 256;
    {
        const int sub = tid & 7;
        float kg[8]; pg8::ld8f(p.in[I_CKG] + 8 * sub, kg);
        constexpr int NIT = SAMPLE ? 3 : 4;
        float kk[NIT][8], vv[NIT][8];
#pragma unroll
        for (int it = 0; it < NIT; ++it) { const int s = (tid >> 3) + 64 * it;
            const float* kp = nullptr; const float* vp = nullptr;
            if (!SAMPLE) { const int trel = (nb - 1) * 128 + s;
                if (trel >= 0) { kp = KV + ((size_t)b * 8192 + trel) * 512 + kvh * 64 + sub * 8; vp = kp + 256; } }
            else { if (s < 128) { const size_t o = (((size_t)b * 128 + s) * 4 + kvh) * 64 + sub * 8; kp = p.in[I_CSK] + o; vp = p.in[I_CSV] + o; }
                else if (s < 136) { kp = KV + ((size_t)MP + 8 * b + (s - 128)) * 512 + kvh * 64 + sub * 8; vp = kp + 256; } }
            if (kp) { if (SAMPLE) { pg8::ld8f_nt(kp, kk[it]); pg8::ld8f_nt(vp, vv[it]); } else { pg8::ld8f(kp, kk[it]); pg8::ld8f(vp, vv[it]); } } else { pg8::zero8(kk[it]); pg8::zero8(vv[it]); } }
#pragma unroll
        for (int it = 0; it < NIT; ++it) { const int s = (tid >> 3) + 64 * it;
            __builtin_amdgcn_sched_barrier(0);
            if (s < NKEY) {
            bool norm; float pos;
            if (!SAMPLE) { const int trel = (nb - 1) * 128 + s; norm = trel >= 0; pos = (float)trel; }
            else { norm = (s >= 128 && s < 136); pos = (float)(16384 + s - 128); }
            float (&k)[8] = kk[it]; float (&v)[8] = vv[it];
            asm volatile("" : "+v"(pos));
            if (norm) { float ss = 0.f;
#pragma unroll
                for (int e = 0; e < 8; ++e) ss += k[e] * k[e];
                ss += __shfl_xor(ss, 1); ss += __shfl_xor(ss, 2); ss += __shfl_xor(ss, 4);
                const float rs = rsqrtf(ss * (1.f / 64.f) + EPS);
#pragma unroll
                for (int e = 0; e < 8; ++e) k[e] *= rs * kg[e];
#pragma unroll
                for (int e = 0; e < 8; ++e) { const float pk = __shfl_xor(k[e], 1); float cs, sn; rope_cs(pos, e, cs, sn);
                    if (sub == 0) k[e] = k[e] * cs - pk * sn; else if (sub == 1) k[e] = k[e] * cs + pk * sn; }
            }
            *(LAS bf16x8*)(Kl + s * SWA_KS + sub * 8) = pack8(k);
            *(LAS bf16x8*)(Vt + s * SWA_VS + sub * 8) = pack8(v);
            if (!SAMPLE) { if (nb == 63 && s >= 128) { const size_t o = (((size_t)b * 128 + (s - 128)) * 4 + kvh) * 64 + sub * 8;
                    *(f32x4*)(p.out + O_SKP + o) = (f32x4){k[0], k[1], k[2], k[3]}; *(f32x4*)(p.out + O_SKP + o + 4) = (f32x4){k[4], k[5], k[6], k[7]};
                    *(f32x4*)(p.out + O_SVP + o) = (f32x4){v[0], v[1], v[2], v[3]}; *(f32x4*)(p.out + O_SVP + o + 4) = (f32x4){v[4], v[5], v[6], v[7]}; } }
            else { if (s >= 8 && s < 136) { const size_t o = (((size_t)b * 128 + (s - 8)) * 4 + kvh) * 64 + sub * 8;
                    __builtin_nontemporal_store((f32x4){k[0], k[1], k[2], k[3]}, (f32x4*)(p.out + O_SKS + o)); __builtin_nontemporal_store((f32x4){k[4], k[5], k[6], k[7]}, (f32x4*)(p.out + O_SKS + o + 4));
                    __builtin_nontemporal_store((f32x4){v[0], v[1], v[2], v[3]}, (f32x4*)(p.out + O_SVS + o)); __builtin_nontemporal_store((f32x4){v[4], v[5], v[6], v[7]}, (f32x4*)(p.out + O_SVS + o + 4)); } }
            }
        }
    }
    __syncthreads();
    constexpr int NPASS = SAMPLE ? 1 : 4;
    if (!SAMPLE || wave < 2) {
        asm volatile("" : "+v"(lane));
        float rc[8], rsn[8];
        { const int q16 = lane & 15; const float pos0 = SAMPLE ? (float)(16384 + (q16 & 7)) : (float)(nb * 128 + 16 * wave + q16);
#pragma unroll
          for (int e = 0; e < 8; ++e) rope_cs(pos0, e, rc[e], rsn[e]); }
        float qgs[2][8];
        {
#pragma unroll
          for (int dc = 0; dc < 2; ++dc) { pg8::ld8f(p.in[I_CQG] + 32 * dc + 8 * (lane >> 4), qgs[dc]);
#pragma unroll
            for (int e = 0; e < 8; ++e) qgs[dc][e] *= 0.125f; } }
        v4u qraw[2];
        { const int q16 = lane & 15, kq = lane >> 4;
          const size_t row0 = SAMPLE ? (size_t)MP + 8 * b + (q16 & 7) : (size_t)b * 8192 + nb * 128 + 16 * wave + q16;
          const int h0 = kvh * 4 + (SAMPLE ? 2 * wave + (q16 >> 3) : 0);
#pragma unroll
          for (int dc = 0; dc < 2; ++dc) qraw[dc] = *(const v4u*)(Q + row0 * 1024 + h0 * 64 + 32 * dc + 8 * kq); }
#pragma unroll 1
        for (int ps = 0; ps < NPASS; ++ps) {
            int q16 = lane & 15, kq = lane >> 4; asm volatile("" : "+v"(q16), "+v"(kq));
            int g, i, c0; size_t row; float pos;
            if (!SAMPLE) { g = ps; i = 16 * wave + q16; row = (size_t)b * 8192 + nb * 128 + i; pos = (float)(nb * 128 + i); c0 = wave >> 1; }
            else { g = 2 * wave + (q16 >> 3); i = q16 & 7; row = (size_t)MP + 8 * b + i; pos = (float)(16384 + i); c0 = 0; }
            const int h = kvh * 4 + g;
            float qv[2][8];
#pragma unroll
            for (int dc = 0; dc < 2; ++dc) unpack8(qraw[dc], qv[dc]);
            if (!SAMPLE && ps + 1 < NPASS) {
#pragma unroll
                for (int dc = 0; dc < 2; ++dc) qraw[dc] = *(const v4u*)(Q + row * 1024 + (h + 1) * 64 + 32 * dc + 8 * kq); }
            float ss = 0.f;
#pragma unroll
            for (int dc = 0; dc < 2; ++dc)
#pragma unroll
                for (int e = 0; e < 8; ++e) ss += qv[dc][e] * qv[dc][e];
            ss += __shfl_xor(ss, 16); ss += __shfl_xor(ss, 32);
            const float rs = rsqrtf(ss * (1.f / 64.f) + EPS);
#pragma unroll
            for (int dc = 0; dc < 2; ++dc) {
#pragma unroll
                for (int e = 0; e < 8; ++e) qv[dc][e] *= rs * qgs[dc][e]; }
#pragma unroll
            for (int e = 0; e < 8; ++e) { const float pk = __shfl_xor(qv[0][e], 16); const float cs = rc[e], sn = rsn[e];
                if (kq == 0) qv[0][e] = qv[0][e] * cs - pk * sn; else if (kq == 1) qv[0][e] = qv[0][e] * cs + pk * sn; }
            bf16x8 qf[2];
#pragma unroll
            for (int dc = 0; dc < 2; ++dc) qf[dc] = pack8(qv[dc]);
            f32x4 S[5][2];
            const float sink = p.in[I_CSINK][h];
            float mx = sink;
#pragma unroll
            for (int cc = 0; cc < 5; ++cc)
#pragma unroll
                for (int tt = 0; tt < 2; ++tt) { const int kb = 32 * (c0 + cc) + 16 * tt; f32x4 a = (f32x4){0.f, 0.f, 0.f, 0.f};
#pragma unroll
                    for (int dc = 0; dc < 2; ++dc) { const bf16x8 kf = *(const LAS bf16x8*)(Kl + (kb + q16) * SWA_KS + 32 * dc + 8 * kq);
                        a = __builtin_amdgcn_mfma_f32_16x16x32_bf16(kf, qf[dc], a, 0, 0, 0); }
                    const int rel = (kb >> 4) - wave;
                    const bool full = !SAMPLE && rel >= 1 && rel <= 7 && (nb > 0 || kb >= 128);
                    if (!full) {
#pragma unroll
                        for (int e = 0; e < 4; ++e) { const int s = kb + 4 * kq + e; const bool ok = (s > i) && (s <= i + 128) && (SAMPLE || nb > 0 || s >= 128);
                            a[e] = ok ? a[e] : -INFINITY; } }
#pragma unroll
                    for (int e = 0; e < 4; ++e) mx = fmaxf(mx, a[e]);
                    S[cc][tt] = a; }
            mx = fmaxf(mx, __shfl_xor(mx, 16)); mx = fmaxf(mx, __shfl_xor(mx, 32));
            float den = 0.f;
#pragma unroll
            for (int cc = 0; cc < 5; ++cc)
#pragma unroll
                for (int tt = 0; tt < 2; ++tt)
#pragma unroll
                    for (int e = 0; e < 4; ++e) { const float pe = __expf(S[cc][tt][e] - mx); S[cc][tt][e] = pe; den += pe; }
            den += __shfl_xor(den, 16); den += __shfl_xor(den, 32);
            den += __expf(sink - mx);
            const float rden = 1.f / den;
            bf16x8 pf[5];
#pragma unroll
            for (int cc = 0; cc < 5; ++cc) { float t8[8];
#pragma unroll
                for (int e = 0; e < 4; ++e) { t8[e] = S[cc][0][e]; t8[4 + e] = S[cc][1][e]; }
                pf[cc] = pack8(t8); }
#pragma unroll
            for (int dt = 0; dt < 4; ++dt) { f32x4 o = (f32x4){0.f, 0.f, 0.f, 0.f};
#pragma unroll
                for (int cc = 0; cc < 5; ++cc) { const LAS bf16* vp = Vt + (32 * (c0 + cc) + 4 * kq + (q16 >> 2)) * SWA_VS + 16 * dt + 4 * (q16 & 3);
                    const v2u lo = vtr(vp), hi = vtr(vp + 16 * SWA_VS);
                    v4u av; av.x = lo.x; av.y = lo.y; av.z = hi.x; av.w = hi.y;
                    o = __builtin_amdgcn_mfma_f32_16x16x32_bf16(__builtin_bit_cast(bf16x8, av), pf[cc], o, 0, 0, 0); }
                v2u w; w.x = pk2(o[0] * rden, o[1] * rden); w.y = pk2(o[2] * rden, o[3] * rden);
                *(v2u*)(AO + row * 1024 + h * 64 + 16 * dt + 4 * kq) = w; }
        }
    }
    __syncthreads();
}

constexpr int MEM_KS = 136, MEM_VS = 136, MEM_VOFF = 256 * MEM_KS * 2;
static_assert(MEM_VOFF + 256 * MEM_VS * 2 <= LDS_CTL_OFF && 128 * SG_VS * 2 <= LDS_CTL_OFF, "LDS");
template <bool SAMPLE>
__device__ __forceinline__ void mem_unit(const Params& p, int l, LAS unsigned char* lds, int unit, int tid, int wave, int lane) {
    const bf16* MQ = (const bf16*)(p.ws + W_MQ); bf16* MO = (bf16*)(p.ws + W_MO);
    LAS bf16* Kl = (LAS bf16*)lds; LAS bf16* Vt = (LAS bf16*)(lds + MEM_VOFF);
    int b, h, qt;
    if (!SAMPLE) { qt = unit & 15; h = (unit >> 4) & 3; b = unit >> 6; } else { h = unit & 3; b = unit >> 2; qt = 0; }
    {
        const int sub = tid & 15;
        float kg[8]; pg8::ld8f(p.in[I_MKG] + l * 128 + 8 * sub, kg);
#pragma unroll 1
        for (int hb = 0; hb < 2; ++hb) {
            float kk[4][8], vv[4][8];
#pragma unroll
            for (int it = 0; it < 4; ++it) { const int s = (tid >> 4) + 32 * (4 * hb + it);
                const float* kp; const float* vp;
                if (!SAMPLE) { kp = (const float*)(p.ws + W_MKV) + ((size_t)l * 1024 + b * 256 + s) * 1024 + h * 128 + sub * 8; vp = kp + 512; }
                else { const size_t o = ((((size_t)l * 128 + b) * 256 + s) * 4 + h) * 128 + sub * 8; kp = p.in[I_CMK] + o; vp = p.in[I_CMV] + o; }
                if (SAMPLE) { pg8::ld8f_nt(kp, kk[it]); pg8::ld8f_nt(vp, vv[it]); } else { pg8::ld8f(kp, kk[it]); pg8::ld8f(vp, vv[it]); } }
#pragma unroll
            for (int it = 0; it < 4; ++it) { const int s = (tid >> 4) + 32 * (4 * hb + it);
                float (&k)[8] = kk[it]; float (&v)[8] = vv[it];
                if (!SAMPLE) { float ss = 0.f;
#pragma unroll
                    for (int e = 0; e < 8; ++e) ss += k[e] * k[e];
                    ss += __shfl_xor(ss, 1); ss += __shfl_xor(ss, 2); ss += __shfl_xor(ss, 4); ss += __shfl_xor(ss, 8);
                    const float rs = rsqrtf(ss * (1.f / 128.f) + EPS);
#pragma unroll
                    for (int e = 0; e < 8; ++e) k[e] *= rs * kg[e];
                    if (qt == 0) { const size_t o = ((((size_t)l * 4 + b) * 256 + s) * 4 + h) * 128 + sub * 8;
                        *(f32x4*)(p.out + O_MKP + o) = (f32x4){k[0], k[1], k[2], k[3]}; *(f32x4*)(p.out + O_MKP + o + 4) = (f32x4){k[4], k[5], k[6], k[7]};
                        *(f32x4*)(p.out + O_MVP + o) = (f32x4){v[0], v[1], v[2], v[3]}; *(f32x4*)(p.out + O_MVP + o + 4) = (f32x4){v[4], v[5], v[6], v[7]}; }
                }
                *(LAS bf16x8*)(Kl + s * MEM_KS + sub * 8) = pack8(k);
                *(LAS bf16x8*)(Vt + s * MEM_VS + sub * 8) = pack8(v);
            }
        }
    }
    __syncthreads();
    if (!SAMPLE || wave == 0) {
#pragma unroll 1
      for (int qq = 0; qq < (SAMPLE ? 1 : 4); ++qq) {
        int q16 = lane & 15, kq = lane >> 4; asm volatile("" : "+v"(q16), "+v"(kq));
        size_t row; bool st;
        if (!SAMPLE) { row = (size_t)b * 8192 + (qt * 4 + qq) * 128 + 16 * wave + q16; st = true; } else { row = (size_t)MP + 8 * b + (q16 & 7); st = q16 < 8; }
        bf16x8 qf[4];
        {
            float qv[4][8]; float ss = 0.f;
#pragma unroll
            for (int dc = 0; dc < 4; ++dc) { unpack8(*(const v4u*)(MQ + row * 512 + h * 128 + 32 * dc + 8 * kq), qv[dc]);
#pragma unroll
                for (int e = 0; e < 8; ++e) ss += qv[dc][e] * qv[dc][e]; }
            ss += __shfl_xor(ss, 16); ss += __shfl_xor(ss, 32);
            const float rs = rsqrtf(ss * (1.f / 128.f) + EPS) * 0.08838834764831845f;
#pragma unroll
            for (int dc = 0; dc < 4; ++dc) { float qg[8]; pg8::ld8f(p.in[I_MQG] + l * 128 + 32 * dc + 8 * kq, qg);
#pragma unroll
                for (int e = 0; e < 8; ++e) qv[dc][e] *= rs * qg[e];
                qf[dc] = pack8(qv[dc]); }
        }
        f32x4 S[8][2]; float mx = -INFINITY;
#pragma unroll
        for (int cc = 0; cc < 8; ++cc)
#pragma unroll
            for (int tt = 0; tt < 2; ++tt) { const int kb = 32 * cc + 16 * tt; f32x4 a = (f32x4){0.f, 0.f, 0.f, 0.f};
#pragma unroll
                for (int dc = 0; dc < 4; ++dc) { const bf16x8 kf = *(const LAS bf16x8*)(Kl + (kb + q16) * MEM_KS + 32 * dc + 8 * kq);
                    a = __builtin_amdgcn_mfma_f32_16x16x32_bf16(kf, qf[dc], a, 0, 0, 0); }
#pragma unroll
                for (int e = 0; e < 4; ++e) mx = fmaxf(mx, a[e]);
                S[cc][tt] = a; }
        mx = fmaxf(mx, __shfl_xor(mx, 16)); mx = fmaxf(mx, __shfl_xor(mx, 32));
        float den = 0.f;
#pragma unroll
        for (int cc = 0; cc < 8; ++cc)
#pragma unroll
            for (int tt = 0; tt < 2; ++tt)
#pragma unroll
                for (int e = 0; e < 4; ++e) { const float pe = __expf(S[cc][tt][e] - mx); S[cc][tt][e] = pe; den += pe; }
        den += __shfl_xor(den, 16); den += __shfl_xor(den, 32);
        const float rden = 1.f / den;
        bf16x8 pf[8];
#pragma unroll
        for (int cc = 0; cc < 8; ++cc) { float t8[8];
#pragma unroll
            for (int e = 0; e < 4; ++e) { t8[e] = S[cc][0][e]; t8[4 + e] = S[cc][1][e]; }
            pf[cc] = pack8(t8); }
#pragma unroll
        for (int dt = 0; dt < 8; ++dt) { f32x4 o = (f32x4){0.f, 0.f, 0.f, 0.f};
#pragma unroll
            for (int cc = 0; cc < 8; ++cc) { const LAS bf16* vp = Vt + (32 * cc + 4 * kq + (q16 >> 2)) * MEM_VS + 16 * dt + 4 * (q16 & 3);
                const v2u lo = vtr(vp), hi = vtr(vp + 16 * MEM_VS);
                v4u av; av.x = lo.x; av.y = lo.y; av.z = hi.x; av.w = hi.y;
                o = __builtin_amdgcn_mfma_f32_16x16x32_bf16(__builtin_bit_cast(bf16x8, av), pf[cc], o, 0, 0, 0); }
            if (st) { v2u w; w.x = pk2(o[0] * rden, o[1] * rden); w.y = pk2(o[2] * rden, o[3] * rden);
                *(v2u*)(MO + row * 512 + h * 128 + 16 * dt + 4 * kq) = w; } }
      }
    }
    __syncthreads();
}

#ifndef REP_LIGHT
#define REP_LIGHT 1
#endif
#ifndef REP_G9
#define REP_G9 1
#endif
#ifndef REP_G10
#define REP_G10 1
#endif
#ifndef REP_PRO
#define REP_PRO 1
#endif
#ifndef REP_MEM
#define REP_MEM 1
#endif
#ifndef REP_P15
#define REP_P15 1
#endif
#ifndef REP_SYNC
#define REP_SYNC 1
#endif
#define GSYNC() do { for (int r_ = 0; r_ < REP_SYNC; ++r_) xcd_barrier(xbar); } while (0)
#define PHASE_IDS int t_ = threadIdx.x; asm volatile("" : "+v"(t_)); const int tid = t_, lane = tid & 63, wave = __builtin_amdgcn_readfirstlane(tid >> 6); const int gw = bx * NWAVES + wave; (void)gw; (void)lane; (void)tid;
__global__ void __launch_bounds__(NTHR, 2) fwd_megakernel(Params p) {
    extern __shared__ __attribute__((aligned(16))) unsigned char lds_raw[];
    LAS unsigned char* lds = (LAS unsigned char*)lds_raw;
    cg::grid_group grid = cg::this_grid();
    const int G = gridDim.x, bx = blockIdx.x;
    const int wave0 = __builtin_amdgcn_readfirstlane((int)threadIdx.x >> 6);
    const int ngw = G * NWAVES;
    unsigned char* ws = p.ws;
    bf16* XN = (bf16*)(ws + W_XN);
    float* SSb = (float*)(ws + W_SS);
    float* X = p.out;
    typedef pg8::bf16_t pb;

    if (threadIdx.x < 16) ((LAS unsigned*)(lds + LDS_CTL_OFF))[threadIdx.x] = 0u;
    __syncthreads();
    const XcdBarrier xbar = xcd_barrier_post((unsigned*)(ws + W_CTL), (volatile LAS unsigned*)(lds + LDS_CTL_OFF));
    for (int rep = 0; rep < REP_LIGHT * REP_PRO; ++rep) { PHASE_IDS prologue(p, lds, gw, ngw, wave, lane); }
    grid.sync();

    auto layer_body = [&](auto LC) __attribute__((always_inline)) {
        constexpr int l = decltype(LC)::value;
        unsigned char* wl = ws + W_LAYER + (size_t)l * WL_SIZE;
        if (l == 0) {
            { pg8::Gemm g{(const pb*)XN, (const pb*)(ws + W_WIN), MT, 1536, 1024}; pg8::StaticOrder S; S.init(MP, 1536, G, bx);
              pg8::EpiAct E{(pb*)(ws + W_PROJ), 1536, 4, SSb};
              pg8::gemm_phase<pg8::EpiAct, pg8::StaticOrder, true, true>(lds, g, S, E, wave0);
              pg8::mini_gemm(lds, g.A, g.Bt, 1024, 12, E, bx, G, wave0); }
#pragma unroll 1
            for (int ll = 0; ll < 2; ++ll) {
              pg8::EpiRes E{(float*)(ws + W_MKV) + (size_t)ll * 1024 * 1024, nullptr, nullptr, 0, nullptr, nullptr, 0};
              pg8::mini_gemm(lds, (const pb*)(ws + W_MN) + (size_t)ll * 1024 * 1024, (const pb*)(ws + W_LAYER + (size_t)ll * WL_SIZE + WL_WKV), 1024, 8, E, (bx + G - 96 - 64 * ll) % G, G, wave0, 0); }
        } else {
            pg8::Gemm g{(const pb*)XN, (const pb*)(ws + W_WQKV), MT, 1536, 1024}; pg8::StaticOrder S; S.init(MP, 1536, G, bx);
            pg8::EpiQKV E{(pb*)(ws + W_PROJ), (float*)(ws + W_KV32), SSb + (size_t)3 * MT};
            pg8::gemm_phase<pg8::EpiQKV, pg8::StaticOrder, true, true>(lds, g, S, E, wave0);
            pg8::mini_gemm(lds, g.A, g.Bt, 1024, 12, E, bx, G, wave0);
        }
        GSYNC();
        if (l == 0) {
#ifndef NO_SGU
            PHASE_IDS
            for (int rep = 0; rep < REP_LIGHT; ++rep)
            for (int u = bx; u < 256 + 128; u += G) { if (u < 256) sgu_prompt_unit(p, lds, u, tid, wave, lane); else sgu_sample_unit(p, lds, u - 256, tid, wave, lane); }
#endif
        } else {
#ifndef NO_SWA
            PHASE_IDS
            for (int rep = 0; rep < REP_LIGHT; ++rep)
            for (int u = bx; u < 1024 + 512; u += G) { if (u < 1024) swa_unit<false>(p, lds, u, tid, wave, lane); else swa_unit<true>(p, lds, u - 1024, tid, wave, lane); }
#endif
        }
        GSYNC();
        {
            pg8::Gemm g{(const pb*)(ws + W_AO), (const pb*)(ws + (l == 0 ? W_WOUT : W_CWO)), MT, 1024, 1024}; pg8::StaticOrder S; S.init(MP, 1024, G, bx);
            pg8::EpiRes E{nullptr, nullptr, nullptr, 1, (pb*)XN, SSb + (size_t)(1 + 3 * l) * MT, 1};
            pg8::gemm_phase<pg8::EpiRes, pg8::StaticOrder, true, true>(lds, g, S, E, wave0);
            pg8::mini_gemm<pg8::EpiRes, true, true>(lds, g.A, g.Bt, 1024, 16, E, bx, G, wave0);
        }
        GSYNC();
        {
            pg8::Gemm g{(const pb*)XN, (const pb*)(wl + WL_WQ), MT, 512, 1024}; pg8::StaticOrder S; S.init(MP, 512, G, bx);
            pg8::EpiAct E{(pb*)(ws + W_MQ), 512, 0, SSb + (size_t)(1 + 3 * l) * MT};
            pg8::gemm_phase<pg8::EpiAct, pg8::StaticOrder, true, true>(lds, g, S, E, wave0);
            pg8::mini_gemm<pg8::EpiAct, true, true>(lds, g.A, g.Bt, 1024, 8, E, bx, G, wave0);
        }
        GSYNC();
#ifndef NO_MEM
        { PHASE_IDS
        for (int rep = 0; rep < REP_LIGHT * REP_MEM; ++rep)
        for (int u = bx; u < 256 + 512; u += G) { if (u < 256) mem_unit<false>(p, l, lds, u, tid, wave, lane); else mem_unit<true>(p, l, lds, u - 256, tid, wave, lane); } }
#endif
        GSYNC();
        {
            pg8::Gemm g{(const pb*)(ws + W_MO), (const pb*)(wl + WL_WO), MT, 1024, 512}; pg8::StaticOrder S; S.init(MP, 1024, G, bx);
            pg8::EpiRes E{nullptr, nullptr, nullptr, 1, (pb*)XN, SSb + (size_t)(2 + 3 * l) * MT, 1};
            pg8::gemm_phase<pg8::EpiRes, pg8::StaticOrder, true, true>(lds, g, S, E, wave0);
            pg8::mini_gemm<pg8::EpiRes, true, true>(lds, g.A, g.Bt, 512, 16, E, bx, G, wave0);
        }
        GSYNC();
        {
            pg8::Gemm g{(const pb*)XN, (const pb*)(wl + WL_WUP), MT, DFF, 1024}; pg8::SplitOrder S; S.init(DFF, G, bx);
            pg8::EpiG E{(pb*)(ws + W_G), p.out + O_FCP + (size_t)l * 4 * 2 * DFF, p.out + O_FCS + (size_t)l * 128 * 2 * DFF, SSb + (size_t)(2 + 3 * l) * MT};
            for (int rep = 0; rep < REP_G9; ++rep) pg8::gemm_phase<pg8::EpiG, pg8::SplitOrder, true, true>(lds, g, S, E, wave0);
        }
        GSYNC();
        {
            pg8::Gemm g{(const pb*)XN, (const pb*)(wl + WL_WUP) + (size_t)DFF * 1024, MT, DFF, 1024}; pg8::SplitOrder S; S.init(DFF, G, bx);
            pg8::EpiH E{(const pb*)(ws + W_G), (pb*)(ws + W_H), p.in[I_FCW] + (size_t)l * 3 * DFF, p.in[I_FCB] + (size_t)l * DFF, p.in[I_CFC] + (size_t)l * 128 * 2 * DFF, SSb + (size_t)(2 + 3 * l) * MT};
            for (int rep = 0; rep < REP_G10; ++rep) pg8::gemm_phase<pg8::EpiH, pg8::SplitOrder, true, true>(lds, g, S, E, wave0);
        }
        GSYNC();
        {
            pg8::Gemm g{(const pb*)(ws + W_H), (const pb*)(wl + WL_WDN), MT, 1024, DFF}; pg8::StaticOrder S; S.init(MP, 1024, G, bx);
            pg8::EpiRes E{l == 0 ? nullptr : X, nullptr, nullptr, 1, (pb*)XN, SSb + (size_t)3 * MT, l == 0};
            pg8::gemm_phase<pg8::EpiRes, pg8::StaticOrder, true, true>(lds, g, S, E, wave0);
            pg8::mini_gemm<pg8::EpiRes, true, true>(lds, g.A, g.Bt, DFF, 16, E, bx, G, wave0);
        }
        GSYNC();
    };
    layer_body(std::integral_constant<int, 0>{});
    layer_body(std::integral_constant<int, 1>{});
}

extern "C" void kernel_launch(void* const* d_in, const int* in_sizes, int n_in, void* d_out, int out_size, void* d_ws, size_t ws_size, hipStream_t stream) {
    static int grid_blocks = 0;
    if (grid_blocks == 0) {
        if (n_in != N_IN || (size_t)out_size != O_END || ws_size < W_NEED) { fprintf(stderr, "kernel_launch: unexpected shapes: n_in %d out %d ws %zu (need %zu)\n", n_in, out_size, ws_size, (size_t)W_NEED); grid_blocks = -1; return; }
        int dev = 0, cus = 0, per_cu = 0;
        hipGetDevice(&dev);
        hipDeviceGetAttribute(&cus, hipDeviceAttributeMultiprocessorCount, dev);
        if (hipFuncSetAttribute((const void*)fwd_megakernel, hipFuncAttributeMaxDynamicSharedMemorySize, LDS_BYTES) != hipSuccess) { fprintf(stderr, "kernel_launch: hipFuncSetAttribute failed\n"); grid_blocks = -1; return; }
        if (hipOccupancyMaxActiveBlocksPerMultiprocessor(&per_cu, (const void*)fwd_megakernel, NTHR, LDS_BYTES) != hipSuccess || per_cu < 1) { fprintf(stderr, "kernel_launch: occupancy query failed (%d)\n", per_cu); (void)hipGetLastError(); grid_blocks = -1; return; }
        grid_blocks = cus * per_cu;
    }
    if (grid_blocks < 0) return;
    if (hipMemsetAsync((char*)d_ws + W_CTL, 0, CTL_BYTES, stream) != hipSuccess) { fprintf(stderr, "kernel_launch: memset failed\n"); return; }
    Params p{};
    for (int i = 0; i < N_IN; ++i) p.in[i] = (const float*)d_in[i];
    p.out = (float*)d_out; p.ws = (unsigned char*)d_ws;
    void* args[] = {&p};
    hipError_t e = hipLaunchCooperativeKernel((const void*)fwd_megakernel, dim3(grid_blocks), dim3(NTHR), args, LDS_BYTES, stream);
    if (e != hipSuccess) fprintf(stderr, "cooperative launch failed: %s (grid %d)\n", hipGetErrorString(e), grid_blocks);
}
```

```cpp
#include <hip/hip_runtime.h>
#include <hip/hip_cooperative_groups.h>
#include <cstdio>
#include <cstdint>
#include <type_traits>
namespace cg = cooperative_groups;
namespace pg8 {
#define PG8_LAS __attribute__((address_space(3)))
typedef unsigned short bf16_t;
typedef short bf16x8 __attribute__((ext_vector_type(8)));
typedef float f32x4 __attribute__((ext_vector_type(4)));
typedef unsigned u32x4 __attribute__((ext_vector_type(4)));
constexpr int BM = 256, BK = 64, HALF = 128, HTB = HALF * BK * 2  , STAGE_BYTES = 8 * HTB, NXCD = 8, WGM = 8;

__host__ __device__ __forceinline__ int lds_byte(int r, int c) { const int st = (r >> 4) * 2 + (c >> 5), rr = r & 15, cc = c & 31, ob = rr * 64 + cc * 2; return st * 1024 + (ob ^ (((ob >> 9) & 1) << 5)); }
__host__ __device__ __forceinline__ void stage_rc(int b, int& R, int& C) { const int st = b / 1024, sb = b % 1024, swz = sb ^ (((sb >> 9) & 1) << 5); R = (st >> 1) * 16 + swz / 64; C = (st & 1) * 32 + (swz % 64) / 2; }
__host__ __device__ __forceinline__ int perm32(int rho) { const int n = rho >> 4, i = rho & 15; return 8 * (i >> 2) + 4 * n + (i & 3); }

struct Unit { int pm, pn; int rb; int half; int q; int cb; };
struct Gemm { const bf16_t* A; const bf16_t* Bt; int M, N, K; };

struct StaticOrder {
    int nM, nN, nwg, G, c;
    __host__ __device__ void init(int M, int N, int G_, int c_) { nM = M / BM; nN = N / BM; nwg = nM * nN; G = G_; c = c_; }
    __host__ __device__ bool next(int i, Unit& u) const {
        const long L = (long)i * G + c; if (L >= nwg) return false;
        int wgid = (int)L; { const int q = nwg / NXCD, r = nwg % NXCD, xcd = wgid % NXCD, off = wgid / NXCD; wgid = (xcd < r ? xcd * (q + 1) : r * (q + 1) + (xcd - r) * q) + off; }
        const int nig = WGM * nN, gid = wgid / nig, fm = gid * WGM, gsz = (nM - fm) < WGM ? (nM - fm) : WGM;
        u.pm = fm + ((wgid % nig) % gsz); u.pn = (wgid % nig) / gsz; u.rb = u.pm * BM; u.half = 0; u.q = 0; u.cb = u.pn * BM; return true;
    }
    __device__ __forceinline__ void a_ready(const Unit&) const {}
    __device__ __forceinline__ void done(const Unit&) const {}
};
struct SplitOrder {
    StaticOrder P; int nP, nS, nN, G, c;
    __host__ __device__ void init(int N, int G_, int c_) { P.init(32768, N, G_, c_); nP = P.nwg; nN = N / BM; nS = 8 * nN; G = G_; c = c_; }
    __host__ __device__ bool next(int i, Unit& u) const {
        const long L = (long)i * G + c;
        if (L < nP) return P.next(i, u);
        const int j = (int)(L - nP); if (j >= nS) return false;
        const int hm = j & 7; u.pn = j >> 3; u.pm = 128 + (hm >> 1); u.rb = 32768 + 128 * hm; u.half = 1; u.q = 0; u.cb = u.pn * BM; return true;
    }
    __device__ __forceinline__ void a_ready(const Unit&) const {}
    __device__ __forceinline__ void done(const Unit&) const {}
};


__device__ __forceinline__ unsigned cvt_pk_bf16(float lo, float hi) { unsigned r; asm volatile("v_cvt_pk_bf16_f32 %0, %1, %2" : "=v"(r) : "v"(lo), "v"(hi)); return r; }
typedef float f32x2 __attribute__((ext_vector_type(2)));
__device__ __forceinline__ f32x2 gelu_pk(f32x2 v) {
    f32x2 x = v * 0.70710678118f;
    x.x = __builtin_amdgcn_fmed3f(x.x, -2.9f, 2.9f); x.y = __builtin_amdgcn_fmed3f(x.y, -2.9f, 2.9f);
    const f32x2 t = x * x;
    f32x2 p = t * (-4.953124630e-07f) + 1.987094038e-05f;
    p = p * t + (-3.472001117e-04f); p = p * t + 3.517547622e-03f; p = p * t + (-2.333305031e-02f); p = p * t + 1.087993085e-01f; p = p * t + (-3.740358949e-01f); p = p * t + 1.128076553e+00f;
    const f32x2 hv = v * 0.5f;
    return hv * (x * p) + hv;
}

__device__ __forceinline__ float bf_lo(unsigned w) { return __builtin_bit_cast(float, w << 16); }
__device__ __forceinline__ float bf_hi(unsigned w) { return __builtin_bit_cast(float, w & 0xffff0000u); }
__device__ __forceinline__ void ld8bf(const bf16_t* p, float (&o)[8]) { const u32x4 w = *(const u32x4*)p;
    o[0] = bf_lo(w.x); o[1] = bf_hi(w.x); o[2] = bf_lo(w.y); o[3] = bf_hi(w.y); o[4] = bf_lo(w.z); o[5] = bf_hi(w.z); o[6] = bf_lo(w.w); o[7] = bf_hi(w.w); }
__device__ __forceinline__ void ld8f(const float* p, float (&o)[8]) { const f32x4 a = *(const f32x4*)p, b = *(const f32x4*)(p + 4);
    o[0] = a[0]; o[1] = a[1]; o[2] = a[2]; o[3] = a[3]; o[4] = b[0]; o[5] = b[1]; o[6] = b[2]; o[7] = b[3]; }
__device__ __forceinline__ void ld8f_nt(const float* p, float (&o)[8]) { const f32x4 a = __builtin_nontemporal_load((const f32x4*)p), b = __builtin_nontemporal_load((const f32x4*)(p + 4));
    o[0] = a[0]; o[1] = a[1]; o[2] = a[2]; o[3] = a[3]; o[4] = b[0]; o[5] = b[1]; o[6] = b[2]; o[7] = b[3]; }
__device__ __forceinline__ void zero8(float (&o)[8]) {
#pragma unroll
    for (int j = 0; j < 8; ++j) o[j] = 0.f; }

struct EpiAct {
    static constexpr bool PERM = true, AFTER_DRAIN = false;
    bf16_t* O; int ldc; int gelu_tiles; const float* SS;
    __device__ __forceinline__ void operator()(const f32x4 (&acc)[2][2][4][2], const Unit& u, int wr, int wc, int fr, int fq) const {
        asm volatile("" : "+v"(fr), "+v"(fq));
        const int row0 = u.rb + wr * 64 + fr, col0 = u.cb + wc * 32 + 8 * fq;
        const bool act = u.pn < gelu_tiles;
        float rsv[2][4];
#pragma unroll
        for (int ai = 0; ai < 2; ++ai)
#pragma unroll
            for (int m = 0; m < 4; ++m) rsv[ai][m] = SS[row0 + (u.half ? 0 : ai * HALF) + m * 16];
#pragma unroll
        for (int ai = 0; ai < 2; ++ai) if (ai == 0 || !u.half)
#pragma unroll
            for (int m = 0; m < 4; ++m) { bf16_t* rowp = O + (size_t)(row0 + ai * HALF + m * 16) * ldc + col0;
                const float rs = rsqrtf(rsv[ai][m] * (1.f / 1024.f) + 1e-6f);
#pragma unroll
                for (int bj = 0; bj < 2; ++bj) if (bj == 0 || !u.q) { f32x4 v0 = acc[ai][bj][m][0] * rs, v1 = acc[ai][bj][m][1] * rs;
                    if (act) { f32x2 a = gelu_pk((f32x2){v0[0], v0[1]}), b = gelu_pk((f32x2){v0[2], v0[3]}), c = gelu_pk((f32x2){v1[0], v1[1]}), d = gelu_pk((f32x2){v1[2], v1[3]});
                        v0 = (f32x4){a.x, a.y, b.x, b.y}; v1 = (f32x4){c.x, c.y, d.x, d.y}; }
                    u32x4 w; w.x = cvt_pk_bf16(v0[0], v0[1]); w.y = cvt_pk_bf16(v0[2], v0[3]); w.z = cvt_pk_bf16(v1[0], v1[1]); w.w = cvt_pk_bf16(v1[2], v1[3]);
                    *(u32x4*)(rowp + bj * HALF) = w; } }
    }
};

struct EpiQKV {
    static constexpr bool PERM = true, AFTER_DRAIN = false;
    bf16_t* Q; float* KV; const float* SS;
    __device__ __forceinline__ void operator()(const f32x4 (&acc)[2][2][4][2], const Unit& u, int wr, int wc, int fr, int fq) const {
        asm volatile("" : "+v"(fr), "+v"(fq));
        const int row0 = u.rb + wr * 64 + fr;
        float rs[2][4];
#pragma unroll
        for (int ai = 0; ai < 2; ++ai) if (ai == 0 || !u.half)
#pragma unroll
            for (int m = 0; m < 4; ++m) rs[ai][m] = rsqrtf(SS[row0 + (u.half ? 0 : ai * HALF) + m * 16] * (1.f / 1024.f) + 1e-6f);
        if (u.pn < 4) {
            const int col0 = u.cb + wc * 32 + 8 * fq;
#pragma unroll
            for (int ai = 0; ai < 2; ++ai) if (ai == 0 || !u.half)
#pragma unroll
                for (int m = 0; m < 4; ++m) { bf16_t* rowp = Q + (size_t)(row0 + ai * HALF + m * 16) * 1024 + col0;
#pragma unroll
                    for (int bj = 0; bj < 2; ++bj) if (bj == 0 || !u.q) { const f32x4 v0 = acc[ai][bj][m][0] * rs[ai][m], v1 = acc[ai][bj][m][1] * rs[ai][m];
                        u32x4 w; w.x = cvt_pk_bf16(v0[0], v0[1]); w.y = cvt_pk_bf16(v0[2], v0[3]); w.z = cvt_pk_bf16(v1[0], v1[1]); w.w = cvt_pk_bf16(v1[2], v1[3]);
                        *(u32x4*)(rowp + bj * HALF) = w; } }
        } else {
            const int col0 = (u.cb - 1024) + wc * 32 + 8 * fq;
#pragma unroll
            for (int ai = 0; ai < 2; ++ai) if (ai == 0 || !u.half)
#pragma unroll
                for (int m = 0; m < 4; ++m) { float* rowp = KV + (size_t)(row0 + ai * HALF + m * 16) * 512 + col0;
#pragma unroll
                    for (int bj = 0; bj < 2; ++bj) if (bj == 0 || !u.q) { *(f32x4*)(rowp + bj * HALF) = acc[ai][bj][m][0] * rs[ai][m]; *(f32x4*)(rowp + bj * HALF + 4) = acc[ai][bj][m][1] * rs[ai][m]; } }
        }
    }
};

struct EpiRes {
    static constexpr bool PERM = true, AFTER_DRAIN = false;
    float* C; const float* resP; const float* resS; int inplace; bf16_t* XB0; float* SS; int wxb;
    static constexpr int ldc = 1024, split = 32768;
    __device__ __forceinline__ void row_out(const f32x4 v0, const f32x4 v1, int row, int col, float& ss) const {
        if (C) { float* rowp = C + (size_t)row * ldc + col; __builtin_nontemporal_store(v0, (f32x4*)rowp); __builtin_nontemporal_store(v1, (f32x4*)(rowp + 4)); }
        if (wxb) { u32x4 w; w.x = cvt_pk_bf16(v0[0], v0[1]); w.y = cvt_pk_bf16(v0[2], v0[3]); w.z = cvt_pk_bf16(v1[0], v1[1]); w.w = cvt_pk_bf16(v1[2], v1[3]);
            *(u32x4*)(XB0 + (size_t)row * ldc + col) = w;
            ss += (v0[0] * v0[0] + v0[1] * v0[1]) + (v0[2] * v0[2] + v0[3] * v0[3]) + (v1[0] * v1[0] + v1[1] * v1[1]) + (v1[2] * v1[2] + v1[3] * v1[3]); }
    }
    __device__ __forceinline__ void operator()(const f32x4 (&acc)[2][2][4][2], const Unit& u, int wr, int wc, int fr, int fq) const {
        asm volatile("" : "+v"(fr), "+v"(fq));
        const int row0 = u.rb + wr * 64 + fr, col0 = u.cb + wc * 32 + 8 * fq;
        if (inplace) {
#pragma unroll
            for (int ai = 0; ai < 2; ++ai) if (ai == 0 || !u.half)
#pragma unroll
              for (int mh = 0; mh < 4; mh += 2) {
                u32x4 rw[2][2];
#pragma unroll
                for (int mm = 0; mm < 2; ++mm) { const int row = row0 + ai * HALF + (mh + mm) * 16;
#pragma unroll
                    for (int bj = 0; bj < 2; ++bj) if (bj == 0 || !u.q) rw[mm][bj] = *(const u32x4*)(XB0 + (size_t)row * ldc + col0 + bj * HALF); }
#pragma unroll
                for (int mm = 0; mm < 2; ++mm) { const int m = mh + mm, row = row0 + ai * HALF + m * 16; float ss = 0.f;
#pragma unroll
                    for (int bj = 0; bj < 2; ++bj) if (bj == 0 || !u.q) { const u32x4 w = rw[mm][bj];
                        const f32x4 v0 = acc[ai][bj][m][0] + (f32x4){bf_lo(w.x), bf_hi(w.x), bf_lo(w.y), bf_hi(w.y)}, v1 = acc[ai][bj][m][1] + (f32x4){bf_lo(w.z), bf_hi(w.z), bf_lo(w.w), bf_hi(w.w)};
                        row_out(v0, v1, row, col0 + bj * HALF, ss); }
                    if (wxb) { ss += __shfl_xor(ss, 16); ss += __shfl_xor(ss, 32); if (fq == 0) unsafeAtomicAdd(SS + row, ss); } }
              }
        } else {
#pragma unroll
            for (int ai = 0; ai < 2; ++ai) if (ai == 0 || !u.half)
#pragma unroll
                for (int m = 0; m < 4; ++m) { const int row = row0 + ai * HALF + m * 16; float ss = 0.f;
                    const float* rp = resP ? ((row < split ? resP + (size_t)row * ldc : resS + (size_t)(row - split) * ldc) + col0) : nullptr;
                    f32x4 rv[2][2];
#pragma unroll
                    for (int bj = 0; bj < 2; ++bj) if (bj == 0 || !u.q) { rv[bj][0] = rp ? *(const f32x4*)(rp + bj * HALF) : (f32x4){0.f, 0.f, 0.f, 0.f}; rv[bj][1] = rp ? *(const f32x4*)(rp + bj * HALF + 4) : (f32x4){0.f, 0.f, 0.f, 0.f}; }
#pragma unroll
                    for (int bj = 0; bj < 2; ++bj) if (bj == 0 || !u.q) row_out(acc[ai][bj][m][0] + rv[bj][0], acc[ai][bj][m][1] + rv[bj][1], row, col0 + bj * HALF, ss);
                    if (wxb) { ss += __shfl_xor(ss, 16); ss += __shfl_xor(ss, 32); if (fq == 0) unsafeAtomicAdd(SS + row, ss); } }
        }
    }
};

struct EpiG {
    static constexpr bool PERM = true, AFTER_DRAIN = false;
    bf16_t* G; float* outP; float* outS; const float* SS;
    __device__ __forceinline__ void operator()(const f32x4 (&acc)[2][2][4][2], const Unit& u, int wr, int wc, int fr, int fq) const {
        asm volatile("" : "+v"(fr), "+v"(fq));
        const int row0 = u.rb + wr * 64 + fr, col0 = u.pn * BM + wc * 32 + 8 * fq;
        float rsv[2][4];
#pragma unroll
        for (int ai = 0; ai < 2; ++ai)
#pragma unroll
            for (int m = 0; m < 4; ++m) rsv[ai][m] = SS[row0 + (u.half ? 0 : ai * HALF) + m * 16];
#pragma unroll
        for (int ai = 0; ai < 2; ++ai) if (ai == 0 || !u.half)
#pragma unroll
            for (int m = 0; m < 4; ++m) { const int row = row0 + ai * HALF + m * 16; bf16_t* rowp = G + (size_t)row * 2816 + col0;
                float* co = nullptr;
                if (row < 32768) { const int t = row & 8191; if (t >= 8190) co = outP + ((size_t)(row >> 13) * 2 + (t - 8190)) * 2816 + col0; }
                else { const int i = row & 7; if (i >= 6) co = outS + ((size_t)((row - 32768) >> 3) * 2 + (i - 6)) * 2816 + col0; }
                const float rs = rsqrtf(rsv[ai][m] * (1.f / 1024.f) + 1e-6f);
#pragma unroll
                for (int bj = 0; bj < 2; ++bj) { const f32x4 v0 = acc[ai][bj][m][0] * rs, v1 = acc[ai][bj][m][1] * rs;
                    u32x4 w; w.x = cvt_pk_bf16(v0[0], v0[1]); w.y = cvt_pk_bf16(v0[2], v0[3]); w.z = cvt_pk_bf16(v1[0], v1[1]); w.w = cvt_pk_bf16(v1[2], v1[3]);
                    *(u32x4*)(rowp + bj * HALF) = w;
                    if (co) { *(f32x4*)(co + bj * HALF) = v0; *(f32x4*)(co + bj * HALF + 4) = v1; } } }
    }
};

typedef unsigned u32x2 __attribute__((ext_vector_type(2)));
struct EpiH {
    static constexpr bool PERM = true, AFTER_DRAIN = false;
    const bf16_t* G; bf16_t* H; const float* cw; const float* cb; const float* ctx; const float* SS;
    static __device__ __forceinline__ void unpk4(const u32x2 w, float (&o)[4]) { o[0] = bf_lo(w.x); o[1] = bf_hi(w.x); o[2] = bf_lo(w.y); o[3] = bf_hi(w.y); }
    static __device__ __forceinline__ void ld4f(const float* p, float (&o)[4]) { const f32x4 a = *(const f32x4*)p; o[0] = a[0]; o[1] = a[1]; o[2] = a[2]; o[3] = a[3]; }
    template <int N> static __device__ __forceinline__ unsigned dpp_prev1(unsigned pv, unsigned cur) {
        const int t = __builtin_amdgcn_update_dpp(0, (int)pv, 0x120 + N, 0xf, 0xf, true);
        return (unsigned)__builtin_amdgcn_update_dpp(t, (int)cur, 0x110 + N, 0xf, 0xf, false); }
    template <int N> static __device__ __forceinline__ u32x2 dpp_prev(const u32x2 pv, const u32x2 cur) { u32x2 r; r.x = dpp_prev1<N>(pv.x, cur.x); r.y = dpp_prev1<N>(pv.y, cur.y); return r; }
    static __device__ __forceinline__ u32x2 shf(const u32x2 w, int src) { u32x2 r; r.x = (unsigned)__shfl((int)w.x, src); r.y = (unsigned)__shfl((int)w.y, src); return r; }
    static __device__ __forceinline__ void finish(const float (&g0)[4], const float (&g1)[4], const float (&g2)[4], const float (&w0)[4], const float (&w1)[4], const float (&w2)[4], const float (&bb)[4],
                                                  const f32x4 v, float rs, bf16_t* dst) {
        float h[4];
#pragma unroll
        for (int j = 0; j < 4; j += 2) {
            const f32x2 gc = (f32x2){bb[j] + w0[j] * g2[j] + w1[j] * g1[j] + w2[j] * g0[j], bb[j + 1] + w0[j + 1] * g2[j + 1] + w1[j + 1] * g1[j + 1] + w2[j + 1] * g0[j + 1]};
            const f32x2 ge = gelu_pk(gc); h[j] = ge.x * v[j] * rs; h[j + 1] = ge.y * v[j + 1] * rs; }
        u32x2 w; w.x = cvt_pk_bf16(h[0], h[1]); w.y = cvt_pk_bf16(h[2], h[3]);
        *(u32x2*)dst = w;
    }
    __device__ __forceinline__ void operator()(const f32x4 (&acc)[2][2][4][2], const Unit& u, int wr, int wc, int fr, int fq) const {
        asm volatile("" : "+v"(fr), "+v"(fq));
        const int row0 = u.rb + wr * 64 + fr;
        const int lane = fq * 16 + fr;
        const int s1 = fr >= 1 ? lane - 1 : lane + 15, s2 = fr >= 2 ? lane - 2 : lane + 14;
#pragma unroll
        for (int bj = 0; bj < 2; ++bj)
#pragma unroll
          for (int hv = 0; hv < 2; ++hv) {
            const int col = u.pn * BM + bj * HALF + wc * 32 + 8 * fq + 4 * hv;
            float w0[4], w1[4], w2[4], bb[4];
            ld4f(cw + col, w0); ld4f(cw + 2816 + col, w1); ld4f(cw + 2 * 2816 + col, w2); ld4f(cb + col, bb);
            if (u.pm < 128) {
#pragma unroll
                for (int ai = 0; ai < 2; ++ai) {
                    const int R0 = u.rb + ai * HALF + wr * 64;
                    const bf16_t* gp = G + (size_t)(R0 + fr) * 2816 + col;
                    u32x2 gq[4];
#pragma unroll
                    for (int m = 0; m < 4; ++m) gq[m] = *(const u32x2*)(gp + (size_t)m * 16 * 2816);
                    u32x2 prv = (u32x2){0u, 0u};
                    if ((R0 & 8191) != 0) prv = *(const u32x2*)(gp - (size_t)16 * 2816);
#pragma unroll
                    for (int m = 0; m < 4; ++m) {
                        const u32x2 q1 = dpp_prev<1>(prv, gq[m]), q2 = dpp_prev<2>(prv, gq[m]);
                        float g0[4], g1[4], g2[4]; unpk4(gq[m], g0); unpk4(q1, g1); unpk4(q2, g2);
                        finish(g0, g1, g2, w0, w1, w2, bb, acc[ai][bj][m][hv], rsqrtf(SS[R0 + fr + 16 * m] * (1.f / 1024.f) + 1e-6f), H + (size_t)(R0 + fr + 16 * m) * 2816 + col);
                        prv = gq[m];
                    }
                }
            } else {
                const int i = fr & 7;
                u32x2 gq[4]; float ssv[4];
#pragma unroll
                for (int m = 0; m < 4; ++m) { const int row = row0 + m * 16; gq[m] = *(const u32x2*)(G + (size_t)row * 2816 + col); ssv[m] = SS[row]; }
#pragma unroll
                for (int mh = 0; mh < 4; mh += 2) {
                f32x4 c0[4], c1[4];
#pragma unroll
                for (int m = mh; m < mh + 2; ++m) { const int row = row0 + m * 16; const float* cx = ctx + (size_t)((row - 32768) >> 3) * 2 * 2816 + col;
                    c0[m] = *(const f32x4*)cx; c1[m] = *(const f32x4*)(cx + 2816); }
#pragma unroll
                for (int m = mh; m < mh + 2; ++m) { const int row = row0 + m * 16; const u32x2 cur = gq[m];
                    const u32x2 q1 = dpp_prev<1>(cur, cur), q2 = dpp_prev<2>(cur, cur);
                    float g0[4], g1[4], g2[4]; unpk4(cur, g0); unpk4(q1, g1); unpk4(q2, g2);
#pragma unroll
                    for (int j = 0; j < 4; ++j) { const float x1 = c1[m][j], x0 = c0[m][j];
                        if (i < 1) g1[j] = x1;
                        if (i < 2) g2[j] = (i == 1) ? x1 : x0; }
                    finish(g0, g1, g2, w0, w1, w2, bb, acc[0][bj][m][hv], rsqrtf(ssv[m] * (1.f / 1024.f) + 1e-6f), H + (size_t)row * 2816 + col); }
                }
            }
        }
    }
};

template <class Epi, class Sched, bool ALIGN_EPI = false, bool SP2 = false>
__device__ __forceinline__ void gemm_phase(PG8_LAS unsigned char* lds, const Gemm g, const Sched& S, const Epi& E, int wave0) {
    int tid_ = threadIdx.x; (void)wave0; asm volatile("" : "+v"(tid_));
    const int tid = tid_, wid = __builtin_amdgcn_readfirstlane(tid >> 6), lane = tid & 63, wr = wid >> 2, wc = wid & 3, fr = lane & 15, fq = lane >> 4;
    const int K = g.K, nt = K / BK;
    unsigned voffA[2], voffB[2];
#pragma unroll
    for (int i = 0; i < 2; ++i) { int R, C; stage_rc(tid * 16 + i * 8192, R, C); const int Rb = Epi::PERM ? ((R & ~31) + perm32(R & 31)) : R;
        voffA[i] = (unsigned)(R * K + C) * 2u; voffB[i] = (unsigned)(Rb * K + C) * 2u; }
    const size_t kstep = (size_t)(BK * 2);
    const size_t hstep = (size_t)HALF * K * 2;
    const size_t tstep = 2 * hstep;
    const unsigned ldsw = (unsigned)wid * 1024u;
    const int aoff = lds_byte(wr * 64 + fr, fq * 8), boff = lds_byte(wc * 32 + fr, fq * 8);
#define PG8_SA(b, h) (((b) * 2 + (h)) * HTB)
#define PG8_SB(b, h) ((4 + (b) * 2 + (h)) * HTB)
#define PG8_STAGE(bufoff, gbase, voff) do { _Pragma("unroll") for (int _i = 0; _i < 2; ++_i) \
        __builtin_amdgcn_global_load_lds((const unsigned*)((const char*)(gbase) + (voff)[_i]), (PG8_LAS unsigned*)(lds + (bufoff) + ldsw + _i * 8192), 16, 0, 0); } while (0)
#define PG8_LDA(dst, b, h) do { _Pragma("unroll") for (int m = 0; m < 4; ++m) _Pragma("unroll") for (int k = 0; k < 2; ++k) dst[m][k] = *(const PG8_LAS bf16x8*)(lds + PG8_SA(b, h) + aoff + m * 2048 + k * 1024); } while (0)
#define PG8_LDB(dst, b, h) do { _Pragma("unroll") for (int n = 0; n < 2; ++n) _Pragma("unroll") for (int k = 0; k < 2; ++k) dst[n][k] = *(const PG8_LAS bf16x8*)(lds + PG8_SB(b, h) + boff + n * 2048 + k * 1024); } while (0)
#define PG8_MMA(ai, bj, At, Bt) do { __builtin_amdgcn_s_setprio(1); _Pragma("unroll") for (int m = 0; m < 4; ++m) _Pragma("unroll") for (int n = 0; n < 2; ++n) _Pragma("unroll") for (int k = 0; k < 2; ++k) \
        acc[ai][bj][m][n] = __builtin_amdgcn_mfma_f32_16x16x32_bf16(Bt[n][k], At[m][k], acc[ai][bj][m][n], 0, 0, 0); __builtin_amdgcn_s_setprio(0); } while (0)
#define PG8_WAIT_V(n) asm volatile("s_waitcnt vmcnt(" #n ")" ::: "memory")
#define PG8_WAIT_L(n) asm volatile("s_waitcnt lgkmcnt(" #n ")" ::: "memory")
#define PG8_BAR __builtin_amdgcn_s_barrier()
#define PG8_SCHED __builtin_amdgcn_sched_barrier(0)
    Unit cur, nxt; int ui = 0;
    if (!S.next(0, cur)) return;
    f32x4 acc[2][2][4][2];
#pragma unroll
    for (int a = 0; a < 2; ++a)
#pragma unroll
        for (int b = 0; b < 2; ++b)
#pragma unroll
            for (int m = 0; m < 4; ++m)
#pragma unroll
                for (int n = 0; n < 2; ++n) acc[a][b][m][n] = (f32x4){0.f, 0.f, 0.f, 0.f};
    bf16x8 At[4][2], B0[2][2], B1[2][2];
    const char* cA = (const char*)g.A + (size_t)cur.rb * K * 2; const char* cB = (const char*)g.Bt + (size_t)cur.pn * tstep;
    S.a_ready(cur);
    if constexpr (SP2) {
        PG8_STAGE(PG8_SB(0, 0), cB, voffB); PG8_STAGE(PG8_SB(0, 1), cB + hstep, voffB); PG8_STAGE(PG8_SA(0, 0), cA, voffA); PG8_STAGE(PG8_SA(0, 1), cA + hstep, voffA);
        if (wr == 1) PG8_BAR;
        PG8_WAIT_V(2); PG8_BAR;
        PG8_STAGE(PG8_SB(1, 0), cB + kstep, voffB); PG8_STAGE(PG8_SA(1, 0), cA + kstep, voffA); PG8_STAGE(PG8_SB(1, 1), cB + hstep + kstep, voffB);
        PG8_WAIT_V(6); PG8_BAR;
    } else {
        PG8_STAGE(PG8_SB(0, 0), cB, voffB); PG8_STAGE(PG8_SA(0, 0), cA, voffA); PG8_STAGE(PG8_SB(0, 1), cB + hstep, voffB); PG8_STAGE(PG8_SA(0, 1), cA + hstep, voffA);
        if (wr == 1) PG8_BAR;
        PG8_WAIT_V(4); PG8_BAR;
        PG8_STAGE(PG8_SB(1, 0), cB + kstep, voffB); PG8_STAGE(PG8_SA(1, 0), cA + kstep, voffA); PG8_STAGE(PG8_SB(1, 1), cB + hstep + kstep, voffB);
        PG8_WAIT_V(6); PG8_BAR;
    }
    for (;;) {
        const bool has_next = S.next(ui + 1, nxt);
        const char* nA = has_next ? (const char*)g.A + (size_t)nxt.rb * K * 2 : cA; const char* nB = has_next ? (const char*)g.Bt + (size_t)nxt.pn * tstep : cB;
        for (int t = 0; t < nt; t += 2) {
            const bool last = (t == nt - 2);
            const char* a1 = cA + (size_t)(t + 1) * kstep;
            const char* a2 = last ? nA : cA + (size_t)(t + 2) * kstep; const char* b2 = last ? nB : cB + (size_t)(t + 2) * kstep;
            const char* a3 = a2 + kstep; const char* b3 = b2 + kstep;
            if (last && has_next) S.a_ready(nxt);
            if constexpr (SP2) {
            PG8_LDB(B0, 0, 0); PG8_LDB(B1, 0, 1); PG8_SCHED; PG8_LDA(At, 0, 0); PG8_STAGE(PG8_SA(1, 1), a1 + hstep, voffA);
            PG8_WAIT_V(8); PG8_WAIT_L(0); PG8_BAR; PG8_MMA(0, 0, At, B0); PG8_MMA(0, 1, At, B1); PG8_BAR; PG8_SCHED;
            PG8_LDA(At, 0, 1); PG8_STAGE(PG8_SB(0, 0), b2, voffB); PG8_STAGE(PG8_SB(0, 1), b2 + hstep, voffB); PG8_STAGE(PG8_SA(0, 0), a2, voffA);
            PG8_WAIT_V(8); PG8_WAIT_L(0); PG8_BAR; if (!cur.half) { PG8_MMA(1, 0, At, B0); PG8_MMA(1, 1, At, B1); } PG8_BAR; PG8_SCHED;
            PG8_LDB(B0, 1, 0); PG8_LDB(B1, 1, 1); PG8_SCHED; PG8_LDA(At, 1, 0); PG8_STAGE(PG8_SA(0, 1), a2 + hstep, voffA);
            PG8_WAIT_V(8); PG8_WAIT_L(0); PG8_BAR; PG8_MMA(0, 0, At, B0); PG8_MMA(0, 1, At, B1); PG8_BAR; PG8_SCHED;
            PG8_LDA(At, 1, 1); PG8_STAGE(PG8_SB(1, 0), b3, voffB); PG8_STAGE(PG8_SB(1, 1), b3 + hstep, voffB); PG8_STAGE(PG8_SA(1, 0), a3, voffA);
            PG8_WAIT_V(8); PG8_WAIT_L(0); PG8_BAR; if (!cur.half) { PG8_MMA(1, 0, At, B0); PG8_MMA(1, 1, At, B1); } PG8_BAR; PG8_SCHED;
            } else {
            PG8_LDB(B0, 0, 0); PG8_SCHED; PG8_LDA(At, 0, 0); PG8_STAGE(PG8_SA(1, 1), a1 + hstep, voffA);
            PG8_WAIT_L(8); PG8_BAR; PG8_WAIT_L(0); PG8_MMA(0, 0, At, B0); PG8_BAR; PG8_SCHED;
            PG8_LDB(B1, 0, 1); PG8_STAGE(PG8_SB(0, 0), b2, voffB);
            PG8_BAR; PG8_WAIT_L(0); PG8_MMA(0, 1, At, B1); PG8_BAR;
            PG8_LDA(At, 0, 1); PG8_STAGE(PG8_SA(0, 0), a2, voffA);
            PG8_BAR; PG8_WAIT_L(0); if (!cur.half) PG8_MMA(1, 0, At, B0); PG8_BAR; PG8_SCHED;
            PG8_STAGE(PG8_SB(0, 1), b2 + hstep, voffB);
            PG8_WAIT_V(6); PG8_BAR; if (!cur.half) PG8_MMA(1, 1, At, B1); PG8_BAR;
            PG8_LDB(B0, 1, 0); PG8_SCHED; PG8_LDA(At, 1, 0); PG8_STAGE(PG8_SA(0, 1), a2 + hstep, voffA);
            PG8_WAIT_L(8); PG8_BAR; PG8_WAIT_L(0); PG8_MMA(0, 0, At, B0); PG8_BAR; PG8_SCHED;
            PG8_LDB(B1, 1, 1); PG8_STAGE(PG8_SB(1, 0), b3, voffB);
            PG8_BAR; PG8_WAIT_L(0); PG8_MMA(0, 1, At, B1); PG8_BAR;
            PG8_LDA(At, 1, 1); PG8_STAGE(PG8_SA(1, 0), a3, voffA);
            PG8_BAR; PG8_WAIT_L(0); if (!cur.half) PG8_MMA(1, 0, At, B0); PG8_BAR; PG8_SCHED;
            PG8_STAGE(PG8_SB(1, 1), b3 + hstep, voffB);
            PG8_WAIT_V(6); PG8_BAR; if (!cur.half) PG8_MMA(1, 1, At, B1); PG8_BAR;
            }
        }
        if constexpr (ALIGN_EPI) { if (wr == 0) PG8_BAR; }
        if constexpr (!Epi::AFTER_DRAIN) { E(acc, cur, wr, wc, fr, fq); S.done(cur); }
        if (!has_next) break;
#pragma unroll
        for (int a = 0; a < 2; ++a)
#pragma unroll
            for (int b = 0; b < 2; ++b)
#pragma unroll
                for (int m = 0; m < 4; ++m)
#pragma unroll
                    for (int n = 0; n < 2; ++n) acc[a][b][m][n] = (f32x4){0.f, 0.f, 0.f, 0.f};
        cur = nxt; cA = nA; cB = nB; ++ui;
        if constexpr (ALIGN_EPI) { if (wr == 1) PG8_BAR; }
    }
    PG8_WAIT_V(0);
    if constexpr (!ALIGN_EPI) { if (wr == 0) PG8_BAR; }
    PG8_BAR;
    if constexpr (Epi::AFTER_DRAIN) { E.fused(acc, cur, wr, wc, fr, fq, lds, wid, lane); S.done(cur); }
#undef PG8_SA
#undef PG8_SB
#undef PG8_STAGE
#undef PG8_LDA
#undef PG8_LDB
#undef PG8_MMA
#undef PG8_WAIT_V
#undef PG8_WAIT_L
#undef PG8_BAR
#undef PG8_SCHED
}

template <class Epi, bool NARROW = false, bool SHORT = false>
__device__ __forceinline__ void mini_gemm(PG8_LAS unsigned char* lds, const bf16_t* A, const bf16_t* Bt, int K, int ntn, const Epi& E, int c, int G, int wave0, int row_base = 32768) {
    int tid_ = threadIdx.x; (void)wave0; asm volatile("" : "+v"(tid_));
    const int tid = tid_, wid = __builtin_amdgcn_readfirstlane(tid >> 6), lane = tid & 63, wr = wid >> 2, wc = wid & 3, fr = lane & 15, fq = lane >> 4;
    constexpr int LS = 136, BUFB = 2 * 128 * LS * 2;
    constexpr int NB = NARROW ? 2 : 4, TW = NARROW ? 64 : 128;
    constexpr int NA = SHORT ? 2 : 4, TH = SHORT ? 64 : 128, NTM = SHORT ? 16 : 8;
    const int lr = SHORT ? (tid >> 3) : (tid >> 2), lp = SHORT ? (tid & 7) * 2 : (tid & 3) * 4;
    const int lrb = NARROW ? (tid >> 3) : lr, lpb = NARROW ? (tid & 7) * 2 : lp;
    const bool active = (!NARROW || wc < 2) && (!SHORT || wr == 0);
    const int nst = K / 128;
#pragma unroll 1
    for (int t = c; t < NTM * ntn; t += G) {
        const int tm = t % NTM, tn = t / NTM;
        const bf16_t* ga = A + ((size_t)row_base + TH * tm + lr) * K + lp * 8;
        const bf16_t* gb = Bt + ((size_t)TW * tn + lrb) * K + lpb * 8;
        u32x4 ra[2][NA], rb[2][NB];
#pragma unroll
        for (int s2 = 0; s2 < 2; ++s2) {
#pragma unroll
            for (int j = 0; j < NA; ++j) ra[s2][j] = *(const u32x4*)(ga + 128 * s2 + 8 * j);
#pragma unroll
            for (int j = 0; j < NB; ++j) rb[s2][j] = *(const u32x4*)(gb + 128 * s2 + 8 * j); }
        f32x4 acc[4][2];
#pragma unroll
        for (int m = 0; m < 4; ++m)
#pragma unroll
            for (int n = 0; n < 2; ++n) acc[m][n] = (f32x4){0.f, 0.f, 0.f, 0.f};
#pragma unroll 1
        for (int st = 0; st < nst; st += 2) {
#pragma unroll
          for (int s2 = 0; s2 < 2; ++s2) {
            PG8_LAS bf16_t* As = (PG8_LAS bf16_t*)(lds + s2 * BUFB); PG8_LAS bf16_t* Bs = As + 128 * LS;
#pragma unroll
            for (int j = 0; j < NA; ++j) *(PG8_LAS u32x4*)(As + lr * LS + (lp + j) * 8) = ra[s2][j];
#pragma unroll
            for (int j = 0; j < NB; ++j) *(PG8_LAS u32x4*)(Bs + lrb * LS + (lpb + j) * 8) = rb[s2][j];
            __syncthreads();
            if (st + 2 < nst) {
#pragma unroll
                for (int j = 0; j < NA; ++j) ra[s2][j] = *(const u32x4*)(ga + 128 * (st + 2 + s2) + 8 * j);
#pragma unroll
                for (int j = 0; j < NB; ++j) rb[s2][j] = *(const u32x4*)(gb + 128 * (st + 2 + s2) + 8 * j); }
            if (active) {
#pragma unroll
            for (int kc = 0; kc < 4; ++kc) {
                bf16x8 af[4], bfr[2];
#pragma unroll
                for (int m = 0; m < 4; ++m) af[m] = *(const PG8_LAS bf16x8*)(As + (64 * wr + 16 * m + fr) * LS + 32 * kc + 8 * fq);
#pragma unroll
                for (int n = 0; n < 2; ++n) bfr[n] = *(const PG8_LAS bf16x8*)(Bs + (32 * wc + 8 * (fr >> 2) + 4 * n + (fr & 3)) * LS + 32 * kc + 8 * fq);
#pragma unroll
                for (int m = 0; m < 4; ++m)
#pragma unroll
                    for (int n = 0; n < 2; ++n) acc[m][n] = __builtin_amdgcn_mfma_f32_16x16x32_bf16(bfr[n], af[m], acc[m][n], 0, 0, 0);
            } }
          }
        }
        if (active) {
        f32x4 accf[2][2][4][2];
#pragma unroll
        for (int a = 0; a < 2; ++a)
#pragma unroll
            for (int bq = 0; bq < 2; ++bq)
#pragma unroll
                for (int m = 0; m < 4; ++m)
#pragma unroll
                    for (int n = 0; n < 2; ++n) accf[a][bq][m][n] = (a == 0 && bq == 0) ? acc[m][n] : (f32x4){0.f, 0.f, 0.f, 0.f};
        Unit u; u.pm = 128 + (TH * tm >> 8); u.cb = TW * tn; u.pn = u.cb >> 8; u.rb = row_base + TH * tm; u.half = 1; u.q = 1;
        E(accf, u, wr, wc, fr, fq);
        }
        __syncthreads();
    }
}
}

#define LAS __attribute__((address_space(3)))
typedef unsigned short bf16;
typedef unsigned v4u __attribute__((ext_vector_type(4)));
typedef unsigned v2u __attribute__((ext_vector_type(2)));
typedef float f32x4 __attribute__((ext_vector_type(4)));
typedef short bf16x8 __attribute__((ext_vector_type(8)));

constexpr int NTHR = 512, NWAVES = 8;
constexpr int MP = 32768, MS = 1024, MT = MP + MS;
constexpr int D = 1024, DFF = 2816;
constexpr int LDS_BYTES = 147456;
constexpr float EPS = 1e-6f;

enum { I_XP = 0, I_XS, I_CPOOL, I_CSK, I_CSV, I_CMK, I_CMV, I_CFC, I_MEMP, I_LNMIX, I_LNMEM, I_LNMEMKV, I_LNFFN, I_ABWIN, I_ABVG, I_ABWS, I_ABBS, I_ABPW, I_ABPS, I_ABWOUT,
       I_CWQKV, I_CQG, I_CKG, I_CSINK, I_CWO, I_MWQ, I_MWKV, I_MQG, I_MKG, I_MWO, I_FWUP, I_FCW, I_FCB, I_FWDN, N_IN };
constexpr size_t O_YP = 0, O_YS = O_YP + (size_t)MP * D, O_POOLP = O_YS + (size_t)MS * D, O_POOLS = O_POOLP + 4 * 15 * 512, O_CHV = O_POOLS + 128 * 15 * 512,
                 O_SKP = O_CHV + 128 * 8 * 512, O_SVP = O_SKP + 4 * 128 * 256, O_SKS = O_SVP + 4 * 128 * 256, O_SVS = O_SKS + (size_t)128 * 128 * 256,
                 O_MKP = O_SVS + (size_t)128 * 128 * 256, O_MVP = O_MKP + 2 * 4 * 256 * 512, O_FCP = O_MVP + 2 * 4 * 256 * 512, O_FCS = O_FCP + 2 * 4 * 2 * DFF,
                 O_END = O_FCS + (size_t)2 * 128 * 2 * DFF;
constexpr size_t MiB = 1u << 20;
constexpr size_t W_WIN = 0, W_WOUT = W_WIN + 1536 * 1024 * 2, W_WQKV = W_WOUT + 1024 * 1024 * 2, W_CWO = W_WQKV + 1536 * 1024 * 2, W_LAYER = W_CWO + 1024 * 1024 * 2;
constexpr size_t WL_WQ = 0, WL_WKV = WL_WQ + 512 * 1024 * 2, WL_WO = WL_WKV + 1024 * 1024 * 2, WL_WUP = WL_WO + 1024 * 512 * 2, WL_WDN = WL_WUP + (size_t)2 * DFF * 1024 * 2,
                 WL_SIZE = WL_WDN + (size_t)1024 * DFF * 2;
constexpr size_t W_MN = W_LAYER + 2 * WL_SIZE;
constexpr size_t W_MKV = W_MN + 2 * 1024 * 1024 * 2;
constexpr size_t W_SS = W_MKV + 2 * 1024 * 1024 * 4;
constexpr size_t W_SMALL_END = W_SS + (size_t)6 * MT * 4;
static_assert(W_SMALL_END <= 72 * MiB, "weights region");
constexpr size_t W_XN = 72 * MiB;
constexpr size_t W_G = 138 * MiB;
constexpr size_t W_PROJ = W_G;
constexpr size_t W_AO = W_PROJ + 99 * MiB;
constexpr size_t W_H = 320 * MiB;
constexpr size_t W_KV32 = W_H;
constexpr size_t W_MQ = W_KV32 + 66 * MiB;
constexpr size_t W_MO = W_MQ + 33 * MiB;
constexpr size_t W_END = 502 * MiB;
constexpr size_t W_CTL = 504 * MiB, CTL_BYTES = 65536, W_NEED = W_CTL + CTL_BYTES;
constexpr int LDS_CTL_OFF = LDS_BYTES - 64;
static_assert(W_XN + (size_t)MT * 1024 * 2 <= W_G && W_PROJ + (size_t)MT * 1536 * 2 <= W_AO && W_AO + (size_t)MT * 1024 * 2 <= W_H && W_G + (size_t)MT * DFF * 2 <= W_H, "ws map 1");
static_assert(W_KV32 + (size_t)MT * 512 * 4 <= W_MQ && W_MQ + (size_t)MT * 512 * 2 <= W_MO && W_MO + (size_t)MT * 512 * 2 <= W_END && W_H + (size_t)MT * DFF * 2 <= W_END, "ws map 2");

struct Params { const float* in[N_IN]; float* out; unsigned char* ws; };

__device__ __forceinline__ unsigned pk2(float lo, float hi) { return pg8::cvt_pk_bf16(lo, hi); }
__device__ __forceinline__ unsigned f2bf(float f) { return pg8::cvt_pk_bf16(f, 0.f) & 0xffffu; }
__device__ __forceinline__ float bflo(unsigned w) { return __builtin_bit_cast(float, w << 16); }
__device__ __forceinline__ float bfhi(unsigned w) { return __builtin_bit_cast(float, w & 0xffff0000u); }
__device__ __forceinline__ float bf1(bf16 h) { return __builtin_bit_cast(float, (unsigned)h << 16); }
__device__ __forceinline__ void unpack8(const v4u w, float (&o)[8]) { o[0] = bflo(w.x); o[1] = bfhi(w.x); o[2] = bflo(w.y); o[3] = bfhi(w.y); o[4] = bflo(w.z); o[5] = bfhi(w.z); o[6] = bflo(w.w); o[7] = bfhi(w.w); }
__device__ __forceinline__ bf16x8 pack8(const float (&o)[8]) { v4u w; w.x = pk2(o[0], o[1]); w.y = pk2(o[2], o[3]); w.z = pk2(o[4], o[5]); w.w = pk2(o[6], o[7]); return __builtin_bit_cast(bf16x8, w); }
typedef short v4i16_t __attribute__((ext_vector_type(4)));
__device__ __forceinline__ v2u vtr(const LAS bf16* p) { return __builtin_bit_cast(v2u, __builtin_amdgcn_ds_read_tr16_b64_v4i16((LAS v4i16_t*)p)); }
__device__ __forceinline__ float wave_sum(float v) {
#pragma unroll
    for (int o = 1; o < 64; o <<= 1) v += __shfl_xor(v, o);
    return v;
}
__device__ __forceinline__ float gelu1(float v) { const pg8::f32x2 r = pg8::gelu_pk((pg8::f32x2){v, 0.f}); return r.x; }
__device__ __forceinline__ void rope_cs(float pos, int e, float& c, float& s) {
    const float inv = exp2f(-(float)e * (0.125f * 18.931568569324174f));
    const float ang = pos * inv;
    const float k = rintf(ang * 0.15915494309189535f);
    float r = fmaf(-k, 6.28125f, ang);
    r = fmaf(-k, 0.0019353071795864769f, r);
    s = __sinf(r); c = __cosf(r);
}

#define XB_TMO      128
#define XB_XCNT(j)  (256  + 64 * (j))
#define XB_XSUB(j)  (1280 + 64 * (j))
#define XB_XGEN(j)  (2304 + 64 * (j))
#define XB_TOP      3328
#define XB_TOPGEN   3392
#define XCD_BAR_WORDS 3456
#define XB_SPIN_CAP (1u << 18)

__device__ __forceinline__ unsigned xb_ld(unsigned* p)              { return __hip_atomic_load(p, __ATOMIC_RELAXED, __HIP_MEMORY_SCOPE_AGENT); }
__device__ __forceinline__ unsigned xb_add(unsigned* p, unsigned v) { return __hip_atomic_fetch_add(p, v, __ATOMIC_RELAXED, __HIP_MEMORY_SCOPE_AGENT); }
__device__ __forceinline__ unsigned xb_xcc_id() { return (unsigned)__builtin_amdgcn_s_getreg((3 << 11) | 20) & 0xFu; }
#define XB_SPIN(cond, bar) do { unsigned _sp = 0; while (cond) { __builtin_amdgcn_s_sleep(1); \
    if ((++_sp & 255u) == 0u) { if (xb_ld(&(bar)[XB_TMO])) break; if (_sp > XB_SPIN_CAP) { atomicAdd(&(bar)[XB_TMO], 1u); break; } } } } while (0)

struct XcdBarrier {
    unsigned* bar; unsigned x; int w0;
    volatile LAS unsigned* st;
};

__device__ __forceinline__ XcdBarrier xcd_barrier_post(unsigned* bar, volatile LAS unsigned* st) {
    XcdBarrier b; b.bar = bar; b.x = xb_xcc_id(); b.st = st; b.w0 = __builtin_amdgcn_readfirstlane((int)threadIdx.x >> 6);
    if (threadIdx.x == 0) (void)xb_add(&bar[XB_XCNT(b.x)], 1u);
    return b;
}
__device__ __forceinline__ void xcd_barrier_complete(unsigned* bar, unsigned x, unsigned& nloc, unsigned& nx) {
    const unsigned G = gridDim.x * gridDim.y * gridDim.z;
    unsigned sum, cnt, mine, sp = 0u;
    for (;;) {
        sum = 0u; cnt = 0u; mine = 0u;
#pragma unroll
        for (unsigned j = 0; j < 16; ++j) { const unsigned c = xb_ld(&bar[XB_XCNT(j)]); sum += c; cnt += (c > 0u) ? 1u : 0u; mine = (j == x) ? c : mine; }
        if (sum == G) break;
        __builtin_amdgcn_s_sleep(1);
        if ((++sp & 255u) == 0u) { if (xb_ld(&bar[XB_TMO])) break; if (sp > XB_SPIN_CAP) { atomicAdd(&bar[XB_TMO], 1u); break; } }
    }
    nloc = mine > 0u ? mine : 1u; nx = cnt > 0u ? cnt : 1u;
}

__device__ __forceinline__ void xcd_barrier(const XcdBarrier& b) {
    asm volatile("s_waitcnt vmcnt(0)" ::: "memory");
    __syncthreads();
    if (threadIdx.x == 0) {
        unsigned* bar = b.bar;
        __builtin_amdgcn_s_waitcnt(0);
        unsigned nloc = b.st[0], nx = b.st[1];
        if (nloc == 0u) { xcd_barrier_complete(bar, b.x, nloc, nx); b.st[0] = nloc; b.st[1] = nx; }
        const unsigned old = xb_add(&bar[XB_XSUB(b.x)], 1u);
        const unsigned gen = old / nloc;
        if (old + 1u == (gen + 1u) * nloc) {
            __builtin_amdgcn_fence(__ATOMIC_RELEASE, "agent");
            asm volatile("s_waitcnt vmcnt(0)" ::: "memory");
            const unsigned og = xb_add(&bar[XB_TOP], 1u);
            const unsigned tg = og / nx;
            if (og + 1u == (tg + 1u) * nx) xb_add(&bar[XB_TOPGEN], 1u);
            else XB_SPIN(xb_ld(&bar[XB_TOPGEN]) == tg, bar);
            __builtin_amdgcn_fence(__ATOMIC_ACQUIRE, "agent");
            xb_add(&bar[XB_XGEN(b.x)], 1u);
            asm volatile("s_waitcnt vmcnt(0)" ::: "memory");
        } else {
            XB_SPIN(xb_ld(&bar[XB_XGEN(b.x)]) == gen, bar);
            __builtin_amdgcn_fence(__ATOMIC_ACQUIRE, "agent");
            asm volatile("s_waitcnt vmcnt(0)" ::: "memory");
        }
    }
    __syncthreads();
}

__device__ __forceinline__ void transpose_item(const float* W, const float* gain, int ldn, int nblk, bf16* WT, int ldk, int koff, LAS float* scr, int item, int lane) {
    const int kb = item / nblk, nb = item % nblk, k0 = 64 * kb, n0 = 32 * nb;
    float wv[32];
#pragma unroll
    for (int i = 0; i < 32; ++i) wv[i] = __builtin_nontemporal_load(W + (size_t)(k0 + 2 * i + (lane >> 5)) * ldn + n0 + (lane & 31));
    if (gain) {
#pragma unroll
        for (int i = 0; i < 32; ++i) wv[i] *= gain[k0 + 2 * i + (lane >> 5)]; }
#pragma unroll
    for (int i = 0; i < 32; ++i) scr[(2 * i + (lane >> 5)) * 33 + (lane & 31)] = wv[i];
    asm volatile("s_waitcnt lgkmcnt(0)" ::: "memory");
    const int c = lane & 7;
#pragma unroll
    for (int j = 0; j < 4; ++j) { const int n = (lane >> 3) + 8 * j; const LAS float* s = scr + (8 * c) * 33 + n;
        v4u o; o.x = pk2(s[0 * 33], s[1 * 33]); o.y = pk2(s[2 * 33], s[3 * 33]); o.z = pk2(s[4 * 33], s[5 * 33]); o.w = pk2(s[6 * 33], s[7 * 33]);
        *(v4u*)(WT + (size_t)(n0 + n) * ldk + koff + k0 + 8 * c) = o; }
    asm volatile("s_waitcnt lgkmcnt(0)" ::: "memory");
}
__device__ __forceinline__ void rms_row(const float* xrow, const float* g, bf16* orow, int lane) {
    const f32x4* xr = (const f32x4*)xrow + lane; const f32x4* gr = (const f32x4*)g + lane;
    f32x4 v[4]; float s = 0.f;
#pragma unroll
    for (int j = 0; j < 4; ++j) { v[j] = xr[64 * j]; s += (v[j].x * v[j].x + v[j].y * v[j].y) + (v[j].z * v[j].z + v[j].w * v[j].w); }
    const float rs = rsqrtf(wave_sum(s) * (1.f / 1024.f) + EPS);
    unsigned long long* o8 = (unsigned long long*)orow + lane;
#pragma unroll
    for (int j = 0; j < 4; ++j) { const f32x4 gg = gr[64 * j];
        o8[64 * j] = (unsigned long long)pk2(v[j].x * rs * gg.x, v[j].y * rs * gg.y) | ((unsigned long long)pk2(v[j].z * rs * gg.z, v[j].w * rs * gg.w) << 32); }
}
__device__ __forceinline__ void xb_row(const float* xrow, bf16* orow, float* ss, int lane) {
    const f32x4* xr = (const f32x4*)xrow + lane;
    f32x4 v[4]; float s = 0.f;
#pragma unroll
    for (int j = 0; j < 4; ++j) { v[j] = xr[64 * j]; s += (v[j].x * v[j].x + v[j].y * v[j].y) + (v[j].z * v[j].z + v[j].w * v[j].w); }
    s = wave_sum(s);
    unsigned long long* o8 = (unsigned long long*)orow + lane;
#pragma unroll
    for (int j = 0; j < 4; ++j) o8[64 * j] = (unsigned long long)pk2(v[j].x, v[j].y) | ((unsigned long long)pk2(v[j].z, v[j].w) << 32);
    if (lane == 0) *ss = s;
}

struct TItem { const float* W; int ldn, nblk, nitems; bf16* WT; int ldk, koff; };

__device__ __forceinline__ void prologue(const Params& p, LAS unsigned char* lds, int gw, int ngw, int wave, int lane) {
    unsigned char* ws = p.ws;
    LAS float* scr = (LAS float*)(lds + wave * 16384);
#define TR(Wp, gn_, K_, N_, ldn_, dst_, ldk_, koff_) do { const int nblk_ = (N_) / 32, nit_ = ((K_) / 64) * nblk_; \
        for (int it = gw; it < nit_; it += ngw) transpose_item((Wp), (gn_), (ldn_), nblk_, (bf16*)(dst_), (ldk_), (koff_), scr, it, lane); } while (0)
    const float* nog = nullptr;
    TR(p.in[I_ABWIN], p.in[I_LNMIX], 1024, 1536, 1536, ws + W_WIN, 1024, 0);
    TR(p.in[I_ABWOUT], nog, 512, 1024, 1024, ws + W_WOUT, 1024, 0);
    TR(p.in[I_CWQKV], p.in[I_LNMIX] + D, 1024, 1536, 1536, ws + W_WQKV, 1024, 0);
    TR(p.in[I_CWO], nog, 1024, 1024, 1024, ws + W_CWO, 1024, 0);
#pragma unroll 1
    for (int l = 0; l < 2; ++l) {
        unsigned char* wl = ws + W_LAYER + l * WL_SIZE;
        TR(p.in[I_MWQ] + (size_t)l * 1024 * 512, p.in[I_LNMEM] + l * D, 1024, 512, 512, wl + WL_WQ, 1024, 0);
        TR(p.in[I_MWKV] + (size_t)l * 1024 * 1024, nog, 1024, 1024, 1024, wl + WL_WKV, 1024, 0);
        TR(p.in[I_MWO] + (size_t)l * 512 * 1024, nog, 512, 1024, 1024, wl + WL_WO, 512, 0);
        TR(p.in[I_FWUP] + (size_t)l * 1024 * 2 * DFF, p.in[I_LNFFN] + l * D, 1024, 2 * DFF, 2 * DFF, wl + WL_WUP, 1024, 0);
        TR(p.in[I_FWDN] + (size_t)l * DFF * 1024, nog, DFF, 1024, 1024, wl + WL_WDN, DFF, 0);
    }
#undef TR
    {
        const float* pw = p.in[I_ABPW]; const float* ps = p.in[I_ABPS]; const float* wo = p.in[I_ABWOUT] + (size_t)512 * 1024;
        bf16* WT = (bf16*)(ws + W_WOUT);
        const int gt = gw * 64 + lane, ngt = ngw * 64;
        for (int o = gt; o < 128 * 1024; o += ngt) {
            const int n = o & 1023, d = o >> 10;
            float a[4] = {0.f, 0.f, 0.f, 0.f};
#pragma unroll 4
            for (int e = 0; e < 128; ++e) {
#pragma unroll
                for (int g = 0; g < 4; ++g) a[g] += pw[((size_t)g * 128 + d) * 128 + e] * ps[g * 128 + e] * wo[((size_t)g * 128 + e) * 1024 + n]; }
#pragma unroll
            for (int g = 0; g < 4; ++g) WT[(size_t)n * 1024 + 512 + g * 128 + d] = (bf16)f2bf(a[g]); }
    }
    for (int m0 = gw * 4; m0 < MT; m0 += ngw * 4) {
        f32x4 v[4][4];
#pragma unroll
        for (int r = 0; r < 4; ++r) { const int m = m0 + r; const f32x4* xr = (const f32x4*)(m < MP ? p.in[I_XP] + (size_t)m * D : p.in[I_XS] + (size_t)(m - MP) * D) + lane;
#pragma unroll
            for (int j = 0; j < 4; ++j) v[r][j] = __builtin_nontemporal_load(xr + 64 * j); }
#pragma unroll
        for (int r = 0; r < 4; ++r) { const int m = m0 + r; float sq = 0.f;
#pragma unroll
            for (int j = 0; j < 4; ++j) sq += (v[r][j].x * v[r][j].x + v[r][j].y * v[r][j].y) + (v[r][j].z * v[r][j].z + v[r][j].w * v[r][j].w);
            sq = wave_sum(sq);
            unsigned long long* o8 = (unsigned long long*)((bf16*)(ws + W_XN) + (size_t)m * D) + lane;
#pragma unroll
            for (int j = 0; j < 4; ++j) o8[64 * j] = (unsigned long long)pk2(v[r][j].x, v[r][j].y) | ((unsigned long long)pk2(v[r][j].z, v[r][j].w) << 32);
            if (lane == 0) ((float*)(ws + W_SS))[m] = sq; }
    }
    for (int o = gw * 64 + lane; o < 5 * MT; o += ngw * 64) ((float*)(ws + W_SS))[MT + o] = 0.f;
    for (int m = gw; m < 2048; m += ngw) { const int l = m >> 10, r = m & 1023;
        rms_row(p.in[I_MEMP] + (size_t)r * D, p.in[I_LNMEMKV] + l * D, (bf16*)(ws + W_MN) + (size_t)m * D, lane); }
}

constexpr int SG_VS = 520;
template <int W> __device__ __forceinline__ void pool_block(const float (&prev)[16], const float (&cur)[16], float (&o)[16], int t0, bool clampcnt) {
#pragma unroll
    for (int k = 0; k < 16; ++k) { float s = 0.f;
#pragma unroll
        for (int kk = 0; kk < W; ++kk) s += (k - kk >= 0) ? cur[(k - kk) & 15] : prev[(16 + k - kk) & 15];
        float inv = 1.f / (float)W;
        if (clampcnt) { const int t1 = t0 + k + 1; if (t1 < W) inv = __builtin_amdgcn_rcpf((float)t1); }
        o[k] = s * inv - cur[k]; }
}
__device__ __forceinline__ void pool_dispatch(int gi, const float (&prev)[16], const float (&cur)[16], float (&o)[16], int t0, bool clampcnt) {
    if (gi == 0) pool_block<2>(prev, cur, o, t0, clampcnt); else if (gi == 1) pool_block<4>(prev, cur, o, t0, clampcnt);
    else if (gi == 2) pool_block<8>(prev, cur, o, t0, clampcnt); else pool_block<16>(prev, cur, o, t0, clampcnt);
}

__device__ __forceinline__ void sgu_prompt_unit(const Params& p, LAS unsigned char* lds, int unit, int tid, int wave, int lane) {
    const bf16* PROJ = (const bf16*)(p.ws + W_PROJ); bf16* AO = (bf16*)(p.ws + W_AO);
    LAS bf16* Vn = (LAS bf16*)lds;
    const int b = unit >> 6, ch = unit & 63; const size_t r0 = (size_t)b * 8192 + ch * 128;
    {
        float gn[8]; pg8::ld8f(p.in[I_ABVG] + 8 * lane, gn);
        v4u raw[16];
#pragma unroll
        for (int jj = 0; jj < 16; ++jj) raw[jj] = *(const v4u*)(PROJ + (r0 + wave + 8 * jj) * 1536 + 512 + 8 * lane);
#pragma unroll
        for (int jj = 0; jj < 16; ++jj) { const int j = wave + 8 * jj;
            float x[8]; unpack8(raw[jj], x);
            float s = 0.f;
#pragma unroll
            for (int e = 0; e < 8; ++e) s += x[e];
            const float mean = wave_sum(s) * (1.f / 512.f); float q = 0.f;
#pragma unroll
            for (int e = 0; e < 8; ++e) { x[e] -= mean; q += x[e] * x[e]; }
            const float rstd = rsqrtf(wave_sum(q) * (1.f / 512.f) + EPS);
#pragma unroll
            for (int e = 0; e < 8; ++e) x[e] *= rstd * gn[e];
            *(LAS bf16x8*)(Vn + j * SG_VS + 8 * lane) = pack8(x); }
    }
    __syncthreads();
    {
        const int q16 = lane & 15, kq = lane >> 4, nch = (wave >> 1) + 1; int i = 16 * wave + q16;
#pragma unroll 1
        for (int g = 0; g < 4; ++g) {
            asm volatile("" : "+v"(i));
            f32x4 acc[8];
#pragma unroll
            for (int dt = 0; dt < 8; ++dt) acc[dt] = (f32x4){0.f, 0.f, 0.f, 0.f};
            const float* wsr = p.in[I_ABWS] + ((size_t)g * 128 + i) * 128;
            float wva[4][8]; v2u uu8[8];
#pragma unroll
            for (int c = 0; c < 4; ++c) pg8::ld8f(wsr + 32 * c + 8 * kq, wva[c]);
#pragma unroll
            for (int dt = 0; dt < 8; ++dt) uu8[dt] = *(const v2u*)(PROJ + (r0 + i) * 1536 + g * 128 + 16 * dt + 4 * kq);
#pragma unroll
            for (int c = 0; c < 4; ++c) if (c < nch) {
                float (&wv)[8] = wva[c];
#pragma unroll
                for (int e = 0; e < 8; ++e) if (32 * c + 8 * kq + e > i) wv[e] = 0.f;
                const bf16x8 bfrag = pack8(wv);
#pragma unroll
                for (int dt = 0; dt < 8; ++dt) { const LAS bf16* vp = Vn + (32 * c + 8 * kq + (q16 >> 2)) * SG_VS + g * 128 + 16 * dt + 4 * (q16 & 3);
                    const v2u lo = vtr(vp), hi = vtr(vp + 4 * SG_VS);
                    v4u av; av.x = lo.x; av.y = lo.y; av.z = hi.x; av.w = hi.y;
                    acc[dt] = __builtin_amdgcn_mfma_f32_16x16x32_bf16(__builtin_bit_cast(bf16x8, av), bfrag, acc[dt], 0, 0, 0); }
            }
            const float bs = p.in[I_ABBS][g * 128 + i];
#pragma unroll
            for (int dt = 0; dt < 8; ++dt) { const v2u uu = uu8[dt];
                const float o0 = bflo(uu.x) * (acc[dt][0] + bs), o1 = bfhi(uu.x) * (acc[dt][1] + bs), o2 = bflo(uu.y) * (acc[dt][2] + bs), o3 = bfhi(uu.y) * (acc[dt][3] + bs);
                v2u w; w.x = pk2(o0, o1); w.y = pk2(o2, o3);
                *(v2u*)(AO + (r0 + i) * 1024 + g * 128 + 16 * dt + 4 * kq) = w; }
        }
    }
    {
        const int c = tid, gi = c >> 7;
        const bf16* pp = PROJ + 1024 + c;
        float prev[16], cur[16], o[16];
#pragma unroll
        for (int k = 0; k < 16; ++k) prev[k] = (ch > 0) ? bf1(pp[(r0 - 16 + k) * 1536]) : 0.f;
        bf16 nxt[16];
#pragma unroll
        for (int k = 0; k < 16; ++k) nxt[k] = pp[(r0 + k) * 1536];
#pragma unroll 1
        for (int blk = 0; blk < 8; ++blk) {
#pragma unroll
            for (int k = 0; k < 16; ++k) cur[k] = bf1(nxt[k]);
            if (blk < 7) {
#pragma unroll
                for (int k = 0; k < 16; ++k) nxt[k] = pp[(r0 + 16 * (blk + 1) + k) * 1536]; }
            pool_dispatch(gi, prev, cur, o, ch * 128 + 16 * blk, ch == 0 && blk == 0);
#pragma unroll
            for (int k = 0; k < 16; ++k) AO[(r0 + 16 * blk + k) * 1024 + 512 + c] = (bf16)f2bf(o[k]);
            if (ch == 63 && blk == 7) {
#pragma unroll
                for (int k = 1; k < 16; ++k) p.out[O_POOLP + ((size_t)b * 15 + (k - 1)) * 512 + c] = cur[k]; }
#pragma unroll
            for (int k = 0; k < 16; ++k) prev[k] = cur[k];
        }
    }
    __syncthreads();
}

__device__ __forceinline__ void sgu_sample_unit(const Params& p, LAS unsigned char* lds, int b, int tid, int wave, int lane) {
    const bf16* PROJ = (const bf16*)(p.ws + W_PROJ); bf16* AO = (bf16*)(p.ws + W_AO);
    LAS float* red = (LAS float*)lds;
    const int c = tid, g = c >> 7; const size_t rs = (size_t)MP + 8 * b;
    float x[8], st[16];
#pragma unroll
    for (int j = 0; j < 8; ++j) { x[j] = bf1(PROJ[(rs + j) * 1536 + 512 + c]); st[j] = wave_sum(x[j]); st[8 + j] = wave_sum(x[j] * x[j]); }
    if (lane == 0) {
#pragma unroll
        for (int j = 0; j < 16; ++j) red[wave * 16 + j] = st[j]; }
    __syncthreads();
    float v[8]; const float gn = p.in[I_ABVG][c];
#pragma unroll
    for (int j = 0; j < 8; ++j) { float s = 0.f, q = 0.f;
#pragma unroll
        for (int w = 0; w < 8; ++w) { s += red[w * 16 + j]; q += red[w * 16 + 8 + j]; }
        const float mean = s * (1.f / 512.f), var = fmaxf(q * (1.f / 512.f) - mean * mean, 0.f);
        v[j] = (x[j] - mean) * rsqrtf(var + EPS) * gn;
        p.out[O_CHV + ((size_t)b * 8 + j) * 512 + c] = v[j]; }
    const float* wsg = p.in[I_ABWS] + (size_t)g * 128 * 128;
#pragma unroll
    for (int i = 0; i < 8; ++i) { float sg = p.in[I_ABBS][g * 128 + i];
#pragma unroll
        for (int j = 0; j < 8; ++j) if (j <= i) sg += wsg[i * 128 + j] * v[j];
        AO[(rs + i) * 1024 + c] = (bf16)f2bf(bf1(PROJ[(rs + i) * 1536 + c]) * sg); }
    float pe[24];
    pe[0] = 0.f;
#pragma unroll
    for (int k = 0; k < 15; ++k) pe[1 + k] = p.in[I_CPOOL][((size_t)b * 15 + k) * 512 + c];
#pragma unroll
    for (int i = 0; i < 8; ++i) pe[16 + i] = bf1(PROJ[(rs + i) * 1536 + 1024 + c]);
    const int W = 2 << g; const float invW = __builtin_amdgcn_rcpf((float)W);
#pragma unroll
    for (int i = 0; i < 8; ++i) { float s = 0.f;
#pragma unroll
        for (int kk = 0; kk < 16; ++kk) if (kk < W) s += pe[16 + i - kk];
        AO[(rs + i) * 1024 + 512 + c] = (bf16)f2bf(s * invW - pe[16 + i]); }
#pragma unroll
    for (int k = 0; k < 15; ++k) p.out[O_POOLS + ((size_t)b * 15 + k) * 512 + c] = pe[9 + k];
    __syncthreads();
}

constexpr int SWA_KS = 72, SWA_VS = 72, SWA_VOFF = 256 * SWA_KS * 2;
template <bool SAMPLE>
__device__ __forceinline__ void swa_unit(const Params& p, LAS unsigned char* lds, int unit, int tid, int wave, int lane) {
    const bf16* Q = (const bf16*)(p.ws + W_PROJ); const float* KV = (const float*)(p.ws + W_KV32); bf16* AO = (bf16*)(p.ws + W_AO);
    LAS bf16* Kl = (LAS bf16*)lds; LAS bf16* Vt = (LAS bf16*)(lds + SWA_VOFF);
    int b, kvh, nb;
    if (!SAMPLE) { nb = unit & 63; kvh = (unit >> 6) & 3; b = unit >> 8; } else { kvh = unit & 3; b = unit >> 2; nb = 0; }
    constexpr int NKEY = SAMPLE ? 160 : 256;
    {
        const int sub = tid & 7;
        float kg[8]; pg8::ld8f(p.in[I_CKG] + 8 * sub, kg);
        constexpr int NIT = SAMPLE ? 3 : 4;
        float kk[NIT][8], vv[NIT][8];
#pragma unroll
        for (int it = 0; it < NIT; ++it) { const int s = (tid >> 3) + 64 * it;
            const float* kp = nullptr; const float* vp = nullptr;
            if (!SAMPLE) { const int trel = (nb - 1) * 128 + s;
                if (trel >= 0) { kp = KV + ((size_t)b * 8192 + trel) * 512 + kvh * 64 + sub * 8; vp = kp + 256; } }
            else { if (s < 128) { const size_t o = (((size_t)b * 128 + s) * 4 + kvh) * 64 + sub * 8; kp = p.in[I_CSK] + o; vp = p.in[I_CSV] + o; }
                else if (s < 136) { kp = KV + ((size_t)MP + 8 * b + (s - 128)) * 512 + kvh * 64 + sub * 8; vp = kp + 256; } }
            if (kp) { if (SAMPLE) { pg8::ld8f_nt(kp, kk[it]); pg8::ld8f_nt(vp, vv[it]); } else { pg8::ld8f(kp, kk[it]); pg8::ld8f(vp, vv[it]); } } else { pg8::zero8(kk[it]); pg8::zero8(vv[it]); } }
#pragma unroll
        for (int it = 0; it < NIT; ++it) { const int s = (tid >> 3) + 64 * it;
            __builtin_amdgcn_sched_barrier(0);
            if (s < NKEY) {
            bool norm; float pos;
            if (!SAMPLE) { const int trel = (nb - 1) * 128 + s; norm = trel >= 0; pos = (float)trel; }
            else { norm = (s >= 128 && s < 136); pos = (float)(16384 + s - 128); }
            float (&k)[8] = kk[it]; float (&v)[8] = vv[it];
            asm volatile("" : "+v"(pos));
            if (norm) { float ss = 0.f;
#pragma unroll
                for (int e = 0; e < 8; ++e) ss += k[e] * k[e];
                ss += __shfl_xor(ss, 1); ss += __shfl_xor(ss, 2); ss += __shfl_xor(ss, 4);
                const float rs = rsqrtf(ss * (1.f / 64.f) + EPS);
#pragma unroll
                for (int e = 0; e < 8; ++e) k[e] *= rs * kg[e];
#pragma unroll
                for (int e = 0; e < 8; ++e) { const float pk = __shfl_xor(k[e], 1); float cs, sn; rope_cs(pos, e, cs, sn);
                    if (sub == 0) k[e] = k[e] * cs - pk * sn; else if (sub == 1) k[e] = k[e] * cs + pk * sn; }
            }
            *(LAS bf16x8*)(Kl + s * SWA_KS + sub * 8) = pack8(k);
            *(LAS bf16x8*)(Vt + s * SWA_VS + sub * 8) = pack8(v);
            if (!SAMPLE) { if (nb == 63 && s >= 128) { const size_t o = (((size_t)b * 128 + (s - 128)) * 4 + kvh) * 64 + sub * 8;
                    *(f32x4*)(p.out + O_SKP + o) = (f32x4){k[0], k[1], k[2], k[3]}; *(f32x4*)(p.out + O_SKP + o + 4) = (f32x4){k[4], k[5], k[6], k[7]};
                    *(f32x4*)(p.out + O_SVP + o) = (f32x4){v[0], v[1], v[2], v[3]}; *(f32x4*)(p.out + O_SVP + o + 4) = (f32x4){v[4], v[5], v[6], v[7]}; } }
            else { if (s >= 8 && s < 136) { const size_t o = (((size_t)b * 128 + (s - 8)) * 4 + kvh) * 64 + sub * 8;
                    __builtin_nontemporal_store((f32x4){k[0], k[1], k[2], k[3]}, (f32x4*)(p.out + O_SKS + o)); __builtin_nontemporal_store((f32x4){k[4], k[5], k[6], k[7]}, (f32x4*)(p.out + O_SKS + o + 4));
                    __builtin_nontemporal_store((f32x4){v[0], v[1], v[2], v[3]}, (f32x4*)(p.out + O_SVS + o)); __builtin_nontemporal_store((f32x4){v[4], v[5], v[6], v[7]}, (f32x4*)(p.out + O_SVS + o + 4)); } }
            }
        }
    }
    __syncthreads();
    constexpr int NPASS = SAMPLE ? 1 : 4;
    if (!SAMPLE || wave < 2) {
        asm volatile("" : "+v"(lane));
        float rc[8], rsn[8];
        { const int q16 = lane & 15; const float pos0 = SAMPLE ? (float)(16384 + (q16 & 7)) : (float)(nb * 128 + 16 * wave + q16);
#pragma unroll
          for (int e = 0; e < 8; ++e) rope_cs(pos0, e, rc[e], rsn[e]); }
        float qgs[2][8];
        {
#pragma unroll
          for (int dc = 0; dc < 2; ++dc) { pg8::ld8f(p.in[I_CQG] + 32 * dc + 8 * (lane >> 4), qgs[dc]);
#pragma unroll
            for (int e = 0; e < 8; ++e) qgs[dc][e] *= 0.125f; } }
        v4u qraw[2];
        { const int q16 = lane & 15, kq = lane >> 4;
          const size_t row0 = SAMPLE ? (size_t)MP + 8 * b + (q16 & 7) : (size_t)b * 8192 + nb * 128 + 16 * wave + q16;
          const int h0 = kvh * 4 + (SAMPLE ? 2 * wave + (q16 >> 3) : 0);
#pragma unroll
          for (int dc = 0; dc < 2; ++dc) qraw[dc] = *(const v4u*)(Q + row0 * 1024 + h0 * 64 + 32 * dc + 8 * kq); }
#pragma unroll 1
        for (int ps = 0; ps < NPASS; ++ps) {
            int q16 = lane & 15, kq = lane >> 4; asm volatile("" : "+v"(q16), "+v"(kq));
            int g, i, c0; size_t row; float pos;
            if (!SAMPLE) { g = ps; i = 16 * wave + q16; row = (size_t)b * 8192 + nb * 128 + i; pos = (float)(nb * 128 + i); c0 = wave >> 1; }
            else { g = 2 * wave + (q16 >> 3); i = q16 & 7; row = (size_t)MP + 8 * b + i; pos = (float)(16384 + i); c0 = 0; }
            const int h = kvh * 4 + g;
            float qv[2][8];
#pragma unroll
            for (int dc = 0; dc < 2; ++dc) unpack8(qraw[dc], qv[dc]);
            if (!SAMPLE && ps + 1 < NPASS) {
#pragma unroll
                for (int dc = 0; dc < 2; ++dc) qraw[dc] = *(const v4u*)(Q + row * 1024 + (h + 1) * 64 + 32 * dc + 8 * kq); }
            float ss = 0.f;
#pragma unroll
            for (int dc = 0; dc < 2; ++dc)
#pragma unroll
                for (int e = 0; e < 8; ++e) ss += qv[dc][e] * qv[dc][e];
            ss += __shfl_xor(ss, 16); ss += __shfl_xor(ss, 32);
            const float rs = rsqrtf(ss * (1.f / 64.f) + EPS);
#pragma unroll
            for (int dc = 0; dc < 2; ++dc) {
#pragma unroll
                for (int e = 0; e < 8; ++e) qv[dc][e] *= rs * qgs[dc][e]; }
#pragma unroll
            for (int e = 0; e < 8; ++e) { const float pk = __shfl_xor(qv[0][e], 16); const float cs = rc[e], sn = rsn[e];
                if (kq == 0) qv[0][e] = qv[0][e] * cs - pk * sn; else if (kq == 1) qv[0][e] = qv[0][e] * cs + pk * sn; }
            bf16x8 qf[2];
#pragma unroll
            for (int dc = 0; dc < 2; ++dc) qf[dc] = pack8(qv[dc]);
            f32x4 S[5][2];
            const float sink = p.in[I_CSINK][h];
            float mx = sink;
#pragma unroll
            for (int cc = 0; cc < 5; ++cc)
#pragma unroll
                for (int tt = 0; tt < 2; ++tt) { const int kb = 32 * (c0 + cc) + 16 * tt; f32x4 a = (f32x4){0.f, 0.f, 0.f, 0.f};
#pragma unroll
                    for (int dc = 0; dc < 2; ++dc) { const bf16x8 kf = *(const LAS bf16x8*)(Kl + (kb + q16) * SWA_KS + 32 * dc + 8 * kq);
                        a = __builtin_amdgcn_mfma_f32_16x16x32_bf16(kf, qf[dc], a, 0, 0, 0); }
                    const int rel = (kb >> 4) - wave;
                    const bool full = !SAMPLE && rel >= 1 && rel <= 7 && (nb > 0 || kb >= 128);
                    if (!full) {
#pragma unroll
                        for (int e = 0; e < 4; ++e) { const int s = kb + 4 * kq + e; const bool ok = (s > i) && (s <= i + 128) && (SAMPLE || nb > 0 || s >= 128);
                            a[e] = ok ? a[e] : -INFINITY; } }
#pragma unroll
                    for (int e = 0; e < 4; ++e) mx = fmaxf(mx, a[e]);
                    S[cc][tt] = a; }
            mx = fmaxf(mx, __shfl_xor(mx, 16)); mx = fmaxf(mx, __shfl_xor(mx, 32));
            float den = 0.f;
#pragma unroll
            for (int cc = 0; cc < 5; ++cc)
#pragma unroll
                for (int tt = 0; tt < 2; ++tt)
#pragma unroll
                    for (int e = 0; e < 4; ++e) { const float pe = __expf(S[cc][tt][e] - mx); S[cc][tt][e] = pe; den += pe; }
            den += __shfl_xor(den, 16); den += __shfl_xor(den, 32);
            den += __expf(sink - mx);
            const float rden = 1.f / den;
            bf16x8 pf[5];
#pragma unroll
            for (int cc = 0; cc < 5; ++cc) { float t8[8];
#pragma unroll
                for (int e = 0; e < 4; ++e) { t8[e] = S[cc][0][e]; t8[4 + e] = S[cc][1][e]; }
                pf[cc] = pack8(t8); }
#pragma unroll
            for (int dt = 0; dt < 4; ++dt) { f32x4 o = (f32x4){0.f, 0.f, 0.f, 0.f};
#pragma unroll
                for (int cc = 0; cc < 5; ++cc) { const LAS bf16* vp = Vt + (32 * (c0 + cc) + 4 * kq + (q16 >> 2)) * SWA_VS + 16 * dt + 4 * (q16 & 3);
                    const v2u lo = vtr(vp), hi = vtr(vp + 16 * SWA_VS);
                    v4u av; av.x = lo.x; av.y = lo.y; av.z = hi.x; av.w = hi.y;
                    o = __builtin_amdgcn_mfma_f32_16x16x32_bf16(__builtin_bit_cast(bf16x8, av), pf[cc], o, 0, 0, 0); }
                v2u w; w.x = pk2(o[0] * rden, o[1] * rden); w.y = pk2(o[2] * rden, o[3] * rden);
                *(v2u*)(AO + row * 1024 + h * 64 + 16 * dt + 4 * kq) = w; }
        }
    }
    __syncthreads();
}

constexpr int MEM_KS = 136, MEM_VS = 136, MEM_VOFF = 256 * MEM_KS * 2;
static_assert(MEM_VOFF + 256 * MEM_VS * 2 <= LDS_CTL_OFF && 128 * SG_VS * 2 <= LDS_CTL_OFF, "LDS");
template <bool SAMPLE>
__device__ __forceinline__ void mem_unit(const Params& p, int l, LAS unsigned char* lds, int unit, int tid, int wave, int lane) {
    const bf16* MQ = (const bf16*)(p.ws + W_MQ); bf16* MO = (bf16*)(p.ws + W_MO);
    LAS bf16* Kl = (LAS bf16*)lds; LAS bf16* Vt = (LAS bf16*)(lds + MEM_VOFF);
    int b, h, qt;
    if (!SAMPLE) { qt = unit & 15; h = (unit >> 4) & 3; b = unit >> 6; } else { h = unit & 3; b = unit >> 2; qt = 0; }
    {
        const int sub = tid & 15;
        float kg[8]; pg8::ld8f(p.in[I_MKG] + l * 128 + 8 * sub, kg);
#pragma unroll 1
        for (int hb = 0; hb < 2; ++hb) {
            float kk[4][8], vv[4][8];
#pragma unroll
            for (int it = 0; it < 4; ++it) { const int s = (tid >> 4) + 32 * (4 * hb + it);
                const float* kp; const float* vp;
                if (!SAMPLE) { kp = (const float*)(p.ws + W_MKV) + ((size_t)l * 1024 + b * 256 + s) * 1024 + h * 128 + sub * 8; vp = kp + 512; }
                else { const size_t o = ((((size_t)l * 128 + b) * 256 + s) * 4 + h) * 128 + sub * 8; kp = p.in[I_CMK] + o; vp = p.in[I_CMV] + o; }
                if (SAMPLE) { pg8::ld8f_nt(kp, kk[it]); pg8::ld8f_nt(vp, vv[it]); } else { pg8::ld8f(kp, kk[it]); pg8::ld8f(vp, vv[it]); } }
#pragma unroll
            for (int it = 0; it < 4; ++it) { const int s = (tid >> 4) + 32 * (4 * hb + it);
                float (&k)[8] = kk[it]; float (&v)[8] = vv[it];
                if (!SAMPLE) { float ss = 0.f;
#pragma unroll
                    for (int e = 0; e < 8; ++e) ss += k[e] * k[e];
                    ss += __shfl_xor(ss, 1); ss += __shfl_xor(ss, 2); ss += __shfl_xor(ss, 4); ss += __shfl_xor(ss, 8);
                    const float rs = rsqrtf(ss * (1.f / 128.f) + EPS);
#pragma unroll
                    for (int e = 0; e < 8; ++e) k[e] *= rs * kg[e];
                    if (qt == 0) { const size_t o = ((((size_t)l * 4 + b) * 256 + s) * 4 + h) * 128 + sub * 8;
                        *(f32x4*)(p.out + O_MKP + o) = (f32x4){k[0], k[1], k[2], k[3]}; *(f32x4*)(p.out + O_MKP + o + 4) = (f32x4){k[4], k[5], k[6], k[7]};
                        *(f32x4*)(p.out + O_MVP + o) = (f32x4){v[0], v[1], v[2], v[3]}; *(f32x4*)(p.out + O_MVP + o + 4) = (f32x4){v[4], v[5], v[6], v[7]}; }
                }
                *(LAS bf16x8*)(Kl + s * MEM_KS + sub * 8) = pack8(k);
                *(LAS bf16x8*)(Vt + s * MEM_VS + sub * 8) = pack8(v);
            }
        }
    }
    __syncthreads();
    if (!SAMPLE || wave == 0) {
#pragma unroll 1
      for (int qq = 0; qq < (SAMPLE ? 1 : 4); ++qq) {
        int q16 = lane & 15, kq = lane >> 4; asm volatile("" : "+v"(q16), "+v"(kq));
        size_t row; bool st;
        if (!SAMPLE) { row = (size_t)b * 8192 + (qt * 4 + qq) * 128 + 16 * wave + q16; st = true; } else { row = (size_t)MP + 8 * b + (q16 & 7); st = q16 < 8; }
        bf16x8 qf[4];
        {
            float qv[4][8]; float ss = 0.f;
#pragma unroll
            for (int dc = 0; dc < 4; ++dc) { unpack8(*(const v4u*)(MQ + row * 512 + h * 128 + 32 * dc + 8 * kq), qv[dc]);
#pragma unroll
                for (int e = 0; e < 8; ++e) ss += qv[dc][e] * qv[dc][e]; }
            ss += __shfl_xor(ss, 16); ss += __shfl_xor(ss, 32);
            const float rs = rsqrtf(ss * (1.f / 128.f) + EPS) * 0.08838834764831845f;
#pragma unroll
            for (int dc = 0; dc < 4; ++dc) { float qg[8]; pg8::ld8f(p.in[I_MQG] + l * 128 + 32 * dc + 8 * kq, qg);
#pragma unroll
                for (int e = 0; e < 8; ++e) qv[dc][e] *= rs * qg[e];
                qf[dc] = pack8(qv[dc]); }
        }
        f32x4 S[8][2]; float mx = -INFINITY;
#pragma unroll
        for (int cc = 0; cc < 8; ++cc)
#pragma unroll
            for (int tt = 0; tt < 2; ++tt) { const int kb = 32 * cc + 16 * tt; f32x4 a = (f32x4){0.f, 0.f, 0.f, 0.f};
#pragma unroll
                for (int dc = 0; dc < 4; ++dc) { const bf16x8 kf = *(const LAS bf16x8*)(Kl + (kb + q16) * MEM_KS + 32 * dc + 8 * kq);
                    a = __builtin_amdgcn_mfma_f32_16x16x32_bf16(kf, qf[dc], a, 0, 0, 0); }
#pragma unroll
                for (int e = 0; e < 4; ++e) mx = fmaxf(mx, a[e]);
                S[cc][tt] = a; }
        mx = fmaxf(mx, __shfl_xor(mx, 16)); mx = fmaxf(mx, __shfl_xor(mx, 32));
        float den = 0.f;
#pragma unroll
        for (int cc = 0; cc < 8; ++cc)
#pragma unroll
            for (int tt = 0; tt < 2; ++tt)
#pragma unroll
                for (int e = 0; e < 4; ++e) { const float pe = __expf(S[cc][tt][e] - mx); S[cc][tt][e] = pe; den += pe; }
        den += __shfl_xor(den, 16); den += __shfl_xor(den, 32);
        const float rden = 1.f / den;
        bf16x8 pf[8];
#pragma unroll
        for (int cc = 0; cc < 8; ++cc) { float t8[8];
#pragma unroll
            for (int e = 0; e < 4; ++e) { t8[e] = S[cc][0][e]; t8[4 + e] = S[cc][1][e]; }
            pf[cc] = pack8(t8); }
#pragma unroll
        for (int dt = 0; dt < 8; ++dt) { f32x4 o = (f32x4){0.f, 0.f, 0.f, 0.f};
#pragma unroll
            for (int cc = 0; cc < 8; ++cc) { const LAS bf16* vp = Vt + (32 * cc + 4 * kq + (q16 >> 2)) * MEM_VS + 16 * dt + 4 * (q16 & 3);
                const v2u lo = vtr(vp), hi = vtr(vp + 16 * MEM_VS);
                v4u av; av.x = lo.x; av.y = lo.y; av.z = hi.x; av.w = hi.y;
                o = __builtin_amdgcn_mfma_f32_16x16x32_bf16(__builtin_bit_cast(bf16x8, av), pf[cc], o, 0, 0, 0); }
            if (st) { v2u w; w.x = pk2(o[0] * rden, o[1] * rden); w.y = pk2(o[2] * rden, o[3] * rden);
                *(v2u*)(MO + row * 512 + h * 128 + 16 * dt + 4 * kq) = w; } }
      }
    }
    __syncthreads();
}

#ifndef REP_LIGHT
#define REP_LIGHT 1
#endif
#ifndef REP_G9
#define REP_G9 1
#endif
#ifndef REP_G10
#define REP_G10 1
#endif
#ifndef REP_PRO
#define REP_PRO 1
#endif
#ifndef REP_MEM
#define REP_MEM 1
#endif
#ifndef REP_P15
#define REP_P15 1
#endif
#ifndef REP_SYNC
#define REP_SYNC 1
#endif
#define GSYNC() do { for (int r_ = 0; r_ < REP_SYNC; ++r_) xcd_barrier(xbar); } while (0)
#define PHASE_IDS int t_ = threadIdx.x; asm volatile("" : "+v"(t_)); const int tid = t_, lane = tid & 63, wave = __builtin_amdgcn_readfirstlane(tid >> 6); const int gw = bx * NWAVES + wave; (void)gw; (void)lane; (void)tid;
__global__ void __launch_bounds__(NTHR, 2) fwd_megakernel(Params p) {
    extern __shared__ __attribute__((aligned(16))) unsigned char lds_raw[];
    LAS unsigned char* lds = (LAS unsigned char*)lds_raw;
    cg::grid_group grid = cg::this_grid();
    const int G = gridDim.x, bx = blockIdx.x;
    const int wave0 = __builtin_amdgcn_readfirstlane((int)threadIdx.x >> 6);
    const int ngw = G * NWAVES;
    unsigned char* ws = p.ws;
    bf16* XN = (bf16*)(ws + W_XN);
    float* SSb = (float*)(ws + W_SS);
    float* X = p.out;
    typedef pg8::bf16_t pb;

    if (threadIdx.x < 16) ((LAS unsigned*)(lds + LDS_CTL_OFF))[threadIdx.x] = 0u;
    __syncthreads();
    const XcdBarrier xbar = xcd_barrier_post((unsigned*)(ws + W_CTL), (volatile LAS unsigned*)(lds + LDS_CTL_OFF));
    for (int rep = 0; rep < REP_LIGHT * REP_PRO; ++rep) { PHASE_IDS prologue(p, lds, gw, ngw, wave, lane); }
    grid.sync();

    auto layer_body = [&](auto LC) __attribute__((always_inline)) {
        constexpr int l = decltype(LC)::value;
        unsigned char* wl = ws + W_LAYER + (size_t)l * WL_SIZE;
        if (l == 0) {
            { pg8::Gemm g{(const pb*)XN, (const pb*)(ws + W_WIN), MT, 1536, 1024}; pg8::StaticOrder S; S.init(MP, 1536, G, bx);
              pg8::EpiAct E{(pb*)(ws + W_PROJ), 1536, 4, SSb};
              pg8::gemm_phase<pg8::EpiAct, pg8::StaticOrder, true, true>(lds, g, S, E, wave0);
              pg8::mini_gemm<pg8::EpiAct, true>(lds, g.A, g.Bt, 1024, 24, E, bx, G, wave0); }
        } else {
            pg8::Gemm g{(const pb*)XN, (const pb*)(ws + W_WQKV), MT, 1536, 1024}; pg8::StaticOrder S; S.init(MP, 1536, G, bx);
            pg8::EpiQKV E{(pb*)(ws + W_PROJ), (float*)(ws + W_KV32), SSb + (size_t)3 * MT};
            pg8::gemm_phase<pg8::EpiQKV, pg8::StaticOrder, true, true>(lds, g, S, E, wave0);
            pg8::mini_gemm<pg8::EpiQKV, true>(lds, g.A, g.Bt, 1024, 24, E, bx, G, wave0);
        }
        GSYNC();
        if (l == 0) {
#ifndef NO_SGU
            PHASE_IDS
            for (int rep = 0; rep < REP_LIGHT; ++rep)
            for (int u = bx; u < 256 + 128; u += G) { if (u < 256) sgu_prompt_unit(p, lds, u, tid, wave, lane); else sgu_sample_unit(p, lds, u - 256, tid, wave, lane); }
#pragma unroll 1
            for (int ll = 0; ll < 2; ++ll) {
              pg8::EpiRes E{(float*)(ws + W_MKV) + (size_t)ll * 1024 * 1024, nullptr, nullptr, 0, nullptr, nullptr, 0};
              pg8::mini_gemm(lds, (const pb*)(ws + W_MN) + (size_t)ll * 1024 * 1024, (const pb*)(ws + W_LAYER + (size_t)ll * WL_SIZE + WL_WKV), 1024, 8, E, (bx + G - 128 - 64 * ll) % G, G, wave0, 0); }
#endif
        } else {
#ifndef NO_SWA
            PHASE_IDS
            for (int rep = 0; rep < REP_LIGHT; ++rep)
            for (int u = bx; u < 1024 + 512; u += G) { if (u < 1024) swa_unit<false>(p, lds, u, tid, wave, lane); else swa_unit<true>(p, lds, u - 1024, tid, wave, lane); }
#endif
        }
        GSYNC();
        {
            pg8::Gemm g{(const pb*)(ws + W_AO), (const pb*)(ws + (l == 0 ? W_WOUT : W_CWO)), MT, 1024, 1024}; pg8::StaticOrder S; S.init(MP, 1024, G, bx);
            pg8::EpiRes E{nullptr, nullptr, nullptr, 1, (pb*)XN, SSb + (size_t)(1 + 3 * l) * MT, 1};
            pg8::gemm_phase<pg8::EpiRes, pg8::StaticOrder, true, true>(lds, g, S, E, wave0);
            pg8::mini_gemm<pg8::EpiRes, true, true>(lds, g.A, g.Bt, 1024, 16, E, bx, G, wave0);
        }
        GSYNC();
        {
            pg8::Gemm g{(const pb*)XN, (const pb*)(wl + WL_WQ), MT, 512, 1024}; pg8::StaticOrder S; S.init(MP, 512, G, bx);
            pg8::EpiAct E{(pb*)(ws + W_MQ), 512, 0, SSb + (size_t)(1 + 3 * l) * MT};
            pg8::gemm_phase<pg8::EpiAct, pg8::StaticOrder, true, true>(lds, g, S, E, wave0);
            pg8::mini_gemm<pg8::EpiAct, true, true>(lds, g.A, g.Bt, 1024, 8, E, bx, G, wave0);
        }
        GSYNC();
#ifndef NO_MEM
        { PHASE_IDS
        for (int rep = 0; rep < REP_LIGHT * REP_MEM; ++rep)
        for (int u = bx; u < 256 + 512; u += G) { if (u < 256) mem_unit<false>(p, l, lds, u, tid, wave, lane); else mem_unit<true>(p, l, lds, u - 256, tid, wave, lane); } }
#endif
        GSYNC();
        {
            pg8::Gemm g{(const pb*)(ws + W_MO), (const pb*)(wl + WL_WO), MT, 1024, 512}; pg8::StaticOrder S; S.init(MP, 1024, G, bx);
            pg8::EpiRes E{nullptr, nullptr, nullptr, 1, (pb*)XN, SSb + (size_t)(2 + 3 * l) * MT, 1};
            pg8::gemm_phase<pg8::EpiRes, pg8::StaticOrder, true, true>(lds, g, S, E, wave0);
            pg8::mini_gemm<pg8::EpiRes, true, true>(lds, g.A, g.Bt, 512, 16, E, bx, G, wave0);
        }
        GSYNC();
        {
            pg8::Gemm g{(const pb*)XN, (const pb*)(wl + WL_WUP), MT, DFF, 1024}; pg8::SplitOrder S; S.init(DFF, G, bx);
            pg8::EpiG E{(pb*)(ws + W_G), p.out + O_FCP + (size_t)l * 4 * 2 * DFF, p.out + O_FCS + (size_t)l * 128 * 2 * DFF, SSb + (size_t)(2 + 3 * l) * MT};
            for (int rep = 0; rep < REP_G9; ++rep) pg8::gemm_phase<pg8::EpiG, pg8::SplitOrder, true, true>(lds, g, S, E, wave0);
        }
        GSYNC();
        {
            pg8::Gemm g{(const pb*)XN, (const pb*)(wl + WL_WUP) + (size_t)DFF * 1024, MT, DFF, 1024}; pg8::SplitOrder S; S.init(DFF, G, bx);
            pg8::EpiH E{(const pb*)(ws + W_G), (pb*)(ws + W_H), p.in[I_FCW] + (size_t)l * 3 * DFF, p.in[I_FCB] + (size_t)l * DFF, p.in[I_CFC] + (size_t)l * 128 * 2 * DFF, SSb + (size_t)(2 + 3 * l) * MT};
            for (int rep = 0; rep < REP_G10; ++rep) pg8::gemm_phase<pg8::EpiH, pg8::SplitOrder, true, true>(lds, g, S, E, wave0);
        }
        GSYNC();
        {
            pg8::Gemm g{(const pb*)(ws + W_H), (const pb*)(wl + WL_WDN), MT, 1024, DFF}; pg8::StaticOrder S; S.init(MP, 1024, G, bx);
            pg8::EpiRes E{l == 0 ? nullptr : X, nullptr, nullptr, 1, (pb*)XN, SSb + (size_t)3 * MT, l == 0};
            pg8::gemm_phase<pg8::EpiRes, pg8::StaticOrder, true, true>(lds, g, S, E, wave0);
            pg8::mini_gemm<pg8::EpiRes, true, true>(lds, g.A, g.Bt, DFF, 16, E, bx, G, wave0);
        }
        GSYNC();
    };
    layer_body(std::integral_constant<int, 0>{});
    layer_body(std::integral_constant<int, 1>{});
}

extern "C" void kernel_launch(void* const* d_in, const int* in_sizes, int n_in, void* d_out, int out_size, void* d_ws, size_t ws_size, hipStream_t stream) {
    static int grid_blocks = 0;
    if (grid_blocks == 0) {
        if (n_in != N_IN || (size_t)out_size != O_END || ws_size < W_NEED) { fprintf(stderr, "kernel_launch: unexpected shapes: n_in %d out %d ws %zu (need %zu)\n", n_in, out_size, ws_size, (size_t)W_NEED); grid_blocks = -1; return; }
        int dev = 0, cus = 0, per_cu = 0;
        hipGetDevice(&dev);
        hipDeviceGetAttribute(&cus, hipDeviceAttributeMultiprocessorCount, dev);
        if (hipFuncSetAttribute((const void*)fwd_megakernel, hipFuncAttributeMaxDynamicSharedMemorySize, LDS_BYTES) != hipSuccess) { fprintf(stderr, "kernel_launch: hipFuncSetAttribute failed\n"); grid_blocks = -1; return; }
        if (hipOccupancyMaxActiveBlocksPerMultiprocessor(&per_cu, (const void*)fwd_megakernel, NTHR, LDS_BYTES) != hipSuccess || per_cu < 1) { fprintf(stderr, "kernel_launch: occupancy query failed (%d)\n", per_cu); (void)hipGetLastError(); grid_blocks = -1; return; }
        grid_blocks = cus * per_cu;
    }
    if (grid_blocks < 0) return;
    if (hipMemsetAsync((char*)d_ws + W_CTL, 0, CTL_BYTES, stream) != hipSuccess) { fprintf(stderr, "kernel_launch: memset failed\n"); return; }
    Params p{};
    for (int i = 0; i < N_IN; ++i) p.in[i] = (const float*)d_in[i];
    p.out = (float*)d_out; p.ws = (unsigned char*)d_ws;
    void* args[] = {&p};
    hipError_t e = hipLaunchCooperativeKernel((const void*)fwd_megakernel, dim3(grid_blocks), dim3(NTHR), args, LDS_BYTES, stream);
    if (e != hipSuccess) fprintf(stderr, "cooperative launch failed: %s (grid %d)\n", hipGetErrorString(e), grid_blocks);
}
```

```cpp
#include <hip/hip_runtime.h>
#include <hip/hip_cooperative_groups.h>
#include <cstdio>
#include <cstdint>
#include <type_traits>
namespace cg = cooperative_groups;
namespace pg8 {
#define PG8_LAS __attribute__((address_space(3)))
typedef unsigned short bf16_t;
typedef short bf16x8 __attribute__((ext_vector_type(8)));
typedef float f32x4 __attribute__((ext_vector_type(4)));
typedef unsigned u32x4 __attribute__((ext_vector_type(4)));
constexpr int BM = 256, BK = 64, HALF = 128, HTB = HALF * BK * 2  , STAGE_BYTES = 8 * HTB, NXCD = 8, WGM = 8;

__host__ __device__ __forceinline__ int lds_byte(int r, int c) { const int st = (r >> 4) * 2 + (c >> 5), rr = r & 15, cc = c & 31, ob = rr * 64 + cc * 2; return st * 1024 + (ob ^ (((ob >> 9) & 1) << 5)); }
__host__ __device__ __forceinline__ void stage_rc(int b, int& R, int& C) { const int st = b / 1024, sb = b % 1024, swz = sb ^ (((sb >> 9) & 1) << 5); R = (st >> 1) * 16 + swz / 64; C = (st & 1) * 32 + (swz % 64) / 2; }
__host__ __device__ __forceinline__ int perm32(int rho) { const int n = rho >> 4, i = rho & 15; return 8 * (i >> 2) + 4 * n + (i & 3); }

struct Unit { int pm, pn; int rb; int half; int q; int cb; };
struct Gemm { const bf16_t* A; const bf16_t* Bt; int M, N, K; };

struct StaticOrder {
    int nM, nN, nwg, G, c;
    __host__ __device__ void init(int M, int N, int G_, int c_) { nM = M / BM; nN = N / BM; nwg = nM * nN; G = G_; c = c_; }
    __host__ __device__ bool next(int i, Unit& u) const {
        const long L = (long)i * G + c; if (L >= nwg) return false;
        int wgid = (int)L; { const int q = nwg / NXCD, r = nwg % NXCD, xcd = wgid % NXCD, off = wgid / NXCD; wgid = (xcd < r ? xcd * (q + 1) : r * (q + 1) + (xcd - r) * q) + off; }
        const int nig = WGM * nN, gid = wgid / nig, fm = gid * WGM, gsz = (nM - fm) < WGM ? (nM - fm) : WGM;
        u.pm = fm + ((wgid % nig) % gsz); u.pn = (wgid % nig) / gsz; u.rb = u.pm * BM; u.half = 0; u.q = 0; u.cb = u.pn * BM; return true;
    }
    __device__ __forceinline__ void a_ready(const Unit&) const {}
    __device__ __forceinline__ void done(const Unit&) const {}
};
struct SplitOrder {
    StaticOrder P; int nP, nS, nN, G, c;
    __host__ __device__ void init(int N, int G_, int c_) { P.init(32768, N, G_, c_); nP = P.nwg; nN = N / BM; nS = 8 * nN; G = G_; c = c_; }
    __host__ __device__ bool next(int i, Unit& u) const {
        const long L = (long)i * G + c;
        if (L < nP) return P.next(i, u);
        const int j = (int)(L - nP); if (j >= nS) return false;
        const int hm = j & 7; u.pn = j >> 3; u.pm = 128 + (hm >> 1); u.rb = 32768 + 128 * hm; u.half = 1; u.q = 0; u.cb = u.pn * BM; return true;
    }
    __device__ __forceinline__ void a_ready(const Unit&) const {}
    __device__ __forceinline__ void done(const Unit&) const {}
};


__device__ __forceinline__ unsigned cvt_pk_bf16(float lo, float hi) { unsigned r; asm volatile("v_cvt_pk_bf16_f32 %0, %1, %2" : "=v"(r) : "v"(lo), "v"(hi)); return r; }
typedef float f32x2 __attribute__((ext_vector_type(2)));
__device__ __forceinline__ f32x2 gelu_pk(f32x2 v) {
    f32x2 x = v * 0.70710678118f;
    x.x = __builtin_amdgcn_fmed3f(x.x, -2.9f, 2.9f); x.y = __builtin_amdgcn_fmed3f(x.y, -2.9f, 2.9f);
    const f32x2 t = x * x;
    f32x2 p = t * (-4.953124630e-07f) + 1.987094038e-05f;
    p = p * t + (-3.472001117e-04f); p = p * t + 3.517547622e-03f; p = p * t + (-2.333305031e-02f); p = p * t + 1.087993085e-01f; p = p * t + (-3.740358949e-01f); p = p * t + 1.128076553e+00f;
    const f32x2 hv = v * 0.5f;
    return hv * (x * p) + hv;
}

__device__ __forceinline__ float bf_lo(unsigned w) { return __builtin_bit_cast(float, w << 16); }
__device__ __forceinline__ float bf_hi(unsigned w) { return __builtin_bit_cast(float, w & 0xffff0000u); }
__device__ __forceinline__ void ld8bf(const bf16_t* p, float (&o)[8]) { const u32x4 w = *(const u32x4*)p;
    o[0] = bf_lo(w.x); o[1] = bf_hi(w.x); o[2] = bf_lo(w.y); o[3] = bf_hi(w.y); o[4] = bf_lo(w.z); o[5] = bf_hi(w.z); o[6] = bf_lo(w.w); o[7] = bf_hi(w.w); }
__device__ __forceinline__ void ld8f(const float* p, float (&o)[8]) { const f32x4 a = *(const f32x4*)p, b = *(const f32x4*)(p + 4);
    o[0] = a[0]; o[1] = a[1]; o[2] = a[2]; o[3] = a[3]; o[4] = b[0]; o[5] = b[1]; o[6] = b[2]; o[7] = b[3]; }
__device__ __forceinline__ void ld8f_nt(const float* p, float (&o)[8]) { const f32x4 a = __builtin_nontemporal_load((const f32x4*)p), b = __builtin_nontemporal_load((const f32x4*)(p + 4));
    o[0] = a[0]; o[1] = a[1]; o[2] = a[2]; o[3] = a[3]; o[4] = b[0]; o[5] = b[1]; o[6] = b[2]; o[7] = b[3]; }
__device__ __forceinline__ void zero8(float (&o)[8]) {
#pragma unroll
    for (int j = 0; j < 8; ++j) o[j] = 0.f; }

struct EpiAct {
    static constexpr bool PERM = true, AFTER_DRAIN = false;
    bf16_t* O; int ldc; int gelu_tiles; const float* SS;
    __device__ __forceinline__ void operator()(const f32x4 (&acc)[2][2][4][2], const Unit& u, int wr, int wc, int fr, int fq) const {
        asm volatile("" : "+v"(fr), "+v"(fq));
        const int row0 = u.rb + wr * 64 + fr, col0 = u.cb + wc * 32 + 8 * fq;
        const bool act = u.pn < gelu_tiles;
        float rsv[2][4];
#pragma unroll
        for (int ai = 0; ai < 2; ++ai)
#pragma unroll
            for (int m = 0; m < 4; ++m) rsv[ai][m] = SS[row0 + (u.half ? 0 : ai * HALF) + m * 16];
#pragma unroll
        for (int ai = 0; ai < 2; ++ai) if (ai == 0 || !u.half)
#pragma unroll
            for (int m = 0; m < 4; ++m) { bf16_t* rowp = O + (size_t)(row0 + ai * HALF + m * 16) * ldc + col0;
                const float rs = rsqrtf(rsv[ai][m] * (1.f / 1024.f) + 1e-6f);
#pragma unroll
                for (int bj = 0; bj < 2; ++bj) if (bj == 0 || !u.q) { f32x4 v0 = acc[ai][bj][m][0] * rs, v1 = acc[ai][bj][m][1] * rs;
                    if (act) { f32x2 a = gelu_pk((f32x2){v0[0], v0[1]}), b = gelu_pk((f32x2){v0[2], v0[3]}), c = gelu_pk((f32x2){v1[0], v1[1]}), d = gelu_pk((f32x2){v1[2], v1[3]});
                        v0 = (f32x4){a.x, a.y, b.x, b.y}; v1 = (f32x4){c.x, c.y, d.x, d.y}; }
                    u32x4 w; w.x = cvt_pk_bf16(v0[0], v0[1]); w.y = cvt_pk_bf16(v0[2], v0[3]); w.z = cvt_pk_bf16(v1[0], v1[1]); w.w = cvt_pk_bf16(v1[2], v1[3]);
                    *(u32x4*)(rowp + bj * HALF) = w; } }
    }
};

struct EpiQKV {
    static constexpr bool PERM = true, AFTER_DRAIN = false;
    bf16_t* Q; float* KV; const float* SS;
    __device__ __forceinline__ void operator()(const f32x4 (&acc)[2][2][4][2], const Unit& u, int wr, int wc, int fr, int fq) const {
        asm volatile("" : "+v"(fr), "+v"(fq));
        const int row0 = u.rb + wr * 64 + fr;
        float rs[2][4];
#pragma unroll
        for (int ai = 0; ai < 2; ++ai) if (ai == 0 || !u.half)
#pragma unroll
            for (int m = 0; m < 4; ++m) rs[ai][m] = rsqrtf(SS[row0 + (u.half ? 0 : ai * HALF) + m * 16] * (1.f / 1024.f) + 1e-6f);
        if (u.pn < 4) {
            const int col0 = u.cb + wc * 32 + 8 * fq;
#pragma unroll
            for (int ai = 0; ai < 2; ++ai) if (ai == 0 || !u.half)
#pragma unroll
                for (int m = 0; m < 4; ++m) { bf16_t* rowp = Q + (size_t)(row0 + ai * HALF + m * 16) * 1024 + col0;
#pragma unroll
                    for (int bj = 0; bj < 2; ++bj) if (bj == 0 || !u.q) { const f32x4 v0 = acc[ai][bj][m][0] * rs[ai][m], v1 = acc[ai][bj][m][1] * rs[ai][m];
                        u32x4 w; w.x = cvt_pk_bf16(v0[0], v0[1]); w.y = cvt_pk_bf16(v0[2], v0[3]); w.z = cvt_pk_bf16(v1[0], v1[1]); w.w = cvt_pk_bf16(v1[2], v1[3]);
                        *(u32x4*)(rowp + bj * HALF) = w; } }
        } else {
            const int col0 = (u.cb - 1024) + wc * 32 + 8 * fq;
#pragma unroll
            for (int ai = 0; ai < 2; ++ai) if (ai == 0 || !u.half)
#pragma unroll
                for (int m = 0; m < 4; ++m) { float* rowp = KV + (size_t)(row0 + ai * HALF + m * 16) * 512 + col0;
#pragma unroll
                    for (int bj = 0; bj < 2; ++bj) if (bj == 0 || !u.q) { *(f32x4*)(rowp + bj * HALF) = acc[ai][bj][m][0] * rs[ai][m]; *(f32x4*)(rowp + bj * HALF + 4) = acc[ai][bj][m][1] * rs[ai][m]; } }
        }
    }
};

struct EpiRes {
    static constexpr bool PERM = true, AFTER_DRAIN = false;
    float* C; const float* resP; const float* resS; int inplace; bf16_t* XB0; float* SS; int wxb;
    static constexpr int ldc = 1024, split = 32768;
    __device__ __forceinline__ void row_out(const f32x4 v0, const f32x4 v1, int row, int col, float& ss) const {
        if (C) { float* rowp = C + (size_t)row * ldc + col; __builtin_nontemporal_store(v0, (f32x4*)rowp); __builtin_nontemporal_store(v1, (f32x4*)(rowp + 4)); }
        if (wxb) { u32x4 w; w.x = cvt_pk_bf16(v0[0], v0[1]); w.y = cvt_pk_bf16(v0[2], v0[3]); w.z = cvt_pk_bf16(v1[0], v1[1]); w.w = cvt_pk_bf16(v1[2], v1[3]);
            *(u32x4*)(XB0 + (size_t)row * ldc + col) = w;
            ss += (v0[0] * v0[0] + v0[1] * v0[1]) + (v0[2] * v0[2] + v0[3] * v0[3]) + (v1[0] * v1[0] + v1[1] * v1[1]) + (v1[2] * v1[2] + v1[3] * v1[3]); }
    }
    __device__ __forceinline__ void operator()(const f32x4 (&acc)[2][2][4][2], const Unit& u, int wr, int wc, int fr, int fq) const {
        asm volatile("" : "+v"(fr), "+v"(fq));
        const int row0 = u.rb + wr * 64 + fr, col0 = u.cb + wc * 32 + 8 * fq;
        if (inplace) {
#pragma unroll
            for (int ai = 0; ai < 2; ++ai) if (ai == 0 || !u.half)
#pragma unroll
              for (int mh = 0; mh < 4; mh += 2) {
                u32x4 rw[2][2];
#pragma unroll
                for (int mm = 0; mm < 2; ++mm) { const int row = row0 + ai * HALF + (mh + mm) * 16;
#pragma unroll
                    for (int bj = 0; bj < 2; ++bj) if (bj == 0 || !u.q) rw[mm][bj] = *(const u32x4*)(XB0 + (size_t)row * ldc + col0 + bj * HALF); }
#pragma unroll
                for (int mm = 0; mm < 2; ++mm) { const int m = mh + mm, row = row0 + ai * HALF + m * 16; float ss = 0.f;
#pragma unroll
                    for (int bj = 0; bj < 2; ++bj) if (bj == 0 || !u.q) { const u32x4 w = rw[mm][bj];
                        const f32x4 v0 = acc[ai][bj][m][0] + (f32x4){bf_lo(w.x), bf_hi(w.x), bf_lo(w.y), bf_hi(w.y)}, v1 = acc[ai][bj][m][1] + (f32x4){bf_lo(w.z), bf_hi(w.z), bf_lo(w.w), bf_hi(w.w)};
                        row_out(v0, v1, row, col0 + bj * HALF, ss); }
                    if (wxb) { ss += __shfl_xor(ss, 16); ss += __shfl_xor(ss, 32); if (fq == 0) unsafeAtomicAdd(SS + row, ss); } }
              }
        } else {
#pragma unroll
            for (int ai = 0; ai < 2; ++ai) if (ai == 0 || !u.half)
#pragma unroll
                for (int m = 0; m < 4; ++m) { const int row = row0 + ai * HALF + m * 16; float ss = 0.f;
                    const float* rp = resP ? ((row < split ? resP + (size_t)row * ldc : resS + (size_t)(row - split) * ldc) + col0) : nullptr;
                    f32x4 rv[2][2];
#pragma unroll
                    for (int bj = 0; bj < 2; ++bj) if (bj == 0 || !u.q) { rv[bj][0] = rp ? *(const f32x4*)(rp + bj * HALF) : (f32x4){0.f, 0.f, 0.f, 0.f}; rv[bj][1] = rp ? *(const f32x4*)(rp + bj * HALF + 4) : (f32x4){0.f, 0.f, 0.f, 0.f}; }
#pragma unroll
                    for (int bj = 0; bj < 2; ++bj) if (bj == 0 || !u.q) row_out(acc[ai][bj][m][0] + rv[bj][0], acc[ai][bj][m][1] + rv[bj][1], row, col0 + bj * HALF, ss);
                    if (wxb) { ss += __shfl_xor(ss, 16); ss += __shfl_xor(ss, 32); if (fq == 0) unsafeAtomicAdd(SS + row, ss); } }
        }
    }
};

struct EpiG {
    static constexpr bool PERM = true, AFTER_DRAIN = false;
    bf16_t* G; float* outP; float* outS; const float* SS;
    __device__ __forceinline__ void operator()(const f32x4 (&acc)[2][2][4][2], const Unit& u, int wr, int wc, int fr, int fq) const {
        asm volatile("" : "+v"(fr), "+v"(fq));
        const int row0 = u.rb + wr * 64 + fr, col0 = u.pn * BM + wc * 32 + 8 * fq;
        float rsv[2][4];
#pragma unroll
        for (int ai = 0; ai < 2; ++ai)
#pragma unroll
            for (int m = 0; m < 4; ++m) rsv[ai][m] = SS[row0 + (u.half ? 0 : ai * HALF) + m * 16];
#pragma unroll
        for (int ai = 0; ai < 2; ++ai) if (ai == 0 || !u.half)
#pragma unroll
            for (int m = 0; m < 4; ++m) { const int row = row0 + ai * HALF + m * 16; bf16_t* rowp = G + (size_t)row * 2816 + col0;
                float* co = nullptr;
                if (row < 32768) { const int t = row & 8191; if (t >= 8190) co = outP + ((size_t)(row >> 13) * 2 + (t - 8190)) * 2816 + col0; }
                else { const int i = row & 7; if (i >= 6) co = outS + ((size_t)((row - 32768) >> 3) * 2 + (i - 6)) * 2816 + col0; }
                const float rs = rsqrtf(rsv[ai][m] * (1.f / 1024.f) + 1e-6f);
#pragma unroll
                for (int bj = 0; bj < 2; ++bj) { const f32x4 v0 = acc[ai][bj][m][0] * rs, v1 = acc[ai][bj][m][1] * rs;
                    u32x4 w; w.x = cvt_pk_bf16(v0[0], v0[1]); w.y = cvt_pk_bf16(v0[2], v0[3]); w.z = cvt_pk_bf16(v1[0], v1[1]); w.w = cvt_pk_bf16(v1[2], v1[3]);
                    *(u32x4*)(rowp + bj * HALF) = w;
                    if (co) { *(f32x4*)(co + bj * HALF) = v0; *(f32x4*)(co + bj * HALF + 4) = v1; } } }
    }
};

typedef unsigned u32x2 __attribute__((ext_vector_type(2)));
struct EpiH {
    static constexpr bool PERM = true, AFTER_DRAIN = false;
    const bf16_t* G; bf16_t* H; const float* cw; const float* cb; const float* ctx; const float* SS;
    static __device__ __forceinline__ void unpk4(const u32x2 w, float (&o)[4]) { o[0] = bf_lo(w.x); o[1] = bf_hi(w.x); o[2] = bf_lo(w.y); o[3] = bf_hi(w.y); }
    static __device__ __forceinline__ void ld4f(const float* p, float (&o)[4]) { const f32x4 a = *(const f32x4*)p; o[0] = a[0]; o[1] = a[1]; o[2] = a[2]; o[3] = a[3]; }
    template <int N> static __device__ __forceinline__ unsigned dpp_prev1(unsigned pv, unsigned cur) {
        const int t = __builtin_amdgcn_update_dpp(0, (int)pv, 0x120 + N, 0xf, 0xf, true);
        return (unsigned)__builtin_amdgcn_update_dpp(t, (int)cur, 0x110 + N, 0xf, 0xf, false); }
    template <int N> static __device__ __forceinline__ u32x2 dpp_prev(const u32x2 pv, const u32x2 cur) { u32x2 r; r.x = dpp_prev1<N>(pv.x, cur.x); r.y = dpp_prev1<N>(pv.y, cur.y); return r; }
    static __device__ __forceinline__ u32x2 shf(const u32x2 w, int src) { u32x2 r; r.x = (unsigned)__shfl((int)w.x, src); r.y = (unsigned)__shfl((int)w.y, src); return r; }
    static __device__ __forceinline__ void finish(const float (&g0)[4], const float (&g1)[4], const float (&g2)[4], const float (&w0)[4], const float (&w1)[4], const float (&w2)[4], const float (&bb)[4],
                                                  const f32x4 v, float rs, bf16_t* dst) {
        float h[4];
#pragma unroll
        for (int j = 0; j < 4; j += 2) {
            const f32x2 gc = (f32x2){bb[j] + w0[j] * g2[j] + w1[j] * g1[j] + w2[j] * g0[j], bb[j + 1] + w0[j + 1] * g2[j + 1] + w1[j + 1] * g1[j + 1] + w2[j + 1] * g0[j + 1]};
            const f32x2 ge = gelu_pk(gc); h[j] = ge.x * v[j] * rs; h[j + 1] = ge.y * v[j + 1] * rs; }
        u32x2 w; w.x = cvt_pk_bf16(h[0], h[1]); w.y = cvt_pk_bf16(h[2], h[3]);
        *(u32x2*)dst = w;
    }
    __device__ __forceinline__ void operator()(const f32x4 (&acc)[2][2][4][2], const Unit& u, int wr, int wc, int fr, int fq) const {
        asm volatile("" : "+v"(fr), "+v"(fq));
        const int row0 = u.rb + wr * 64 + fr;
        const int lane = fq * 16 + fr;
        const int s1 = fr >= 1 ? lane - 1 : lane + 15, s2 = fr >= 2 ? lane - 2 : lane + 14; (void)s1; (void)s2;
        float rs8[2][4];
#pragma unroll
        for (int ai = 0; ai < 2; ++ai)
#pragma unroll
            for (int m = 0; m < 4; ++m) rs8[ai][m] = rsqrtf(SS[u.rb + (u.half ? 0 : ai * HALF) + wr * 64 + fr + 16 * m] * (1.f / 1024.f) + 1e-6f);
#pragma unroll
        for (int bj = 0; bj < 2; ++bj)
#pragma unroll
          for (int hv = 0; hv < 2; ++hv) {
            const int col = u.pn * BM + bj * HALF + wc * 32 + 8 * fq + 4 * hv;
            float w0[4], w1[4], w2[4], bb[4];
            ld4f(cw + col, w0); ld4f(cw + 2816 + col, w1); ld4f(cw + 2 * 2816 + col, w2); ld4f(cb + col, bb);
            if (u.pm < 128) {
#pragma unroll
                for (int ai = 0; ai < 2; ++ai) {
                    const int R0 = u.rb + ai * HALF + wr * 64;
                    const bf16_t* gp = G + (size_t)(R0 + fr) * 2816 + col;
                    u32x2 gq[4];
#pragma unroll
                    for (int m = 0; m < 4; ++m) gq[m] = *(const u32x2*)(gp + (size_t)m * 16 * 2816);
                    u32x2 prv = (u32x2){0u, 0u};
                    if ((R0 & 8191) != 0) prv = *(const u32x2*)(gp - (size_t)16 * 2816);
#pragma unroll
                    for (int m = 0; m < 4; ++m) {
                        const u32x2 q1 = dpp_prev<1>(prv, gq[m]), q2 = dpp_prev<2>(prv, gq[m]);
                        float g0[4], g1[4], g2[4]; unpk4(gq[m], g0); unpk4(q1, g1); unpk4(q2, g2);
                        finish(g0, g1, g2, w0, w1, w2, bb, acc[ai][bj][m][hv], rs8[ai][m], H + (size_t)(R0 + fr + 16 * m) * 2816 + col);
                        prv = gq[m];
                    }
                }
            } else {
                const int i = fr & 7;
                u32x2 gq[4];
#pragma unroll
                for (int m = 0; m < 4; ++m) { const int row = row0 + m * 16; gq[m] = *(const u32x2*)(G + (size_t)row * 2816 + col); }
#pragma unroll
                for (int mh = 0; mh < 4; mh += 2) {
                f32x4 c0[4], c1[4];
#pragma unroll
                for (int m = mh; m < mh + 2; ++m) { const int row = row0 + m * 16; const float* cx = ctx + (size_t)((row - 32768) >> 3) * 2 * 2816 + col;
                    c0[m] = *(const f32x4*)cx; c1[m] = *(const f32x4*)(cx + 2816); }
#pragma unroll
                for (int m = mh; m < mh + 2; ++m) { const int row = row0 + m * 16; const u32x2 cur = gq[m];
                    const u32x2 q1 = dpp_prev<1>(cur, cur), q2 = dpp_prev<2>(cur, cur);
                    float g0[4], g1[4], g2[4]; unpk4(cur, g0); unpk4(q1, g1); unpk4(q2, g2);
#pragma unroll
                    for (int j = 0; j < 4; ++j) { const float x1 = c1[m][j], x0 = c0[m][j];
                        if (i < 1) g1[j] = x1;
                        if (i < 2) g2[j] = (i == 1) ? x1 : x0; }
                    finish(g0, g1, g2, w0, w1, w2, bb, acc[0][bj][m][hv], rs8[0][m], H + (size_t)row * 2816 + col); }
                }
            }
        }
    }
};

template <class Epi, class Sched, bool ALIGN_EPI = false, bool SP2 = false>
__device__ __forceinline__ void gemm_phase(PG8_LAS unsigned char* lds, const Gemm g, const Sched& S, const Epi& E, int wave0) {
    int tid_ = threadIdx.x; (void)wave0; asm volatile("" : "+v"(tid_));
    const int tid = tid_, wid = __builtin_amdgcn_readfirstlane(tid >> 6), lane = tid & 63, wr = wid >> 2, wc = wid & 3, fr = lane & 15, fq = lane >> 4;
    const int K = g.K, nt = K / BK;
    unsigned voffA[2], voffB[2];
#pragma unroll
    for (int i = 0; i < 2; ++i) { int R, C; stage_rc(tid * 16 + i * 8192, R, C); const int Rb = Epi::PERM ? ((R & ~31) + perm32(R & 31)) : R;
        voffA[i] = (unsigned)(R * K + C) * 2u; voffB[i] = (unsigned)(Rb * K + C) * 2u; }
    const size_t kstep = (size_t)(BK * 2);
    const size_t hstep = (size_t)HALF * K * 2;
    const size_t tstep = 2 * hstep;
    const unsigned ldsw = (unsigned)wid * 1024u;
    const int aoff = lds_byte(wr * 64 + fr, fq * 8), boff = lds_byte(wc * 32 + fr, fq * 8);
#define PG8_SA(b, h) (((b) * 2 + (h)) * HTB)
#define PG8_SB(b, h) ((4 + (b) * 2 + (h)) * HTB)
#define PG8_STAGE(bufoff, gbase, voff) do { _Pragma("unroll") for (int _i = 0; _i < 2; ++_i) \
        __builtin_amdgcn_global_load_lds((const unsigned*)((const char*)(gbase) + (voff)[_i]), (PG8_LAS unsigned*)(lds + (bufoff) + ldsw + _i * 8192), 16, 0, 0); } while (0)
#define PG8_LDA(dst, b, h) do { _Pragma("unroll") for (int m = 0; m < 4; ++m) _Pragma("unroll") for (int k = 0; k < 2; ++k) dst[m][k] = *(const PG8_LAS bf16x8*)(lds + PG8_SA(b, h) + aoff + m * 2048 + k * 1024); } while (0)
#define PG8_LDB(dst, b, h) do { _Pragma("unroll") for (int n = 0; n < 2; ++n) _Pragma("unroll") for (int k = 0; k < 2; ++k) dst[n][k] = *(const PG8_LAS bf16x8*)(lds + PG8_SB(b, h) + boff + n * 2048 + k * 1024); } while (0)
#define PG8_MMA(ai, bj, At, Bt) do { __builtin_amdgcn_s_setprio(1); _Pragma("unroll") for (int m = 0; m < 4; ++m) _Pragma("unroll") for (int n = 0; n < 2; ++n) _Pragma("unroll") for (int k = 0; k < 2; ++k) \
        acc[ai][bj][m][n] = __builtin_amdgcn_mfma_f32_16x16x32_bf16(Bt[n][k], At[m][k], acc[ai][bj][m][n], 0, 0, 0); __builtin_amdgcn_s_setprio(0); } while (0)
#define PG8_WAIT_V(n) asm volatile("s_waitcnt vmcnt(" #n ")" ::: "memory")
#define PG8_WAIT_L(n) asm volatile("s_waitcnt lgkmcnt(" #n ")" ::: "memory")
#define PG8_BAR __builtin_amdgcn_s_barrier()
#define PG8_SCHED __builtin_amdgcn_sched_barrier(0)
    Unit cur, nxt; int ui = 0;
    if (!S.next(0, cur)) return;
    f32x4 acc[2][2][4][2];
#pragma unroll
    for (int a = 0; a < 2; ++a)
#pragma unroll
        for (int b = 0; b < 2; ++b)
#pragma unroll
            for (int m = 0; m < 4; ++m)
#pragma unroll
                for (int n = 0; n < 2; ++n) acc[a][b][m][n] = (f32x4){0.f, 0.f, 0.f, 0.f};
    bf16x8 At[4][2], B0[2][2], B1[2][2];
    const char* cA = (const char*)g.A + (size_t)cur.rb * K * 2; const char* cB = (const char*)g.Bt + (size_t)cur.pn * tstep;
    S.a_ready(cur);
    if constexpr (SP2) {
        PG8_STAGE(PG8_SB(0, 0), cB, voffB); PG8_STAGE(PG8_SB(0, 1), cB + hstep, voffB); PG8_STAGE(PG8_SA(0, 0), cA, voffA); PG8_STAGE(PG8_SA(0, 1), cA + hstep, voffA);
        if (wr == 1) PG8_BAR;
        PG8_WAIT_V(2); PG8_BAR;
        PG8_STAGE(PG8_SB(1, 0), cB + kstep, voffB); PG8_STAGE(PG8_SA(1, 0), cA + kstep, voffA); PG8_STAGE(PG8_SB(1, 1), cB + hstep + kstep, voffB);
        PG8_WAIT_V(6); PG8_BAR;
    } else {
        PG8_STAGE(PG8_SB(0, 0), cB, voffB); PG8_STAGE(PG8_SA(0, 0), cA, voffA); PG8_STAGE(PG8_SB(0, 1), cB + hstep, voffB); PG8_STAGE(PG8_SA(0, 1), cA + hstep, voffA);
        if (wr == 1) PG8_BAR;
        PG8_WAIT_V(4); PG8_BAR;
        PG8_STAGE(PG8_SB(1, 0), cB + kstep, voffB); PG8_STAGE(PG8_SA(1, 0), cA + kstep, voffA); PG8_STAGE(PG8_SB(1, 1), cB + hstep + kstep, voffB);
        PG8_WAIT_V(6); PG8_BAR;
    }
    for (;;) {
        const bool has_next = S.next(ui + 1, nxt);
        const char* nA = has_next ? (const char*)g.A + (size_t)nxt.rb * K * 2 : cA; const char* nB = has_next ? (const char*)g.Bt + (size_t)nxt.pn * tstep : cB;
        for (int t = 0; t < nt; t += 2) {
            const bool last = (t == nt - 2);
            const char* a1 = cA + (size_t)(t + 1) * kstep;
            const char* a2 = last ? nA : cA + (size_t)(t + 2) * kstep; const char* b2 = last ? nB : cB + (size_t)(t + 2) * kstep;
            const char* a3 = a2 + kstep; const char* b3 = b2 + kstep;
            if (last && has_next) S.a_ready(nxt);
            if constexpr (SP2) {
            PG8_LDB(B0, 0, 0); PG8_LDB(B1, 0, 1); PG8_SCHED; PG8_LDA(At, 0, 0); PG8_STAGE(PG8_SA(1, 1), a1 + hstep, voffA);
            PG8_WAIT_V(8); PG8_WAIT_L(0); PG8_BAR; PG8_MMA(0, 0, At, B0); PG8_MMA(0, 1, At, B1); PG8_BAR; PG8_SCHED;
            PG8_LDA(At, 0, 1); PG8_STAGE(PG8_SB(0, 0), b2, voffB); PG8_STAGE(PG8_SB(0, 1), b2 + hstep, voffB); PG8_STAGE(PG8_SA(0, 0), a2, voffA);
            PG8_WAIT_V(8); PG8_WAIT_L(0); PG8_BAR; if (!cur.half) { PG8_MMA(1, 0, At, B0); PG8_MMA(1, 1, At, B1); } PG8_BAR; PG8_SCHED;
            PG8_LDB(B0, 1, 0); PG8_LDB(B1, 1, 1); PG8_SCHED; PG8_LDA(At, 1, 0); PG8_STAGE(PG8_SA(0, 1), a2 + hstep, voffA);
            PG8_WAIT_V(8); PG8_WAIT_L(0); PG8_BAR; PG8_MMA(0, 0, At, B0); PG8_MMA(0, 1, At, B1); PG8_BAR; PG8_SCHED;
            PG8_LDA(At, 1, 1); PG8_STAGE(PG8_SB(1, 0), b3, voffB); PG8_STAGE(PG8_SB(1, 1), b3 + hstep, voffB); PG8_STAGE(PG8_SA(1, 0), a3, voffA);
            PG8_WAIT_V(8); PG8_WAIT_L(0); PG8_BAR; if (!cur.half) { PG8_MMA(1, 0, At, B0); PG8_MMA(1, 1, At, B1); } PG8_BAR; PG8_SCHED;
            } else {
            PG8_LDB(B0, 0, 0); PG8_SCHED; PG8_LDA(At, 0, 0); PG8_STAGE(PG8_SA(1, 1), a1 + hstep, voffA);
            PG8_WAIT_L(8); PG8_BAR; PG8_WAIT_L(0); PG8_MMA(0, 0, At, B0); PG8_BAR; PG8_SCHED;
            PG8_LDB(B1, 0, 1); PG8_STAGE(PG8_SB(0, 0), b2, voffB);
            PG8_BAR; PG8_WAIT_L(0); PG8_MMA(0, 1, At, B1); PG8_BAR;
            PG8_LDA(At, 0, 1); PG8_STAGE(PG8_SA(0, 0), a2, voffA);
            PG8_BAR; PG8_WAIT_L(0); if (!cur.half) PG8_MMA(1, 0, At, B0); PG8_BAR; PG8_SCHED;
            PG8_STAGE(PG8_SB(0, 1), b2 + hstep, voffB);
            PG8_WAIT_V(6); PG8_BAR; if (!cur.half) PG8_MMA(1, 1, At, B1); PG8_BAR;
            PG8_LDB(B0, 1, 0); PG8_SCHED; PG8_LDA(At, 1, 0); PG8_STAGE(PG8_SA(0, 1), a2 + hstep, voffA);
            PG8_WAIT_L(8); PG8_BAR; PG8_WAIT_L(0); PG8_MMA(0, 0, At, B0); PG8_BAR; PG8_SCHED;
            PG8_LDB(B1, 1, 1); PG8_STAGE(PG8_SB(1, 0), b3, voffB);
            PG8_BAR; PG8_WAIT_L(0); PG8_MMA(0, 1, At, B1); PG8_BAR;
            PG8_LDA(At, 1, 1); PG8_STAGE(PG8_SA(1, 0), a3, voffA);
            PG8_BAR; PG8_WAIT_L(0); if (!cur.half) PG8_MMA(1, 0, At, B0); PG8_BAR; PG8_SCHED;
            PG8_STAGE(PG8_SB(1, 1), b3 + hstep, voffB);
            PG8_WAIT_V(6); PG8_BAR; if (!cur.half) PG8_MMA(1, 1, At, B1); PG8_BAR;
            }
        }
        if constexpr (ALIGN_EPI) { if (wr == 0) PG8_BAR; }
        if constexpr (!Epi::AFTER_DRAIN) { E(acc, cur, wr, wc, fr, fq); S.done(cur); }
        if (!has_next) break;
#pragma unroll
        for (int a = 0; a < 2; ++a)
#pragma unroll
            for (int b = 0; b < 2; ++b)
#pragma unroll
                for (int m = 0; m < 4; ++m)
#pragma unroll
                    for (int n = 0; n < 2; ++n) acc[a][b][m][n] = (f32x4){0.f, 0.f, 0.f, 0.f};
        cur = nxt; cA = nA; cB = nB; ++ui;
        if constexpr (ALIGN_EPI) { if (wr == 1) PG8_BAR; }
    }
    PG8_WAIT_V(0);
    if constexpr (!ALIGN_EPI) { if (wr == 0) PG8_BAR; }
    PG8_BAR;
    if constexpr (Epi::AFTER_DRAIN) { E.fused(acc, cur, wr, wc, fr, fq, lds, wid, lane); S.done(cur); }
#undef PG8_SA
#undef PG8_SB
#undef PG8_STAGE
#undef PG8_LDA
#undef PG8_LDB
#undef PG8_MMA
#undef PG8_WAIT_V
#undef PG8_WAIT_L
#undef PG8_BAR
#undef PG8_SCHED
}

template <class Epi, bool NARROW = false, bool SHORT = false>
__device__ __forceinline__ void mini_gemm(PG8_LAS unsigned char* lds, const bf16_t* A, const bf16_t* Bt, int K, int ntn, const Epi& E, int c, int G, int wave0, int row_base = 32768) {
    int tid_ = threadIdx.x; (void)wave0; asm volatile("" : "+v"(tid_));
    const int tid = tid_, wid = __builtin_amdgcn_readfirstlane(tid >> 6), lane = tid & 63, wr = wid >> 2, wc = wid & 3, fr = lane & 15, fq = lane >> 4;
    constexpr int LS = 136, BUFB = 2 * 128 * LS * 2;
    constexpr int NB = NARROW ? 2 : 4, TW = NARROW ? 64 : 128;
    constexpr int NA = SHORT ? 2 : 4, TH = SHORT ? 64 : 128, NTM = SHORT ? 16 : 8;
    const int lr = SHORT ? (tid >> 3) : (tid >> 2), lp = SHORT ? (tid & 7) * 2 : (tid & 3) * 4;
    const int lrb = NARROW ? (tid >> 3) : lr, lpb = NARROW ? (tid & 7) * 2 : lp;
    const bool active = (!NARROW || wc < 2) && (!SHORT || wr == 0);
    const int nst = K / 128;
#pragma unroll 1
    for (int t = c; t < NTM * ntn; t += G) {
        const int tm = t % NTM, tn = t / NTM;
        const bf16_t* ga = A + ((size_t)row_base + TH * tm + lr) * K + lp * 8;
        const bf16_t* gb = Bt + ((size_t)TW * tn + lrb) * K + lpb * 8;
        u32x4 ra[2][NA], rb[2][NB];
#pragma unroll
        for (int s2 = 0; s2 < 2; ++s2) {
#pragma unroll
            for (int j = 0; j < NA; ++j) ra[s2][j] = *(const u32x4*)(ga + 128 * s2 + 8 * j);
#pragma unroll
            for (int j = 0; j < NB; ++j) rb[s2][j] = *(const u32x4*)(gb + 128 * s2 + 8 * j); }
        f32x4 acc[4][2];
#pragma unroll
        for (int m = 0; m < 4; ++m)
#pragma unroll
            for (int n = 0; n < 2; ++n) acc[m][n] = (f32x4){0.f, 0.f, 0.f, 0.f};
#pragma unroll 1
        for (int st = 0; st < nst; st += 2) {
#pragma unroll
          for (int s2 = 0; s2 < 2; ++s2) {
            PG8_LAS bf16_t* As = (PG8_LAS bf16_t*)(lds + s2 * BUFB); PG8_LAS bf16_t* Bs = As + 128 * LS;
#pragma unroll
            for (int j = 0; j < NA; ++j) *(PG8_LAS u32x4*)(As + lr * LS + (lp + j) * 8) = ra[s2][j];
#pragma unroll
            for (int j = 0; j < NB; ++j) *(PG8_LAS u32x4*)(Bs + lrb * LS + (lpb + j) * 8) = rb[s2][j];
            __syncthreads();
            if (st + 2 < nst) {
#pragma unroll
                for (int j = 0; j < NA; ++j) ra[s2][j] = *(const u32x4*)(ga + 128 * (st + 2 + s2) + 8 * j);
#pragma unroll
                for (int j = 0; j < NB; ++j) rb[s2][j] = *(const u32x4*)(gb + 128 * (st + 2 + s2) + 8 * j); }
            if (active) {
#pragma unroll
            for (int kc = 0; kc < 4; ++kc) {
                bf16x8 af[4], bfr[2];
#pragma unroll
                for (int m = 0; m < 4; ++m) af[m] = *(const PG8_LAS bf16x8*)(As + (64 * wr + 16 * m + fr) * LS + 32 * kc + 8 * fq);
#pragma unroll
                for (int n = 0; n < 2; ++n) bfr[n] = *(const PG8_LAS bf16x8*)(Bs + (32 * wc + 8 * (fr >> 2) + 4 * n + (fr & 3)) * LS + 32 * kc + 8 * fq);
#pragma unroll
                for (int m = 0; m < 4; ++m)
#pragma unroll
                    for (int n = 0; n < 2; ++n) acc[m][n] = __builtin_amdgcn_mfma_f32_16x16x32_bf16(bfr[n], af[m], acc[m][n], 0, 0, 0);
            } }
          }
        }
        if (active) {
        f32x4 accf[2][2][4][2];
#pragma unroll
        for (int a = 0; a < 2; ++a)
#pragma unroll
            for (int bq = 0; bq < 2; ++bq)
#pragma unroll
                for (int m = 0; m < 4; ++m)
#pragma unroll
                    for (int n = 0; n < 2; ++n) accf[a][bq][m][n] = (a == 0 && bq == 0) ? acc[m][n] : (f32x4){0.f, 0.f, 0.f, 0.f};
        Unit u; u.pm = 128 + (TH * tm >> 8); u.cb = TW * tn; u.pn = u.cb >> 8; u.rb = row_base + TH * tm; u.half = 1; u.q = 1;
        E(accf, u, wr, wc, fr, fq);
        }
        __syncthreads();
    }
}
}

#define LAS __attribute__((address_space(3)))
typedef unsigned short bf16;
typedef unsigned v4u __attribute__((ext_vector_type(4)));
typedef unsigned v2u __attribute__((ext_vector_type(2)));
typedef float f32x4 __attribute__((ext_vector_type(4)));
typedef short bf16x8 __attribute__((ext_vector_type(8)));

constexpr int NTHR = 512, NWAVES = 8;
constexpr int MP = 32768, MS = 1024, MT = MP + MS;
constexpr int D = 1024, DFF = 2816;
constexpr int LDS_BYTES = 147456;
constexpr float EPS = 1e-6f;

enum { I_XP = 0, I_XS, I_CPOOL, I_CSK, I_CSV, I_CMK, I_CMV, I_CFC, I_MEMP, I_LNMIX, I_LNMEM, I_LNMEMKV, I_LNFFN, I_ABWIN, I_ABVG, I_ABWS, I_ABBS, I_ABPW, I_ABPS, I_ABWOUT,
       I_CWQKV, I_CQG, I_CKG, I_CSINK, I_CWO, I_MWQ, I_MWKV, I_MQG, I_MKG, I_MWO, I_FWUP, I_FCW, I_FCB, I_FWDN, N_IN };
constexpr size_t O_YP = 0, O_YS = O_YP + (size_t)MP * D, O_POOLP = O_YS + (size_t)MS * D, O_POOLS = O_POOLP + 4 * 15 * 512, O_CHV = O_POOLS + 128 * 15 * 512,
                 O_SKP = O_CHV + 128 * 8 * 512, O_SVP = O_SKP + 4 * 128 * 256, O_SKS = O_SVP + 4 * 128 * 256, O_SVS = O_SKS + (size_t)128 * 128 * 256,
                 O_MKP = O_SVS + (size_t)128 * 128 * 256, O_MVP = O_MKP + 2 * 4 * 256 * 512, O_FCP = O_MVP + 2 * 4 * 256 * 512, O_FCS = O_FCP + 2 * 4 * 2 * DFF,
                 O_END = O_FCS + (size_t)2 * 128 * 2 * DFF;
constexpr size_t MiB = 1u << 20;
constexpr size_t W_WIN = 0, W_WOUT = W_WIN + 1536 * 1024 * 2, W_WQKV = W_WOUT + 1024 * 1024 * 2, W_CWO = W_WQKV + 1536 * 1024 * 2, W_LAYER = W_CWO + 1024 * 1024 * 2;
constexpr size_t WL_WQ = 0, WL_WKV = WL_WQ + 512 * 1024 * 2, WL_WO = WL_WKV + 1024 * 1024 * 2, WL_WUP = WL_WO + 1024 * 512 * 2, WL_WDN = WL_WUP + (size_t)2 * DFF * 1024 * 2,
                 WL_SIZE = WL_WDN + (size_t)1024 * DFF * 2;
constexpr size_t W_MN = W_LAYER + 2 * WL_SIZE;
constexpr size_t W_MKV = W_MN + 2 * 1024 * 1024 * 2;
constexpr size_t W_SS = W_MKV + 2 * 1024 * 1024 * 4;
constexpr size_t W_SMALL_END = W_SS + (size_t)6 * MT * 4;
static_assert(W_SMALL_END <= 72 * MiB, "weights region");
constexpr size_t W_XN = 72 * MiB;
constexpr size_t W_G = 138 * MiB;
constexpr size_t W_PROJ = W_G;
constexpr size_t W_AO = W_PROJ + 99 * MiB;
constexpr size_t W_H = 320 * MiB;
constexpr size_t W_KV32 = W_H;
constexpr size_t W_MQ = W_KV32 + 66 * MiB;
constexpr size_t W_MO = W_MQ + 33 * MiB;
constexpr size_t W_END = 502 * MiB;
constexpr size_t W_CTL = 504 * MiB, CTL_BYTES = 65536, W_NEED = W_CTL + CTL_BYTES;
constexpr int LDS_CTL_OFF = LDS_BYTES - 64;
static_assert(W_XN + (size_t)MT * 1024 * 2 <= W_G && W_PROJ + (size_t)MT * 1536 * 2 <= W_AO && W_AO + (size_t)MT * 1024 * 2 <= W_H && W_G + (size_t)MT * DFF * 2 <= W_H, "ws map 1");
static_assert(W_KV32 + (size_t)MT * 512 * 4 <= W_MQ && W_MQ + (size_t)MT * 512 * 2 <= W_MO && W_MO + (size_t)MT * 512 * 2 <= W_END && W_H + (size_t)MT * DFF * 2 <= W_END, "ws map 2");

struct Params { const float* in[N_IN]; float* out; unsigned char* ws; };

__device__ __forceinline__ unsigned pk2(float lo, float hi) { return pg8::cvt_pk_bf16(lo, hi); }
__device__ __forceinline__ unsigned f2bf(float f) { return pg8::cvt_pk_bf16(f, 0.f) & 0xffffu; }
__device__ __forceinline__ float bflo(unsigned w) { return __builtin_bit_cast(float, w << 16); }
__device__ __forceinline__ float bfhi(unsigned w) { return __builtin_bit_cast(float, w & 0xffff0000u); }
__device__ __forceinline__ float bf1(bf16 h) { return __builtin_bit_cast(float, (unsigned)h << 16); }
__device__ __forceinline__ void unpack8(const v4u w, float (&o)[8]) { o[0] = bflo(w.x); o[1] = bfhi(w.x); o[2] = bflo(w.y); o[3] = bfhi(w.y); o[4] = bflo(w.z); o[5] = bfhi(w.z); o[6] = bflo(w.w); o[7] = bfhi(w.w); }
__device__ __forceinline__ bf16x8 pack8(const float (&o)[8]) { v4u w; w.x = pk2(o[0], o[1]); w.y = pk2(o[2], o[3]); w.z = pk2(o[4], o[5]); w.w = pk2(o[6], o[7]); return __builtin_bit_cast(bf16x8, w); }
typedef short v4i16_t __attribute__((ext_vector_type(4)));
__device__ __forceinline__ v2u vtr(const LAS bf16* p) { return __builtin_bit_cast(v2u, __builtin_amdgcn_ds_read_tr16_b64_v4i16((LAS v4i16_t*)p)); }
__device__ __forceinline__ float wave_sum(float v) {
#pragma unroll
    for (int o = 1; o < 64; o <<= 1) v += __shfl_xor(v, o);
    return v;
}
__device__ __forceinline__ float gelu1(float v) { const pg8::f32x2 r = pg8::gelu_pk((pg8::f32x2){v, 0.f}); return r.x; }
__device__ __forceinline__ void rope_cs(float pos, int e, float& c, float& s) {
    const float inv = exp2f(-(float)e * (0.125f * 18.931568569324174f));
    const float ang = pos * inv;
    const float k = rintf(ang * 0.15915494309189535f);
    float r = fmaf(-k, 6.28125f, ang);
    r = fmaf(-k, 0.0019353071795864769f, r);
    s = __sinf(r); c = __cosf(r);
}

#define XB_TMO      128
#define XB_XCNT(j)  (256  + 64 * (j))
#define XB_XSUB(j)  (1280 + 64 * (j))
#define XB_XGEN(j)  (2304 + 64 * (j))
#define XB_TOP      3328
#define XB_TOPGEN   3392
#define XCD_BAR_WORDS 3456
#define XB_SPIN_CAP (1u << 18)

__device__ __forceinline__ unsigned xb_ld(unsigned* p)              { return __hip_atomic_load(p, __ATOMIC_RELAXED, __HIP_MEMORY_SCOPE_AGENT); }
__device__ __forceinline__ unsigned xb_add(unsigned* p, unsigned v) { return __hip_atomic_fetch_add(p, v, __ATOMIC_RELAXED, __HIP_MEMORY_SCOPE_AGENT); }
__device__ __forceinline__ unsigned xb_xcc_id() { return (unsigned)__builtin_amdgcn_s_getreg((3 << 11) | 20) & 0xFu; }
#define XB_SPIN(cond, bar) do { unsigned _sp = 0; while (cond) { __builtin_amdgcn_s_sleep(1); \
    if ((++_sp & 255u) == 0u) { if (xb_ld(&(bar)[XB_TMO])) break; if (_sp > XB_SPIN_CAP) { atomicAdd(&(bar)[XB_TMO], 1u); break; } } } } while (0)

struct XcdBarrier {
    unsigned* bar; unsigned x; int w0;
    volatile LAS unsigned* st;
};

__device__ __forceinline__ XcdBarrier xcd_barrier_post(unsigned* bar, volatile LAS unsigned* st) {
    XcdBarrier b; b.bar = bar; b.x = xb_xcc_id(); b.st = st; b.w0 = __builtin_amdgcn_readfirstlane((int)threadIdx.x >> 6);
    if (threadIdx.x == 0) (void)xb_add(&bar[XB_XCNT(b.x)], 1u);
    return b;
}
__device__ __forceinline__ void xcd_barrier_complete(unsigned* bar, unsigned x, unsigned& nloc, unsigned& nx) {
    const unsigned G = gridDim.x * gridDim.y * gridDim.z;
    unsigned sum, cnt, mine, sp = 0u;
    for (;;) {
        sum = 0u; cnt = 0u; mine = 0u;
#pragma unroll
        for (unsigned j = 0; j < 16; ++j) { const unsigned c = xb_ld(&bar[XB_XCNT(j)]); sum += c; cnt += (c > 0u) ? 1u : 0u; mine = (j == x) ? c : mine; }
        if (sum == G) break;
        __builtin_amdgcn_s_sleep(1);
        if ((++sp & 255u) == 0u) { if (xb_ld(&bar[XB_TMO])) break; if (sp > XB_SPIN_CAP) { atomicAdd(&bar[XB_TMO], 1u); break; } }
    }
    nloc = mine > 0u ? mine : 1u; nx = cnt > 0u ? cnt : 1u;
}

__device__ __forceinline__ void xcd_barrier(const XcdBarrier& b) {
    asm volatile("s_waitcnt vmcnt(0)" ::: "memory");
    __syncthreads();
    if (threadIdx.x == 0) {
        unsigned* bar = b.bar;
        __builtin_amdgcn_s_waitcnt(0);
        unsigned nloc = b.st[0], nx = b.st[1];
        if (nloc == 0u) { xcd_barrier_complete(bar, b.x, nloc, nx); b.st[0] = nloc; b.st[1] = nx; }
        const unsigned old = xb_add(&bar[XB_XSUB(b.x)], 1u);
        const unsigned gen = old / nloc;
        if (old + 1u == (gen + 1u) * nloc) {
            __builtin_amdgcn_fence(__ATOMIC_RELEASE, "agent");
            asm volatile("s_waitcnt vmcnt(0)" ::: "memory");
            const unsigned og = xb_add(&bar[XB_TOP], 1u);
            const unsigned tg = og / nx;
            if (og + 1u == (tg + 1u) * nx) xb_add(&bar[XB_TOPGEN], 1u);
            else XB_SPIN(xb_ld(&bar[XB_TOPGEN]) == tg, bar);
            __builtin_amdgcn_fence(__ATOMIC_ACQUIRE, "agent");
            xb_add(&bar[XB_XGEN(b.x)], 1u);
            asm volatile("s_waitcnt vmcnt(0)" ::: "memory");
        } else {
            XB_SPIN(xb_ld(&bar[XB_XGEN(b.x)]) == gen, bar);
            __builtin_amdgcn_fence(__ATOMIC_ACQUIRE, "agent");
            asm volatile("s_waitcnt vmcnt(0)" ::: "memory");
        }
    }
    __syncthreads();
}

__device__ __forceinline__ void transpose_item(const float* W, const float* gain, int ldn, int nblk, bf16* WT, int ldk, int koff, LAS float* scr, int item, int lane) {
    const int kb = item / nblk, nb = item % nblk, k0 = 64 * kb, n0 = 32 * nb;
    float wv[32];
#pragma unroll
    for (int i = 0; i < 32; ++i) wv[i] = __builtin_nontemporal_load(W + (size_t)(k0 + 2 * i + (lane >> 5)) * ldn + n0 + (lane & 31));
    if (gain) {
#pragma unroll
        for (int i = 0; i < 32; ++i) wv[i] *= gain[k0 + 2 * i + (lane >> 5)]; }
#pragma unroll
    for (int i = 0; i < 32; ++i) scr[(2 * i + (lane >> 5)) * 33 + (lane & 31)] = wv[i];
    asm volatile("s_waitcnt lgkmcnt(0)" ::: "memory");
    const int c = lane & 7;
#pragma unroll
    for (int j = 0; j < 4; ++j) { const int n = (lane >> 3) + 8 * j; const LAS float* s = scr + (8 * c) * 33 + n;
        v4u o; o.x = pk2(s[0 * 33], s[1 * 33]); o.y = pk2(s[2 * 33], s[3 * 33]); o.z = pk2(s[4 * 33], s[5 * 33]); o.w = pk2(s[6 * 33], s[7 * 33]);
        *(v4u*)(WT + (size_t)(n0 + n) * ldk + koff + k0 + 8 * c) = o; }
    asm volatile("s_waitcnt lgkmcnt(0)" ::: "memory");
}
__device__ __forceinline__ void rms_row(const float* xrow, const float* g, bf16* orow, int lane) {
    const f32x4* xr = (const f32x4*)xrow + lane; const f32x4* gr = (const f32x4*)g + lane;
    f32x4 v[4]; float s = 0.f;
#pragma unroll
    for (int j = 0; j < 4; ++j) { v[j] = xr[64 * j]; s += (v[j].x * v[j].x + v[j].y * v[j].y) + (v[j].z * v[j].z + v[j].w * v[j].w); }
    const float rs = rsqrtf(wave_sum(s) * (1.f / 1024.f) + EPS);
    unsigned long long* o8 = (unsigned long long*)orow + lane;
#pragma unroll
    for (int j = 0; j < 4; ++j) { const f32x4 gg = gr[64 * j];
        o8[64 * j] = (unsigned long long)pk2(v[j].x * rs * gg.x, v[j].y * rs * gg.y) | ((unsigned long long)pk2(v[j].z * rs * gg.z, v[j].w * rs * gg.w) << 32); }
}
__device__ __forceinline__ void xb_row(const float* xrow, bf16* orow, float* ss, int lane) {
    const f32x4* xr = (const f32x4*)xrow + lane;
    f32x4 v[4]; float s = 0.f;
#pragma unroll
    for (int j = 0; j < 4; ++j) { v[j] = xr[64 * j]; s += (v[j].x * v[j].x + v[j].y * v[j].y) + (v[j].z * v[j].z + v[j].w * v[j].w); }
    s = wave_sum(s);
    unsigned long long* o8 = (unsigned long long*)orow + lane;
#pragma unroll
    for (int j = 0; j < 4; ++j) o8[64 * j] = (unsigned long long)pk2(v[j].x, v[j].y) | ((unsigned long long)pk2(v[j].z, v[j].w) << 32);
    if (lane == 0) *ss = s;
}

struct TItem { const float* W; int ldn, nblk, nitems; bf16* WT; int ldk, koff; };

__device__ __forceinline__ void prologue(const Params& p, LAS unsigned char* lds, int gw, int ngw, int wave, int lane) {
    unsigned char* ws = p.ws;
    LAS float* scr = (LAS float*)(lds + wave * 16384);
#define TR(Wp, gn_, K_, N_, ldn_, dst_, ldk_, koff_) do { const int nblk_ = (N_) / 32, nit_ = ((K_) / 64) * nblk_; \
        for (int it = gw; it < nit_; it += ngw) transpose_item((Wp), (gn_), (ldn_), nblk_, (bf16*)(dst_), (ldk_), (koff_), scr, it, lane); } while (0)
    const float* nog = nullptr;
    TR(p.in[I_ABWIN], p.in[I_LNMIX], 1024, 1536, 1536, ws + W_WIN, 1024, 0);
    TR(p.in[I_ABWOUT], nog, 512, 1024, 1024, ws + W_WOUT, 1024, 0);
    TR(p.in[I_CWQKV], p.in[I_LNMIX] + D, 1024, 1536, 1536, ws + W_WQKV, 1024, 0);
    TR(p.in[I_CWO], nog, 1024, 1024, 1024, ws + W_CWO, 1024, 0);
#pragma unroll 1
    for (int l = 0; l < 2; ++l) {
        unsigned char* wl = ws + W_LAYER + l * WL_SIZE;
        TR(p.in[I_MWQ] + (size_t)l * 1024 * 512, p.in[I_LNMEM] + l * D, 1024, 512, 512, wl + WL_WQ, 1024, 0);
        TR(p.in[I_MWKV] + (size_t)l * 1024 * 1024, nog, 1024, 1024, 1024, wl + WL_WKV, 1024, 0);
        TR(p.in[I_MWO] + (size_t)l * 512 * 1024, nog, 512, 1024, 1024, wl + WL_WO, 512, 0);
        TR(p.in[I_FWUP] + (size_t)l * 1024 * 2 * DFF, p.in[I_LNFFN] + l * D, 1024, 2 * DFF, 2 * DFF, wl + WL_WUP, 1024, 0);
        TR(p.in[I_FWDN] + (size_t)l * DFF * 1024, nog, DFF, 1024, 1024, wl + WL_WDN, DFF, 0);
    }
#undef TR
    {
        const float* pw = p.in[I_ABPW]; const float* ps = p.in[I_ABPS]; const float* wo = p.in[I_ABWOUT] + (size_t)512 * 1024;
        bf16* WT = (bf16*)(ws + W_WOUT);
        const int gt = gw * 64 + lane, ngt = ngw * 64;
        for (int o = gt; o < 128 * 1024; o += ngt) {
            const int n = o & 1023, d = o >> 10;
            float a[4] = {0.f, 0.f, 0.f, 0.f};
#pragma unroll 4
            for (int e = 0; e < 128; ++e) {
#pragma unroll
                for (int g = 0; g < 4; ++g) a[g] += pw[((size_t)g * 128 + d) * 128 + e] * ps[g * 128 + e] * wo[((size_t)g * 128 + e) * 1024 + n]; }
#pragma unroll
            for (int g = 0; g < 4; ++g) WT[(size_t)n * 1024 + 512 + g * 128 + d] = (bf16)f2bf(a[g]); }
    }
    for (int m0 = gw * 4; m0 < MT; m0 += ngw * 4) {
        f32x4 v[4][4];
#pragma unroll
        for (int r = 0; r < 4; ++r) { const int m = m0 + r; const f32x4* xr = (const f32x4*)(m < MP ? p.in[I_XP] + (size_t)m * D : p.in[I_XS] + (size_t)(m - MP) * D) + lane;
#pragma unroll
            for (int j = 0; j < 4; ++j) v[r][j] = __builtin_nontemporal_load(xr + 64 * j); }
#pragma unroll
        for (int r = 0; r < 4; ++r) { const int m = m0 + r; float sq = 0.f;
#pragma unroll
            for (int j = 0; j < 4; ++j) sq += (v[r][j].x * v[r][j].x + v[r][j].y * v[r][j].y) + (v[r][j].z * v[r][j].z + v[r][j].w * v[r][j].w);
            sq = wave_sum(sq);
            unsigned long long* o8 = (unsigned long long*)((bf16*)(ws + W_XN) + (size_t)m * D) + lane;
#pragma unroll
            for (int j = 0; j < 4; ++j) o8[64 * j] = (unsigned long long)pk2(v[r][j].x, v[r][j].y) | ((unsigned long long)pk2(v[r][j].z, v[r][j].w) << 32);
            if (lane == 0) ((float*)(ws + W_SS))[m] = sq; }
    }
    for (int o = gw * 64 + lane; o < 5 * MT; o += ngw * 64) ((float*)(ws + W_SS))[MT + o] = 0.f;
    for (int m = gw; m < 2048; m += ngw) { const int l = m >> 10, r = m & 1023;
        rms_row(p.in[I_MEMP] + (size_t)r * D, p.in[I_LNMEMKV] + l * D, (bf16*)(ws + W_MN) + (size_t)m * D, lane); }
}

constexpr int SG_VS = 520;
template <int W> __device__ __forceinline__ void pool_block(const float (&prev)[16], const float (&cur)[16], float (&o)[16], int t0, bool clampcnt) {
#pragma unroll
    for (int k = 0; k < 16; ++k) { float s = 0.f;
#pragma unroll
        for (int kk = 0; kk < W; ++kk) s += (k - kk >= 0) ? cur[(k - kk) & 15] : prev[(16 + k - kk) & 15];
        float inv = 1.f / (float)W;
        if (clampcnt) { const int t1 = t0 + k + 1; if (t1 < W) inv = __builtin_amdgcn_rcpf((float)t1); }
        o[k] = s * inv - cur[k]; }
}
__device__ __forceinline__ void pool_dispatch(int gi, const float (&prev)[16], const float (&cur)[16], float (&o)[16], int t0, bool clampcnt) {
    if (gi == 0) pool_block<2>(prev, cur, o, t0, clampcnt); else if (gi == 1) pool_block<4>(prev, cur, o, t0, clampcnt);
    else if (gi == 2) pool_block<8>(prev, cur, o, t0, clampcnt); else pool_block<16>(prev, cur, o, t0, clampcnt);
}

__device__ __forceinline__ void sgu_prompt_unit(const Params& p, LAS unsigned char* lds, int unit, int tid, int wave, int lane) {
    const bf16* PROJ = (const bf16*)(p.ws + W_PROJ); bf16* AO = (bf16*)(p.ws + W_AO);
    LAS bf16* Vn = (LAS bf16*)lds;
    const int b = unit >> 6, ch = unit & 63; const size_t r0 = (size_t)b * 8192 + ch * 128;
    {
        float gn[8]; pg8::ld8f(p.in[I_ABVG] + 8 * lane, gn);
        v4u raw[16];
#pragma unroll
        for (int jj = 0; jj < 16; ++jj) raw[jj] = *(const v4u*)(PROJ + (r0 + wave + 8 * jj) * 1536 + 512 + 8 * lane);
#pragma unroll
        for (int jj = 0; jj < 16; ++jj) { const int j = wave + 8 * jj;
            float x[8]; unpack8(raw[jj], x);
            float s = 0.f;
#pragma unroll
            for (int e = 0; e < 8; ++e) s += x[e];
            const float mean = wave_sum(s) * (1.f / 512.f); float q = 0.f;
#pragma unroll
            for (int e = 0; e < 8; ++e) { x[e] -= mean; q += x[e] * x[e]; }
            const float rstd = rsqrtf(wave_sum(q) * (1.f / 512.f) + EPS);
#pragma unroll
            for (int e = 0; e < 8; ++e) x[e] *= rstd * gn[e];
            *(LAS bf16x8*)(Vn + j * SG_VS + 8 * lane) = pack8(x); }
    }
    __syncthreads();
    {
        const int q16 = lane & 15, kq = lane >> 4, nch = (wave >> 1) + 1; int i = 16 * wave + q16;
#pragma unroll 1
        for (int g = 0; g < 4; ++g) {
            asm volatile("" : "+v"(i));
            f32x4 acc[8];
#pragma unroll
            for (int dt = 0; dt < 8; ++dt) acc[dt] = (f32x4){0.f, 0.f, 0.f, 0.f};
            const float* wsr = p.in[I_ABWS] + ((size_t)g * 128 + i) * 128;
            float wva[4][8]; v2u uu8[8];
#pragma unroll
            for (int c = 0; c < 4; ++c) pg8::ld8f(wsr + 32 * c + 8 * kq, wva[c]);
#pragma unroll
            for (int dt = 0; dt < 8; ++dt) uu8[dt] = *(const v2u*)(PROJ + (r0 + i) * 1536 + g * 128 + 16 * dt + 4 * kq);
#pragma unroll
            for (int c = 0; c < 4; ++c) if (c < nch) {
                float (&wv)[8] = wva[c];
#pragma unroll
                for (int e = 0; e < 8; ++e) if (32 * c + 8 * kq + e > i) wv[e] = 0.f;
                const bf16x8 bfrag = pack8(wv);
#pragma unroll
                for (int dt = 0; dt < 8; ++dt) { const LAS bf16* vp = Vn + (32 * c + 8 * kq + (q16 >> 2)) * SG_VS + g * 128 + 16 * dt + 4 * (q16 & 3);
                    const v2u lo = vtr(vp), hi = vtr(vp + 4 * SG_VS);
                    v4u av; av.x = lo.x; av.y = lo.y; av.z = hi.x; av.w = hi.y;
                    acc[dt] = __builtin_amdgcn_mfma_f32_16x16x32_bf16(__builtin_bit_cast(bf16x8, av), bfrag, acc[dt], 0, 0, 0); }
            }
            const float bs = p.in[I_ABBS][g * 128 + i];
#pragma unroll
            for (int dt = 0; dt < 8; ++dt) { const v2u uu = uu8[dt];
                const float o0 = bflo(uu.x) * (acc[dt][0] + bs), o1 = bfhi(uu.x) * (acc[dt][1] + bs), o2 = bflo(uu.y) * (acc[dt][2] + bs), o3 = bfhi(uu.y) * (acc[dt][3] + bs);
                v2u w; w.x = pk2(o0, o1); w.y = pk2(o2, o3);
                *(v2u*)(AO + (r0 + i) * 1024 + g * 128 + 16 * dt + 4 * kq) = w; }
        }
    }
    {
        const int c = tid, gi = c >> 7;
        const bf16* pp = PROJ + 1024 + c;
        float prev[16], cur[16], o[16];
#pragma unroll
        for (int k = 0; k < 16; ++k) prev[k] = (ch > 0) ? bf1(pp[(r0 - 16 + k) * 1536]) : 0.f;
        bf16 nxt[16];
#pragma unroll
        for (int k = 0; k < 16; ++k) nxt[k] = pp[(r0 + k) * 1536];
#pragma unroll 1
        for (int blk = 0; blk < 8; ++blk) {
#pragma unroll
            for (int k = 0; k < 16; ++k) cur[k] = bf1(nxt[k]);
            if (blk < 7) {
#pragma unroll
                for (int k = 0; k < 16; ++k) nxt[k] = pp[(r0 + 16 * (blk + 1) + k) * 1536]; }
            pool_dispatch(gi, prev, cur, o, ch * 128 + 16 * blk, ch == 0 && blk == 0);
#pragma unroll
            for (int k = 0; k < 16; ++k) AO[(r0 + 16 * blk + k) * 1024 + 512 + c] = (bf16)f2bf(o[k]);
            if (ch == 63 && blk == 7) {
#pragma unroll
                for (int k = 1; k < 16; ++k) p.out[O_POOLP + ((size_t)b * 15 + (k - 1)) * 512 + c] = cur[k]; }
#pragma unroll
            for (int k = 0; k < 16; ++k) prev[k] = cur[k];
        }
    }
    __syncthreads();
}

__device__ __forceinline__ void sgu_sample_unit(const Params& p, LAS unsigned char* lds, int b, int tid, int wave, int lane) {
    const bf16* PROJ = (const bf16*)(p.ws + W_PROJ); bf16* AO = (bf16*)(p.ws + W_AO);
    LAS float* red = (LAS float*)lds;
    const int c = tid, g = c >> 7; const size_t rs = (size_t)MP + 8 * b;
    float x[8], st[16];
#pragma unroll
    for (int j = 0; j < 8; ++j) { x[j] = bf1(PROJ[(rs + j) * 1536 + 512 + c]); st[j] = wave_sum(x[j]); st[8 + j] = wave_sum(x[j] * x[j]); }
    if (lane == 0) {
#pragma unroll
        for (int j = 0; j < 16; ++j) red[wave * 16 + j] = st[j]; }
    __syncthreads();
    float v[8]; const float gn = p.in[I_ABVG][c];
#pragma unroll
    for (int j = 0; j < 8; ++j) { float s = 0.f, q = 0.f;
#pragma unroll
        for (int w = 0; w < 8; ++w) { s += red[w * 16 + j]; q += red[w * 16 + 8 + j]; }
        const float mean = s * (1.f / 512.f), var = fmaxf(q * (1.f / 512.f) - mean * mean, 0.f);
        v[j] = (x[j] - mean) * rsqrtf(var + EPS) * gn;
        p.out[O_CHV + ((size_t)b * 8 + j) * 512 + c] = v[j]; }
    const float* wsg = p.in[I_ABWS] + (size_t)g * 128 * 128;
#pragma unroll
    for (int i = 0; i < 8; ++i) { float sg = p.in[I_ABBS][g * 128 + i];
#pragma unroll
        for (int j = 0; j < 8; ++j) if (j <= i) sg += wsg[i * 128 + j] * v[j];
        AO[(rs + i) * 1024 + c] = (bf16)f2bf(bf1(PROJ[(rs + i) * 1536 + c]) * sg); }
    float pe[24];
    pe[0] = 0.f;
#pragma unroll
    for (int k = 0; k < 15; ++k) pe[1 + k] = p.in[I_CPOOL][((size_t)b * 15 + k) * 512 + c];
#pragma unroll
    for (int i = 0; i < 8; ++i) pe[16 + i] = bf1(PROJ[(rs + i) * 1536 + 1024 + c]);
    const int W = 2 << g; const float invW = __builtin_amdgcn_rcpf((float)W);
#pragma unroll
    for (int i = 0; i < 8; ++i) { float s = 0.f;
#pragma unroll
        for (int kk = 0; kk < 16; ++kk) if (kk < W) s += pe[16 + i - kk];
        AO[(rs + i) * 1024 + 512 + c] = (bf16)f2bf(s * invW - pe[16 + i]); }
#pragma unroll
    for (int k = 0; k < 15; ++k) p.out[O_POOLS + ((size_t)b * 15 + k) * 512 + c] = pe[9 + k];
    __syncthreads();
}

constexpr int SWA_KS = 72, SWA_VS = 72, SWA_VOFF = 256 * SWA_KS * 2;
template <bool SAMPLE>
__device__ __forceinline__ void swa_unit(const Params& p, LAS unsigned char* lds, int unit, int tid, int wave, int lane) {
    const bf16* Q = (const bf16*)(p.ws + W_PROJ); const float* KV = (const float*)(p.ws + W_KV32); bf16* AO = (bf16*)(p.ws + W_AO);
    LAS bf16* Kl = (LAS bf16*)lds; LAS bf16* Vt = (LAS bf16*)(lds + SWA_VOFF);
    int b, kvh, nb;
    if (!SAMPLE) { nb = unit & 63; kvh = (unit >> 6) & 3; b = unit >> 8; } else { kvh = unit & 3; b = unit >> 2; nb = 0; }
    constexpr int NKEY = SAMPLE ? 160 : 256;
    {
        const int sub = tid & 7;
        float kg[8]; pg8::ld8f(p.in[I_CKG] + 8 * sub, kg);
        constexpr int NIT = SAMPLE ? 3 : 4;
        float kk[NIT][8], vv[NIT][8];
#pragma unroll
        for (int it = 0; it < NIT; ++it) { const int s = (tid >> 3) + 64 * it;
            const float* kp = nullptr; const float* vp = nullptr;
            if (!SAMPLE) { const int trel = (nb - 1) * 128 + s;
                if (trel >= 0) { kp = KV + ((size_t)b * 8192 + trel) * 512 + kvh * 64 + sub * 8; vp = kp + 256; } }
            else { if (s < 128) { const size_t o = (((size_t)b * 128 + s) * 4 + kvh) * 64 + sub * 8; kp = p.in[I_CSK] + o; vp = p.in[I_CSV] + o; }
                else if (s < 136) { kp = KV + ((size_t)MP + 8 * b + (s - 128)) * 512 + kvh * 64 + sub * 8; vp = kp + 256; } }
            if (kp) { if (SAMPLE) { pg8::ld8f_nt(kp, kk[it]); pg8::ld8f_nt(vp, vv[it]); } else { pg8::ld8f(kp, kk[it]); pg8::ld8f(vp, vv[it]); } } else { pg8::zero8(kk[it]); pg8::zero8(vv[it]); } }
#pragma unroll
        for (int it = 0; it < NIT; ++it) { const int s = (tid >> 3) + 64 * it;
            __builtin_amdgcn_sched_barrier(0);
            if (s < NKEY) {
            bool norm; float pos;
            if (!SAMPLE) { const int trel = (nb - 1) * 128 + s; norm = trel >= 0; pos = (float)trel; }
            else { norm = (s >= 128 && s < 136); pos = (float)(16384 + s - 128); }
            float (&k)[8] = kk[it]; float (&v)[8] = vv[it];
            asm volatile("" : "+v"(pos));
            if (norm) { float ss = 0.f;
#pragma unroll
                for (int e = 0; e < 8; ++e) ss += k[e] * k[e];
                ss += __shfl_xor(ss, 1); ss += __shfl_xor(ss, 2); ss += __shfl_xor(ss, 4);
                const float rs = rsqrtf(ss * (1.f / 64.f) + EPS);
#pragma unroll
                for (int e = 0; e < 8; ++e) k[e] *= rs * kg[e];
#pragma unroll
                for (int e = 0; e < 8; ++e) { const float pk = __shfl_xor(k[e], 1); float cs, sn; rope_cs(pos, e, cs, sn);
                    if (sub == 0) k[e] = k[e] * cs - pk * sn; else if (sub == 1) k[e] = k[e] * cs + pk * sn; }
            }
            *(LAS bf16x8*)(Kl + s * SWA_KS + sub * 8) = pack8(k);
            *(LAS bf16x8*)(Vt + s * SWA_VS + sub * 8) = pack8(v);
            if (!SAMPLE) { if (nb == 63 && s >= 128) { const size_t o = (((size_t)b * 128 + (s - 128)) * 4 + kvh) * 64 + sub * 8;
                    *(f32x4*)(p.out + O_SKP + o) = (f32x4){k[0], k[1], k[2], k[3]}; *(f32x4*)(p.out + O_SKP + o + 4) = (f32x4){k[4], k[5], k[6], k[7]};
                    *(f32x4*)(p.out + O_SVP + o) = (f32x4){v[0], v[1], v[2], v[3]}; *(f32x4*)(p.out + O_SVP + o + 4) = (f32x4){v[4], v[5], v[6], v[7]}; } }
            else { if (s >= 8 && s < 136) { const size_t o = (((size_t)b * 128 + (s - 8)) * 4 + kvh) * 64 + sub * 8;
                    __builtin_nontemporal_store((f32x4){k[0], k[1], k[2], k[3]}, (f32x4*)(p.out + O_SKS + o)); __builtin_nontemporal_store((f32x4){k[4], k[5], k[6], k[7]}, (f32x4*)(p.out + O_SKS + o + 4));
                    __builtin_nontemporal_store((f32x4){v[0], v[1], v[2], v[3]}, (f32x4*)(p.out + O_SVS + o)); __builtin_nontemporal_store((f32x4){v[4], v[5], v[6], v[7]}, (f32x4*)(p.out + O_SVS + o + 4)); } }
            }
        }
    }
    __syncthreads();
    constexpr int NPASS = SAMPLE ? 1 : 4;
    if (!SAMPLE || wave < 2) {
        asm volatile("" : "+v"(lane));
        float rc[8], rsn[8];
        { const int q16 = lane & 15; const float pos0 = SAMPLE ? (float)(16384 + (q16 & 7)) : (float)(nb * 128 + 16 * wave + q16);
#pragma unroll
          for (int e = 0; e < 8; ++e) rope_cs(pos0, e, rc[e], rsn[e]); }
        float qgs[2][8];
        {
#pragma unroll
          for (int dc = 0; dc < 2; ++dc) { pg8::ld8f(p.in[I_CQG] + 32 * dc + 8 * (lane >> 4), qgs[dc]);
#pragma unroll
            for (int e = 0; e < 8; ++e) qgs[dc][e] *= 0.125f; } }
        v4u qraw[2];
        { const int q16 = lane & 15, kq = lane >> 4;
          const size_t row0 = SAMPLE ? (size_t)MP + 8 * b + (q16 & 7) : (size_t)b * 8192 + nb * 128 + 16 * wave + q16;
          const int h0 = kvh * 4 + (SAMPLE ? 2 * wave + (q16 >> 3) : 0);
#pragma unroll
          for (int dc = 0; dc < 2; ++dc) qraw[dc] = *(const v4u*)(Q + row0 * 1024 + h0 * 64 + 32 * dc + 8 * kq); }
#pragma unroll 1
        for (int ps = 0; ps < NPASS; ++ps) {
            int q16 = lane & 15, kq = lane >> 4; asm volatile("" : "+v"(q16), "+v"(kq));
            int g, i, c0; size_t row; float pos;
            if (!SAMPLE) { g = ps; i = 16 * wave + q16; row = (size_t)b * 8192 + nb * 128 + i; pos = (float)(nb * 128 + i); c0 = wave >> 1; }
            else { g = 2 * wave + (q16 >> 3); i = q16 & 7; row = (size_t)MP + 8 * b + i; pos = (float)(16384 + i); c0 = 0; }
            const int h = kvh * 4 + g;
            float qv[2][8];
#pragma unroll
            for (int dc = 0; dc < 2; ++dc) unpack8(qraw[dc], qv[dc]);
            if (!SAMPLE && ps + 1 < NPASS) {
#pragma unroll
                for (int dc = 0; dc < 2; ++dc) qraw[dc] = *(const v4u*)(Q + row * 1024 + (h + 1) * 64 + 32 * dc + 8 * kq); }
            float ss = 0.f;
#pragma unroll
            for (int dc = 0; dc < 2; ++dc)
#pragma unroll
                for (int e = 0; e < 8; ++e) ss += qv[dc][e] * qv[dc][e];
            ss += __shfl_xor(ss, 16); ss += __shfl_xor(ss, 32);
            const float rs = rsqrtf(ss * (1.f / 64.f) + EPS);
#pragma unroll
            for (int dc = 0; dc < 2; ++dc) {
#pragma unroll
                for (int e = 0; e < 8; ++e) qv[dc][e] *= rs * qgs[dc][e]; }
#pragma unroll
            for (int e = 0; e < 8; ++e) { const float pk = __shfl_xor(qv[0][e], 16); const float cs = rc[e], sn = rsn[e];
                if (kq == 0) qv[0][e] = qv[0][e] * cs - pk * sn; else if (kq == 1) qv[0][e] = qv[0][e] * cs + pk * sn; }
            bf16x8 qf[2];
#pragma unroll
            for (int dc = 0; dc < 2; ++dc) qf[dc] = pack8(qv[dc]);
            f32x4 S[5][2];
            const float sink = p.in[I_CSINK][h];
            float mx = sink;
#pragma unroll
            for (int cc = 0; cc < 5; ++cc)
#pragma unroll
                for (int tt = 0; tt < 2; ++tt) { const int kb = 32 * (c0 + cc) + 16 * tt; f32x4 a = (f32x4){0.f, 0.f, 0.f, 0.f};
#pragma unroll
                    for (int dc = 0; dc < 2; ++dc) { const bf16x8 kf = *(const LAS bf16x8*)(Kl + (kb + q16) * SWA_KS + 32 * dc + 8 * kq);
                        a = __builtin_amdgcn_mfma_f32_16x16x32_bf16(kf, qf[dc], a, 0, 0, 0); }
                    const int rel = (kb >> 4) - wave;
                    const bool full = !SAMPLE && rel >= 1 && rel <= 7 && (nb > 0 || kb >= 128);
                    if (!full) {
#pragma unroll
                        for (int e = 0; e < 4; ++e) { const int s = kb + 4 * kq + e; const bool ok = (s > i) && (s <= i + 128) && (SAMPLE || nb > 0 || s >= 128);
                            a[e] = ok ? a[e] : -INFINITY; } }
#pragma unroll
                    for (int e = 0; e < 4; ++e) mx = fmaxf(mx, a[e]);
                    S[cc][tt] = a; }
            mx = fmaxf(mx, __shfl_xor(mx, 16)); mx = fmaxf(mx, __shfl_xor(mx, 32));
            float den = 0.f;
#pragma unroll
            for (int cc = 0; cc < 5; ++cc)
#pragma unroll
                for (int tt = 0; tt < 2; ++tt)
#pragma unroll
                    for (int e = 0; e < 4; ++e) { const float pe = __expf(S[cc][tt][e] - mx); S[cc][tt][e] = pe; den += pe; }
            den += __shfl_xor(den, 16); den += __shfl_xor(den, 32);
            den += __expf(sink - mx);
            const float rden = 1.f / den;
            bf16x8 pf[5];
#pragma unroll
            for (int cc = 0; cc < 5; ++cc) { float t8[8];
#pragma unroll
                for (int e = 0; e < 4; ++e) { t8[e] = S[cc][0][e]; t8[4 + e] = S[cc][1][e]; }
                pf[cc] = pack8(t8); }
#pragma unroll
            for (int dt = 0; dt < 4; ++dt) { f32x4 o = (f32x4){0.f, 0.f, 0.f, 0.f};
#pragma unroll
                for (int cc = 0; cc < 5; ++cc) { const LAS bf16* vp = Vt + (32 * (c0 + cc) + 4 * kq + (q16 >> 2)) * SWA_VS + 16 * dt + 4 * (q16 & 3);
                    const v2u lo = vtr(vp), hi = vtr(vp + 16 * SWA_VS);
                    v4u av; av.x = lo.x; av.y = lo.y; av.z = hi.x; av.w = hi.y;
                    o = __builtin_amdgcn_mfma_f32_16x16x32_bf16(__builtin_bit_cast(bf16x8, av), pf[cc], o, 0, 0, 0); }
                v2u w; w.x = pk2(o[0] * rden, o[1] * rden); w.y = pk2(o[2] * rden, o[3] * rden);
                *(v2u*)(AO + row * 1024 + h * 64 + 16 * dt + 4 * kq) = w; }
        }
    }
    __syncthreads();
}

constexpr int MEM_KS = 136, MEM_VS = 136, MEM_VOFF = 256 * MEM_KS * 2;
static_assert(MEM_VOFF + 256 * MEM_VS * 2 <= LDS_CTL_OFF && 128 * SG_VS * 2 <= LDS_CTL_OFF, "LDS");
template <bool SAMPLE>
__device__ __forceinline__ void mem_unit(const Params& p, int l, LAS unsigned char* lds, int unit, int tid, int wave, int lane) {
    const bf16* MQ = (const bf16*)(p.ws + W_MQ); bf16* MO = (bf16*)(p.ws + W_MO);
    LAS bf16* Kl = (LAS bf16*)lds; LAS bf16* Vt = (LAS bf16*)(lds + MEM_VOFF);
    int b, h, qt;
    if (!SAMPLE) { qt = unit & 15; h = (unit >> 4) & 3; b = unit >> 6; } else { h = unit & 3; b = unit >> 2; qt = 0; }
    {
        const int sub = tid & 15;
        float kg[8]; pg8::ld8f(p.in[I_MKG] + l * 128 + 8 * sub, kg);
#pragma unroll 1
        for (int hb = 0; hb < 2; ++hb) {
            float kk[4][8], vv[4][8];
#pragma unroll
            for (int it = 0; it < 4; ++it) { const int s = (tid >> 4) + 32 * (4 * hb + it);
                const float* kp; const float* vp;
                if (!SAMPLE) { kp = (const float*)(p.ws + W_MKV) + ((size_t)l * 1024 + b * 256 + s) * 1024 + h * 128 + sub * 8; vp = kp + 512; }
                else { const size_t o = ((((size_t)l * 128 + b) * 256 + s) * 4 + h) * 128 + sub * 8; kp = p.in[I_CMK] + o; vp = p.in[I_CMV] + o; }
                if (SAMPLE) { pg8::ld8f_nt(kp, kk[it]); pg8::ld8f_nt(vp, vv[it]); } else { pg8::ld8f(kp, kk[it]); pg8::ld8f(vp, vv[it]); } }
#pragma unroll
            for (int it = 0; it < 4; ++it) { const int s = (tid >> 4) + 32 * (4 * hb + it);
                float (&k)[8] = kk[it]; float (&v)[8] = vv[it];
                if (!SAMPLE) { float ss = 0.f;
#pragma unroll
                    for (int e = 0; e < 8; ++e) ss += k[e] * k[e];
                    ss += __shfl_xor(ss, 1); ss += __shfl_xor(ss, 2); ss += __shfl_xor(ss, 4); ss += __shfl_xor(ss, 8);
                    const float rs = rsqrtf(ss * (1.f / 128.f) + EPS);
#pragma unroll
                    for (int e = 0; e < 8; ++e) k[e] *= rs * kg[e];
                    if (qt == 0) { const size_t o = ((((size_t)l * 4 + b) * 256 + s) * 4 + h) * 128 + sub * 8;
                        *(f32x4*)(p.out + O_MKP + o) = (f32x4){k[0], k[1], k[2], k[3]}; *(f32x4*)(p.out + O_MKP + o + 4) = (f32x4){k[4], k[5], k[6], k[7]};
                        *(f32x4*)(p.out + O_MVP + o) = (f32x4){v[0], v[1], v[2], v[3]}; *(f32x4*)(p.out + O_MVP + o + 4) = (f32x4){v[4], v[5], v[6], v[7]}; }
                }
                *(LAS bf16x8*)(Kl + s * MEM_KS + sub * 8) = pack8(k);
                *(LAS bf16x8*)(Vt + s * MEM_VS + sub * 8) = pack8(v);
            }
        }
    }
    __syncthreads();
    if (!SAMPLE || wave == 0) {
#pragma unroll 1
      for (int qq = 0; qq < (SAMPLE ? 1 : 4); ++qq) {
        int q16 = lane & 15, kq = lane >> 4; asm volatile("" : "+v"(q16), "+v"(kq));
        size_t row; bool st;
        if (!SAMPLE) { row = (size_t)b * 8192 + (qt * 4 + qq) * 128 + 16 * wave + q16; st = true; } else { row = (size_t)MP + 8 * b + (q16 & 7); st = q16 < 8; }
        bf16x8 qf[4];
        {
            float qv[4][8]; float ss = 0.f;
#pragma unroll
            for (int dc = 0; dc < 4; ++dc) { unpack8(*(const v4u*)(MQ + row * 512 + h * 128 + 32 * dc + 8 * kq), qv[dc]);
#pragma unroll
                for (int e = 0; e < 8; ++e) ss += qv[dc][e] * qv[dc][e]; }
            ss += __shfl_xor(ss, 16); ss += __shfl_xor(ss, 32);
            const float rs = rsqrtf(ss * (1.f / 128.f) + EPS) * 0.08838834764831845f;
#pragma unroll
            for (int dc = 0; dc < 4; ++dc) { float qg[8]; pg8::ld8f(p.in[I_MQG] + l * 128 + 32 * dc + 8 * kq, qg);
#pragma unroll
                for (int e = 0; e < 8; ++e) qv[dc][e] *= rs * qg[e];
                qf[dc] = pack8(qv[dc]); }
        }
        f32x4 S[8][2]; float mx = -INFINITY;
#pragma unroll
        for (int cc = 0; cc < 8; ++cc)
#pragma unroll
            for (int tt = 0; tt < 2; ++tt) { const int kb = 32 * cc + 16 * tt; f32x4 a = (f32x4){0.f, 0.f, 0.f, 0.f};
#pragma unroll
                for (int dc = 0; dc < 4; ++dc) { const bf16x8 kf = *(const LAS bf16x8*)(Kl + (kb + q16) * MEM_KS + 32 * dc + 8 * kq);
                    a = __builtin_amdgcn_mfma_f32_16x16x32_bf16(kf, qf[dc], a, 0, 0, 0); }
#pragma unroll
                for (int e = 0; e < 4; ++e) mx = fmaxf(mx, a[e]);
                S[cc][tt] = a; }
        mx = fmaxf(mx, __shfl_xor(mx, 16)); mx = fmaxf(mx, __shfl_xor(mx, 32));
        float den = 0.f;
#pragma unroll
        for (int cc = 0; cc < 8; ++cc)
#pragma unroll
            for (int tt = 0; tt < 2; ++tt)
#pragma unroll
                for (int e = 0; e < 4; ++e) { const float pe = __expf(S[cc][tt][e] - mx); S[cc][tt][e] = pe; den += pe; }
        den += __shfl_xor(den, 16); den += __shfl_xor(den, 32);
        const float rden = 1.f / den;
        bf16x8 pf[8];
#pragma unroll
        for (int cc = 0; cc < 8; ++cc) { float t8[8];
#pragma unroll
            for (int e = 0; e < 4; ++e) { t8[e] = S[cc][0][e]; t8[4 + e] = S[cc][1][e]; }
            pf[cc] = pack8(t8); }
#pragma unroll
        for (int dt = 0; dt < 8; ++dt) { f32x4 o = (f32x4){0.f, 0.f, 0.f, 0.f};
#pragma unroll
            for (int cc = 0; cc < 8; ++cc) { const LAS bf16* vp = Vt + (32 * cc + 4 * kq + (q16 >> 2)) * MEM_VS + 16 * dt + 4 * (q16 & 3);
                const v2u lo = vtr(vp), hi = vtr(vp + 16 * MEM_VS);
                v4u av; av.x = lo.x; av.y = lo.y; av.z = hi.x; av.w = hi.y;
                o = __builtin_amdgcn_mfma_f32_16x16x32_bf16(__builtin_bit_cast(bf16x8, av), pf[cc], o, 0, 0, 0); }
            if (st) { v2u w; w.x = pk2(o[0] * rden, o[1] * rden); w.y = pk2(o[2] * rden, o[3] * rden);
                *(v2u*)(MO + row * 512 + h * 128 + 16 * dt + 4 * kq) = w; } }
      }
    }
    __syncthreads();
}

#ifndef REP_LIGHT
#define REP_LIGHT 1
#endif
#ifndef REP_G9
#define REP_G9 1
#endif
#ifndef REP_G10
#define REP_G10 1
#endif
#ifndef REP_PRO
#define REP_PRO 1
#endif
#ifndef REP_MEM
#define REP_MEM 1
#endif
#ifndef REP_P15
#define REP_P15 1
#endif
#ifndef REP_SYNC
#define REP_SYNC 1
#endif
#define GSYNC() do { for (int r_ = 0; r_ < REP_SYNC; ++r_) xcd_barrier(xbar); } while (0)
#define PHASE_IDS int t_ = threadIdx.x; asm volatile("" : "+v"(t_)); const int tid = t_, lane = tid & 63, wave = __builtin_amdgcn_readfirstlane(tid >> 6); const int gw = bx * NWAVES + wave; (void)gw; (void)lane; (void)tid;
__global__ void __launch_bounds__(NTHR, 2) fwd_megakernel(Params p) {
    extern __shared__ __attribute__((aligned(16))) unsigned char lds_raw[];
    LAS unsigned char* lds = (LAS unsigned char*)lds_raw;
    cg::grid_group grid = cg::this_grid();
    const int G = gridDim.x, bx = blockIdx.x;
    const int wave0 = __builtin_amdgcn_readfirstlane((int)threadIdx.x >> 6);
    const int ngw = G * NWAVES;
    unsigned char* ws = p.ws;
    bf16* XN = (bf16*)(ws + W_XN);
    float* SSb = (float*)(ws + W_SS);
    float* X = p.out;
    typedef pg8::bf16_t pb;

    if (threadIdx.x < 16) ((LAS unsigned*)(lds + LDS_CTL_OFF))[threadIdx.x] = 0u;
    __syncthreads();
    const XcdBarrier xbar = xcd_barrier_post((unsigned*)(ws + W_CTL), (volatile LAS unsigned*)(lds + LDS_CTL_OFF));
    for (int rep = 0; rep < REP_LIGHT * REP_PRO; ++rep) { PHASE_IDS prologue(p, lds, gw, ngw, wave, lane); }
    grid.sync();

    auto layer_body = [&](auto LC) __attribute__((always_inline)) {
        constexpr int l = decltype(LC)::value;
        unsigned char* wl = ws + W_LAYER + (size_t)l * WL_SIZE;
        if (l == 0) {
            { pg8::Gemm g{(const pb*)XN, (const pb*)(ws + W_WIN), MT, 1536, 1024}; pg8::StaticOrder S; S.init(MP, 1536, G, bx);
              pg8::EpiAct E{(pb*)(ws + W_PROJ), 1536, 4, SSb};
              pg8::gemm_phase<pg8::EpiAct, pg8::StaticOrder, true, true>(lds, g, S, E, wave0);
              pg8::mini_gemm<pg8::EpiAct, true>(lds, g.A, g.Bt, 1024, 24, E, bx, G, wave0); }
        } else {
            pg8::Gemm g{(const pb*)XN, (const pb*)(ws + W_WQKV), MT, 1536, 1024}; pg8::StaticOrder S; S.init(MP, 1536, G, bx);
            pg8::EpiQKV E{(pb*)(ws + W_PROJ), (float*)(ws + W_KV32), SSb + (size_t)3 * MT};
            pg8::gemm_phase<pg8::EpiQKV, pg8::StaticOrder, true, true>(lds, g, S, E, wave0);
            pg8::mini_gemm<pg8::EpiQKV, true>(lds, g.A, g.Bt, 1024, 24, E, bx, G, wave0);
        }
        GSYNC();
        if (l == 0) {
#ifndef NO_SGU
            PHASE_IDS
            for (int rep = 0; rep < REP_LIGHT; ++rep)
            for (int u = bx; u < 256 + 128; u += G) { if (u < 256) sgu_prompt_unit(p, lds, u, tid, wave, lane); else sgu_sample_unit(p, lds, u - 256, tid, wave, lane); }
#pragma unroll 1
            for (int ll = 0; ll < 2; ++ll) {
              pg8::EpiRes E{(float*)(ws + W_MKV) + (size_t)ll * 1024 * 1024, nullptr, nullptr, 0, nullptr, nullptr, 0};
              pg8::mini_gemm(lds, (const pb*)(ws + W_MN) + (size_t)ll * 1024 * 1024, (const pb*)(ws + W_LAYER + (size_t)ll * WL_SIZE + WL_WKV), 1024, 8, E, (bx + G - 128 - 64 * ll) % G, G, wave0, 0); }
#endif
        } else {
#ifndef NO_SWA
            PHASE_IDS
            for (int rep = 0; rep < REP_LIGHT; ++rep)
            for (int u = bx; u < 1024 + 512; u += G) { if (u < 1024) swa_unit<false>(p, lds, u, tid, wave, lane); else swa_unit<true>(p, lds, u - 1024, tid, wave, lane); }
#endif
        }
        GSYNC();
        {
            pg8::Gemm g{(const pb*)(ws + W_AO), (const pb*)(ws + (l == 0 ? W_WOUT : W_CWO)), MT, 1024, 1024}; pg8::StaticOrder S; S.init(MP, 1024, G, bx);
            pg8::EpiRes E{nullptr, nullptr, nullptr, 1, (pb*)XN, SSb + (size_t)(1 + 3 * l) * MT, 1};
            pg8::gemm_phase<pg8::EpiRes, pg8::StaticOrder, true, true>(lds, g, S, E, wave0);
            pg8::mini_gemm<pg8::EpiRes, true, true>(lds, g.A, g.Bt, 1024, 16, E, bx, G, wave0);
        }
        GSYNC();
        {
            pg8::Gemm g{(const pb*)XN, (const pb*)(wl + WL_WQ), MT, 512, 1024}; pg8::StaticOrder S; S.init(MP, 512, G, bx);
            pg8::EpiAct E{(pb*)(ws + W_MQ), 512, 0, SSb + (size_t)(1 + 3 * l) * MT};
            pg8::gemm_phase<pg8::EpiAct, pg8::StaticOrder, true, true>(lds, g, S, E, wave0);
            pg8::mini_gemm<pg8::EpiAct, true, true>(lds, g.A, g.Bt, 1024, 8, E, bx, G, wave0);
        }
        GSYNC();
#ifndef NO_MEM
        { PHASE_IDS
        for (int rep = 0; rep < REP_LIGHT * REP_MEM; ++rep)
        for (int u = bx; u < 256 + 512; u += G) { if (u < 256) mem_unit<false>(p, l, lds, u, tid, wave, lane); else mem_unit<true>(p, l, lds, u - 256, tid, wave, lane); } }
#endif
        GSYNC();
        {
            pg8::Gemm g{(const pb*)(ws + W_MO), (const pb*)(wl + WL_WO), MT, 1024, 512}; pg8::StaticOrder S; S.init(MP, 1024, G, bx);
            pg8::EpiRes E{nullptr, nullptr, nullptr, 1, (pb*)XN, SSb + (size_t)(2 + 3 * l) * MT, 1};
            pg8::gemm_phase<pg8::EpiRes, pg8::StaticOrder, true, true>(lds, g, S, E, wave0);
            pg8::mini_gemm<pg8::EpiRes, true, true>(lds, g.A, g.Bt, 512, 16, E, bx, G, wave0);
        }
        GSYNC();
        {
            pg8::Gemm g{(const pb*)XN, (const pb*)(wl + WL_WUP), MT, DFF, 1024}; pg8::SplitOrder S; S.init(DFF, G, bx);
            pg8::EpiG E{(pb*)(ws + W_G), p.out + O_FCP + (size_t)l * 4 * 2 * DFF, p.out + O_FCS + (size_t)l * 128 * 2 * DFF, SSb + (size_t)(2 + 3 * l) * MT};
            for (int rep = 0; rep < REP_G9; ++rep) pg8::gemm_phase<pg8::EpiG, pg8::SplitOrder, true, true>(lds, g, S, E, wave0);
        }
        GSYNC();
        {
            pg8::Gemm g{(const pb*)XN, (const pb*)(wl + WL_WUP) + (size_t)DFF * 1024, MT, DFF, 1024}; pg8::SplitOrder S; S.init(DFF, G, bx);
            pg8::EpiH E{(const pb*)(ws + W_G), (pb*)(ws + W_H), p.in[I_FCW] + (size_t)l * 3 * DFF, p.in[I_FCB] + (size_t)l * DFF, p.in[I_CFC] + (size_t)l * 128 * 2 * DFF, SSb + (size_t)(2 + 3 * l) * MT};
            for (int rep = 0; rep < REP_G10; ++rep) pg8::gemm_phase<pg8::EpiH, pg8::SplitOrder, true, true>(lds, g, S, E, wave0);
        }
        GSYNC();
        {
            pg8::Gemm g{(const pb*)(ws + W_H), (const pb*)(wl + WL_WDN), MT, 1024, DFF}; pg8::StaticOrder S; S.init(MP, 1024, G, bx);
            pg8::EpiRes E{l == 0 ? nullptr : X, nullptr, nullptr, 1, (pb*)XN, SSb + (size_t)3 * MT, l == 0};
            pg8::gemm_phase<pg8::EpiRes, pg8::StaticOrder, true, true>(lds, g, S, E, wave0);
            pg8::mini_gemm<pg8::EpiRes, true, true>(lds, g.A, g.Bt, DFF, 16, E, bx, G, wave0);
        }
        GSYNC();
    };
    layer_body(std::integral_constant<int, 0>{});
    layer_body(std::integral_constant<int, 1>{});
}

extern "C" void kernel_launch(void* const* d_in, const int* in_sizes, int n_in, void* d_out, int out_size, void* d_ws, size_t ws_size, hipStream_t stream) {
    static int grid_blocks = 0;
    if (grid_blocks == 0) {
        if (n_in != N_IN || (size_t)out_size != O_END || ws_size < W_NEED) { fprintf(stderr, "kernel_launch: unexpected shapes: n_in %d out %d ws %zu (need %zu)\n", n_in, out_size, ws_size, (size_t)W_NEED); grid_blocks = -1; return; }
        int dev = 0, cus = 0, per_cu = 0;
        hipGetDevice(&dev);
        hipDeviceGetAttribute(&cus, hipDeviceAttributeMultiprocessorCount, dev);
        if (hipFuncSetAttribute((const void*)fwd_megakernel, hipFuncAttributeMaxDynamicSharedMemorySize, LDS_BYTES) != hipSuccess) { fprintf(stderr, "kernel_launch: hipFuncSetAttribute failed\n"); grid_blocks = -1; return; }
        if (hipOccupancyMaxActiveBlocksPerMultiprocessor(&per_cu, (const void*)fwd_megakernel, NTHR, LDS_BYTES) != hipSuccess || per_cu < 1) { fprintf(stderr, "kernel_launch: occupancy query failed (%d)\n", per_cu); (void)hipGetLastError(); grid_blocks = -1; return; }
        grid_blocks = cus * per_cu;
    }
    if (grid_blocks < 0) return;
    if (hipMemsetAsync((char*)d_ws + W_CTL, 0, CTL_BYTES, stream) != hipSuccess) { fprintf(stderr, "kernel_launch: memset failed\n"); return; }
    Params p{};
    for (int i = 0; i < N_IN; ++i) p.in[i] = (const float*)d_in[i];
    p.out = (float*)d_out; p.ws = (unsigned char*)d_ws;
    void* args[] = {&p};
    hipError_t e = hipLaunchCooperativeKernel((const void*)fwd_megakernel, dim3(grid_blocks), dim3(NTHR), args, LDS_BYTES, stream);
    if (e != hipSuccess) fprintf(stderr, "cooperative launch failed: %s (grid %d)\n", hipGetErrorString(e), grid_blocks);
}
```

```cpp
#include <hip/hip_runtime.h>
#include <hip/hip_cooperative_groups.h>
#include <cstdio>
#include <cstdint>
#include <type_traits>
namespace cg = cooperative_groups;
namespace pg8 {
#define PG8_LAS __attribute__((address_space(3)))
typedef unsigned short bf16_t;
typedef short bf16x8 __attribute__((ext_vector_type(8)));
typedef float f32x4 __attribute__((ext_vector_type(4)));
typedef unsigned u32x4 __attribute__((ext_vector_type(4)));
constexpr int BM = 256, BK = 64, HALF = 128, HTB = HALF * BK * 2  , STAGE_BYTES = 8 * HTB, NXCD = 8, WGM = 8;

__host__ __device__ __forceinline__ int lds_byte(int r, int c) { const int st = (r >> 4) * 2 + (c >> 5), rr = r & 15, cc = c & 31, ob = rr * 64 + cc * 2; return st * 1024 + (ob ^ (((ob >> 9) & 1) << 5)); }
__host__ __device__ __forceinline__ void stage_rc(int b, int& R, int& C) { const int st = b / 1024, sb = b % 1024, swz = sb ^ (((sb >> 9) & 1) << 5); R = (st >> 1) * 16 + swz / 64; C = (st & 1) * 32 + (swz % 64) / 2; }
__host__ __device__ __forceinline__ int perm32(int rho) { const int n = rho >> 4, i = rho & 15; return 8 * (i >> 2) + 4 * n + (i & 3); }

struct Unit { int pm, pn; int rb; int half; int q; int cb; };
struct Gemm { const bf16_t* A; const bf16_t* Bt; int M, N, K; };

struct StaticOrder {
    int nM, nN, nwg, G, c;
    __host__ __device__ void init(int M, int N, int G_, int c_) { nM = M / BM; nN = N / BM; nwg = nM * nN; G = G_; c = c_; }
    __host__ __device__ bool next(int i, Unit& u) const {
        const long L = (long)i * G + c; if (L >= nwg) return false;
        int wgid = (int)L; { const int q = nwg / NXCD, r = nwg % NXCD, xcd = wgid % NXCD, off = wgid / NXCD; wgid = (xcd < r ? xcd * (q + 1) : r * (q + 1) + (xcd - r) * q) + off; }
        const int nig = WGM * nN, gid = wgid / nig, fm = gid * WGM, gsz = (nM - fm) < WGM ? (nM - fm) : WGM;
        u.pm = fm + ((wgid % nig) % gsz); u.pn = (wgid % nig) / gsz; u.rb = u.pm * BM; u.half = 0; u.q = 0; u.cb = u.pn * BM; return true;
    }
    __device__ __forceinline__ void a_ready(const Unit&) const {}
    __device__ __forceinline__ void done(const Unit&) const {}
};
struct SplitOrder {
    StaticOrder P; int nP, nS, nN, G, c;
    __host__ __device__ void init(int N, int G_, int c_) { P.init(32768, N, G_, c_); nP = P.nwg; nN = N / BM; nS = 8 * nN; G = G_; c = c_; }
    __host__ __device__ bool next(int i, Unit& u) const {
        const long L = (long)i * G + c;
        if (L < nP) return P.next(i, u);
        const int j = (int)(L - nP); if (j >= nS) return false;
        const int hm = j & 7; u.pn = j >> 3; u.pm = 128 + (hm >> 1); u.rb = 32768 + 128 * hm; u.half = 1; u.q = 0; u.cb = u.pn * BM; return true;
    }
    __device__ __forceinline__ void a_ready(const Unit&) const {}
    __device__ __forceinline__ void done(const Unit&) const {}
};


__device__ __forceinline__ unsigned cvt_pk_bf16(float lo, float hi) { unsigned r; asm volatile("v_cvt_pk_bf16_f32 %0, %1, %2" : "=v"(r) : "v"(lo), "v"(hi)); return r; }
typedef float f32x2 __attribute__((ext_vector_type(2)));
__device__ __forceinline__ f32x2 gelu_pk(f32x2 v) {
    f32x2 x = v * 0.70710678118f;
    x.x = __builtin_amdgcn_fmed3f(x.x, -2.9f, 2.9f); x.y = __builtin_amdgcn_fmed3f(x.y, -2.9f, 2.9f);
    const f32x2 t = x * x;
    f32x2 p = t * (-4.953124630e-07f) + 1.987094038e-05f;
    p = p * t + (-3.472001117e-04f); p = p * t + 3.517547622e-03f; p = p * t + (-2.333305031e-02f); p = p * t + 1.087993085e-01f; p = p * t + (-3.740358949e-01f); p = p * t + 1.128076553e+00f;
    const f32x2 hv = v * 0.5f;
    return hv * (x * p) + hv;
}

__device__ __forceinline__ float bf_lo(unsigned w) { return __builtin_bit_cast(float, w << 16); }
__device__ __forceinline__ float bf_hi(unsigned w) { return __builtin_bit_cast(float, w & 0xffff0000u); }
__device__ __forceinline__ void ld8bf(const bf16_t* p, float (&o)[8]) { const u32x4 w = *(const u32x4*)p;
    o[0] = bf_lo(w.x); o[1] = bf_hi(w.x); o[2] = bf_lo(w.y); o[3] = bf_hi(w.y); o[4] = bf_lo(w.z); o[5] = bf_hi(w.z); o[6] = bf_lo(w.w); o[7] = bf_hi(w.w); }
__device__ __forceinline__ void ld8f(const float* p, float (&o)[8]) { const f32x4 a = *(const f32x4*)p, b = *(const f32x4*)(p + 4);
    o[0] = a[0]; o[1] = a[1]; o[2] = a[2]; o[3] = a[3]; o[4] = b[0]; o[5] = b[1]; o[6] = b[2]; o[7] = b[3]; }
__device__ __forceinline__ void ld8f_nt(const float* p, float (&o)[8]) { const f32x4 a = __builtin_nontemporal_load((const f32x4*)p), b = __builtin_nontemporal_load((const f32x4*)(p + 4));
    o[0] = a[0]; o[1] = a[1]; o[2] = a[2]; o[3] = a[3]; o[4] = b[0]; o[5] = b[1]; o[6] = b[2]; o[7] = b[3]; }
__device__ __forceinline__ void zero8(float (&o)[8]) {
#pragma unroll
    for (int j = 0; j < 8; ++j) o[j] = 0.f; }

struct EpiAct {
    static constexpr bool PERM = true, AFTER_DRAIN = false;
    bf16_t* O; int ldc; int gelu_tiles; const float* SS;
    __device__ __forceinline__ void operator()(const f32x4 (&acc)[2][2][4][2], const Unit& u, int wr, int wc, int fr, int fq) const {
        asm volatile("" : "+v"(fr), "+v"(fq));
        const int row0 = u.rb + wr * 64 + fr, col0 = u.cb + wc * 32 + 8 * fq;
        const bool act = u.pn < gelu_tiles;
        float rsv[2][4];
#pragma unroll
        for (int ai = 0; ai < 2; ++ai)
#pragma unroll
            for (int m = 0; m < 4; ++m) rsv[ai][m] = SS[row0 + (u.half ? 0 : ai * HALF) + m * 16];
#pragma unroll
        for (int ai = 0; ai < 2; ++ai) if (ai == 0 || !u.half)
#pragma unroll
            for (int m = 0; m < 4; ++m) { bf16_t* rowp = O + (size_t)(row0 + ai * HALF + m * 16) * ldc + col0;
                const float rs = rsqrtf(rsv[ai][m] * (1.f / 1024.f) + 1e-6f);
#pragma unroll
                for (int bj = 0; bj < 2; ++bj) if (bj == 0 || !u.q) { f32x4 v0 = acc[ai][bj][m][0] * rs, v1 = acc[ai][bj][m][1] * rs;
                    if (act) { f32x2 a = gelu_pk((f32x2){v0[0], v0[1]}), b = gelu_pk((f32x2){v0[2], v0[3]}), c = gelu_pk((f32x2){v1[0], v1[1]}), d = gelu_pk((f32x2){v1[2], v1[3]});
                        v0 = (f32x4){a.x, a.y, b.x, b.y}; v1 = (f32x4){c.x, c.y, d.x, d.y}; }
                    u32x4 w; w.x = cvt_pk_bf16(v0[0], v0[1]); w.y = cvt_pk_bf16(v0[2], v0[3]); w.z = cvt_pk_bf16(v1[0], v1[1]); w.w = cvt_pk_bf16(v1[2], v1[3]);
                    *(u32x4*)(rowp + bj * HALF) = w; } }
    }
};

struct EpiQKV {
    static constexpr bool PERM = true, AFTER_DRAIN = false;
    bf16_t* Q; float* KV; const float* SS;
    __device__ __forceinline__ void operator()(const f32x4 (&acc)[2][2][4][2], const Unit& u, int wr, int wc, int fr, int fq) const {
        asm volatile("" : "+v"(fr), "+v"(fq));
        const int row0 = u.rb + wr * 64 + fr;
        float rs[2][4];
#pragma unroll
        for (int ai = 0; ai < 2; ++ai) if (ai == 0 || !u.half)
#pragma unroll
            for (int m = 0; m < 4; ++m) rs[ai][m] = rsqrtf(SS[row0 + (u.half ? 0 : ai * HALF) + m * 16] * (1.f / 1024.f) + 1e-6f);
        if (u.pn < 4) {
            const int col0 = u.cb + wc * 32 + 8 * fq;
#pragma unroll
            for (int ai = 0; ai < 2; ++ai) if (ai == 0 || !u.half)
#pragma unroll
                for (int m = 0; m < 4; ++m) { bf16_t* rowp = Q + (size_t)(row0 + ai * HALF + m * 16) * 1024 + col0;
#pragma unroll
                    for (int bj = 0; bj < 2; ++bj) if (bj == 0 || !u.q) { const f32x4 v0 = acc[ai][bj][m][0] * rs[ai][m], v1 = acc[ai][bj][m][1] * rs[ai][m];
                        u32x4 w; w.x = cvt_pk_bf16(v0[0], v0[1]); w.y = cvt_pk_bf16(v0[2], v0[3]); w.z = cvt_pk_bf16(v1[0], v1[1]); w.w = cvt_pk_bf16(v1[2], v1[3]);
                        *(u32x4*)(rowp + bj * HALF) = w; } }
        } else {
            const int col0 = (u.cb - 1024) + wc * 32 + 8 * fq;
#pragma unroll
            for (int ai = 0; ai < 2; ++ai) if (ai == 0 || !u.half)
#pragma unroll
                for (int m = 0; m < 4; ++m) { float* rowp = KV + (size_t)(row0 + ai * HALF + m * 16) * 512 + col0;
#pragma unroll
                    for (int bj = 0; bj < 2; ++bj) if (bj == 0 || !u.q) { *(f32x4*)(rowp + bj * HALF) = acc[ai][bj][m][0] * rs[ai][m]; *(f32x4*)(rowp + bj * HALF + 4) = acc[ai][bj][m][1] * rs[ai][m]; } }
        }
    }
};

struct EpiRes {
    static constexpr bool PERM = true, AFTER_DRAIN = false;
    float* C; const float* resP; const float* resS; int inplace; bf16_t* XB0; float* SS; int wxb;
    static constexpr int ldc = 1024, split = 32768;
    __device__ __forceinline__ void row_out(const f32x4 v0, const f32x4 v1, int row, int col, float& ss) const {
        if (C) { float* rowp = C + (size_t)row * ldc + col; __builtin_nontemporal_store(v0, (f32x4*)rowp); __builtin_nontemporal_store(v1, (f32x4*)(rowp + 4)); }
        if (wxb) { u32x4 w; w.x = cvt_pk_bf16(v0[0], v0[1]); w.y = cvt_pk_bf16(v0[2], v0[3]); w.z = cvt_pk_bf16(v1[0], v1[1]); w.w = cvt_pk_bf16(v1[2], v1[3]);
            *(u32x4*)(XB0 + (size_t)row * ldc + col) = w;
            ss += (v0[0] * v0[0] + v0[1] * v0[1]) + (v0[2] * v0[2] + v0[3] * v0[3]) + (v1[0] * v1[0] + v1[1] * v1[1]) + (v1[2] * v1[2] + v1[3] * v1[3]); }
    }
    __device__ __forceinline__ void operator()(const f32x4 (&acc)[2][2][4][2], const Unit& u, int wr, int wc, int fr, int fq) const {
        asm volatile("" : "+v"(fr), "+v"(fq));
        const int row0 = u.rb + wr * 64 + fr, col0 = u.cb + wc * 32 + 8 * fq;
        if (inplace) {
#pragma unroll
            for (int ai = 0; ai < 2; ++ai) if (ai == 0 || !u.half)
#pragma unroll
              for (int mh = 0; mh < 4; mh += 2) {
                u32x4 rw[2][2];
#pragma unroll
                for (int mm = 0; mm < 2; ++mm) { const int row = row0 + ai * HALF + (mh + mm) * 16;
#pragma unroll
                    for (int bj = 0; bj < 2; ++bj) if (bj == 0 || !u.q) rw[mm][bj] = *(const u32x4*)(XB0 + (size_t)row * ldc + col0 + bj * HALF); }
#pragma unroll
                for (int mm = 0; mm < 2; ++mm) { const int m = mh + mm, row = row0 + ai * HALF + m * 16; float ss = 0.f;
#pragma unroll
                    for (int bj = 0; bj < 2; ++bj) if (bj == 0 || !u.q) { const u32x4 w = rw[mm][bj];
                        const f32x4 v0 = acc[ai][bj][m][0] + (f32x4){bf_lo(w.x), bf_hi(w.x), bf_lo(w.y), bf_hi(w.y)}, v1 = acc[ai][bj][m][1] + (f32x4){bf_lo(w.z), bf_hi(w.z), bf_lo(w.w), bf_hi(w.w)};
                        row_out(v0, v1, row, col0 + bj * HALF, ss); }
                    if (wxb) { ss += __shfl_xor(ss, 16); ss += __shfl_xor(ss, 32); if (fq == 0) unsafeAtomicAdd(SS + row, ss); } }
              }
        } else {
#pragma unroll
            for (int ai = 0; ai < 2; ++ai) if (ai == 0 || !u.half)
#pragma unroll
                for (int m = 0; m < 4; ++m) { const int row = row0 + ai * HALF + m * 16; float ss = 0.f;
                    const float* rp = resP ? ((row < split ? resP + (size_t)row * ldc : resS + (size_t)(row - split) * ldc) + col0) : nullptr;
                    f32x4 rv[2][2];
#pragma unroll
                    for (int bj = 0; bj < 2; ++bj) if (bj == 0 || !u.q) { rv[bj][0] = rp ? *(const f32x4*)(rp + bj * HALF) : (f32x4){0.f, 0.f, 0.f, 0.f}; rv[bj][1] = rp ? *(const f32x4*)(rp + bj * HALF + 4) : (f32x4){0.f, 0.f, 0.f, 0.f}; }
#pragma unroll
                    for (int bj = 0; bj < 2; ++bj) if (bj == 0 || !u.q) row_out(acc[ai][bj][m][0] + rv[bj][0], acc[ai][bj][m][1] + rv[bj][1], row, col0 + bj * HALF, ss);
                    if (wxb) { ss += __shfl_xor(ss, 16); ss += __shfl_xor(ss, 32); if (fq == 0) unsafeAtomicAdd(SS + row, ss); } }
        }
    }
};

struct EpiG {
    static constexpr bool PERM = true, AFTER_DRAIN = false;
    bf16_t* G; float* outP; float* outS; const float* SS;
    __device__ __forceinline__ void operator()(const f32x4 (&acc)[2][2][4][2], const Unit& u, int wr, int wc, int fr, int fq) const {
        asm volatile("" : "+v"(fr), "+v"(fq));
        const int row0 = u.rb + wr * 64 + fr, col0 = u.pn * BM + wc * 32 + 8 * fq;
        float rsv[2][4];
#pragma unroll
        for (int ai = 0; ai < 2; ++ai)
#pragma unroll
            for (int m = 0; m < 4; ++m) rsv[ai][m] = SS[row0 + (u.half ? 0 : ai * HALF) + m * 16];
#pragma unroll
        for (int ai = 0; ai < 2; ++ai) if (ai == 0 || !u.half)
#pragma unroll
            for (int m = 0; m < 4; ++m) { const int row = row0 + ai * HALF + m * 16; bf16_t* rowp = G + (size_t)row * 2816 + col0;
                float* co = nullptr;
                if (row < 32768) { const int t = row & 8191; if (t >= 8190) co = outP + ((size_t)(row >> 13) * 2 + (t - 8190)) * 2816 + col0; }
                else { const int i = row & 7; if (i >= 6) co = outS + ((size_t)((row - 32768) >> 3) * 2 + (i - 6)) * 2816 + col0; }
                const float rs = rsqrtf(rsv[ai][m] * (1.f / 1024.f) + 1e-6f);
#pragma unroll
                for (int bj = 0; bj < 2; ++bj) { const f32x4 v0 = acc[ai][bj][m][0] * rs, v1 = acc[ai][bj][m][1] * rs;
                    u32x4 w; w.x = cvt_pk_bf16(v0[0], v0[1]); w.y = cvt_pk_bf16(v0[2], v0[3]); w.z = cvt_pk_bf16(v1[0], v1[1]); w.w = cvt_pk_bf16(v1[2], v1[3]);
                    *(u32x4*)(rowp + bj * HALF) = w;
                    if (co) { *(f32x4*)(co + bj * HALF) = v0; *(f32x4*)(co + bj * HALF + 4) = v1; } } }
    }
};

typedef unsigned u32x2 __attribute__((ext_vector_type(2)));
struct EpiH {
    static constexpr bool PERM = true, AFTER_DRAIN = false;
    const bf16_t* G; bf16_t* H; const float* cw; const float* cb; const float* ctx; const float* SS;
    static __device__ __forceinline__ void unpk4(const u32x2 w, float (&o)[4]) { o[0] = bf_lo(w.x); o[1] = bf_hi(w.x); o[2] = bf_lo(w.y); o[3] = bf_hi(w.y); }
    static __device__ __forceinline__ void ld4f(const float* p, float (&o)[4]) { const f32x4 a = *(const f32x4*)p; o[0] = a[0]; o[1] = a[1]; o[2] = a[2]; o[3] = a[3]; }
    template <int N> static __device__ __forceinline__ unsigned dpp_prev1(unsigned pv, unsigned cur) {
        const int t = __builtin_amdgcn_update_dpp(0, (int)pv, 0x120 + N, 0xf, 0xf, true);
        return (unsigned)__builtin_amdgcn_update_dpp(t, (int)cur, 0x110 + N, 0xf, 0xf, false); }
    template <int N> static __device__ __forceinline__ u32x2 dpp_prev(const u32x2 pv, const u32x2 cur) { u32x2 r; r.x = dpp_prev1<N>(pv.x, cur.x); r.y = dpp_prev1<N>(pv.y, cur.y); return r; }
    static __device__ __forceinline__ u32x2 shf(const u32x2 w, int src) { u32x2 r; r.x = (unsigned)__shfl((int)w.x, src); r.y = (unsigned)__shfl((int)w.y, src); return r; }
    static __device__ __forceinline__ void finish(const float (&g0)[4], const float (&g1)[4], const float (&g2)[4], const float (&w0)[4], const float (&w1)[4], const float (&w2)[4], const float (&bb)[4],
                                                  const f32x4 v, float rs, bf16_t* dst) {
        float h[4];
#pragma unroll
        for (int j = 0; j < 4; j += 2) {
            const f32x2 gc = (f32x2){bb[j] + w0[j] * g2[j] + w1[j] * g1[j] + w2[j] * g0[j], bb[j + 1] + w0[j + 1] * g2[j + 1] + w1[j + 1] * g1[j + 1] + w2[j + 1] * g0[j + 1]};
            const f32x2 ge = gelu_pk(gc); h[j] = ge.x * v[j] * rs; h[j + 1] = ge.y * v[j + 1] * rs; }
        u32x2 w; w.x = cvt_pk_bf16(h[0], h[1]); w.y = cvt_pk_bf16(h[2], h[3]);
        *(u32x2*)dst = w;
    }
    __device__ __forceinline__ void operator()(const f32x4 (&acc)[2][2][4][2], const Unit& u, int wr, int wc, int fr, int fq) const {
        asm volatile("" : "+v"(fr), "+v"(fq));
        const int row0 = u.rb + wr * 64 + fr;
        const int lane = fq * 16 + fr;
        const int s1 = fr >= 1 ? lane - 1 : lane + 15, s2 = fr >= 2 ? lane - 2 : lane + 14; (void)s1; (void)s2;
        float rs8[2][4];
#pragma unroll
        for (int ai = 0; ai < 2; ++ai)
#pragma unroll
            for (int m = 0; m < 4; ++m) rs8[ai][m] = rsqrtf(SS[u.rb + (u.half ? 0 : ai * HALF) + wr * 64 + fr + 16 * m] * (1.f / 1024.f) + 1e-6f);
        if (u.pm < 128) {
#pragma unroll
          for (int bj = 0; bj < 2; ++bj)
#pragma unroll
            for (int hv = 0; hv < 2; ++hv) {
            const int col = u.pn * BM + bj * HALF + wc * 32 + 8 * fq + 4 * hv;
            float w0[4], w1[4], w2[4], bb[4];
            ld4f(cw + col, w0); ld4f(cw + 2816 + col, w1); ld4f(cw + 2 * 2816 + col, w2); ld4f(cb + col, bb);
            u32x2 gq[2][4], prv[2];
#pragma unroll
            for (int ai = 0; ai < 2; ++ai) { const int R0 = u.rb + ai * HALF + wr * 64; const bf16_t* gp = G + (size_t)(R0 + fr) * 2816 + col;
#pragma unroll
                for (int m = 0; m < 4; ++m) gq[ai][m] = *(const u32x2*)(gp + (size_t)m * 16 * 2816);
                prv[ai] = (u32x2){0u, 0u};
                if ((R0 & 8191) != 0) prv[ai] = *(const u32x2*)(gp - (size_t)16 * 2816); }
#pragma unroll
            for (int ai = 0; ai < 2; ++ai) { const int R0 = u.rb + ai * HALF + wr * 64;
                u32x2 pv = prv[ai];
#pragma unroll
                for (int m = 0; m < 4; ++m) { const u32x2 cur = gq[ai][m];
                    const u32x2 q1 = dpp_prev<1>(pv, cur), q2 = dpp_prev<2>(pv, cur);
                    float g0[4], g1[4], g2[4]; unpk4(cur, g0); unpk4(q1, g1); unpk4(q2, g2);
                    finish(g0, g1, g2, w0, w1, w2, bb, acc[ai][bj][m][hv], rs8[ai][m], H + (size_t)(R0 + fr + 16 * m) * 2816 + col);
                    pv = cur; } }
            }
        } else {
#pragma unroll
        for (int bj = 0; bj < 2; ++bj)
#pragma unroll
          for (int hv = 0; hv < 2; ++hv) {
            const int col = u.pn * BM + bj * HALF + wc * 32 + 8 * fq + 4 * hv;
            float w0[4], w1[4], w2[4], bb[4];
            ld4f(cw + col, w0); ld4f(cw + 2816 + col, w1); ld4f(cw + 2 * 2816 + col, w2); ld4f(cb + col, bb);
            {
                const int i = fr & 7;
                u32x2 gq[4];
#pragma unroll
                for (int m = 0; m < 4; ++m) { const int row = row0 + m * 16; gq[m] = *(const u32x2*)(G + (size_t)row * 2816 + col); }
#pragma unroll
                for (int mh = 0; mh < 4; mh += 2) {
                f32x4 c0[4], c1[4];
#pragma unroll
                for (int m = mh; m < mh + 2; ++m) { const int row = row0 + m * 16; const float* cx = ctx + (size_t)((row - 32768) >> 3) * 2 * 2816 + col;
                    c0[m] = *(const f32x4*)cx; c1[m] = *(const f32x4*)(cx + 2816); }
#pragma unroll
                for (int m = mh; m < mh + 2; ++m) { const int row = row0 + m * 16; const u32x2 cur = gq[m];
                    const u32x2 q1 = dpp_prev<1>(cur, cur), q2 = dpp_prev<2>(cur, cur);
                    float g0[4], g1[4], g2[4]; unpk4(cur, g0); unpk4(q1, g1); unpk4(q2, g2);
#pragma unroll
                    for (int j = 0; j < 4; ++j) { const float x1 = c1[m][j], x0 = c0[m][j];
                        if (i < 1) g1[j] = x1;
                        if (i < 2) g2[j] = (i == 1) ? x1 : x0; }
                    finish(g0, g1, g2, w0, w1, w2, bb, acc[0][bj][m][hv], rs8[0][m], H + (size_t)row * 2816 + col); }
                }
                        }
          }
        }
    }
};

template <class Epi, class Sched, bool ALIGN_EPI = false, bool SP2 = false>
__device__ __forceinline__ void gemm_phase(PG8_LAS unsigned char* lds, const Gemm g, const Sched& S, const Epi& E, int wave0) {
    int tid_ = threadIdx.x; (void)wave0; asm volatile("" : "+v"(tid_));
    const int tid = tid_, wid = __builtin_amdgcn_readfirstlane(tid >> 6), lane = tid & 63, wr = wid >> 2, wc = wid & 3, fr = lane & 15, fq = lane >> 4;
    const int K = g.K, nt = K / BK;
    unsigned voffA[2], voffB[2];
#pragma unroll
    for (int i = 0; i < 2; ++i) { int R, C; stage_rc(tid * 16 + i * 8192, R, C); const int Rb = Epi::PERM ? ((R & ~31) + perm32(R & 31)) : R;
        voffA[i] = (unsigned)(R * K + C) * 2u; voffB[i] = (unsigned)(Rb * K + C) * 2u; }
    const size_t kstep = (size_t)(BK * 2);
    const size_t hstep = (size_t)HALF * K * 2;
    const size_t tstep = 2 * hstep;
    const unsigned ldsw = (unsigned)wid * 1024u;
    const int aoff = lds_byte(wr * 64 + fr, fq * 8), boff = lds_byte(wc * 32 + fr, fq * 8);
#define PG8_SA(b, h) (((b) * 2 + (h)) * HTB)
#define PG8_SB(b, h) ((4 + (b) * 2 + (h)) * HTB)
#define PG8_STAGE(bufoff, gbase, voff) do { _Pragma("unroll") for (int _i = 0; _i < 2; ++_i) \
        __builtin_amdgcn_global_load_lds((const unsigned*)((const char*)(gbase) + (voff)[_i]), (PG8_LAS unsigned*)(lds + (bufoff) + ldsw + _i * 8192), 16, 0, 0); } while (0)
#define PG8_LDA(dst, b, h) do { _Pragma("unroll") for (int m = 0; m < 4; ++m) _Pragma("unroll") for (int k = 0; k < 2; ++k) dst[m][k] = *(const PG8_LAS bf16x8*)(lds + PG8_SA(b, h) + aoff + m * 2048 + k * 1024); } while (0)
#define PG8_LDB(dst, b, h) do { _Pragma("unroll") for (int n = 0; n < 2; ++n) _Pragma("unroll") for (int k = 0; k < 2; ++k) dst[n][k] = *(const PG8_LAS bf16x8*)(lds + PG8_SB(b, h) + boff + n * 2048 + k * 1024); } while (0)
#define PG8_MMA(ai, bj, At, Bt) do { __builtin_amdgcn_s_setprio(1); _Pragma("unroll") for (int m = 0; m < 4; ++m) _Pragma("unroll") for (int n = 0; n < 2; ++n) _Pragma("unroll") for (int k = 0; k < 2; ++k) \
        acc[ai][bj][m][n] = __builtin_amdgcn_mfma_f32_16x16x32_bf16(Bt[n][k], At[m][k], acc[ai][bj][m][n], 0, 0, 0); __builtin_amdgcn_s_setprio(0); } while (0)
#define PG8_WAIT_V(n) asm volatile("s_waitcnt vmcnt(" #n ")" ::: "memory")
#define PG8_WAIT_L(n) asm volatile("s_waitcnt lgkmcnt(" #n ")" ::: "memory")
#define PG8_BAR __builtin_amdgcn_s_barrier()
#define PG8_SCHED __builtin_amdgcn_sched_barrier(0)
    Unit cur, nxt; int ui = 0;
    if (!S.next(0, cur)) return;
    f32x4 acc[2][2][4][2];
#pragma unroll
    for (int a = 0; a < 2; ++a)
#pragma unroll
        for (int b = 0; b < 2; ++b)
#pragma unroll
            for (int m = 0; m < 4; ++m)
#pragma unroll
                for (int n = 0; n < 2; ++n) acc[a][b][m][n] = (f32x4){0.f, 0.f, 0.f, 0.f};
    bf16x8 At[4][2], B0[2][2], B1[2][2];
    const char* cA = (const char*)g.A + (size_t)cur.rb * K * 2; const char* cB = (const char*)g.Bt + (size_t)cur.pn * tstep;
    S.a_ready(cur);
    if constexpr (SP2) {
        PG8_STAGE(PG8_SB(0, 0), cB, voffB); PG8_STAGE(PG8_SB(0, 1), cB + hstep, voffB); PG8_STAGE(PG8_SA(0, 0), cA, voffA); PG8_STAGE(PG8_SA(0, 1), cA + hstep, voffA);
        if (wr == 1) PG8_BAR;
        PG8_WAIT_V(2); PG8_BAR;
        PG8_STAGE(PG8_SB(1, 0), cB + kstep, voffB); PG8_STAGE(PG8_SA(1, 0), cA + kstep, voffA); PG8_STAGE(PG8_SB(1, 1), cB + hstep + kstep, voffB);
        PG8_WAIT_V(6); PG8_BAR;
    } else {
        PG8_STAGE(PG8_SB(0, 0), cB, voffB); PG8_STAGE(PG8_SA(0, 0), cA, voffA); PG8_STAGE(PG8_SB(0, 1), cB + hstep, voffB); PG8_STAGE(PG8_SA(0, 1), cA + hstep, voffA);
        if (wr == 1) PG8_BAR;
        PG8_WAIT_V(4); PG8_BAR;
        PG8_STAGE(PG8_SB(1, 0), cB + kstep, voffB); PG8_STAGE(PG8_SA(1, 0), cA + kstep, voffA); PG8_STAGE(PG8_SB(1, 1), cB + hstep + kstep, voffB);
        PG8_WAIT_V(6); PG8_BAR;
    }
    for (;;) {
        const bool has_next = S.next(ui + 1, nxt);
        const char* nA = has_next ? (const char*)g.A + (size_t)nxt.rb * K * 2 : cA; const char* nB = has_next ? (const char*)g.Bt + (size_t)nxt.pn * tstep : cB;
        for (int t = 0; t < nt; t += 2) {
            const bool last = (t == nt - 2);
            const char* a1 = cA + (size_t)(t + 1) * kstep;
            const char* a2 = last ? nA : cA + (size_t)(t + 2) * kstep; const char* b2 = last ? nB : cB + (size_t)(t + 2) * kstep;
            const char* a3 = a2 + kstep; const char* b3 = b2 + kstep;
            if (last && has_next) S.a_ready(nxt);
            if constexpr (SP2) {
            PG8_LDB(B0, 0, 0); PG8_LDB(B1, 0, 1); PG8_SCHED; PG8_LDA(At, 0, 0); PG8_STAGE(PG8_SA(1, 1), a1 + hstep, voffA);
            PG8_WAIT_V(8); PG8_WAIT_L(0); PG8_BAR; PG8_MMA(0, 0, At, B0); PG8_MMA(0, 1, At, B1); PG8_BAR; PG8_SCHED;
            PG8_LDA(At, 0, 1); PG8_STAGE(PG8_SB(0, 0), b2, voffB); PG8_STAGE(PG8_SB(0, 1), b2 + hstep, voffB); PG8_STAGE(PG8_SA(0, 0), a2, voffA);
            PG8_WAIT_V(8); PG8_WAIT_L(0); PG8_BAR; if (!cur.half) { PG8_MMA(1, 0, At, B0); PG8_MMA(1, 1, At, B1); } PG8_BAR; PG8_SCHED;
            PG8_LDB(B0, 1, 0); PG8_LDB(B1, 1, 1); PG8_SCHED; PG8_LDA(At, 1, 0); PG8_STAGE(PG8_SA(0, 1), a2 + hstep, voffA);
            PG8_WAIT_V(8); PG8_WAIT_L(0); PG8_BAR; PG8_MMA(0, 0, At, B0); PG8_MMA(0, 1, At, B1); PG8_BAR; PG8_SCHED;
            PG8_LDA(At, 1, 1); PG8_STAGE(PG8_SB(1, 0), b3, voffB); PG8_STAGE(PG8_SB(1, 1), b3 + hstep, voffB); PG8_STAGE(PG8_SA(1, 0), a3, voffA);
            PG8_WAIT_V(8); PG8_WAIT_L(0); PG8_BAR; if (!cur.half) { PG8_MMA(1, 0, At, B0); PG8_MMA(1, 1, At, B1); } PG8_BAR; PG8_SCHED;
            } else {
            PG8_LDB(B0, 0, 0); PG8_SCHED; PG8_LDA(At, 0, 0); PG8_STAGE(PG8_SA(1, 1), a1 + hstep, voffA);
            PG8_WAIT_L(8); PG8_BAR; PG8_WAIT_L(0); PG8_MMA(0, 0, At, B0); PG8_BAR; PG8_SCHED;
            PG8_LDB(B1, 0, 1); PG8_STAGE(PG8_SB(0, 0), b2, voffB);
            PG8_BAR; PG8_WAIT_L(0); PG8_MMA(0, 1, At, B1); PG8_BAR;
            PG8_LDA(At, 0, 1); PG8_STAGE(PG8_SA(0, 0), a2, voffA);
            PG8_BAR; PG8_WAIT_L(0); if (!cur.half) PG8_MMA(1, 0, At, B0); PG8_BAR; PG8_SCHED;
            PG8_STAGE(PG8_SB(0, 1), b2 + hstep, voffB);
            PG8_WAIT_V(6); PG8_BAR; if (!cur.half) PG8_MMA(1, 1, At, B1); PG8_BAR;
            PG8_LDB(B0, 1, 0); PG8_SCHED; PG8_LDA(At, 1, 0); PG8_STAGE(PG8_SA(0, 1), a2 + hstep, voffA);
            PG8_WAIT_L(8); PG8_BAR; PG8_WAIT_L(0); PG8_MMA(0, 0, At, B0); PG8_BAR; PG8_SCHED;
            PG8_LDB(B1, 1, 1); PG8_STAGE(PG8_SB(1, 0), b3, voffB);
            PG8_BAR; PG8_WAIT_L(0); PG8_MMA(0, 1, At, B1); PG8_BAR;
            PG8_LDA(At, 1, 1); PG8_STAGE(PG8_SA(1, 0), a3, voffA);
            PG8_BAR; PG8_WAIT_L(0); if (!cur.half) PG8_MMA(1, 0, At, B0); PG8_BAR; PG8_SCHED;
            PG8_STAGE(PG8_SB(1, 1), b3 + hstep, voffB);
            PG8_WAIT_V(6); PG8_BAR; if (!cur.half) PG8_MMA(1, 1, At, B1); PG8_BAR;
            }
        }
        if constexpr (ALIGN_EPI) { if (wr == 0) PG8_BAR; }
        if constexpr (!Epi::AFTER_DRAIN) { E(acc, cur, wr, wc, fr, fq); S.done(cur); }
        if (!has_next) break;
#pragma unroll
        for (int a = 0; a < 2; ++a)
#pragma unroll
            for (int b = 0; b < 2; ++b)
#pragma unroll
                for (int m = 0; m < 4; ++m)
#pragma unroll
                    for (int n = 0; n < 2; ++n) acc[a][b][m][n] = (f32x4){0.f, 0.f, 0.f, 0.f};
        cur = nxt; cA = nA; cB = nB; ++ui;
        if constexpr (ALIGN_EPI) { if (wr == 1) PG8_BAR; }
    }
    PG8_WAIT_V(0);
    if constexpr (!ALIGN_EPI) { if (wr == 0) PG8_BAR; }
    PG8_BAR;
    if constexpr (Epi::AFTER_DRAIN) { E.fused(acc, cur, wr, wc, fr, fq, lds, wid, lane); S.done(cur); }
#undef PG8_SA
#undef PG8_SB
#undef PG8_STAGE
#undef PG8_LDA
#undef PG8_LDB
#undef PG8_MMA
#undef PG8_WAIT_V
#undef PG8_WAIT_L
#undef PG8_BAR
#undef PG8_SCHED
}

template <class Epi, bool NARROW = false, bool SHORT = false>
__device__ __forceinline__ void mini_gemm(PG8_LAS unsigned char* lds, const bf16_t* A, const bf16_t* Bt, int K, int ntn, const Epi& E, int c, int G, int wave0, int row_base = 32768) {
    int tid_ = threadIdx.x; (void)wave0; asm volatile("" : "+v"(tid_));
    const int tid = tid_, wid = __builtin_amdgcn_readfirstlane(tid >> 6), lane = tid & 63, wr = wid >> 2, wc = wid & 3, fr = lane & 15, fq = lane >> 4;
    constexpr int LS = 136, BUFB = 2 * 128 * LS * 2;
    constexpr int NB = NARROW ? 2 : 4, TW = NARROW ? 64 : 128;
    constexpr int NA = SHORT ? 2 : 4, TH = SHORT ? 64 : 128, NTM = SHORT ? 16 : 8;
    const int lr = SHORT ? (tid >> 3) : (tid >> 2), lp = SHORT ? (tid & 7) * 2 : (tid & 3) * 4;
    const int lrb = NARROW ? (tid >> 3) : lr, lpb = NARROW ? (tid & 7) * 2 : lp;
    const bool active = (!NARROW || wc < 2) && (!SHORT || wr == 0);
    const int nst = K / 128;
#pragma unroll 1
    for (int t = c; t < NTM * ntn; t += G) {
        const int tm = t % NTM, tn = t / NTM;
        const bf16_t* ga = A + ((size_t)row_base + TH * tm + lr) * K + lp * 8;
        const bf16_t* gb = Bt + ((size_t)TW * tn + lrb) * K + lpb * 8;
        u32x4 ra[2][NA], rb[2][NB];
#pragma unroll
        for (int s2 = 0; s2 < 2; ++s2) {
#pragma unroll
            for (int j = 0; j < NA; ++j) ra[s2][j] = *(const u32x4*)(ga + 128 * s2 + 8 * j);
#pragma unroll
            for (int j = 0; j < NB; ++j) rb[s2][j] = *(const u32x4*)(gb + 128 * s2 + 8 * j); }
        f32x4 acc[4][2];
#pragma unroll
        for (int m = 0; m < 4; ++m)
#pragma unroll
            for (int n = 0; n < 2; ++n) acc[m][n] = (f32x4){0.f, 0.f, 0.f, 0.f};
#pragma unroll 1
        for (int st = 0; st < nst; st += 2) {
#pragma unroll
          for (int s2 = 0; s2 < 2; ++s2) {
            PG8_LAS bf16_t* As = (PG8_LAS bf16_t*)(lds + s2 * BUFB); PG8_LAS bf16_t* Bs = As + 128 * LS;
#pragma unroll
            for (int j = 0; j < NA; ++j) *(PG8_LAS u32x4*)(As + lr * LS + (lp + j) * 8) = ra[s2][j];
#pragma unroll
            for (int j = 0; j < NB; ++j) *(PG8_LAS u32x4*)(Bs + lrb * LS + (lpb + j) * 8) = rb[s2][j];
            __syncthreads();
            if (st + 2 < nst) {
#pragma unroll
                for (int j = 0; j < NA; ++j) ra[s2][j] = *(const u32x4*)(ga + 128 * (st + 2 + s2) + 8 * j);
#pragma unroll
                for (int j = 0; j < NB; ++j) rb[s2][j] = *(const u32x4*)(gb + 128 * (st + 2 + s2) + 8 * j); }
            if (active) {
#pragma unroll
            for (int kc = 0; kc < 4; ++kc) {
                bf16x8 af[4], bfr[2];
#pragma unroll
                for (int m = 0; m < 4; ++m) af[m] = *(const PG8_LAS bf16x8*)(As + (64 * wr + 16 * m + fr) * LS + 32 * kc + 8 * fq);
#pragma unroll
                for (int n = 0; n < 2; ++n) bfr[n] = *(const PG8_LAS bf16x8*)(Bs + (32 * wc + 8 * (fr >> 2) + 4 * n + (fr & 3)) * LS + 32 * kc + 8 * fq);
#pragma unroll
                for (int m = 0; m < 4; ++m)
#pragma unroll
                    for (int n = 0; n < 2; ++n) acc[m][n] = __builtin_amdgcn_mfma_f32_16x16x32_bf16(bfr[n], af[m], acc[m][n], 0, 0, 0);
            } }
          }
        }
        if (active) {
        f32x4 accf[2][2][4][2];
#pragma unroll
        for (int a = 0; a < 2; ++a)
#pragma unroll
            for (int bq = 0; bq < 2; ++bq)
#pragma unroll
                for (int m = 0; m < 4; ++m)
#pragma unroll
                    for (int n = 0; n < 2; ++n) accf[a][bq][m][n] = (a == 0 && bq == 0) ? acc[m][n] : (f32x4){0.f, 0.f, 0.f, 0.f};
        Unit u; u.pm = 128 + (TH * tm >> 8); u.cb = TW * tn; u.pn = u.cb >> 8; u.rb = row_base + TH * tm; u.half = 1; u.q = 1;
        E(accf, u, wr, wc, fr, fq);
        }
        __syncthreads();
    }
}
}

#define LAS __attribute__((address_space(3)))
typedef unsigned short bf16;
typedef unsigned v4u __attribute__((ext_vector_type(4)));
typedef unsigned v2u __attribute__((ext_vector_type(2)));
typedef float f32x4 __attribute__((ext_vector_type(4)));
typedef short bf16x8 __attribute__((ext_vector_type(8)));

constexpr int NTHR = 512, NWAVES = 8;
constexpr int MP = 32768, MS = 1024, MT = MP + MS;
constexpr int D = 1024, DFF = 2816;
constexpr int LDS_BYTES = 147456;
constexpr float EPS = 1e-6f;

enum { I_XP = 0, I_XS, I_CPOOL, I_CSK, I_CSV, I_CMK, I_CMV, I_CFC, I_MEMP, I_LNMIX, I_LNMEM, I_LNMEMKV, I_LNFFN, I_ABWIN, I_ABVG, I_ABWS, I_ABBS, I_ABPW, I_ABPS, I_ABWOUT,
       I_CWQKV, I_CQG, I_CKG, I_CSINK, I_CWO, I_MWQ, I_MWKV, I_MQG, I_MKG, I_MWO, I_FWUP, I_FCW, I_FCB, I_FWDN, N_IN };
constexpr size_t O_YP = 0, O_YS = O_YP + (size_t)MP * D, O_POOLP = O_YS + (size_t)MS * D, O_POOLS = O_POOLP + 4 * 15 * 512, O_CHV = O_POOLS + 128 * 15 * 512,
                 O_SKP = O_CHV + 128 * 8 * 512, O_SVP = O_SKP + 4 * 128 * 256, O_SKS = O_SVP + 4 * 128 * 256, O_SVS = O_SKS + (size_t)128 * 128 * 256,
                 O_MKP = O_SVS + (size_t)128 * 128 * 256, O_MVP = O_MKP + 2 * 4 * 256 * 512, O_FCP = O_MVP + 2 * 4 * 256 * 512, O_FCS = O_FCP + 2 * 4 * 2 * DFF,
                 O_END = O_FCS + (size_t)2 * 128 * 2 * DFF;
constexpr size_t MiB = 1u << 20;
constexpr size_t W_WIN = 0, W_WOUT = W_WIN + 1536 * 1024 * 2, W_WQKV = W_WOUT + 1024 * 1024 * 2, W_CWO = W_WQKV + 1536 * 1024 * 2, W_LAYER = W_CWO + 1024 * 1024 * 2;
constexpr size_t WL_WQ = 0, WL_WKV = WL_WQ + 512 * 1024 * 2, WL_WO = WL_WKV + 1024 * 1024 * 2, WL_WUP = WL_WO + 1024 * 512 * 2, WL_WDN = WL_WUP + (size_t)2 * DFF * 1024 * 2,
                 WL_SIZE = WL_WDN + (size_t)1024 * DFF * 2;
constexpr size_t W_MN = W_LAYER + 2 * WL_SIZE;
constexpr size_t W_MKV = W_MN + 2 * 1024 * 1024 * 2;
constexpr size_t W_SS = W_MKV + 2 * 1024 * 1024 * 4;
constexpr size_t W_SMALL_END = W_SS + (size_t)6 * MT * 4;
static_assert(W_SMALL_END <= 72 * MiB, "weights region");
constexpr size_t W_XN = 72 * MiB;
constexpr size_t W_G = 138 * MiB;
constexpr size_t W_PROJ = W_G;
constexpr size_t W_AO = W_PROJ + 99 * MiB;
constexpr size_t W_H = 320 * MiB;
constexpr size_t W_KV32 = W_H;
constexpr size_t W_MQ = W_KV32 + 66 * MiB;
constexpr size_t W_MO = W_MQ + 33 * MiB;
constexpr size_t W_END = 502 * MiB;
constexpr size_t W_CTL = 504 * MiB, CTL_BYTES = 65536, W_NEED = W_CTL + CTL_BYTES;
constexpr int LDS_CTL_OFF = LDS_BYTES - 64;
static_assert(W_XN + (size_t)MT * 1024 * 2 <= W_G && W_PROJ + (size_t)MT * 1536 * 2 <= W_AO && W_AO + (size_t)MT * 1024 * 2 <= W_H && W_G + (size_t)MT * DFF * 2 <= W_H, "ws map 1");
static_assert(W_KV32 + (size_t)MT * 512 * 4 <= W_MQ && W_MQ + (size_t)MT * 512 * 2 <= W_MO && W_MO + (size_t)MT * 512 * 2 <= W_END && W_H + (size_t)MT * DFF * 2 <= W_END, "ws map 2");

struct Params { const float* in[N_IN]; float* out; unsigned char* ws; };

__device__ __forceinline__ unsigned pk2(float lo, float hi) { return pg8::cvt_pk_bf16(lo, hi); }
__device__ __forceinline__ unsigned f2bf(float f) { return pg8::cvt_pk_bf16(f, 0.f) & 0xffffu; }
__device__ __forceinline__ float bflo(unsigned w) { return __builtin_bit_cast(float, w << 16); }
__device__ __forceinline__ float bfhi(unsigned w) { return __builtin_bit_cast(float, w & 0xffff0000u); }
__device__ __forceinline__ float bf1(bf16 h) { return __builtin_bit_cast(float, (unsigned)h << 16); }
__device__ __forceinline__ void unpack8(const v4u w, float (&o)[8]) { o[0] = bflo(w.x); o[1] = bfhi(w.x); o[2] = bflo(w.y); o[3] = bfhi(w.y); o[4] = bflo(w.z); o[5] = bfhi(w.z); o[6] = bflo(w.w); o[7] = bfhi(w.w); }
__device__ __forceinline__ bf16x8 pack8(const float (&o)[8]) { v4u w; w.x = pk2(o[0], o[1]); w.y = pk2(o[2], o[3]); w.z = pk2(o[4], o[5]); w.w = pk2(o[6], o[7]); return __builtin_bit_cast(bf16x8, w); }
typedef short v4i16_t __attribute__((ext_vector_type(4)));
__device__ __forceinline__ v2u vtr(const LAS bf16* p) { return __builtin_bit_cast(v2u, __builtin_amdgcn_ds_read_tr16_b64_v4i16((LAS v4i16_t*)p)); }
__device__ __forceinline__ float wave_sum(float v) {
#pragma unroll
    for (int o = 1; o < 64; o <<= 1) v += __shfl_xor(v, o);
    return v;
}
__device__ __forceinline__ float gelu1(float v) { const pg8::f32x2 r = pg8::gelu_pk((pg8::f32x2){v, 0.f}); return r.x; }
__device__ __forceinline__ void rope_cs(float pos, int e, float& c, float& s) {
    const float inv = exp2f(-(float)e * (0.125f * 18.931568569324174f));
    const float ang = pos * inv;
    const float k = rintf(ang * 0.15915494309189535f);
    float r = fmaf(-k, 6.28125f, ang);
    r = fmaf(-k, 0.0019353071795864769f, r);
    s = __sinf(r); c = __cosf(r);
}

#define XB_TMO      128
#define XB_XCNT(j)  (256  + 64 * (j))
#define XB_XSUB(j)  (1280 + 64 * (j))
#define XB_XGEN(j)  (2304 + 64 * (j))
#define XB_TOP      3328
#define XB_TOPGEN   3392
#define XCD_BAR_WORDS 3456
#define XB_SPIN_CAP (1u << 18)

__device__ __forceinline__ unsigned xb_ld(unsigned* p)              { return __hip_atomic_load(p, __ATOMIC_RELAXED, __HIP_MEMORY_SCOPE_AGENT); }
__device__ __forceinline__ unsigned xb_add(unsigned* p, unsigned v) { return __hip_atomic_fetch_add(p, v, __ATOMIC_RELAXED, __HIP_MEMORY_SCOPE_AGENT); }
__device__ __forceinline__ unsigned xb_xcc_id() { return (unsigned)__builtin_amdgcn_s_getreg((3 << 11) | 20) & 0xFu; }
#define XB_SPIN(cond, bar) do { unsigned _sp = 0; while (cond) { __builtin_amdgcn_s_sleep(1); \
    if ((++_sp & 255u) == 0u) { if (xb_ld(&(bar)[XB_TMO])) break; if (_sp > XB_SPIN_CAP) { atomicAdd(&(bar)[XB_TMO], 1u); break; } } } } while (0)

struct XcdBarrier {
    unsigned* bar; unsigned x; int w0;
    volatile LAS unsigned* st;
};

__device__ __forceinline__ XcdBarrier xcd_barrier_post(unsigned* bar, volatile LAS unsigned* st) {
    XcdBarrier b; b.bar = bar; b.x = xb_xcc_id(); b.st = st; b.w0 = __builtin_amdgcn_readfirstlane((int)threadIdx.x >> 6);
    if (threadIdx.x == 0) (void)xb_add(&bar[XB_XCNT(b.x)], 1u);
    return b;
}
__device__ __forceinline__ void xcd_barrier_complete(unsigned* bar, unsigned x, unsigned& nloc, unsigned& nx) {
    const unsigned G = gridDim.x * gridDim.y * gridDim.z;
    unsigned sum, cnt, mine, sp = 0u;
    for (;;) {
        sum = 0u; cnt = 0u; mine = 0u;
#pragma unroll
        for (unsigned j = 0; j < 16; ++j) { const unsigned c = xb_ld(&bar[XB_XCNT(j)]); sum += c; cnt += (c > 0u) ? 1u : 0u; mine = (j == x) ? c : mine; }
        if (sum == G) break;
        __builtin_amdgcn_s_sleep(1);
        if ((++sp & 255u) == 0u) { if (xb_ld(&bar[XB_TMO])) break; if (sp > XB_SPIN_CAP) { atomicAdd(&bar[XB_TMO], 1u); break; } }
    }
    nloc = mine > 0u ? mine : 1u; nx = cnt > 0u ? cnt : 1u;
}

__device__ __forceinline__ void xcd_barrier(const XcdBarrier& b) {
    asm volatile("s_waitcnt vmcnt(0)" ::: "memory");
    __syncthreads();
    if (threadIdx.x == 0) {
        unsigned* bar = b.bar;
        __builtin_amdgcn_s_waitcnt(0);
        unsigned nloc = b.st[0], nx = b.st[1];
        if (nloc == 0u) { xcd_barrier_complete(bar, b.x, nloc, nx); b.st[0] = nloc; b.st[1] = nx; }
        const unsigned old = xb_add(&bar[XB_XSUB(b.x)], 1u);
        const unsigned gen = old / nloc;
        if (old + 1u == (gen + 1u) * nloc) {
            __builtin_amdgcn_fence(__ATOMIC_RELEASE, "agent");
            asm volatile("s_waitcnt vmcnt(0)" ::: "memory");
            const unsigned og = xb_add(&bar[XB_TOP], 1u);
            const unsigned tg = og / nx;
            if (og + 1u == (tg + 1u) * nx) xb_add(&bar[XB_TOPGEN], 1u);
            else XB_SPIN(xb_ld(&bar[XB_TOPGEN]) == tg, bar);
            __builtin_amdgcn_fence(__ATOMIC_ACQUIRE, "agent");
            xb_add(&bar[XB_XGEN(b.x)], 1u);
            asm volatile("s_waitcnt vmcnt(0)" ::: "memory");
        } else {
            XB_SPIN(xb_ld(&bar[XB_XGEN(b.x)]) == gen, bar);
            __builtin_amdgcn_fence(__ATOMIC_ACQUIRE, "agent");
            asm volatile("s_waitcnt vmcnt(0)" ::: "memory");
        }
    }
    __syncthreads();
}

__device__ __forceinline__ void transpose_item(const float* W, const float* gain, int ldn, int nblk, bf16* WT, int ldk, int koff, LAS float* scr, int item, int lane) {
    const int kb = item / nblk, nb = item % nblk, k0 = 64 * kb, n0 = 32 * nb;
    float wv[32];
#pragma unroll
    for (int i = 0; i < 32; ++i) wv[i] = __builtin_nontemporal_load(W + (size_t)(k0 + 2 * i + (lane >> 5)) * ldn + n0 + (lane & 31));
    if (gain) {
#pragma unroll
        for (int i = 0; i < 32; ++i) wv[i] *= gain[k0 + 2 * i + (lane >> 5)]; }
#pragma unroll
    for (int i = 0; i < 32; ++i) scr[(2 * i + (lane >> 5)) * 33 + (lane & 31)] = wv[i];
    asm volatile("s_waitcnt lgkmcnt(0)" ::: "memory");
    const int c = lane & 7;
#pragma unroll
    for (int j = 0; j < 4; ++j) { const int n = (lane >> 3) + 8 * j; const LAS float* s = scr + (8 * c) * 33 + n;
        v4u o; o.x = pk2(s[0 * 33], s[1 * 33]); o.y = pk2(s[2 * 33], s[3 * 33]); o.z = pk2(s[4 * 33], s[5 * 33]); o.w = pk2(s[6 * 33], s[7 * 33]);
        *(v4u*)(WT + (size_t)(n0 + n) * ldk + koff + k0 + 8 * c) = o; }
    asm volatile("s_waitcnt lgkmcnt(0)" ::: "memory");
}
__device__ __forceinline__ void rms_row(const float* xrow, const float* g, bf16* orow, int lane) {
    const f32x4* xr = (const f32x4*)xrow + lane; const f32x4* gr = (const f32x4*)g + lane;
    f32x4 v[4]; float s = 0.f;
#pragma unroll
    for (int j = 0; j < 4; ++j) { v[j] = xr[64 * j]; s += (v[j].x * v[j].x + v[j].y * v[j].y) + (v[j].z * v[j].z + v[j].w * v[j].w); }
    const float rs = rsqrtf(wave_sum(s) * (1.f / 1024.f) + EPS);
    unsigned long long* o8 = (unsigned long long*)orow + lane;
#pragma unroll
    for (int j = 0; j < 4; ++j) { const f32x4 gg = gr[64 * j];
        o8[64 * j] = (unsigned long long)pk2(v[j].x * rs * gg.x, v[j].y * rs * gg.y) | ((unsigned long long)pk2(v[j].z * rs * gg.z, v[j].w * rs * gg.w) << 32); }
}
__device__ __forceinline__ void xb_row(const float* xrow, bf16* orow, float* ss, int lane) {
    const f32x4* xr = (const f32x4*)xrow + lane;
    f32x4 v[4]; float s = 0.f;
#pragma unroll
    for (int j = 0; j < 4; ++j) { v[j] = xr[64 * j]; s += (v[j].x * v[j].x + v[j].y * v[j].y) + (v[j].z * v[j].z + v[j].w * v[j].w); }
    s = wave_sum(s);
    unsigned long long* o8 = (unsigned long long*)orow + lane;
#pragma unroll
    for (int j = 0; j < 4; ++j) o8[64 * j] = (unsigned long long)pk2(v[j].x, v[j].y) | ((unsigned long long)pk2(v[j].z, v[j].w) << 32);
    if (lane == 0) *ss = s;
}

struct TItem { const float* W; int ldn, nblk, nitems; bf16* WT; int ldk, koff; };

__device__ __forceinline__ void prologue(const Params& p, LAS unsigned char* lds, int gw, int ngw, int wave, int lane) {
    unsigned char* ws = p.ws;
    LAS float* scr = (LAS float*)(lds + wave * 16384);
#define TR(Wp, gn_, K_, N_, ldn_, dst_, ldk_, koff_) do { const int nblk_ = (N_) / 32, nit_ = ((K_) / 64) * nblk_; \
        for (int it = gw; it < nit_; it += ngw) transpose_item((Wp), (gn_), (ldn_), nblk_, (bf16*)(dst_), (ldk_), (koff_), scr, it, lane); } while (0)
    const float* nog = nullptr;
    TR(p.in[I_ABWIN], p.in[I_LNMIX], 1024, 1536, 1536, ws + W_WIN, 1024, 0);
    TR(p.in[I_ABWOUT], nog, 512, 1024, 1024, ws + W_WOUT, 1024, 0);
    TR(p.in[I_CWQKV], p.in[I_LNMIX] + D, 1024, 1536, 1536, ws + W_WQKV, 1024, 0);
    TR(p.in[I_CWO], nog, 1024, 1024, 1024, ws + W_CWO, 1024, 0);
#pragma unroll 1
    for (int l = 0; l < 2; ++l) {
        unsigned char* wl = ws + W_LAYER + l * WL_SIZE;
        TR(p.in[I_MWQ] + (size_t)l * 1024 * 512, p.in[I_LNMEM] + l * D, 1024, 512, 512, wl + WL_WQ, 1024, 0);
        TR(p.in[I_MWKV] + (size_t)l * 1024 * 1024, nog, 1024, 1024, 1024, wl + WL_WKV, 1024, 0);
        TR(p.in[I_MWO] + (size_t)l * 512 * 1024, nog, 512, 1024, 1024, wl + WL_WO, 512, 0);
        TR(p.in[I_FWUP] + (size_t)l * 1024 * 2 * DFF, p.in[I_LNFFN] + l * D, 1024, 2 * DFF, 2 * DFF, wl + WL_WUP, 1024, 0);
        TR(p.in[I_FWDN] + (size_t)l * DFF * 1024, nog, DFF, 1024, 1024, wl + WL_WDN, DFF, 0);
    }
#undef TR
    {
        const float* pw = p.in[I_ABPW]; const float* ps = p.in[I_ABPS]; const float* wo = p.in[I_ABWOUT] + (size_t)512 * 1024;
        bf16* WT = (bf16*)(ws + W_WOUT);
        const int gt = gw * 64 + lane, ngt = ngw * 64;
        for (int o = gt; o < 128 * 1024; o += ngt) {
            const int n = o & 1023, d = o >> 10;
            float a[4] = {0.f, 0.f, 0.f, 0.f};
#pragma unroll 4
            for (int e = 0; e < 128; ++e) {
#pragma unroll
                for (int g = 0; g < 4; ++g) a[g] += pw[((size_t)g * 128 + d) * 128 + e] * ps[g * 128 + e] * wo[((size_t)g * 128 + e) * 1024 + n]; }
#pragma unroll
            for (int g = 0; g < 4; ++g) WT[(size_t)n * 1024 + 512 + g * 128 + d] = (bf16)f2bf(a[g]); }
    }
    for (int m0 = gw * 4; m0 < MT; m0 += ngw * 4) {
        f32x4 v[4][4];
#pragma unroll
        for (int r = 0; r < 4; ++r) { const int m = m0 + r; const f32x4* xr = (const f32x4*)(m < MP ? p.in[I_XP] + (size_t)m * D : p.in[I_XS] + (size_t)(m - MP) * D) + lane;
#pragma unroll
            for (int j = 0; j < 4; ++j) v[r][j] = __builtin_nontemporal_load(xr + 64 * j); }
#pragma unroll
        for (int r = 0; r < 4; ++r) { const int m = m0 + r; float sq = 0.f;
#pragma unroll
            for (int j = 0; j < 4; ++j) sq += (v[r][j].x * v[r][j].x + v[r][j].y * v[r][j].y) + (v[r][j].z * v[r][j].z + v[r][j].w * v[r][j].w);
            sq = wave_sum(sq);
            unsigned long long* o8 = (unsigned long long*)((bf16*)(ws + W_XN) + (size_t)m * D) + lane;
#pragma unroll
            for (int j = 0; j < 4; ++j) o8[64 * j] = (unsigned long long)pk2(v[r][j].x, v[r][j].y) | ((unsigned long long)pk2(v[r][j].z, v[r][j].w) << 32);
            if (lane == 0) ((float*)(ws + W_SS))[m] = sq; }
    }
    for (int o = gw * 64 + lane; o < 5 * MT; o += ngw * 64) ((float*)(ws + W_SS))[MT + o] = 0.f;
    for (int m = gw; m < 2048; m += ngw) { const int l = m >> 10, r = m & 1023;
        rms_row(p.in[I_MEMP] + (size_t)r * D, p.in[I_LNMEMKV] + l * D, (bf16*)(ws + W_MN) + (size_t)m * D, lane); }
}

constexpr int SG_VS = 520;
template <int W> __device__ __forceinline__ void pool_block(const float (&prev)[16], const float (&cur)[16], float (&o)[16], int t0, bool clampcnt) {
#pragma unroll
    for (int k = 0; k < 16; ++k) { float s = 0.f;
#pragma unroll
        for (int kk = 0; kk < W; ++kk) s += (k - kk >= 0) ? cur[(k - kk) & 15] : prev[(16 + k - kk) & 15];
        float inv = 1.f / (float)W;
        if (clampcnt) { const int t1 = t0 + k + 1; if (t1 < W) inv = __builtin_amdgcn_rcpf((float)t1); }
        o[k] = s * inv - cur[k]; }
}
__device__ __forceinline__ void pool_dispatch(int gi, const float (&prev)[16], const float (&cur)[16], float (&o)[16], int t0, bool clampcnt) {
    if (gi == 0) pool_block<2>(prev, cur, o, t0, clampcnt); else if (gi == 1) pool_block<4>(prev, cur, o, t0, clampcnt);
    else if (gi == 2) pool_block<8>(prev, cur, o, t0, clampcnt); else pool_block<16>(prev, cur, o, t0, clampcnt);
}

__device__ __forceinline__ void sgu_prompt_unit(const Params& p, LAS unsigned char* lds, int unit, int tid, int wave, int lane) {
    const bf16* PROJ = (const bf16*)(p.ws + W_PROJ); bf16* AO = (bf16*)(p.ws + W_AO);
    LAS bf16* Vn = (LAS bf16*)lds;
    const int b = unit >> 6, ch = unit & 63; const size_t r0 = (size_t)b * 8192 + ch * 128;
    {
        float gn[8]; pg8::ld8f(p.in[I_ABVG] + 8 * lane, gn);
        v4u raw[16];
#pragma unroll
        for (int jj = 0; jj < 16; ++jj) raw[jj] = *(const v4u*)(PROJ + (r0 + wave + 8 * jj) * 1536 + 512 + 8 * lane);
#pragma unroll
        for (int jj = 0; jj < 16; ++jj) { const int j = wave + 8 * jj;
            float x[8]; unpack8(raw[jj], x);
            float s = 0.f;
#pragma unroll
            for (int e = 0; e < 8; ++e) s += x[e];
            const float mean = wave_sum(s) * (1.f / 512.f); float q = 0.f;
#pragma unroll
            for (int e = 0; e < 8; ++e) { x[e] -= mean; q += x[e] * x[e]; }
            const float rstd = rsqrtf(wave_sum(q) * (1.f / 512.f) + EPS);
#pragma unroll
            for (int e = 0; e < 8; ++e) x[e] *= rstd * gn[e];
            *(LAS bf16x8*)(Vn + j * SG_VS + 8 * lane) = pack8(x); }
    }
    __syncthreads();
    {
        const int q16 = lane & 15, kq = lane >> 4, nch = (wave >> 1) + 1; int i = 16 * wave + q16;
#pragma unroll 1
        for (int g = 0; g < 4; ++g) {
            asm volatile("" : "+v"(i));
            f32x4 acc[8];
#pragma unroll
            for (int dt = 0; dt < 8; ++dt) acc[dt] = (f32x4){0.f, 0.f, 0.f, 0.f};
            const float* wsr = p.in[I_ABWS] + ((size_t)g * 128 + i) * 128;
            float wva[4][8]; v2u uu8[8];
#pragma unroll
            for (int c = 0; c < 4; ++c) pg8::ld8f(wsr + 32 * c + 8 * kq, wva[c]);
#pragma unroll
            for (int dt = 0; dt < 8; ++dt) uu8[dt] = *(const v2u*)(PROJ + (r0 + i) * 1536 + g * 128 + 16 * dt + 4 * kq);
#pragma unroll
            for (int c = 0; c < 4; ++c) if (c < nch) {
                float (&wv)[8] = wva[c];
#pragma unroll
                for (int e = 0; e < 8; ++e) if (32 * c + 8 * kq + e > i) wv[e] = 0.f;
                const bf16x8 bfrag = pack8(wv);
#pragma unroll
                for (int dt = 0; dt < 8; ++dt) { const LAS bf16* vp = Vn + (32 * c + 8 * kq + (q16 >> 2)) * SG_VS + g * 128 + 16 * dt + 4 * (q16 & 3);
                    const v2u lo = vtr(vp), hi = vtr(vp + 4 * SG_VS);
                    v4u av; av.x = lo.x; av.y = lo.y; av.z = hi.x; av.w = hi.y;
                    acc[dt] = __builtin_amdgcn_mfma_f32_16x16x32_bf16(__builtin_bit_cast(bf16x8, av), bfrag, acc[dt], 0, 0, 0); }
            }
            const float bs = p.in[I_ABBS][g * 128 + i];
#pragma unroll
            for (int dt = 0; dt < 8; ++dt) { const v2u uu = uu8[dt];
                const float o0 = bflo(uu.x) * (acc[dt][0] + bs), o1 = bfhi(uu.x) * (acc[dt][1] + bs), o2 = bflo(uu.y) * (acc[dt][2] + bs), o3 = bfhi(uu.y) * (acc[dt][3] + bs);
                v2u w; w.x = pk2(o0, o1); w.y = pk2(o2, o3);
                *(v2u*)(AO + (r0 + i) * 1024 + g * 128 + 16 * dt + 4 * kq) = w; }
        }
    }
    {
        const int c = tid, gi = c >> 7;
        const bf16* pp = PROJ + 1024 + c;
        float prev[16], cur[16], o[16];
#pragma unroll
        for (int k = 0; k < 16; ++k) prev[k] = (ch > 0) ? bf1(pp[(r0 - 16 + k) * 1536]) : 0.f;
        bf16 nxt[16];
#pragma unroll
        for (int k = 0; k < 16; ++k) nxt[k] = pp[(r0 + k) * 1536];
#pragma unroll 1
        for (int blk = 0; blk < 8; ++blk) {
#pragma unroll
            for (int k = 0; k < 16; ++k) cur[k] = bf1(nxt[k]);
            if (blk < 7) {
#pragma unroll
                for (int k = 0; k < 16; ++k) nxt[k] = pp[(r0 + 16 * (blk + 1) + k) * 1536]; }
            pool_dispatch(gi, prev, cur, o, ch * 128 + 16 * blk, ch == 0 && blk == 0);
#pragma unroll
            for (int k = 0; k < 16; ++k) AO[(r0 + 16 * blk + k) * 1024 + 512 + c] = (bf16)f2bf(o[k]);
            if (ch == 63 && blk == 7) {
#pragma unroll
                for (int k = 1; k < 16; ++k) p.out[O_POOLP + ((size_t)b * 15 + (k - 1)) * 512 + c] = cur[k]; }
#pragma unroll
            for (int k = 0; k < 16; ++k) prev[k] = cur[k];
        }
    }
    __syncthreads();
}

__device__ __forceinline__ void sgu_sample_unit(const Params& p, LAS unsigned char* lds, int b, int tid, int wave, int lane) {
    const bf16* PROJ = (const bf16*)(p.ws + W_PROJ); bf16* AO = (bf16*)(p.ws + W_AO);
    LAS float* red = (LAS float*)lds;
    const int c = tid, g = c >> 7; const size_t rs = (size_t)MP + 8 * b;
    float x[8], st[16];
#pragma unroll
    for (int j = 0; j < 8; ++j) { x[j] = bf1(PROJ[(rs + j) * 1536 + 512 + c]); st[j] = wave_sum(x[j]); st[8 + j] = wave_sum(x[j] * x[j]); }
    if (lane == 0) {
#pragma unroll
        for (int j = 0; j < 16; ++j) red[wave * 16 + j] = st[j]; }
    __syncthreads();
    float v[8]; const float gn = p.in[I_ABVG][c];
#pragma unroll
    for (int j = 0; j < 8; ++j) { float s = 0.f, q = 0.f;
#pragma unroll
        for (int w = 0; w < 8; ++w) { s += red[w * 16 + j]; q += red[w * 16 + 8 + j]; }
        const float mean = s * (1.f / 512.f), var = fmaxf(q * (1.f / 512.f) - mean * mean, 0.f);
        v[j] = (x[j] - mean) * rsqrtf(var + EPS) * gn;
        p.out[O_CHV + ((size_t)b * 8 + j) * 512 + c] = v[j]; }
    const float* wsg = p.in[I_ABWS] + (size_t)g * 128 * 128;
#pragma unroll
    for (int i = 0; i < 8; ++i) { float sg = p.in[I_ABBS][g * 128 + i];
#pragma unroll
        for (int j = 0; j < 8; ++j) if (j <= i) sg += wsg[i * 128 + j] * v[j];
        AO[(rs + i) * 1024 + c] = (bf16)f2bf(bf1(PROJ[(rs + i) * 1536 + c]) * sg); }
    float pe[24];
    pe[0] = 0.f;
#pragma unroll
    for (int k = 0; k < 15; ++k) pe[1 + k] = p.in[I_CPOOL][((size_t)b * 15 + k) * 512 + c];
#pragma unroll
    for (int i = 0; i < 8; ++i) pe[16 + i] = bf1(PROJ[(rs + i) * 1536 + 1024 + c]);
    const int W = 2 << g; const float invW = __builtin_amdgcn_rcpf((float)W);
#pragma unroll
    for (int i = 0; i < 8; ++i) { float s = 0.f;
#pragma unroll
        for (int kk = 0; kk < 16; ++kk) if (kk < W) s += pe[16 + i - kk];
        AO[(rs + i) * 1024 + 512 + c] = (bf16)f2bf(s * invW - pe[16 + i]); }
#pragma unroll
    for (int k = 0; k < 15; ++k) p.out[O_POOLS + ((size_t)b * 15 + k) * 512 + c] = pe[9 + k];
    __syncthreads();
}

constexpr int SWA_KS = 72, SWA_VS = 72, SWA_VOFF = 256 * SWA_KS * 2;
template <bool SAMPLE>
__device__ __forceinline__ void swa_unit(const Params& p, LAS unsigned char* lds, int unit, int tid, int wave, int lane) {
    const bf16* Q = (const bf16*)(p.ws + W_PROJ); const float* KV = (const float*)(p.ws + W_KV32); bf16* AO = (bf16*)(p.ws + W_AO);
    LAS bf16* Kl = (LAS bf16*)lds; LAS bf16* Vt = (LAS bf16*)(lds + SWA_VOFF);
    int b, kvh, nb;
    if (!SAMPLE) { nb = unit & 63; kvh = (unit >> 6) & 3; b = unit >> 8; } else { kvh = unit & 3; b = unit >> 2; nb = 0; }
    constexpr int NKEY = SAMPLE ? 160 : 256;
    {
        const int sub = tid & 7;
        float kg[8]; pg8::ld8f(p.in[I_CKG] + 8 * sub, kg);
        constexpr int NIT = SAMPLE ? 3 : 4;
        float kk[NIT][8], vv[NIT][8];
#pragma unroll
        for (int it = 0; it < NIT; ++it) { const int s = (tid >> 3) + 64 * it;
            const float* kp = nullptr; const float* vp = nullptr;
            if (!SAMPLE) { const int trel = (nb - 1) * 128 + s;
                if (trel >= 0) { kp = KV + ((size_t)b * 8192 + trel) * 512 + kvh * 64 + sub * 8; vp = kp + 256; } }
            else { if (s < 128) { const size_t o = (((size_t)b * 128 + s) * 4 + kvh) * 64 + sub * 8; kp = p.in[I_CSK] + o; vp = p.in[I_CSV] + o; }
                else if (s < 136) { kp = KV + ((size_t)MP + 8 * b + (s - 128)) * 512 + kvh * 64 + sub * 8; vp = kp + 256; } }
            if (kp) { if (SAMPLE) { pg8::ld8f_nt(kp, kk[it]); pg8::ld8f_nt(vp, vv[it]); } else { pg8::ld8f(kp, kk[it]); pg8::ld8f(vp, vv[it]); } } else { pg8::zero8(kk[it]); pg8::zero8(vv[it]); } }
#pragma unroll
        for (int it = 0; it < NIT; ++it) { const int s = (tid >> 3) + 64 * it;
            __builtin_amdgcn_sched_barrier(0);
            if (s < NKEY) {
            bool norm; float pos;
            if (!SAMPLE) { const int trel = (nb - 1) * 128 + s; norm = trel >= 0; pos = (float)trel; }
            else { norm = (s >= 128 && s < 136); pos = (float)(16384 + s - 128); }
            float (&k)[8] = kk[it]; float (&v)[8] = vv[it];
            asm volatile("" : "+v"(pos));
            if (norm) { float ss = 0.f;
#pragma unroll
                for (int e = 0; e < 8; ++e) ss += k[e] * k[e];
                ss += __shfl_xor(ss, 1); ss += __shfl_xor(ss, 2); ss += __shfl_xor(ss, 4);
                const float rs = rsqrtf(ss * (1.f / 64.f) + EPS);
#pragma unroll
                for (int e = 0; e < 8; ++e) k[e] *= rs * kg[e];
#pragma unroll
                for (int e = 0; e < 8; ++e) { const float pk = __shfl_xor(k[e], 1); float cs, sn; rope_cs(pos, e, cs, sn);
                    if (sub == 0) k[e] = k[e] * cs - pk * sn; else if (sub == 1) k[e] = k[e] * cs + pk * sn; }
            }
            *(LAS bf16x8*)(Kl + s * SWA_KS + sub * 8) = pack8(k);
            *(LAS bf16x8*)(Vt + s * SWA_VS + sub * 8) = pack8(v);
            if (!SAMPLE) { if (nb == 63 && s >= 128) { const size_t o = (((size_t)b * 128 + (s - 128)) * 4 + kvh) * 64 + sub * 8;
                    *(f32x4*)(p.out + O_SKP + o) = (f32x4){k[0], k[1], k[2], k[3]}; *(f32x4*)(p.out + O_SKP + o + 4) = (f32x4){k[4], k[5], k[6], k[7]};
                    *(f32x4*)(p.out + O_SVP + o) = (f32x4){v[0], v[1], v[2], v[3]}; *(f32x4*)(p.out + O_SVP + o + 4) = (f32x4){v[4], v[5], v[6], v[7]}; } }
            else { if (s >= 8 && s < 136) { const size_t o = (((size_t)b * 128 + (s - 8)) * 4 + kvh) * 64 + sub * 8;
                    __builtin_nontemporal_store((f32x4){k[0], k[1], k[2], k[3]}, (f32x4*)(p.out + O_SKS + o)); __builtin_nontemporal_store((f32x4){k[4], k[5], k[6], k[7]}, (f32x4*)(p.out + O_SKS + o + 4));
                    __builtin_nontemporal_store((f32x4){v[0], v[1], v[2], v[3]}, (f32x4*)(p.out + O_SVS + o)); __builtin_nontemporal_store((f32x4){v[4], v[5], v[6], v[7]}, (f32x4*)(p.out + O_SVS + o + 4)); } }
            }
        }
    }
    __syncthreads();
    constexpr int NPASS = SAMPLE ? 1 : 4;
    if (!SAMPLE || wave < 2) {
        asm volatile("" : "+v"(lane));
        float rc[8], rsn[8];
        { const int q16 = lane & 15; const float pos0 = SAMPLE ? (float)(16384 + (q16 & 7)) : (float)(nb * 128 + 16 * wave + q16);
#pragma unroll
          for (int e = 0; e < 8; ++e) rope_cs(pos0, e, rc[e], rsn[e]); }
        float qgs[2][8];
        {
#pragma unroll
          for (int dc = 0; dc < 2; ++dc) { pg8::ld8f(p.in[I_CQG] + 32 * dc + 8 * (lane >> 4), qgs[dc]);
#pragma unroll
            for (int e = 0; e < 8; ++e) qgs[dc][e] *= 0.125f; } }
        v4u qraw[2];
        { const int q16 = lane & 15, kq = lane >> 4;
          const size_t row0 = SAMPLE ? (size_t)MP + 8 * b + (q16 & 7) : (size_t)b * 8192 + nb * 128 + 16 * wave + q16;
          const int h0 = kvh * 4 + (SAMPLE ? 2 * wave + (q16 >> 3) : 0);
#pragma unroll
          for (int dc = 0; dc < 2; ++dc) qraw[dc] = *(const v4u*)(Q + row0 * 1024 + h0 * 64 + 32 * dc + 8 * kq); }
#pragma unroll 1
        for (int ps = 0; ps < NPASS; ++ps) {
            int q16 = lane & 15, kq = lane >> 4; asm volatile("" : "+v"(q16), "+v"(kq));
            int g, i, c0; size_t row; float pos;
            if (!SAMPLE) { g = ps; i = 16 * wave + q16; row = (size_t)b * 8192 + nb * 128 + i; pos = (float)(nb * 128 + i); c0 = wave >> 1; }
            else { g = 2 * wave + (q16 >> 3); i = q16 & 7; row = (size_t)MP + 8 * b + i; pos = (float)(16384 + i); c0 = 0; }
            const int h = kvh * 4 + g;
            float qv[2][8];
#pragma unroll
            for (int dc = 0; dc < 2; ++dc) unpack8(qraw[dc], qv[dc]);
            if (!SAMPLE && ps + 1 < NPASS) {
#pragma unroll
                for (int dc = 0; dc < 2; ++dc) qraw[dc] = *(const v4u*)(Q + row * 1024 + (h + 1) * 64 + 32 * dc + 8 * kq); }
            float ss = 0.f;
#pragma unroll
            for (int dc = 0; dc < 2; ++dc)
#pragma unroll
                for (int e = 0; e < 8; ++e) ss += qv[dc][e] * qv[dc][e];
            ss += __shfl_xor(ss, 16); ss += __shfl_xor(ss, 32);
            const float rs = rsqrtf(ss * (1.f / 64.f) + EPS);
#pragma unroll
            for (int dc = 0; dc < 2; ++dc) {
#pragma unroll
                for (int e = 0; e < 8; ++e) qv[dc][e] *= rs * qgs[dc][e]; }
#pragma unroll
            for (int e = 0; e < 8; ++e) { const float pk = __shfl_xor(qv[0][e], 16); const float cs = rc[e], sn = rsn[e];
                if (kq == 0) qv[0][e] = qv[0][e] * cs - pk * sn; else if (kq == 1) qv[0][e] = qv[0][e] * cs + pk * sn; }
            bf16x8 qf[2];
#pragma unroll
            for (int dc = 0; dc < 2; ++dc) qf[dc] = pack8(qv[dc]);
            f32x4 S[5][2];
            const float sink = p.in[I_CSINK][h];
            float mx = sink;
#pragma unroll
            for (int cc = 0; cc < 5; ++cc)
#pragma unroll
                for (int tt = 0; tt < 2; ++tt) { const int kb = 32 * (c0 + cc) + 16 * tt; f32x4 a = (f32x4){0.f, 0.f, 0.f, 0.f};
#pragma unroll
                    for (int dc = 0; dc < 2; ++dc) { const bf16x8 kf = *(const LAS bf16x8*)(Kl + (kb + q16) * SWA_KS + 32 * dc + 8 * kq);
                        a = __builtin_amdgcn_mfma_f32_16x16x32_bf16(kf, qf[dc], a, 0, 0, 0); }
                    const int rel = (kb >> 4) - wave;
                    const bool full = !SAMPLE && rel >= 1 && rel <= 7 && (nb > 0 || kb >= 128);
                    if (!full) {
#pragma unroll
                        for (int e = 0; e < 4; ++e) { const int s = kb + 4 * kq + e; const bool ok = (s > i) && (s <= i + 128) && (SAMPLE || nb > 0 || s >= 128);
                            a[e] = ok ? a[e] : -INFINITY; } }
#pragma unroll
                    for (int e = 0; e < 4; ++e) mx = fmaxf(mx, a[e]);
                    S[cc][tt] = a; }
            mx = fmaxf(mx, __shfl_xor(mx, 16)); mx = fmaxf(mx, __shfl_xor(mx, 32));
            float den = 0.f;
#pragma unroll
            for (int cc = 0; cc < 5; ++cc)
#pragma unroll
                for (int tt = 0; tt < 2; ++tt)
#pragma unroll
                    for (int e = 0; e < 4; ++e) { const float pe = __expf(S[cc][tt][e] - mx); S[cc][tt][e] = pe; den += pe; }
            den += __shfl_xor(den, 16); den += __shfl_xor(den, 32);
            den += __expf(sink - mx);
            const float rden = 1.f / den;
            bf16x8 pf[5];
#pragma unroll
            for (int cc = 0; cc < 5; ++cc) { float t8[8];
#pragma unroll
                for (int e = 0; e < 4; ++e) { t8[e] = S[cc][0][e]; t8[4 + e] = S[cc][1][e]; }
                pf[cc] = pack8(t8); }
#pragma unroll
            for (int dt = 0; dt < 4; ++dt) { f32x4 o = (f32x4){0.f, 0.f, 0.f, 0.f};
#pragma unroll
                for (int cc = 0; cc < 5; ++cc) { const LAS bf16* vp = Vt + (32 * (c0 + cc) + 4 * kq + (q16 >> 2)) * SWA_VS + 16 * dt + 4 * (q16 & 3);
                    const v2u lo = vtr(vp), hi = vtr(vp + 16 * SWA_VS);
                    v4u av; av.x = lo.x; av.y = lo.y; av.z = hi.x; av.w = hi.y;
                    o = __builtin_amdgcn_mfma_f32_16x16x32_bf16(__builtin_bit_cast(bf16x8, av), pf[cc], o, 0, 0, 0); }
                v2u w; w.x = pk2(o[0] * rden, o[1] * rden); w.y = pk2(o[2] * rden, o[3] * rden);
                *(v2u*)(AO + row * 1024 + h * 64 + 16 * dt + 4 * kq) = w; }
        }
    }
    __syncthreads();
}

constexpr int MEM_KS = 136, MEM_VS = 136, MEM_VOFF = 256 * MEM_KS * 2;
static_assert(MEM_VOFF + 256 * MEM_VS * 2 <= LDS_CTL_OFF && 128 * SG_VS * 2 <= LDS_CTL_OFF, "LDS");
template <bool SAMPLE>
__device__ __forceinline__ void mem_unit(const Params& p, int l, LAS unsigned char* lds, int unit, int tid, int wave, int lane) {
    const bf16* MQ = (const bf16*)(p.ws + W_MQ); bf16* MO = (bf16*)(p.ws + W_MO);
    LAS bf16* Kl = (LAS bf16*)lds; LAS bf16* Vt = (LAS bf16*)(lds + MEM_VOFF);
    int b, h, qt;
    if (!SAMPLE) { qt = unit & 15; h = (unit >> 4) & 3; b = unit >> 6; } else { h = unit & 3; b = unit >> 2; qt = 0; }
    {
        const int sub = tid & 15;
        float kg[8]; pg8::ld8f(p.in[I_MKG] + l * 128 + 8 * sub, kg);
#pragma unroll 1
        for (int hb = 0; hb < 2; ++hb) {
            float kk[4][8], vv[4][8];
#pragma unroll
            for (int it = 0; it < 4; ++it) { const int s = (tid >> 4) + 32 * (4 * hb + it);
                const float* kp; const float* vp;
                if (!SAMPLE) { kp = (const float*)(p.ws + W_MKV) + ((size_t)l * 1024 + b * 256 + s) * 1024 + h * 128 + sub * 8; vp = kp + 512; }
                else { const size_t o = ((((size_t)l * 128 + b) * 256 + s) * 4 + h) * 128 + sub * 8; kp = p.in[I_CMK] + o; vp = p.in[I_CMV] + o; }
                if (SAMPLE) { pg8::ld8f_nt(kp, kk[it]); pg8::ld8f_nt(vp, vv[it]); } else { pg8::ld8f(kp, kk[it]); pg8::ld8f(vp, vv[it]); } }
#pragma unroll
            for (int it = 0; it < 4; ++it) { const int s = (tid >> 4) + 32 * (4 * hb + it);
                float (&k)[8] = kk[it]; float (&v)[8] = vv[it];
                if (!SAMPLE) { float ss = 0.f;
#pragma unroll
                    for (int e = 0; e < 8; ++e) ss += k[e] * k[e];
                    ss += __shfl_xor(ss, 1); ss += __shfl_xor(ss, 2); ss += __shfl_xor(ss, 4); ss += __shfl_xor(ss, 8);
                    const float rs = rsqrtf(ss * (1.f / 128.f) + EPS);
#pragma unroll
                    for (int e = 0; e < 8; ++e) k[e] *= rs * kg[e];
                    if (qt == 0) { const size_t o = ((((size_t)l * 4 + b) * 256 + s) * 4 + h) * 128 + sub * 8;
                        *(f32x4*)(p.out + O_MKP + o) = (f32x4){k[0], k[1], k[2], k[3]}; *(f32x4*)(p.out + O_MKP + o + 4) = (f32x4){k[4], k[5], k[6], k[7]};
                        *(f32x4*)(p.out + O_MVP + o) = (f32x4){v[0], v[1], v[2], v[3]}; *(f32x4*)(p.out + O_MVP + o + 4) = (f32x4){v[4], v[5], v[6], v[7]}; }
                }
                *(LAS bf16x8*)(Kl + s * MEM_KS + sub * 8) = pack8(k);
                *(LAS bf16x8*)(Vt + s * MEM_VS + sub * 8) = pack8(v);
            }
        }
    }
    __syncthreads();
    if (!SAMPLE || wave == 0) {
#pragma unroll 1
      for (int qq = 0; qq < (SAMPLE ? 1 : 4); ++qq) {
        int q16 = lane & 15, kq = lane >> 4; asm volatile("" : "+v"(q16), "+v"(kq));
        size_t row; bool st;
        if (!SAMPLE) { row = (size_t)b * 8192 + (qt * 4 + qq) * 128 + 16 * wave + q16; st = true; } else { row = (size_t)MP + 8 * b + (q16 & 7); st = q16 < 8; }
        bf16x8 qf[4];
        {
            float qv[4][8]; float ss = 0.f;
#pragma unroll
            for (int dc = 0; dc < 4; ++dc) { unpack8(*(const v4u*)(MQ + row * 512 + h * 128 + 32 * dc + 8 * kq), qv[dc]);
#pragma unroll
                for (int e = 0; e < 8; ++e) ss += qv[dc][e] * qv[dc][e]; }
            ss += __shfl_xor(ss, 16); ss += __shfl_xor(ss, 32);
            const float rs = rsqrtf(ss * (1.f / 128.f) + EPS) * 0.08838834764831845f;
#pragma unroll
            for (int dc = 0; dc < 4; ++dc) { float qg[8]; pg8::ld8f(p.in[I_MQG] + l * 128 + 32 * dc + 8 * kq, qg);
#pragma unroll
                for (int e = 0; e < 8; ++e) qv[dc][e] *= rs * qg[e];
                qf[dc] = pack8(qv[dc]); }
        }
        f32x4 S[8][2]; float mx = -INFINITY;
#pragma unroll
        for (int cc = 0; cc < 8; ++cc)
#pragma unroll
            for (int tt = 0; tt < 2; ++tt) { const int kb = 32 * cc + 16 * tt; f32x4 a = (f32x4){0.f, 0.f, 0.f, 0.f};
#pragma unroll
                for (int dc = 0; dc < 4; ++dc) { const bf16x8 kf = *(const LAS bf16x8*)(Kl + (kb + q16) * MEM_KS + 32 * dc + 8 * kq);
                    a = __builtin_amdgcn_mfma_f32_16x16x32_bf16(kf, qf[dc], a, 0, 0, 0); }
#pragma unroll
                for (int e = 0; e < 4; ++e) mx = fmaxf(mx, a[e]);
                S[cc][tt] = a; }
        mx = fmaxf(mx, __shfl_xor(mx, 16)); mx = fmaxf(mx, __shfl_xor(mx, 32));
        float den = 0.f;
#pragma unroll
        for (int cc = 0; cc < 8; ++cc)
#pragma unroll
            for (int tt = 0; tt < 2; ++tt)
#pragma unroll
                for (int e = 0; e < 4; ++e) { const float pe = __expf(S[cc][tt][e] - mx); S[cc][tt][e] = pe; den += pe; }
        den += __shfl_xor(den, 16); den += __shfl_xor(den, 32);
        const float rden = 1.f / den;
        bf16x8 pf[8];
#pragma unroll
        for (int cc = 0; cc < 8; ++cc) { float t8[8];
#pragma unroll
            for (int e = 0; e < 4; ++e) { t8[e] = S[cc][0][e]; t8[4 + e] = S[cc][1][e]; }
            pf[cc] = pack8(t8); }
#pragma unroll
        for (int dt = 0; dt < 8; ++dt) { f32x4 o = (f32x4){0.f, 0.f, 0.f, 0.f};
#pragma unroll
            for (int cc = 0; cc < 8; ++cc) { const LAS bf16* vp = Vt + (32 * cc + 4 * kq + (q16 >> 2)) * MEM_VS + 16 * dt + 4 * (q16 & 3);
                const v2u lo = vtr(vp), hi = vtr(vp + 16 * MEM_VS);
                v4u av; av.x = lo.x; av.y = lo.y; av.z = hi.x; av.w = hi.y;
                o = __builtin_amdgcn_mfma_f32_16x16x32_bf16(__builtin_bit_cast(bf16x8, av), pf[cc], o, 0, 0, 0); }
            if (st) { v2u w; w.x = pk2(o[0] * rden, o[1] * rden); w.y = pk2(o[2] * rden, o[3] * rden);
                *(v2u*)(MO + row * 512 + h * 128 + 16 * dt + 4 * kq) = w; } }
      }
    }
    __syncthreads();
}

#ifndef REP_LIGHT
#define REP_LIGHT 1
#endif
#ifndef REP_G9
#define REP_G9 1
#endif
#ifndef REP_G10
#define REP_G10 1
#endif
#ifndef REP_PRO
#define REP_PRO 1
#endif
#ifndef REP_MEM
#define REP_MEM 1
#endif
#ifndef REP_P15
#define REP_P15 1
#endif
#ifndef REP_SYNC
#define REP_SYNC 1
#endif
#define GSYNC() do { for (int r_ = 0; r_ < REP_SYNC; ++r_) xcd_barrier(xbar); } while (0)
#define PHASE_IDS int t_ = threadIdx.x; asm volatile("" : "+v"(t_)); const int tid = t_, lane = tid & 63, wave = __builtin_amdgcn_readfirstlane(tid >> 6); const int gw = bx * NWAVES + wave; (void)gw; (void)lane; (void)tid;
__global__ void __launch_bounds__(NTHR, 2) fwd_megakernel(Params p) {
    extern __shared__ __attribute__((aligned(16))) unsigned char lds_raw[];
    LAS unsigned char* lds = (LAS unsigned char*)lds_raw;
    cg::grid_group grid = cg::this_grid();
    const int G = gridDim.x, bx = blockIdx.x;
    const int wave0 = __builtin_amdgcn_readfirstlane((int)threadIdx.x >> 6);
    const int ngw = G * NWAVES;
    unsigned char* ws = p.ws;
    bf16* XN = (bf16*)(ws + W_XN);
    float* SSb = (float*)(ws + W_SS);
    float* X = p.out;
    typedef pg8::bf16_t pb;

    if (threadIdx.x < 16) ((LAS unsigned*)(lds + LDS_CTL_OFF))[threadIdx.x] = 0u;
    __syncthreads();
    const XcdBarrier xbar = xcd_barrier_post((unsigned*)(ws + W_CTL), (volatile LAS unsigned*)(lds + LDS_CTL_OFF));
    for (int rep = 0; rep < REP_LIGHT * REP_PRO; ++rep) { PHASE_IDS prologue(p, lds, gw, ngw, wave, lane); }
    grid.sync();

    auto layer_body = [&](auto LC) __attribute__((always_inline)) {
        constexpr int l = decltype(LC)::value;
        unsigned char* wl = ws + W_LAYER + (size_t)l * WL_SIZE;
        if (l == 0) {
            { pg8::Gemm g{(const pb*)XN, (const pb*)(ws + W_WIN), MT, 1536, 1024}; pg8::StaticOrder S; S.init(MP, 1536, G, bx);
              pg8::EpiAct E{(pb*)(ws + W_PROJ), 1536, 4, SSb};
              pg8::gemm_phase<pg8::EpiAct, pg8::StaticOrder, true, true>(lds, g, S, E, wave0);
              pg8::mini_gemm<pg8::EpiAct, true>(lds, g.A, g.Bt, 1024, 24, E, bx, G, wave0); }
        } else {
            pg8::Gemm g{(const pb*)XN, (const pb*)(ws + W_WQKV), MT, 1536, 1024}; pg8::StaticOrder S; S.init(MP, 1536, G, bx);
            pg8::EpiQKV E{(pb*)(ws + W_PROJ), (float*)(ws + W_KV32), SSb + (size_t)3 * MT};
            pg8::gemm_phase<pg8::EpiQKV, pg8::StaticOrder, true, true>(lds, g, S, E, wave0);
            pg8::mini_gemm<pg8::EpiQKV, true>(lds, g.A, g.Bt, 1024, 24, E, bx, G, wave0);
        }
        GSYNC();
        if (l == 0) {
#ifndef NO_SGU
            PHASE_IDS
            for (int rep = 0; rep < REP_LIGHT; ++rep)
            for (int u = bx; u < 256 + 128; u += G) { if (u < 256) sgu_prompt_unit(p, lds, u, tid, wave, lane); else sgu_sample_unit(p, lds, u - 256, tid, wave, lane); }
#pragma unroll 1
            for (int ll = 0; ll < 2; ++ll) {
              pg8::EpiRes E{(float*)(ws + W_MKV) + (size_t)ll * 1024 * 1024, nullptr, nullptr, 0, nullptr, nullptr, 0};
              pg8::mini_gemm(lds, (const pb*)(ws + W_MN) + (size_t)ll * 1024 * 1024, (const pb*)(ws + W_LAYER + (size_t)ll * WL_SIZE + WL_WKV), 1024, 8, E, (bx + G - 128 - 64 * ll) % G, G, wave0, 0); }
#endif
        } else {
#ifndef NO_SWA
            PHASE_IDS
            for (int rep = 0; rep < REP_LIGHT; ++rep)
            for (int u = bx; u < 1024 + 512; u += G) { if (u < 1024) swa_unit<false>(p, lds, u, tid, wave, lane); else swa_unit<true>(p, lds, u - 1024, tid, wave, lane); }
#endif
        }
        GSYNC();
        {
            pg8::Gemm g{(const pb*)(ws + W_AO), (const pb*)(ws + (l == 0 ? W_WOUT : W_CWO)), MT, 1024, 1024}; pg8::StaticOrder S; S.init(MP, 1024, G, bx);
            pg8::EpiRes E{nullptr, nullptr, nullptr, 1, (pb*)XN, SSb + (size_t)(1 + 3 * l) * MT, 1};
            pg8::gemm_phase<pg8::EpiRes, pg8::StaticOrder, true, true>(lds, g, S, E, wave0);
            pg8::mini_gemm<pg8::EpiRes, true, true>(lds, g.A, g.Bt, 1024, 16, E, bx, G, wave0);
        }
        GSYNC();
        {
            pg8::Gemm g{(const pb*)XN, (const pb*)(wl + WL_WQ), MT, 512, 1024}; pg8::StaticOrder S; S.init(MP, 512, G, bx);
            pg8::EpiAct E{(pb*)(ws + W_MQ), 512, 0, SSb + (size_t)(1 + 3 * l) * MT};
            pg8::gemm_phase<pg8::EpiAct, pg8::StaticOrder, true, true>(lds, g, S, E, wave0);
            pg8::mini_gemm<pg8::EpiAct, true, true>(lds, g.A, g.Bt, 1024, 8, E, bx, G, wave0);
        }
        GSYNC();
#ifndef NO_MEM
        { PHASE_IDS
        for (int rep = 0; rep < REP_LIGHT * REP_MEM; ++rep)
        for (int u = bx; u < 256 + 512; u += G) { if (u < 256) mem_unit<false>(p, l, lds, u, tid, wave, lane); else mem_unit<true>(p, l, lds, u - 256, tid, wave, lane); } }
#endif
        GSYNC();
        {
            pg8::Gemm g{(const pb*)(ws + W_MO), (const pb*)(wl + WL_WO), MT, 1024, 512}; pg8::StaticOrder S; S.init(MP, 1024, G, bx);
            pg8::EpiRes E{nullptr, nullptr, nullptr, 1, (pb*)XN, SSb + (size_t)(2 + 3 * l) * MT, 1};
            pg8::gemm_phase<pg8::EpiRes, pg8::StaticOrder, true, true>(lds, g, S, E, wave0);
            pg8::mini_gemm<pg8::EpiRes, true, true>(lds, g.A, g.Bt, 512, 16, E, bx, G, wave0);
        }
        GSYNC();
        {
            pg8::Gemm g{(const pb*)XN, (const pb*)(wl + WL_WUP), MT, DFF, 1024}; pg8::SplitOrder S; S.init(DFF, G, bx);
            pg8::EpiG E{(pb*)(ws + W_G), p.out + O_FCP + (size_t)l * 4 * 2 * DFF, p.out + O_FCS + (size_t)l * 128 * 2 * DFF, SSb + (size_t)(2 + 3 * l) * MT};
            for (int rep = 0; rep < REP_G9; ++rep) pg8::gemm_phase<pg8::EpiG, pg8::SplitOrder, true, true>(lds, g, S, E, wave0);
        }
        GSYNC();
        {
            pg8::Gemm g{(const pb*)XN, (const pb*)(wl + WL_WUP) + (size_t)DFF * 1024, MT, DFF, 1024}; pg8::SplitOrder S; S.init(DFF, G, bx);
            pg8::EpiH E{(const pb*)(ws + W_G), (pb*)(ws + W_H), p.in[I_FCW] + (size_t)l * 3 * DFF, p.in[I_FCB] + (size_t)l * DFF, p.in[I_CFC] + (size_t)l * 128 * 2 * DFF, SSb + (size_t)(2 + 3 * l) * MT};
            for (int rep = 0; rep < REP_G10; ++rep) pg8::gemm_phase<pg8::EpiH, pg8::SplitOrder, true, true>(lds, g, S, E, wave0);
        }
        GSYNC();
        {
            pg8::Gemm g{(const pb*)(ws + W_H), (const pb*)(wl + WL_WDN), MT, 1024, DFF}; pg8::StaticOrder S; S.init(MP, 1024, G, bx);
            pg8::EpiRes E{l == 0 ? nullptr : X, nullptr, nullptr, 1, (pb*)XN, SSb + (size_t)3 * MT, l == 0};
            pg8::gemm_phase<pg8::EpiRes, pg8::StaticOrder, true, true>(lds, g, S, E, wave0);
            pg8::mini_gemm<pg8::EpiRes, true, true>(lds, g.A, g.Bt, DFF, 16, E, bx, G, wave0);
        }
        GSYNC();
    };
    layer_body(std::integral_constant<int, 0>{});
    layer_body(std::integral_constant<int, 1>{});
}

extern "C" void kernel_launch(void* const* d_in, const int* in_sizes, int n_in, void* d_out, int out_size, void* d_ws, size_t ws_size, hipStream_t stream) {
    static int grid_blocks = 0;
    if (grid_blocks == 0) {
        if (n_in != N_IN || (size_t)out_size != O_END || ws_size < W_NEED) { fprintf(stderr, "kernel_launch: unexpected shapes: n_in %d out %d ws %zu (need %zu)\n", n_in, out_size, ws_size, (size_t)W_NEED); grid_blocks = -1; return; }
        int dev = 0, cus = 0, per_cu = 0;
        hipGetDevice(&dev);
        hipDeviceGetAttribute(&cus, hipDeviceAttributeMultiprocessorCount, dev);
        if (hipFuncSetAttribute((const void*)fwd_megakernel, hipFuncAttributeMaxDynamicSharedMemorySize, LDS_BYTES) != hipSuccess) { fprintf(stderr, "kernel_launch: hipFuncSetAttribute failed\n"); grid_blocks = -1; return; }
        if (hipOccupancyMaxActiveBlocksPerMultiprocessor(&per_cu, (const void*)fwd_megakernel, NTHR, LDS_BYTES) != hipSuccess || per_cu < 1) { fprintf(stderr, "kernel_launch: occupancy query failed (%d)\n", per_cu); (void)hipGetLastError(); grid_blocks = -1; return; }
        grid_blocks = cus * per_cu;
    }
    if (grid_blocks < 0) return;
    if (hipMemsetAsync((char*)d_ws + W_CTL, 0, CTL_BYTES, stream) != hipSuccess) { fprintf(stderr, "kernel_launch: memset failed\n"); return; }
    Params p{};
    for (int i = 0; i < N_IN; ++i) p.in[i] = (const float*)d_in[i];
    p.out = (float*)d_out; p.ws = (unsigned char*)d_ws;
    void* args[] = {&p};
    hipError_t e = hipLaunchCooperativeKernel((const void*)fwd_megakernel, dim3(grid_blocks), dim3(NTHR), args, LDS_BYTES, stream);
    if (e != hipSuccess) fprintf(stderr, "cooperative launch failed: %s (grid %d)\n", hipGetErrorString(e), grid_blocks);
}
```

```cpp
#include <hip/hip_runtime.h>
#include <hip/hip_cooperative_groups.h>
#include <cstdio>
#include <cstdint>
#include <type_traits>
namespace cg = cooperative_groups;
namespace pg8 {
#define PG8_LAS __attribute__((address_space(3)))
typedef unsigned short bf16_t;
typedef short bf16x8 __attribute__((ext_vector_type(8)));
typedef float f32x4 __attribute__((ext_vector_type(4)));
typedef unsigned u32x4 __attribute__((ext_vector_type(4)));
constexpr int BM = 256, BK = 64, HALF = 128, HTB = HALF * BK * 2  , STAGE_BYTES = 8 * HTB, NXCD = 8, WGM = 8;

__host__ __device__ __forceinline__ int lds_byte(int r, int c) { const int st = (r >> 4) * 2 + (c >> 5), rr = r & 15, cc = c & 31, ob = rr * 64 + cc * 2; return st * 1024 + (ob ^ (((ob >> 9) & 1) << 5)); }
__host__ __device__ __forceinline__ void stage_rc(int b, int& R, int& C) { const int st = b / 1024, sb = b % 1024, swz = sb ^ (((sb >> 9) & 1) << 5); R = (st >> 1) * 16 + swz / 64; C = (st & 1) * 32 + (swz % 64) / 2; }
__host__ __device__ __forceinline__ int perm32(int rho) { const int n = rho >> 4, i = rho & 15; return 8 * (i >> 2) + 4 * n + (i & 3); }

struct Unit { int pm, pn; int rb; int half; int q; int cb; };
struct Gemm { const bf16_t* A; const bf16_t* Bt; int M, N, K; };

struct StaticOrder {
    int nM, nN, nwg, G, c;
    __host__ __device__ void init(int M, int N, int G_, int c_) { nM = M / BM; nN = N / BM; nwg = nM * nN; G = G_; c = c_; }
    __host__ __device__ bool next(int i, Unit& u) const {
        const long L = (long)i * G + c; if (L >= nwg) return false;
        int wgid = (int)L; { const int q = nwg / NXCD, r = nwg % NXCD, xcd = wgid % NXCD, off = wgid / NXCD; wgid = (xcd < r ? xcd * (q + 1) : r * (q + 1) + (xcd - r) * q) + off; }
        const int nig = WGM * nN, gid = wgid / nig, fm = gid * WGM, gsz = (nM - fm) < WGM ? (nM - fm) : WGM;
        u.pm = fm + ((wgid % nig) % gsz); u.pn = (wgid % nig) / gsz; u.rb = u.pm * BM; u.half = 0; u.q = 0; u.cb = u.pn * BM; return true;
    }
    __device__ __forceinline__ void a_ready(const Unit&) const {}
    __device__ __forceinline__ void done(const Unit&) const {}
};
struct SplitOrder {
    StaticOrder P; int nP, nS, nN, G, c;
    __host__ __device__ void init(int N, int G_, int c_) { P.init(32768, N, G_, c_); nP = P.nwg; nN = N / BM; nS = 8 * nN; G = G_; c = c_; }
    __host__ __device__ bool next(int i, Unit& u) const {
        const long L = (long)i * G + c;
        if (L < nP) return P.next(i, u);
        const int j = (int)(L - nP); if (j >= nS) return false;
        const int hm = j & 7; u.pn = j >> 3; u.pm = 128 + (hm >> 1); u.rb = 32768 + 128 * hm; u.half = 1; u.q = 0; u.cb = u.pn * BM; return true;
    }
    __device__ __forceinline__ void a_ready(const Unit&) const {}
    __device__ __forceinline__ void done(const Unit&) const {}
};


__device__ __forceinline__ unsigned cvt_pk_bf16(float lo, float hi) { unsigned r; asm volatile("v_cvt_pk_bf16_f32 %0, %1, %2" : "=v"(r) : "v"(lo), "v"(hi)); return r; }
typedef float f32x2 __attribute__((ext_vector_type(2)));
__device__ __forceinline__ f32x2 gelu_pk(f32x2 v) {
    f32x2 x = v * 0.70710678118f;
    x.x = __builtin_amdgcn_fmed3f(x.x, -2.9f, 2.9f); x.y = __builtin_amdgcn_fmed3f(x.y, -2.9f, 2.9f);
    const f32x2 t = x * x;
    f32x2 p = t * (-4.953124630e-07f) + 1.987094038e-05f;
    p = p * t + (-3.472001117e-04f); p = p * t + 3.517547622e-03f; p = p * t + (-2.333305031e-02f); p = p * t + 1.087993085e-01f; p = p * t + (-3.740358949e-01f); p = p * t + 1.128076553e+00f;
    const f32x2 hv = v * 0.5f;
    return hv * (x * p) + hv;
}

__device__ __forceinline__ float bf_lo(unsigned w) { return __builtin_bit_cast(float, w << 16); }
__device__ __forceinline__ float bf_hi(unsigned w) { return __builtin_bit_cast(float, w & 0xffff0000u); }
__device__ __forceinline__ void ld8bf(const bf16_t* p, float (&o)[8]) { const u32x4 w = *(const u32x4*)p;
    o[0] = bf_lo(w.x); o[1] = bf_hi(w.x); o[2] = bf_lo(w.y); o[3] = bf_hi(w.y); o[4] = bf_lo(w.z); o[5] = bf_hi(w.z); o[6] = bf_lo(w.w); o[7] = bf_hi(w.w); }
__device__ __forceinline__ void ld8f(const float* p, float (&o)[8]) { const f32x4 a = *(const f32x4*)p, b = *(const f32x4*)(p + 4);
    o[0] = a[0]; o[1] = a[1]; o[2] = a[2]; o[3] = a[3]; o[4] = b[0]; o[5] = b[1]; o[6] = b[2]; o[7] = b[3]; }
__device__ __forceinline__ void ld8f_nt(const float* p, float (&o)[8]) { const f32x4 a = __builtin_nontemporal_load((const f32x4*)p), b = __builtin_nontemporal_load((const f32x4*)(p + 4));
    o[0] = a[0]; o[1] = a[1]; o[2] = a[2]; o[3] = a[3]; o[4] = b[0]; o[5] = b[1]; o[6] = b[2]; o[7] = b[3]; }
__device__ __forceinline__ void zero8(float (&o)[8]) {
#pragma unroll
    for (int j = 0; j < 8; ++j) o[j] = 0.f; }

struct EpiAct {
    static constexpr bool PERM = true, AFTER_DRAIN = false;
    bf16_t* O; int ldc; int gelu_tiles; const float* SS;
    __device__ __forceinline__ void operator()(const f32x4 (&acc)[2][2][4][2], const Unit& u, int wr, int wc, int fr, int fq) const {
        asm volatile("" : "+v"(fr), "+v"(fq));
        const int row0 = u.rb + wr * 64 + fr, col0 = u.cb + wc * 32 + 8 * fq;
        const bool act = u.pn < gelu_tiles;
        float rsv[2][4];
#pragma unroll
        for (int ai = 0; ai < 2; ++ai)
#pragma unroll
            for (int m = 0; m < 4; ++m) rsv[ai][m] = SS[row0 + (u.half ? 0 : ai * HALF) + m * 16];
#pragma unroll
        for (int ai = 0; ai < 2; ++ai) if (ai == 0 || !u.half)
#pragma unroll
            for (int m = 0; m < 4; ++m) { bf16_t* rowp = O + (size_t)(row0 + ai * HALF + m * 16) * ldc + col0;
                const float rs = rsqrtf(rsv[ai][m] * (1.f / 1024.f) + 1e-6f);
#pragma unroll
                for (int bj = 0; bj < 2; ++bj) if (bj == 0 || !u.q) { f32x4 v0 = acc[ai][bj][m][0] * rs, v1 = acc[ai][bj][m][1] * rs;
                    if (act) { f32x2 a = gelu_pk((f32x2){v0[0], v0[1]}), b = gelu_pk((f32x2){v0[2], v0[3]}), c = gelu_pk((f32x2){v1[0], v1[1]}), d = gelu_pk((f32x2){v1[2], v1[3]});
                        v0 = (f32x4){a.x, a.y, b.x, b.y}; v1 = (f32x4){c.x, c.y, d.x, d.y}; }
                    u32x4 w; w.x = cvt_pk_bf16(v0[0], v0[1]); w.y = cvt_pk_bf16(v0[2], v0[3]); w.z = cvt_pk_bf16(v1[0], v1[1]); w.w = cvt_pk_bf16(v1[2], v1[3]);
                    *(u32x4*)(rowp + bj * HALF) = w; } }
    }
};

struct EpiQKV {
    static constexpr bool PERM = true, AFTER_DRAIN = false;
    bf16_t* Q; float* KV; const float* SS;
    __device__ __forceinline__ void operator()(const f32x4 (&acc)[2][2][4][2], const Unit& u, int wr, int wc, int fr, int fq) const {
        asm volatile("" : "+v"(fr), "+v"(fq));
        const int row0 = u.rb + wr * 64 + fr;
        float rs[2][4];
#pragma unroll
        for (int ai = 0; ai < 2; ++ai) if (ai == 0 || !u.half)
#pragma unroll
            for (int m = 0; m < 4; ++m) rs[ai][m] = rsqrtf(SS[row0 + (u.half ? 0 : ai * HALF) + m * 16] * (1.f / 1024.f) + 1e-6f);
        if (u.pn < 4) {
            const int col0 = u.cb + wc * 32 + 8 * fq;
#pragma unroll
            for (int ai = 0; ai < 2; ++ai) if (ai == 0 || !u.half)
#pragma unroll
                for (int m = 0; m < 4; ++m) { bf16_t* rowp = Q + (size_t)(row0 + ai * HALF + m * 16) * 1024 + col0;
#pragma unroll
                    for (int bj = 0; bj < 2; ++bj) if (bj == 0 || !u.q) { const f32x4 v0 = acc[ai][bj][m][0] * rs[ai][m], v1 = acc[ai][bj][m][1] * rs[ai][m];
                        u32x4 w; w.x = cvt_pk_bf16(v0[0], v0[1]); w.y = cvt_pk_bf16(v0[2], v0[3]); w.z = cvt_pk_bf16(v1[0], v1[1]); w.w = cvt_pk_bf16(v1[2], v1[3]);
                        *(u32x4*)(rowp + bj * HALF) = w; } }
        } else {
            const int col0 = (u.cb - 1024) + wc * 32 + 8 * fq;
#pragma unroll
            for (int ai = 0; ai < 2; ++ai) if (ai == 0 || !u.half)
#pragma unroll
                for (int m = 0; m < 4; ++m) { float* rowp = KV + (size_t)(row0 + ai * HALF + m * 16) * 512 + col0;
#pragma unroll
                    for (int bj = 0; bj < 2; ++bj) if (bj == 0 || !u.q) { *(f32x4*)(rowp + bj * HALF) = acc[ai][bj][m][0] * rs[ai][m]; *(f32x4*)(rowp + bj * HALF + 4) = acc[ai][bj][m][1] * rs[ai][m]; } }
        }
    }
};

struct EpiRes {
    static constexpr bool PERM = true, AFTER_DRAIN = false;
    float* C; const float* resP; const float* resS; int inplace; bf16_t* XB0; float* SS; int wxb;
    static constexpr int ldc = 1024, split = 32768;
    __device__ __forceinline__ void row_out(const f32x4 v0, const f32x4 v1, int row, int col, float& ss) const {
        if (C) { float* rowp = C + (size_t)row * ldc + col; __builtin_nontemporal_store(v0, (f32x4*)rowp); __builtin_nontemporal_store(v1, (f32x4*)(rowp + 4)); }
        if (wxb) { u32x4 w; w.x = cvt_pk_bf16(v0[0], v0[1]); w.y = cvt_pk_bf16(v0[2], v0[3]); w.z = cvt_pk_bf16(v1[0], v1[1]); w.w = cvt_pk_bf16(v1[2], v1[3]);
            *(u32x4*)(XB0 + (size_t)row * ldc + col) = w;
            ss += (v0[0] * v0[0] + v0[1] * v0[1]) + (v0[2] * v0[2] + v0[3] * v0[3]) + (v1[0] * v1[0] + v1[1] * v1[1]) + (v1[2] * v1[2] + v1[3] * v1[3]); }
    }
    __device__ __forceinline__ void operator()(const f32x4 (&acc)[2][2][4][2], const Unit& u, int wr, int wc, int fr, int fq) const {
        asm volatile("" : "+v"(fr), "+v"(fq));
        const int row0 = u.rb + wr * 64 + fr, col0 = u.cb + wc * 32 + 8 * fq;
        if (inplace) {
#pragma unroll
            for (int ai = 0; ai < 2; ++ai) if (ai == 0 || !u.half)
#pragma unroll
              for (int mh = 0; mh < 4; mh += 2) {
                u32x4 rw[2][2];
#pragma unroll
                for (int mm = 0; mm < 2; ++mm) { const int row = row0 + ai * HALF + (mh + mm) * 16;
#pragma unroll
                    for (int bj = 0; bj < 2; ++bj) if (bj == 0 || !u.q) rw[mm][bj] = *(const u32x4*)(XB0 + (size_t)row * ldc + col0 + bj * HALF); }
#pragma unroll
                for (int mm = 0; mm < 2; ++mm) { const int m = mh + mm, row = row0 + ai * HALF + m * 16; float ss = 0.f;
#pragma unroll
                    for (int bj = 0; bj < 2; ++bj) if (bj == 0 || !u.q) { const u32x4 w = rw[mm][bj];
                        const f32x4 v0 = acc[ai][bj][m][0] + (f32x4){bf_lo(w.x), bf_hi(w.x), bf_lo(w.y), bf_hi(w.y)}, v1 = acc[ai][bj][m][1] + (f32x4){bf_lo(w.z), bf_hi(w.z), bf_lo(w.w), bf_hi(w.w)};
                        row_out(v0, v1, row, col0 + bj * HALF, ss); }
                    if (wxb) { ss += __shfl_xor(ss, 16); ss += __shfl_xor(ss, 32); if (fq == 0) unsafeAtomicAdd(SS + row, ss); } }
              }
        } else {
#pragma unroll
            for (int ai = 0; ai < 2; ++ai) if (ai == 0 || !u.half)
#pragma unroll
                for (int m = 0; m < 4; ++m) { const int row = row0 + ai * HALF + m * 16; float ss = 0.f;
                    const float* rp = resP ? ((row < split ? resP + (size_t)row * ldc : resS + (size_t)(row - split) * ldc) + col0) : nullptr;
                    f32x4 rv[2][2];
#pragma unroll
                    for (int bj = 0; bj < 2; ++bj) if (bj == 0 || !u.q) { rv[bj][0] = rp ? *(const f32x4*)(rp + bj * HALF) : (f32x4){0.f, 0.f, 0.f, 0.f}; rv[bj][1] = rp ? *(const f32x4*)(rp + bj * HALF + 4) : (f32x4){0.f, 0.f, 0.f, 0.f}; }
#pragma unroll
                    for (int bj = 0; bj < 2; ++bj) if (bj == 0 || !u.q) row_out(acc[ai][bj][m][0] + rv[bj][0], acc[ai][bj][m][1] + rv[bj][1], row, col0 + bj * HALF, ss);
                    if (wxb) { ss += __shfl_xor(ss, 16); ss += __shfl_xor(ss, 32); if (fq == 0) unsafeAtomicAdd(SS + row, ss); } }
        }
    }
};

struct EpiG {
    static constexpr bool PERM = true, AFTER_DRAIN = false;
    bf16_t* G; float* outP; float* outS; const float* SS;
    __device__ __forceinline__ void operator()(const f32x4 (&acc)[2][2][4][2], const Unit& u, int wr, int wc, int fr, int fq) const {
        asm volatile("" : "+v"(fr), "+v"(fq));
        const int row0 = u.rb + wr * 64 + fr, col0 = u.pn * BM + wc * 32 + 8 * fq;
        float rsv[2][4];
#pragma unroll
        for (int ai = 0; ai < 2; ++ai)
#pragma unroll
            for (int m = 0; m < 4; ++m) rsv[ai][m] = SS[row0 + (u.half ? 0 : ai * HALF) + m * 16];
#pragma unroll
        for (int ai = 0; ai < 2; ++ai) if (ai == 0 || !u.half)
#pragma unroll
            for (int m = 0; m < 4; ++m) { const int row = row0 + ai * HALF + m * 16; bf16_t* rowp = G + (size_t)row * 2816 + col0;
                float* co = nullptr;
                if (row < 32768) { const int t = row & 8191; if (t >= 8190) co = outP + ((size_t)(row >> 13) * 2 + (t - 8190)) * 2816 + col0; }
                else { const int i = row & 7; if (i >= 6) co = outS + ((size_t)((row - 32768) >> 3) * 2 + (i - 6)) * 2816 + col0; }
                const float rs = rsqrtf(rsv[ai][m] * (1.f / 1024.f) + 1e-6f);
#pragma unroll
                for (int bj = 0; bj < 2; ++bj) { const f32x4 v0 = acc[ai][bj][m][0] * rs, v1 = acc[ai][bj][m][1] * rs;
                    u32x4 w; w.x = cvt_pk_bf16(v0[0], v0[1]); w.y = cvt_pk_bf16(v0[2], v0[3]); w.z = cvt_pk_bf16(v1[0], v1[1]); w.w = cvt_pk_bf16(v1[2], v1[3]);
                    *(u32x4*)(rowp + bj * HALF) = w;
                    if (co) { *(f32x4*)(co + bj * HALF) = v0; *(f32x4*)(co + bj * HALF + 4) = v1; } } }
    }
};

typedef unsigned u32x2 __attribute__((ext_vector_type(2)));
struct EpiH {
    static constexpr bool PERM = true, AFTER_DRAIN = false;
    const bf16_t* G; bf16_t* H; const float* cw; const float* cb; const float* ctx; const float* SS;
    static __device__ __forceinline__ void unpk4(const u32x2 w, float (&o)[4]) { o[0] = bf_lo(w.x); o[1] = bf_hi(w.x); o[2] = bf_lo(w.y); o[3] = bf_hi(w.y); }
    static __device__ __forceinline__ void ld4f(const float* p, float (&o)[4]) { const f32x4 a = *(const f32x4*)p; o[0] = a[0]; o[1] = a[1]; o[2] = a[2]; o[3] = a[3]; }
    template <int N> static __device__ __forceinline__ unsigned dpp_prev1(unsigned pv, unsigned cur) {
        const int t = __builtin_amdgcn_update_dpp(0, (int)pv, 0x120 + N, 0xf, 0xf, true);
        return (unsigned)__builtin_amdgcn_update_dpp(t, (int)cur, 0x110 + N, 0xf, 0xf, false); }
    template <int N> static __device__ __forceinline__ u32x2 dpp_prev(const u32x2 pv, const u32x2 cur) { u32x2 r; r.x = dpp_prev1<N>(pv.x, cur.x); r.y = dpp_prev1<N>(pv.y, cur.y); return r; }
    static __device__ __forceinline__ u32x2 shf(const u32x2 w, int src) { u32x2 r; r.x = (unsigned)__shfl((int)w.x, src); r.y = (unsigned)__shfl((int)w.y, src); return r; }
    static __device__ __forceinline__ void finish(const float (&g0)[4], const float (&g1)[4], const float (&g2)[4], const float (&w0)[4], const float (&w1)[4], const float (&w2)[4], const float (&bb)[4],
                                                  const f32x4 v, float rs, bf16_t* dst) {
        float h[4];
#pragma unroll
        for (int j = 0; j < 4; j += 2) {
            const f32x2 gc = (f32x2){bb[j] + w0[j] * g2[j] + w1[j] * g1[j] + w2[j] * g0[j], bb[j + 1] + w0[j + 1] * g2[j + 1] + w1[j + 1] * g1[j + 1] + w2[j + 1] * g0[j + 1]};
            const f32x2 ge = gelu_pk(gc); h[j] = ge.x * v[j] * rs; h[j + 1] = ge.y * v[j + 1] * rs; }
        u32x2 w; w.x = cvt_pk_bf16(h[0], h[1]); w.y = cvt_pk_bf16(h[2], h[3]);
        *(u32x2*)dst = w;
    }
    static __device__ __forceinline__ u32x2 half2(const u32x4 w, int hv) { return hv ? (u32x2){w.z, w.w} : (u32x2){w.x, w.y}; }
    static __device__ __forceinline__ u32x2 finish2(const float (&g0)[4], const float (&g1)[4], const float (&g2)[4], const float (&w0)[4], const float (&w1)[4], const float (&w2)[4], const float (&bb)[4],
                                                    const f32x4 v, float rs) {
        float h[4];
#pragma unroll
        for (int j = 0; j < 4; j += 2) {
            const f32x2 gc = (f32x2){bb[j] + w0[j] * g2[j] + w1[j] * g1[j] + w2[j] * g0[j], bb[j + 1] + w0[j + 1] * g2[j + 1] + w1[j + 1] * g1[j + 1] + w2[j + 1] * g0[j + 1]};
            const f32x2 ge = gelu_pk(gc) * ((f32x2){v[j], v[j + 1]} * rs); h[j] = ge.x; h[j + 1] = ge.y; }
        u32x2 w; w.x = cvt_pk_bf16(h[0], h[1]); w.y = cvt_pk_bf16(h[2], h[3]); return w;
    }
    __device__ __forceinline__ void operator()(const f32x4 (&acc)[2][2][4][2], const Unit& u, int wr, int wc, int fr, int fq) const {
        asm volatile("" : "+v"(fr), "+v"(fq));
        const int row0 = u.rb + wr * 64 + fr;
        const int lane = fq * 16 + fr;
        const int s1 = fr >= 1 ? lane - 1 : lane + 15, s2 = fr >= 2 ? lane - 2 : lane + 14; (void)s1; (void)s2;
        float rs8[2][4];
#pragma unroll
        for (int ai = 0; ai < 2; ++ai)
#pragma unroll
            for (int m = 0; m < 4; ++m) rs8[ai][m] = rsqrtf(SS[u.rb + (u.half ? 0 : ai * HALF) + wr * 64 + fr + 16 * m] * (1.f / 1024.f) + 1e-6f);
        if (u.pm < 128) {
#pragma unroll
          for (int bj = 0; bj < 2; ++bj) {
            const int col8 = u.pn * BM + bj * HALF + wc * 32 + 8 * fq;
            float w0[2][4], w1[2][4], w2[2][4], bb[2][4];
#pragma unroll
            for (int hv = 0; hv < 2; ++hv) { ld4f(cw + col8 + 4 * hv, w0[hv]); ld4f(cw + 2816 + col8 + 4 * hv, w1[hv]); ld4f(cw + 2 * 2816 + col8 + 4 * hv, w2[hv]); ld4f(cb + col8 + 4 * hv, bb[hv]); }
#pragma unroll
            for (int ai = 0; ai < 2; ++ai) { const int R0 = u.rb + ai * HALF + wr * 64; const bf16_t* gp = G + (size_t)(R0 + fr) * 2816 + col8;
                u32x4 gq[4], prv = (u32x4){0u, 0u, 0u, 0u};
#pragma unroll
                for (int m = 0; m < 4; ++m) gq[m] = *(const u32x4*)(gp + (size_t)m * 16 * 2816);
                if ((R0 & 8191) != 0) prv = *(const u32x4*)(gp - (size_t)16 * 2816);
                u32x4 pv = prv;
#pragma unroll
                for (int m = 0; m < 4; ++m) { const u32x4 cur = gq[m]; u32x4 hw;
#pragma unroll
                    for (int hv = 0; hv < 2; ++hv) { const u32x2 c2 = half2(cur, hv), p2 = half2(pv, hv);
                        const u32x2 q1 = dpp_prev<1>(p2, c2), q2 = dpp_prev<2>(p2, c2);
                        float g0[4], g1[4], g2[4]; unpk4(c2, g0); unpk4(q1, g1); unpk4(q2, g2);
                        const u32x2 r = finish2(g0, g1, g2, w0[hv], w1[hv], w2[hv], bb[hv], acc[ai][bj][m][hv], rs8[ai][m]);
                        if (hv == 0) { hw.x = r.x; hw.y = r.y; } else { hw.z = r.x; hw.w = r.y; } }
                    *(u32x4*)(H + (size_t)(R0 + fr + 16 * m) * 2816 + col8) = hw;
                    pv = cur; } }
          }
        } else {
#pragma unroll
        for (int bj = 0; bj < 2; ++bj)
#pragma unroll
          for (int hv = 0; hv < 2; ++hv) {
            const int col = u.pn * BM + bj * HALF + wc * 32 + 8 * fq + 4 * hv;
            float w0[4], w1[4], w2[4], bb[4];
            ld4f(cw + col, w0); ld4f(cw + 2816 + col, w1); ld4f(cw + 2 * 2816 + col, w2); ld4f(cb + col, bb);
            {
                const int i = fr & 7;
                u32x2 gq[4];
#pragma unroll
                for (int m = 0; m < 4; ++m) { const int row = row0 + m * 16; gq[m] = *(const u32x2*)(G + (size_t)row * 2816 + col); }
#pragma unroll
                for (int mh = 0; mh < 4; mh += 2) {
                f32x4 c0[4], c1[4];
#pragma unroll
                for (int m = mh; m < mh + 2; ++m) { const int row = row0 + m * 16; const float* cx = ctx + (size_t)((row - 32768) >> 3) * 2 * 2816 + col;
                    c0[m] = *(const f32x4*)cx; c1[m] = *(const f32x4*)(cx + 2816); }
#pragma unroll
                for (int m = mh; m < mh + 2; ++m) { const int row = row0 + m * 16; const u32x2 cur = gq[m];
                    const u32x2 q1 = dpp_prev<1>(cur, cur), q2 = dpp_prev<2>(cur, cur);
                    float g0[4], g1[4], g2[4]; unpk4(cur, g0); unpk4(q1, g1); unpk4(q2, g2);
#pragma unroll
                    for (int j = 0; j < 4; ++j) { const float x1 = c1[m][j], x0 = c0[m][j];
                        if (i < 1) g1[j] = x1;
                        if (i < 2) g2[j] = (i == 1) ? x1 : x0; }
                    finish(g0, g1, g2, w0, w1, w2, bb, acc[0][bj][m][hv], rs8[0][m], H + (size_t)row * 2816 + col); }
                }
                        }
          }
        }
    }
};

template <class Epi, class Sched, bool ALIGN_EPI = false, bool SP2 = false>
__device__ __forceinline__ void gemm_phase(PG8_LAS unsigned char* lds, const Gemm g, const Sched& S, const Epi& E, int wave0) {
    int tid_ = threadIdx.x; (void)wave0; asm volatile("" : "+v"(tid_));
    const int tid = tid_, wid = __builtin_amdgcn_readfirstlane(tid >> 6), lane = tid & 63, wr = wid >> 2, wc = wid & 3, fr = lane & 15, fq = lane >> 4;
    const int K = g.K, nt = K / BK;
    unsigned voffA[2], voffB[2];
#pragma unroll
    for (int i = 0; i < 2; ++i) { int R, C; stage_rc(tid * 16 + i * 8192, R, C); const int Rb = Epi::PERM ? ((R & ~31) + perm32(R & 31)) : R;
        voffA[i] = (unsigned)(R * K + C) * 2u; voffB[i] = (unsigned)(Rb * K + C) * 2u; }
    const size_t kstep = (size_t)(BK * 2);
    const size_t hstep = (size_t)HALF * K * 2;
    const size_t tstep = 2 * hstep;
    const unsigned ldsw = (unsigned)wid * 1024u;
    const int aoff = lds_byte(wr * 64 + fr, fq * 8), boff = lds_byte(wc * 32 + fr, fq * 8);
#define PG8_SA(b, h) (((b) * 2 + (h)) * HTB)
#define PG8_SB(b, h) ((4 + (b) * 2 + (h)) * HTB)
#define PG8_STAGE(bufoff, gbase, voff) do { _Pragma("unroll") for (int _i = 0; _i < 2; ++_i) \
        __builtin_amdgcn_global_load_lds((const unsigned*)((const char*)(gbase) + (voff)[_i]), (PG8_LAS unsigned*)(lds + (bufoff) + ldsw + _i * 8192), 16, 0, 0); } while (0)
#define PG8_LDA(dst, b, h) do { _Pragma("unroll") for (int m = 0; m < 4; ++m) _Pragma("unroll") for (int k = 0; k < 2; ++k) dst[m][k] = *(const PG8_LAS bf16x8*)(lds + PG8_SA(b, h) + aoff + m * 2048 + k * 1024); } while (0)
#define PG8_LDB(dst, b, h) do { _Pragma("unroll") for (int n = 0; n < 2; ++n) _Pragma("unroll") for (int k = 0; k < 2; ++k) dst[n][k] = *(const PG8_LAS bf16x8*)(lds + PG8_SB(b, h) + boff + n * 2048 + k * 1024); } while (0)
#define PG8_MMA(ai, bj, At, Bt) do { __builtin_amdgcn_s_setprio(1); _Pragma("unroll") for (int m = 0; m < 4; ++m) _Pragma("unroll") for (int n = 0; n < 2; ++n) _Pragma("unroll") for (int k = 0; k < 2; ++k) \
        acc[ai][bj][m][n] = __builtin_amdgcn_mfma_f32_16x16x32_bf16(Bt[n][k], At[m][k], acc[ai][bj][m][n], 0, 0, 0); __builtin_amdgcn_s_setprio(0); } while (0)
#define PG8_WAIT_V(n) asm volatile("s_waitcnt vmcnt(" #n ")" ::: "memory")
#define PG8_WAIT_L(n) asm volatile("s_waitcnt lgkmcnt(" #n ")" ::: "memory")
#define PG8_BAR __builtin_amdgcn_s_barrier()
#define PG8_SCHED __builtin_amdgcn_sched_barrier(0)
    Unit cur, nxt; int ui = 0;
    if (!S.next(0, cur)) return;
    f32x4 acc[2][2][4][2];
#pragma unroll
    for (int a = 0; a < 2; ++a)
#pragma unroll
        for (int b = 0; b < 2; ++b)
#pragma unroll
            for (int m = 0; m < 4; ++m)
#pragma unroll
                for (int n = 0; n < 2; ++n) acc[a][b][m][n] = (f32x4){0.f, 0.f, 0.f, 0.f};
    bf16x8 At[4][2], B0[2][2], B1[2][2];
    const char* cA = (const char*)g.A + (size_t)cur.rb * K * 2; const char* cB = (const char*)g.Bt + (size_t)cur.pn * tstep;
    S.a_ready(cur);
    if constexpr (SP2) {
        PG8_STAGE(PG8_SB(0, 0), cB, voffB); PG8_STAGE(PG8_SB(0, 1), cB + hstep, voffB); PG8_STAGE(PG8_SA(0, 0), cA, voffA); PG8_STAGE(PG8_SA(0, 1), cA + hstep, voffA);
        if (wr == 1) PG8_BAR;
        PG8_WAIT_V(2); PG8_BAR;
        PG8_STAGE(PG8_SB(1, 0), cB + kstep, voffB); PG8_STAGE(PG8_SA(1, 0), cA + kstep, voffA); PG8_STAGE(PG8_SB(1, 1), cB + hstep + kstep, voffB);
        PG8_WAIT_V(6); PG8_BAR;
    } else {
        PG8_STAGE(PG8_SB(0, 0), cB, voffB); PG8_STAGE(PG8_SA(0, 0), cA, voffA); PG8_STAGE(PG8_SB(0, 1), cB + hstep, voffB); PG8_STAGE(PG8_SA(0, 1), cA + hstep, voffA);
        if (wr == 1) PG8_BAR;
        PG8_WAIT_V(4); PG8_BAR;
        PG8_STAGE(PG8_SB(1, 0), cB + kstep, voffB); PG8_STAGE(PG8_SA(1, 0), cA + kstep, voffA); PG8_STAGE(PG8_SB(1, 1), cB + hstep + kstep, voffB);
        PG8_WAIT_V(6); PG8_BAR;
    }
    for (;;) {
        const bool has_next = S.next(ui + 1, nxt);
        const char* nA = has_next ? (const char*)g.A + (size_t)nxt.rb * K * 2 : cA; const char* nB = has_next ? (const char*)g.Bt + (size_t)nxt.pn * tstep : cB;
        for (int t = 0; t < nt; t += 2) {
            const bool last = (t == nt - 2);
            const char* a1 = cA + (size_t)(t + 1) * kstep;
            const char* a2 = last ? nA : cA + (size_t)(t + 2) * kstep; const char* b2 = last ? nB : cB + (size_t)(t + 2) * kstep;
            const char* a3 = a2 + kstep; const char* b3 = b2 + kstep;
            if (last && has_next) S.a_ready(nxt);
            if constexpr (SP2) {
            PG8_LDB(B0, 0, 0); PG8_LDB(B1, 0, 1); PG8_SCHED; PG8_LDA(At, 0, 0); PG8_STAGE(PG8_SA(1, 1), a1 + hstep, voffA);
            PG8_WAIT_V(8); PG8_WAIT_L(0); PG8_BAR; PG8_MMA(0, 0, At, B0); PG8_MMA(0, 1, At, B1); PG8_BAR; PG8_SCHED;
            PG8_LDA(At, 0, 1); PG8_STAGE(PG8_SB(0, 0), b2, voffB); PG8_STAGE(PG8_SB(0, 1), b2 + hstep, voffB); PG8_STAGE(PG8_SA(0, 0), a2, voffA);
            PG8_WAIT_V(8); PG8_WAIT_L(0); PG8_BAR; if (!cur.half) { PG8_MMA(1, 0, At, B0); PG8_MMA(1, 1, At, B1); } PG8_BAR; PG8_SCHED;
            PG8_LDB(B0, 1, 0); PG8_LDB(B1, 1, 1); PG8_SCHED; PG8_LDA(At, 1, 0); PG8_STAGE(PG8_SA(0, 1), a2 + hstep, voffA);
            PG8_WAIT_V(8); PG8_WAIT_L(0); PG8_BAR; PG8_MMA(0, 0, At, B0); PG8_MMA(0, 1, At, B1); PG8_BAR; PG8_SCHED;
            PG8_LDA(At, 1, 1); PG8_STAGE(PG8_SB(1, 0), b3, voffB); PG8_STAGE(PG8_SB(1, 1), b3 + hstep, voffB); PG8_STAGE(PG8_SA(1, 0), a3, voffA);
            PG8_WAIT_V(8); PG8_WAIT_L(0); PG8_BAR; if (!cur.half) { PG8_MMA(1, 0, At, B0); PG8_MMA(1, 1, At, B1); } PG8_BAR; PG8_SCHED;
            } else {
            PG8_LDB(B0, 0, 0); PG8_SCHED; PG8_LDA(At, 0, 0); PG8_STAGE(PG8_SA(1, 1), a1 + hstep, voffA);
            PG8_WAIT_L(8); PG8_BAR; PG8_WAIT_L(0); PG8_MMA(0, 0, At, B0); PG8_BAR; PG8_SCHED;
            PG8_LDB(B1, 0, 1); PG8_STAGE(PG8_SB(0, 0), b2, voffB);
            PG8_BAR; PG8_WAIT_L(0); PG8_MMA(0, 1, At, B1); PG8_BAR;
            PG8_LDA(At, 0, 1); PG8_STAGE(PG8_SA(0, 0), a2, voffA);
            PG8_BAR; PG8_WAIT_L(0); if (!cur.half) PG8_MMA(1, 0, At, B0); PG8_BAR; PG8_SCHED;
            PG8_STAGE(PG8_SB(0, 1), b2 + hstep, voffB);
            PG8_WAIT_V(6); PG8_BAR; if (!cur.half) PG8_MMA(1, 1, At, B1); PG8_BAR;
            PG8_LDB(B0, 1, 0); PG8_SCHED; PG8_LDA(At, 1, 0); PG8_STAGE(PG8_SA(0, 1), a2 + hstep, voffA);
            PG8_WAIT_L(8); PG8_BAR; PG8_WAIT_L(0); PG8_MMA(0, 0, At, B0); PG8_BAR; PG8_SCHED;
            PG8_LDB(B1, 1, 1); PG8_STAGE(PG8_SB(1, 0), b3, voffB);
            PG8_BAR; PG8_WAIT_L(0); PG8_MMA(0, 1, At, B1); PG8_BAR;
            PG8_LDA(At, 1, 1); PG8_STAGE(PG8_SA(1, 0), a3, voffA);
            PG8_BAR; PG8_WAIT_L(0); if (!cur.half) PG8_MMA(1, 0, At, B0); PG8_BAR; PG8_SCHED;
            PG8_STAGE(PG8_SB(1, 1), b3 + hstep, voffB);
            PG8_WAIT_V(6); PG8_BAR; if (!cur.half) PG8_MMA(1, 1, At, B1); PG8_BAR;
            }
        }
        if constexpr (ALIGN_EPI) { if (wr == 0) PG8_BAR; }
        if constexpr (!Epi::AFTER_DRAIN) { E(acc, cur, wr, wc, fr, fq); S.done(cur); }
        if (!has_next) break;
#pragma unroll
        for (int a = 0; a < 2; ++a)
#pragma unroll
            for (int b = 0; b < 2; ++b)
#pragma unroll
                for (int m = 0; m < 4; ++m)
#pragma unroll
                    for (int n = 0; n < 2; ++n) acc[a][b][m][n] = (f32x4){0.f, 0.f, 0.f, 0.f};
        cur = nxt; cA = nA; cB = nB; ++ui;
        if constexpr (ALIGN_EPI) { if (wr == 1) PG8_BAR; }
    }
    PG8_WAIT_V(0);
    if constexpr (!ALIGN_EPI) { if (wr == 0) PG8_BAR; }
    PG8_BAR;
    if constexpr (Epi::AFTER_DRAIN) { E.fused(acc, cur, wr, wc, fr, fq, lds, wid, lane); S.done(cur); }
#undef PG8_SA
#undef PG8_SB
#undef PG8_STAGE
#undef PG8_LDA
#undef PG8_LDB
#undef PG8_MMA
#undef PG8_WAIT_V
#undef PG8_WAIT_L
#undef PG8_BAR
#undef PG8_SCHED
}

template <class Epi, bool NARROW = false, bool SHORT = false>
__device__ __forceinline__ void mini_gemm(PG8_LAS unsigned char* lds, const bf16_t* A, const bf16_t* Bt, int K, int ntn, const Epi& E, int c, int G, int wave0, int row_base = 32768) {
    int tid_ = threadIdx.x; (void)wave0; asm volatile("" : "+v"(tid_));
    const int tid = tid_, wid = __builtin_amdgcn_readfirstlane(tid >> 6), lane = tid & 63, wr = wid >> 2, wc = wid & 3, fr = lane & 15, fq = lane >> 4;
    constexpr int LS = 136, BUFB = 2 * 128 * LS * 2;
    constexpr int NB = NARROW ? 2 : 4, TW = NARROW ? 64 : 128;
    constexpr int NA = SHORT ? 2 : 4, TH = SHORT ? 64 : 128, NTM = SHORT ? 16 : 8;
    const int lr = SHORT ? (tid >> 3) : (tid >> 2), lp = SHORT ? (tid & 7) * 2 : (tid & 3) * 4;
    const int lrb = NARROW ? (tid >> 3) : lr, lpb = NARROW ? (tid & 7) * 2 : lp;
    const bool active = (!NARROW || wc < 2) && (!SHORT || wr == 0);
    const int nst = K / 128;
#pragma unroll 1
    for (int t = c; t < NTM * ntn; t += G) {
        const int tm = t % NTM, tn = t / NTM;
        const bf16_t* ga = A + ((size_t)row_base + TH * tm + lr) * K + lp * 8;
        const bf16_t* gb = Bt + ((size_t)TW * tn + lrb) * K + lpb * 8;
        u32x4 ra[2][NA], rb[2][NB];
#pragma unroll
        for (int s2 = 0; s2 < 2; ++s2) {
#pragma unroll
            for (int j = 0; j < NA; ++j) ra[s2][j] = *(const u32x4*)(ga + 128 * s2 + 8 * j);
#pragma unroll
            for (int j = 0; j < NB; ++j) rb[s2][j] = *(const u32x4*)(gb + 128 * s2 + 8 * j); }
        f32x4 acc[4][2];
#pragma unroll
        for (int m = 0; m < 4; ++m)
#pragma unroll
            for (int n = 0; n < 2; ++n) acc[m][n] = (f32x4){0.f, 0.f, 0.f, 0.f};
#pragma unroll 1
        for (int st = 0; st < nst; st += 2) {
#pragma unroll
          for (int s2 = 0; s2 < 2; ++s2) {
            PG8_LAS bf16_t* As = (PG8_LAS bf16_t*)(lds + s2 * BUFB); PG8_LAS bf16_t* Bs = As + 128 * LS;
#pragma unroll
            for (int j = 0; j < NA; ++j) *(PG8_LAS u32x4*)(As + lr * LS + (lp + j) * 8) = ra[s2][j];
#pragma unroll
            for (int j = 0; j < NB; ++j) *(PG8_LAS u32x4*)(Bs + lrb * LS + (lpb + j) * 8) = rb[s2][j];
            __syncthreads();
            if (st + 2 < nst) {
#pragma unroll
                for (int j = 0; j < NA; ++j) ra[s2][j] = *(const u32x4*)(ga + 128 * (st + 2 + s2) + 8 * j);
#pragma unroll
                for (int j = 0; j < NB; ++j) rb[s2][j] = *(const u32x4*)(gb + 128 * (st + 2 + s2) + 8 * j); }
            if (active) {
#pragma unroll
            for (int kc = 0; kc < 4; ++kc) {
                bf16x8 af[4], bfr[2];
#pragma unroll
                for (int m = 0; m < 4; ++m) af[m] = *(const PG8_LAS bf16x8*)(As + (64 * wr + 16 * m + fr) * LS + 32 * kc + 8 * fq);
#pragma unroll
                for (int n = 0; n < 2; ++n) bfr[n] = *(const PG8_LAS bf16x8*)(Bs + (32 * wc + 8 * (fr >> 2) + 4 * n + (fr & 3)) * LS + 32 * kc + 8 * fq);
#pragma unroll
                for (int m = 0; m < 4; ++m)
#pragma unroll
                    for (int n = 0; n < 2; ++n) acc[m][n] = __builtin_amdgcn_mfma_f32_16x16x32_bf16(bfr[n], af[m], acc[m][n], 0, 0, 0);
            } }
          }
        }
        if (active) {
        f32x4 accf[2][2][4][2];
#pragma unroll
        for (int a = 0; a < 2; ++a)
#pragma unroll
            for (int bq = 0; bq < 2; ++bq)
#pragma unroll
                for (int m = 0; m < 4; ++m)
#pragma unroll
                    for (int n = 0; n < 2; ++n) accf[a][bq][m][n] = (a == 0 && bq == 0) ? acc[m][n] : (f32x4){0.f, 0.f, 0.f, 0.f};
        Unit u; u.pm = 128 + (TH * tm >> 8); u.cb = TW * tn; u.pn = u.cb >> 8; u.rb = row_base + TH * tm; u.half = 1; u.q = 1;
        E(accf, u, wr, wc, fr, fq);
        }
        __syncthreads();
    }
}
}

#define LAS __attribute__((address_space(3)))
typedef unsigned short bf16;
typedef unsigned v4u __attribute__((ext_vector_type(4)));
typedef unsigned v2u __attribute__((ext_vector_type(2)));
typedef float f32x4 __attribute__((ext_vector_type(4)));
typedef short bf16x8 __attribute__((ext_vector_type(8)));

constexpr int NTHR = 512, NWAVES = 8;
constexpr int MP = 32768, MS = 1024, MT = MP + MS;
constexpr int D = 1024, DFF = 2816;
constexpr int LDS_BYTES = 147456;
constexpr float EPS = 1e-6f;

enum { I_XP = 0, I_XS, I_CPOOL, I_CSK, I_CSV, I_CMK, I_CMV, I_CFC, I_MEMP, I_LNMIX, I_LNMEM, I_LNMEMKV, I_LNFFN, I_ABWIN, I_ABVG, I_ABWS, I_ABBS, I_ABPW, I_ABPS, I_ABWOUT,
       I_CWQKV, I_CQG, I_CKG, I_CSINK, I_CWO, I_MWQ, I_MWKV, I_MQG, I_MKG, I_MWO, I_FWUP, I_FCW, I_FCB, I_FWDN, N_IN };
constexpr size_t O_YP = 0, O_YS = O_YP + (size_t)MP * D, O_POOLP = O_YS + (size_t)MS * D, O_POOLS = O_POOLP + 4 * 15 * 512, O_CHV = O_POOLS + 128 * 15 * 512,
                 O_SKP = O_CHV + 128 * 8 * 512, O_SVP = O_SKP + 4 * 128 * 256, O_SKS = O_SVP + 4 * 128 * 256, O_SVS = O_SKS + (size_t)128 * 128 * 256,
                 O_MKP = O_SVS + (size_t)128 * 128 * 256, O_MVP = O_MKP + 2 * 4 * 256 * 512, O_FCP = O_MVP + 2 * 4 * 256 * 512, O_FCS = O_FCP + 2 * 4 * 2 * DFF,
                 O_END = O_FCS + (size_t)2 * 128 * 2 * DFF;
constexpr size_t MiB = 1u << 20;
constexpr size_t W_WIN = 0, W_WOUT = W_WIN + 1536 * 1024 * 2, W_WQKV = W_WOUT + 1024 * 1024 * 2, W_CWO = W_WQKV + 1536 * 1024 * 2, W_LAYER = W_CWO + 1024 * 1024 * 2;
constexpr size_t WL_WQ = 0, WL_WKV = WL_WQ + 512 * 1024 * 2, WL_WO = WL_WKV + 1024 * 1024 * 2, WL_WUP = WL_WO + 1024 * 512 * 2, WL_WDN = WL_WUP + (size_t)2 * DFF * 1024 * 2,
                 WL_SIZE = WL_WDN + (size_t)1024 * DFF * 2;
constexpr size_t W_MN = W_LAYER + 2 * WL_SIZE;
constexpr size_t W_MKV = W_MN + 2 * 1024 * 1024 * 2;
constexpr size_t W_SS = W_MKV + 2 * 1024 * 1024 * 4;
constexpr size_t W_SMALL_END = W_SS + (size_t)6 * MT * 4;
static_assert(W_SMALL_END <= 72 * MiB, "weights region");
constexpr size_t W_XN = 72 * MiB;
constexpr size_t W_G = 138 * MiB;
constexpr size_t W_PROJ = W_G;
constexpr size_t W_AO = W_PROJ + 99 * MiB;
constexpr size_t W_H = 320 * MiB;
constexpr size_t W_KV32 = W_H;
constexpr size_t W_MQ = W_KV32 + 66 * MiB;
constexpr size_t W_MO = W_MQ + 33 * MiB;
constexpr size_t W_END = 502 * MiB;
constexpr size_t W_CTL = 504 * MiB, CTL_BYTES = 65536, W_NEED = W_CTL + CTL_BYTES;
constexpr int LDS_CTL_OFF = LDS_BYTES - 64;
static_assert(W_XN + (size_t)MT * 1024 * 2 <= W_G && W_PROJ + (size_t)MT * 1536 * 2 <= W_AO && W_AO + (size_t)MT * 1024 * 2 <= W_H && W_G + (size_t)MT * DFF * 2 <= W_H, "ws map 1");
static_assert(W_KV32 + (size_t)MT * 512 * 4 <= W_MQ && W_MQ + (size_t)MT * 512 * 2 <= W_MO && W_MO + (size_t)MT * 512 * 2 <= W_END && W_H + (size_t)MT * DFF * 2 <= W_END, "ws map 2");

struct Params { const float* in[N_IN]; float* out; unsigned char* ws; };

__device__ __forceinline__ unsigned pk2(float lo, float hi) { return pg8::cvt_pk_bf16(lo, hi); }
__device__ __forceinline__ unsigned f2bf(float f) { return pg8::cvt_pk_bf16(f, 0.f) & 0xffffu; }
__device__ __forceinline__ float bflo(unsigned w) { return __builtin_bit_cast(float, w << 16); }
__device__ __forceinline__ float bfhi(unsigned w) { return __builtin_bit_cast(float, w & 0xffff0000u); }
__device__ __forceinline__ float bf1(bf16 h) { return __builtin_bit_cast(float, (unsigned)h << 16); }
__device__ __forceinline__ void unpack8(const v4u w, float (&o)[8]) { o[0] = bflo(w.x); o[1] = bfhi(w.x); o[2] = bflo(w.y); o[3] = bfhi(w.y); o[4] = bflo(w.z); o[5] = bfhi(w.z); o[6] = bflo(w.w); o[7] = bfhi(w.w); }
__device__ __forceinline__ bf16x8 pack8(const float (&o)[8]) { v4u w; w.x = pk2(o[0], o[1]); w.y = pk2(o[2], o[3]); w.z = pk2(o[4], o[5]); w.w = pk2(o[6], o[7]); return __builtin_bit_cast(bf16x8, w); }
typedef short v4i16_t __attribute__((ext_vector_type(4)));
__device__ __forceinline__ v2u vtr(const LAS bf16* p) { return __builtin_bit_cast(v2u, __builtin_amdgcn_ds_read_tr16_b64_v4i16((LAS v4i16_t*)p)); }
__device__ __forceinline__ float wave_sum(float v) {
#pragma unroll
    for (int o = 1; o < 64; o <<= 1) v += __shfl_xor(v, o);
    return v;
}
__device__ __forceinline__ float gelu1(float v) { const pg8::f32x2 r = pg8::gelu_pk((pg8::f32x2){v, 0.f}); return r.x; }
__device__ __forceinline__ void rope_cs(float pos, int e, float& c, float& s) {
    const float inv = exp2f(-(float)e * (0.125f * 18.931568569324174f));
    const float ang = pos * inv;
    const float k = rintf(ang * 0.15915494309189535f);
    float r = fmaf(-k, 6.28125f, ang);
    r = fmaf(-k, 0.0019353071795864769f, r);
    s = __sinf(r); c = __cosf(r);
}

#define XB_TMO      128
#define XB_XCNT(j)  (256  + 64 * (j))
#define XB_XSUB(j)  (1280 + 64 * (j))
#define XB_XGEN(j)  (2304 + 64 * (j))
#define XB_TOP      3328
#define XB_TOPGEN   3392
#define XCD_BAR_WORDS 3456
#define XB_SPIN_CAP (1u << 18)

__device__ __forceinline__ unsigned xb_ld(unsigned* p)              { return __hip_atomic_load(p, __ATOMIC_RELAXED, __HIP_MEMORY_SCOPE_AGENT); }
__device__ __forceinline__ unsigned xb_add(unsigned* p, unsigned v) { return __hip_atomic_fetch_add(p, v, __ATOMIC_RELAXED, __HIP_MEMORY_SCOPE_AGENT); }
__device__ __forceinline__ unsigned xb_xcc_id() { return (unsigned)__builtin_amdgcn_s_getreg((3 << 11) | 20) & 0xFu; }
#define XB_SPIN(cond, bar) do { unsigned _sp = 0; while (cond) { __builtin_amdgcn_s_sleep(1); \
    if ((++_sp & 255u) == 0u) { if (xb_ld(&(bar)[XB_TMO])) break; if (_sp > XB_SPIN_CAP) { atomicAdd(&(bar)[XB_TMO], 1u); break; } } } } while (0)

struct XcdBarrier {
    unsigned* bar; unsigned x; int w0;
    volatile LAS unsigned* st;
};

__device__ __forceinline__ XcdBarrier xcd_barrier_post(unsigned* bar, volatile LAS unsigned* st) {
    XcdBarrier b; b.bar = bar; b.x = xb_xcc_id(); b.st = st; b.w0 = __builtin_amdgcn_readfirstlane((int)threadIdx.x >> 6);
    if (threadIdx.x == 0) (void)xb_add(&bar[XB_XCNT(b.x)], 1u);
    return b;
}
__device__ __forceinline__ void xcd_barrier_complete(unsigned* bar, unsigned x, unsigned& nloc, unsigned& nx) {
    const unsigned G = gridDim.x * gridDim.y * gridDim.z;
    unsigned sum, cnt, mine, sp = 0u;
    for (;;) {
        sum = 0u; cnt = 0u; mine = 0u;
#pragma unroll
        for (unsigned j = 0; j < 16; ++j) { const unsigned c = xb_ld(&bar[XB_XCNT(j)]); sum += c; cnt += (c > 0u) ? 1u : 0u; mine = (j == x) ? c : mine; }
        if (sum == G) break;
        __builtin_amdgcn_s_sleep(1);
        if ((++sp & 255u) == 0u) { if (xb_ld(&bar[XB_TMO])) break; if (sp > XB_SPIN_CAP) { atomicAdd(&bar[XB_TMO], 1u); break; } }
    }
    nloc = mine > 0u ? mine : 1u; nx = cnt > 0u ? cnt : 1u;
}

__device__ __forceinline__ void xcd_barrier(const XcdBarrier& b) {
    asm volatile("s_waitcnt vmcnt(0)" ::: "memory");
    __syncthreads();
    if (threadIdx.x == 0) {
        unsigned* bar = b.bar;
        __builtin_amdgcn_s_waitcnt(0);
        unsigned nloc = b.st[0], nx = b.st[1];
        if (nloc == 0u) { xcd_barrier_complete(bar, b.x, nloc, nx); b.st[0] = nloc; b.st[1] = nx; }
        const unsigned old = xb_add(&bar[XB_XSUB(b.x)], 1u);
        const unsigned gen = old / nloc;
        if (old + 1u == (gen + 1u) * nloc) {
            __builtin_amdgcn_fence(__ATOMIC_RELEASE, "agent");
            asm volatile("s_waitcnt vmcnt(0)" ::: "memory");
            const unsigned og = xb_add(&bar[XB_TOP], 1u);
            const unsigned tg = og / nx;
            if (og + 1u == (tg + 1u) * nx) xb_add(&bar[XB_TOPGEN], 1u);
            else XB_SPIN(xb_ld(&bar[XB_TOPGEN]) == tg, bar);
            __builtin_amdgcn_fence(__ATOMIC_ACQUIRE, "agent");
            xb_add(&bar[XB_XGEN(b.x)], 1u);
            asm volatile("s_waitcnt vmcnt(0)" ::: "memory");
        } else {
            XB_SPIN(xb_ld(&bar[XB_XGEN(b.x)]) == gen, bar);
            __builtin_amdgcn_fence(__ATOMIC_ACQUIRE, "agent");
            asm volatile("s_waitcnt vmcnt(0)" ::: "memory");
        }
    }
    __syncthreads();
}

__device__ __forceinline__ void transpose_item(const float* W, const float* gain, int ldn, int nblk, bf16* WT, int ldk, int koff, LAS float* scr, int item, int lane) {
    const int kb = item / nblk, nb = item % nblk, k0 = 64 * kb, n0 = 32 * nb;
    float wv[32];
#pragma unroll
    for (int i = 0; i < 32; ++i) wv[i] = __builtin_nontemporal_load(W + (size_t)(k0 + 2 * i + (lane >> 5)) * ldn + n0 + (lane & 31));
    if (gain) {
#pragma unroll
        for (int i = 0; i < 32; ++i) wv[i] *= gain[k0 + 2 * i + (lane >> 5)]; }
#pragma unroll
    for (int i = 0; i < 32; ++i) scr[(2 * i + (lane >> 5)) * 33 + (lane & 31)] = wv[i];
    asm volatile("s_waitcnt lgkmcnt(0)" ::: "memory");
    const int c = lane & 7;
#pragma unroll
    for (int j = 0; j < 4; ++j) { const int n = (lane >> 3) + 8 * j; const LAS float* s = scr + (8 * c) * 33 + n;
        v4u o; o.x = pk2(s[0 * 33], s[1 * 33]); o.y = pk2(s[2 * 33], s[3 * 33]); o.z = pk2(s[4 * 33], s[5 * 33]); o.w = pk2(s[6 * 33], s[7 * 33]);
        *(v4u*)(WT + (size_t)(n0 + n) * ldk + koff + k0 + 8 * c) = o; }
    asm volatile("s_waitcnt lgkmcnt(0)" ::: "memory");
}
__device__ __forceinline__ void rms_row(const float* xrow, const float* g, bf16* orow, int lane) {
    const f32x4* xr = (const f32x4*)xrow + lane; const f32x4* gr = (const f32x4*)g + lane;
    f32x4 v[4]; float s = 0.f;
#pragma unroll
    for (int j = 0; j < 4; ++j) { v[j] = xr[64 * j]; s += (v[j].x * v[j].x + v[j].y * v[j].y) + (v[j].z * v[j].z + v[j].w * v[j].w); }
    const float rs = rsqrtf(wave_sum(s) * (1.f / 1024.f) + EPS);
    unsigned long long* o8 = (unsigned long long*)orow + lane;
#pragma unroll
    for (int j = 0; j < 4; ++j) { const f32x4 gg = gr[64 * j];
        o8[64 * j] = (unsigned long long)pk2(v[j].x * rs * gg.x, v[j].y * rs * gg.y) | ((unsigned long long)pk2(v[j].z * rs * gg.z, v[j].w * rs * gg.w) << 32); }
}
__device__ __forceinline__ void xb_row(const float* xrow, bf16* orow, float* ss, int lane) {
    const f32x4* xr = (const f32x4*)xrow + lane;
    f32x4 v[4]; float s = 0.f;
#pragma unroll
    for (int j = 0; j < 4; ++j) { v[j] = xr[64 * j]; s += (v[j].x * v[j].x + v[j].y * v[j].y) + (v[j].z * v[j].z + v[j].w * v[j].w); }
    s = wave_sum(s);
    unsigned long long* o8 = (unsigned long long*)orow + lane;
#pragma unroll
    for (int j = 0; j < 4; ++j) o8[64 * j] = (unsigned long long)pk2(v[j].x, v[j].y) | ((unsigned long long)pk2(v[j].z, v[j].w) << 32);
    if (lane == 0) *ss = s;
}

struct TItem { const float* W; int ldn, nblk, nitems; bf16* WT; int ldk, koff; };

__device__ __forceinline__ void prologue(const Params& p, LAS unsigned char* lds, int gw, int ngw, int wave, int lane) {
    unsigned char* ws = p.ws;
    LAS float* scr = (LAS float*)(lds + wave * 16384);
#define TR(Wp, gn_, K_, N_, ldn_, dst_, ldk_, koff_) do { const int nblk_ = (N_) / 32, nit_ = ((K_) / 64) * nblk_; \
        for (int it = gw; it < nit_; it += ngw) transpose_item((Wp), (gn_), (ldn_), nblk_, (bf16*)(dst_), (ldk_), (koff_), scr, it, lane); } while (0)
    const float* nog = nullptr;
    TR(p.in[I_ABWIN], p.in[I_LNMIX], 1024, 1536, 1536, ws + W_WIN, 1024, 0);
    TR(p.in[I_ABWOUT], nog, 512, 1024, 1024, ws + W_WOUT, 1024, 0);
    TR(p.in[I_CWQKV], p.in[I_LNMIX] + D, 1024, 1536, 1536, ws + W_WQKV, 1024, 0);
    TR(p.in[I_CWO], nog, 1024, 1024, 1024, ws + W_CWO, 1024, 0);
#pragma unroll 1
    for (int l = 0; l < 2; ++l) {
        unsigned char* wl = ws + W_LAYER + l * WL_SIZE;
        TR(p.in[I_MWQ] + (size_t)l * 1024 * 512, p.in[I_LNMEM] + l * D, 1024, 512, 512, wl + WL_WQ, 1024, 0);
        TR(p.in[I_MWKV] + (size_t)l * 1024 * 1024, nog, 1024, 1024, 1024, wl + WL_WKV, 1024, 0);
        TR(p.in[I_MWO] + (size_t)l * 512 * 1024, nog, 512, 1024, 1024, wl + WL_WO, 512, 0);
        TR(p.in[I_FWUP] + (size_t)l * 1024 * 2 * DFF, p.in[I_LNFFN] + l * D, 1024, 2 * DFF, 2 * DFF, wl + WL_WUP, 1024, 0);
        TR(p.in[I_FWDN] + (size_t)l * DFF * 1024, nog, DFF, 1024, 1024, wl + WL_WDN, DFF, 0);
    }
#undef TR
    {
        const float* pw = p.in[I_ABPW]; const float* ps = p.in[I_ABPS]; const float* wo = p.in[I_ABWOUT] + (size_t)512 * 1024;
        bf16* WT = (bf16*)(ws + W_WOUT);
        const int gt = gw * 64 + lane, ngt = ngw * 64;
        for (int o = gt; o < 128 * 1024; o += ngt) {
            const int n = o & 1023, d = o >> 10;
            float a[4] = {0.f, 0.f, 0.f, 0.f};
#pragma unroll 4
            for (int e = 0; e < 128; ++e) {
#pragma unroll
                for (int g = 0; g < 4; ++g) a[g] += pw[((size_t)g * 128 + d) * 128 + e] * ps[g * 128 + e] * wo[((size_t)g * 128 + e) * 1024 + n]; }
#pragma unroll
            for (int g = 0; g < 4; ++g) WT[(size_t)n * 1024 + 512 + g * 128 + d] = (bf16)f2bf(a[g]); }
    }
    for (int m0 = gw * 4; m0 < MT; m0 += ngw * 4) {
        f32x4 v[4][4];
#pragma unroll
        for (int r = 0; r < 4; ++r) { const int m = m0 + r; const f32x4* xr = (const f32x4*)(m < MP ? p.in[I_XP] + (size_t)m * D : p.in[I_XS] + (size_t)(m - MP) * D) + lane;
#pragma unroll
            for (int j = 0; j < 4; ++j) v[r][j] = __builtin_nontemporal_load(xr + 64 * j); }
#pragma unroll
        for (int r = 0; r < 4; ++r) { const int m = m0 + r; float sq = 0.f;
#pragma unroll
            for (int j = 0; j < 4; ++j) sq += (v[r][j].x * v[r][j].x + v[r][j].y * v[r][j].y) + (v[r][j].z * v[r][j].z + v[r][j].w * v[r][j].w);
            sq = wave_sum(sq);
            unsigned long long* o8 = (unsigned long long*)((bf16*)(ws + W_XN) + (size_t)m * D) + lane;
#pragma unroll
            for (int j = 0; j < 4; ++j) o8[64 * j] = (unsigned long long)pk2(v[r][j].x, v[r][j].y) | ((unsigned long long)pk2(v[r][j].z, v[r][j].w) << 32);
            if (lane == 0) ((float*)(ws + W_SS))[m] = sq; }
    }
    for (int o = gw * 64 + lane; o < 5 * MT; o += ngw * 64) ((float*)(ws + W_SS))[MT + o] = 0.f;
    for (int m = gw; m < 2048; m += ngw) { const int l = m >> 10, r = m & 1023;
        rms_row(p.in[I_MEMP] + (size_t)r * D, p.in[I_LNMEMKV] + l * D, (bf16*)(ws + W_MN) + (size_t)m * D, lane); }
}

constexpr int SG_VS = 520;
template <int W> __device__ __forceinline__ void pool_block(const float (&prev)[16], const float (&cur)[16], float (&o)[16], int t0, bool clampcnt) {
#pragma unroll
    for (int k = 0; k < 16; ++k) { float s = 0.f;
#pragma unroll
        for (int kk = 0; kk < W; ++kk) s += (k - kk >= 0) ? cur[(k - kk) & 15] : prev[(16 + k - kk) & 15];
        float inv = 1.f / (float)W;
        if (clampcnt) { const int t1 = t0 + k + 1; if (t1 < W) inv = __builtin_amdgcn_rcpf((float)t1); }
        o[k] = s * inv - cur[k]; }
}
__device__ __forceinline__ void pool_dispatch(int gi, const float (&prev)[16], const float (&cur)[16], float (&o)[16], int t0, bool clampcnt) {
    if (gi == 0) pool_block<2>(prev, cur, o, t0, clampcnt); else if (gi == 1) pool_block<4>(prev, cur, o, t0, clampcnt);
    else if (gi == 2) pool_block<8>(prev, cur, o, t0, clampcnt); else pool_block<16>(prev, cur, o, t0, clampcnt);
}

__device__ __forceinline__ void sgu_prompt_unit(const Params& p, LAS unsigned char* lds, int unit, int tid, int wave, int lane) {
    const bf16* PROJ = (const bf16*)(p.ws + W_PROJ); bf16* AO = (bf16*)(p.ws + W_AO);
    LAS bf16* Vn = (LAS bf16*)lds;
    const int b = unit >> 6, ch = unit & 63; const size_t r0 = (size_t)b * 8192 + ch * 128;
    {
        float gn[8]; pg8::ld8f(p.in[I_ABVG] + 8 * lane, gn);
        v4u raw[16];
#pragma unroll
        for (int jj = 0; jj < 16; ++jj) raw[jj] = *(const v4u*)(PROJ + (r0 + wave + 8 * jj) * 1536 + 512 + 8 * lane);
#pragma unroll
        for (int jj = 0; jj < 16; ++jj) { const int j = wave + 8 * jj;
            float x[8]; unpack8(raw[jj], x);
            float s = 0.f;
#pragma unroll
            for (int e = 0; e < 8; ++e) s += x[e];
            const float mean = wave_sum(s) * (1.f / 512.f); float q = 0.f;
#pragma unroll
            for (int e = 0; e < 8; ++e) { x[e] -= mean; q += x[e] * x[e]; }
            const float rstd = rsqrtf(wave_sum(q) * (1.f / 512.f) + EPS);
#pragma unroll
            for (int e = 0; e < 8; ++e) x[e] *= rstd * gn[e];
            *(LAS bf16x8*)(Vn + j * SG_VS + 8 * lane) = pack8(x); }
    }
    __syncthreads();
    {
        const int q16 = lane & 15, kq = lane >> 4, nch = (wave >> 1) + 1; int i = 16 * wave + q16;
#pragma unroll 1
        for (int g = 0; g < 4; ++g) {
            asm volatile("" : "+v"(i));
            f32x4 acc[8];
#pragma unroll
            for (int dt = 0; dt < 8; ++dt) acc[dt] = (f32x4){0.f, 0.f, 0.f, 0.f};
            const float* wsr = p.in[I_ABWS] + ((size_t)g * 128 + i) * 128;
            float wva[4][8]; v2u uu8[8];
#pragma unroll
            for (int c = 0; c < 4; ++c) pg8::ld8f(wsr + 32 * c + 8 * kq, wva[c]);
#pragma unroll
            for (int dt = 0; dt < 8; ++dt) uu8[dt] = *(const v2u*)(PROJ + (r0 + i) * 1536 + g * 128 + 16 * dt + 4 * kq);
#pragma unroll
            for (int c = 0; c < 4; ++c) if (c < nch) {
                float (&wv)[8] = wva[c];
#pragma unroll
                for (int e = 0; e < 8; ++e) if (32 * c + 8 * kq + e > i) wv[e] = 0.f;
                const bf16x8 bfrag = pack8(wv);
#pragma unroll
                for (int dt = 0; dt < 8; ++dt) { const LAS bf16* vp = Vn + (32 * c + 8 * kq + (q16 >> 2)) * SG_VS + g * 128 + 16 * dt + 4 * (q16 & 3);
                    const v2u lo = vtr(vp), hi = vtr(vp + 4 * SG_VS);
                    v4u av; av.x = lo.x; av.y = lo.y; av.z = hi.x; av.w = hi.y;
                    acc[dt] = __builtin_amdgcn_mfma_f32_16x16x32_bf16(__builtin_bit_cast(bf16x8, av), bfrag, acc[dt], 0, 0, 0); }
            }
            const float bs = p.in[I_ABBS][g * 128 + i];
#pragma unroll
            for (int dt = 0; dt < 8; ++dt) { const v2u uu = uu8[dt];
                const float o0 = bflo(uu.x) * (acc[dt][0] + bs), o1 = bfhi(uu.x) * (acc[dt][1] + bs), o2 = bflo(uu.y) * (acc[dt][2] + bs), o3 = bfhi(uu.y) * (acc[dt][3] + bs);
                v2u w; w.x = pk2(o0, o1); w.y = pk2(o2, o3);
                *(v2u*)(AO + (r0 + i) * 1024 + g * 128 + 16 * dt + 4 * kq) = w; }
        }
    }
    {
        const int c = tid, gi = c >> 7;
        const bf16* pp = PROJ + 1024 + c;
        float prev[16], cur[16], o[16];
#pragma unroll
        for (int k = 0; k < 16; ++k) prev[k] = (ch > 0) ? bf1(pp[(r0 - 16 + k) * 1536]) : 0.f;
        bf16 nxt[16];
#pragma unroll
        for (int k = 0; k < 16; ++k) nxt[k] = pp[(r0 + k) * 1536];
#pragma unroll 1
        for (int blk = 0; blk < 8; ++blk) {
#pragma unroll
            for (int k = 0; k < 16; ++k) cur[k] = bf1(nxt[k]);
            if (blk < 7) {
#pragma unroll
                for (int k = 0; k < 16; ++k) nxt[k] = pp[(r0 + 16 * (blk + 1) + k) * 1536]; }
            pool_dispatch(gi, prev, cur, o, ch * 128 + 16 * blk, ch == 0 && blk == 0);
#pragma unroll
            for (int k = 0; k < 16; ++k) AO[(r0 + 16 * blk + k) * 1024 + 512 + c] = (bf16)f2bf(o[k]);
            if (ch == 63 && blk == 7) {
#pragma unroll
                for (int k = 1; k < 16; ++k) p.out[O_POOLP + ((size_t)b * 15 + (k - 1)) * 512 + c] = cur[k]; }
#pragma unroll
            for (int k = 0; k < 16; ++k) prev[k] = cur[k];
        }
    }
    __syncthreads();
}

__device__ __forceinline__ void sgu_sample_unit(const Params& p, LAS unsigned char* lds, int b, int tid, int wave, int lane) {
    const bf16* PROJ = (const bf16*)(p.ws + W_PROJ); bf16* AO = (bf16*)(p.ws + W_AO);
    LAS float* red = (LAS float*)lds;
    const int c = tid, g = c >> 7; const size_t rs = (size_t)MP + 8 * b;
    float x[8], st[16];
#pragma unroll
    for (int j = 0; j < 8; ++j) { x[j] = bf1(PROJ[(rs + j) * 1536 + 512 + c]); st[j] = wave_sum(x[j]); st[8 + j] = wave_sum(x[j] * x[j]); }
    if (lane == 0) {
#pragma unroll
        for (int j = 0; j < 16; ++j) red[wave * 16 + j] = st[j]; }
    __syncthreads();
    float v[8]; const float gn = p.in[I_ABVG][c];
#pragma unroll
    for (int j = 0; j < 8; ++j) { float s = 0.f, q = 0.f;
#pragma unroll
        for (int w = 0; w < 8; ++w) { s += red[w * 16 + j]; q += red[w * 16 + 8 + j]; }
        const float mean = s * (1.f / 512.f), var = fmaxf(q * (1.f / 512.f) - mean * mean, 0.f);
        v[j] = (x[j] - mean) * rsqrtf(var + EPS) * gn;
        p.out[O_CHV + ((size_t)b * 8 + j) * 512 + c] = v[j]; }
    const float* wsg = p.in[I_ABWS] + (size_t)g * 128 * 128;
#pragma unroll
    for (int i = 0; i < 8; ++i) { float sg = p.in[I_ABBS][g * 128 + i];
#pragma unroll
        for (int j = 0; j < 8; ++j) if (j <= i) sg += wsg[i * 128 + j] * v[j];
        AO[(rs + i) * 1024 + c] = (bf16)f2bf(bf1(PROJ[(rs + i) * 1536 + c]) * sg); }
    float pe[24];
    pe[0] = 0.f;
#pragma unroll
    for (int k = 0; k < 15; ++k) pe[1 + k] = p.in[I_CPOOL][((size_t)b * 15 + k) * 512 + c];
#pragma unroll
    for (int i = 0; i < 8; ++i) pe[16 + i] = bf1(PROJ[(rs + i) * 1536 + 1024 + c]);
    const int W = 2 << g; const float invW = __builtin_amdgcn_rcpf((float)W);
#pragma unroll
    for (int i = 0; i < 8; ++i) { float s = 0.f;
#pragma unroll
        for (int kk = 0; kk < 16; ++kk) if (kk < W) s += pe[16 + i - kk];
        AO[(rs + i) * 1024 + 512 + c] = (bf16)f2bf(s * invW - pe[16 + i]); }
#pragma unroll
    for (int k = 0; k < 15; ++k) p.out[O_POOLS + ((size_t)b * 15 + k) * 512 + c] = pe[9 + k];
    __syncthreads();
}

constexpr int SWA_KS = 72, SWA_VS = 72, SWA_VOFF = 256 * SWA_KS * 2;
template <bool SAMPLE>
__device__ __forceinline__ void swa_unit(const Params& p, LAS unsigned char* lds, int unit, int tid, int wave, int lane) {
    const bf16* Q = (const bf16*)(p.ws + W_PROJ); const float* KV = (const float*)(p.ws + W_KV32); bf16* AO = (bf16*)(p.ws + W_AO);
    LAS bf16* Kl = (LAS bf16*)lds; LAS bf16* Vt = (LAS bf16*)(lds + SWA_VOFF);
    int b, kvh, nb;
    if (!SAMPLE) { nb = unit & 63; kvh = (unit >> 6) & 3; b = unit >> 8; } else { kvh = unit & 3; b = unit >> 2; nb = 0; }
    constexpr int NKEY = SAMPLE ? 160 : 256;
    {
        const int sub = tid & 7;
        float kg[8]; pg8::ld8f(p.in[I_CKG] + 8 * sub, kg);
        constexpr int NIT = SAMPLE ? 3 : 4;
        float kk[NIT][8], vv[NIT][8];
#pragma unroll
        for (int it = 0; it < NIT; ++it) { const int s = (tid >> 3) + 64 * it;
            const float* kp = nullptr; const float* vp = nullptr;
            if (!SAMPLE) { const int trel = (nb - 1) * 128 + s;
                if (trel >= 0) { kp = KV + ((size_t)b * 8192 + trel) * 512 + kvh * 64 + sub * 8; vp = kp + 256; } }
            else { if (s < 128) { const size_t o = (((size_t)b * 128 + s) * 4 + kvh) * 64 + sub * 8; kp = p.in[I_CSK] + o; vp = p.in[I_CSV] + o; }
                else if (s < 136) { kp = KV + ((size_t)MP + 8 * b + (s - 128)) * 512 + kvh * 64 + sub * 8; vp = kp + 256; } }
            if (kp) { if (SAMPLE) { pg8::ld8f_nt(kp, kk[it]); pg8::ld8f_nt(vp, vv[it]); } else { pg8::ld8f(kp, kk[it]); pg8::ld8f(vp, vv[it]); } } else { pg8::zero8(kk[it]); pg8::zero8(vv[it]); } }
#pragma unroll
        for (int it = 0; it < NIT; ++it) { const int s = (tid >> 3) + 64 * it;
            __builtin_amdgcn_sched_barrier(0);
            if (s < NKEY) {
            bool norm; float pos;
            if (!SAMPLE) { const int trel = (nb - 1) * 128 + s; norm = trel >= 0; pos = (float)trel; }
            else { norm = (s >= 128 && s < 136); pos = (float)(16384 + s - 128); }
            float (&k)[8] = kk[it]; float (&v)[8] = vv[it];
            asm volatile("" : "+v"(pos));
            if (norm) { float ss = 0.f;
#pragma unroll
                for (int e = 0; e < 8; ++e) ss += k[e] * k[e];
                ss += __shfl_xor(ss, 1); ss += __shfl_xor(ss, 2); ss += __shfl_xor(ss, 4);
                const float rs = rsqrtf(ss * (1.f / 64.f) + EPS);
#pragma unroll
                for (int e = 0; e < 8; ++e) k[e] *= rs * kg[e];
#pragma unroll
                for (int e = 0; e < 8; ++e) { const float pk = __shfl_xor(k[e], 1); float cs, sn; rope_cs(pos, e, cs, sn);
                    if (sub == 0) k[e] = k[e] * cs - pk * sn; else if (sub == 1) k[e] = k[e] * cs + pk * sn; }
            }
            *(LAS bf16x8*)(Kl + s * SWA_KS + sub * 8) = pack8(k);
            *(LAS bf16x8*)(Vt + s * SWA_VS + sub * 8) = pack8(v);
            if (!SAMPLE) { if (nb == 63 && s >= 128) { const size_t o = (((size_t)b * 128 + (s - 128)) * 4 + kvh) * 64 + sub * 8;
                    *(f32x4*)(p.out + O_SKP + o) = (f32x4){k[0], k[1], k[2], k[3]}; *(f32x4*)(p.out + O_SKP + o + 4) = (f32x4){k[4], k[5], k[6], k[7]};
                    *(f32x4*)(p.out + O_SVP + o) = (f32x4){v[0], v[1], v[2], v[3]}; *(f32x4*)(p.out + O_SVP + o + 4) = (f32x4){v[4], v[5], v[6], v[7]}; } }
            else { if (s >= 8 && s < 136) { const size_t o = (((size_t)b * 128 + (s - 8)) * 4 + kvh) * 64 + sub * 8;
                    __builtin_nontemporal_store((f32x4){k[0], k[1], k[2], k[3]}, (f32x4*)(p.out + O_SKS + o)); __builtin_nontemporal_store((f32x4){k[4], k[5], k[6], k[7]}, (f32x4*)(p.out + O_SKS + o + 4));
                    __builtin_nontemporal_store((f32x4){v[0], v[1], v[2], v[3]}, (f32x4*)(p.out + O_SVS + o)); __builtin_nontemporal_store((f32x4){v[4], v[5], v[6], v[7]}, (f32x4*)(p.out + O_SVS + o + 4)); } }
            }
        }
    }
    __syncthreads();
    constexpr int NPASS = SAMPLE ? 1 : 4;
    if (!SAMPLE || wave < 2) {
        asm volatile("" : "+v"(lane));
        float rc[8], rsn[8];
        { const int q16 = lane & 15; const float pos0 = SAMPLE ? (float)(16384 + (q16 & 7)) : (float)(nb * 128 + 16 * wave + q16);
#pragma unroll
          for (int e = 0; e < 8; ++e) rope_cs(pos0, e, rc[e], rsn[e]); }
        float qgs[2][8];
        {
#pragma unroll
          for (int dc = 0; dc < 2; ++dc) { pg8::ld8f(p.in[I_CQG] + 32 * dc + 8 * (lane >> 4), qgs[dc]);
#pragma unroll
            for (int e = 0; e < 8; ++e) qgs[dc][e] *= 0.125f; } }
        v4u qraw[2];
        { const int q16 = lane & 15, kq = lane >> 4;
          const size_t row0 = SAMPLE ? (size_t)MP + 8 * b + (q16 & 7) : (size_t)b * 8192 + nb * 128 + 16 * wave + q16;
          const int h0 = kvh * 4 + (SAMPLE ? 2 * wave + (q16 >> 3) : 0);
#pragma unroll
          for (int dc = 0; dc < 2; ++dc) qraw[dc] = *(const v4u*)(Q + row0 * 1024 + h0 * 64 + 32 * dc + 8 * kq); }
#pragma unroll 1
        for (int ps = 0; ps < NPASS; ++ps) {
            int q16 = lane & 15, kq = lane >> 4; asm volatile("" : "+v"(q16), "+v"(kq));
            int g, i, c0; size_t row; float pos;
            if (!SAMPLE) { g = ps; i = 16 * wave + q16; row = (size_t)b * 8192 + nb * 128 + i; pos = (float)(nb * 128 + i); c0 = wave >> 1; }
            else { g = 2 * wave + (q16 >> 3); i = q16 & 7; row = (size_t)MP + 8 * b + i; pos = (float)(16384 + i); c0 = 0; }
            const int h = kvh * 4 + g;
            float qv[2][8];
#pragma unroll
            for (int dc = 0; dc < 2; ++dc) unpack8(qraw[dc], qv[dc]);
            if (!SAMPLE && ps + 1 < NPASS) {
#pragma unroll
                for (int dc = 0; dc < 2; ++dc) qraw[dc] = *(const v4u*)(Q + row * 1024 + (h + 1) * 64 + 32 * dc + 8 * kq); }
            float ss = 0.f;
#pragma unroll
            for (int dc = 0; dc < 2; ++dc)
#pragma unroll
                for (int e = 0; e < 8; ++e) ss += qv[dc][e] * qv[dc][e];
            ss += __shfl_xor(ss, 16); ss += __shfl_xor(ss, 32);
            const float rs = rsqrtf(ss * (1.f / 64.f) + EPS);
#pragma unroll
            for (int dc = 0; dc < 2; ++dc) {
#pragma unroll
                for (int e = 0; e < 8; ++e) qv[dc][e] *= rs * qgs[dc][e]; }
#pragma unroll
            for (int e = 0; e < 8; ++e) { const float pk = __shfl_xor(qv[0][e], 16); const float cs = rc[e], sn = rsn[e];
                if (kq == 0) qv[0][e] = qv[0][e] * cs - pk * sn; else if (kq == 1) qv[0][e] = qv[0][e] * cs + pk * sn; }
            bf16x8 qf[2];
#pragma unroll
            for (int dc = 0; dc < 2; ++dc) qf[dc] = pack8(qv[dc]);
            f32x4 S[5][2];
            const float sink = p.in[I_CSINK][h];
            float mx = sink;
#pragma unroll
            for (int cc = 0; cc < 5; ++cc)
#pragma unroll
                for (int tt = 0; tt < 2; ++tt) { const int kb = 32 * (c0 + cc) + 16 * tt; f32x4 a = (f32x4){0.f, 0.f, 0.f, 0.f};
#pragma unroll
                    for (int dc = 0; dc < 2; ++dc) { const bf16x8 kf = *(const LAS bf16x8*)(Kl + (kb + q16) * SWA_KS + 32 * dc + 8 * kq);
                        a = __builtin_amdgcn_mfma_f32_16x16x32_bf16(kf, qf[dc], a, 0, 0, 0); }
                    const int rel = (kb >> 4) - wave;
                    const bool full = !SAMPLE && rel >= 1 && rel <= 7 && (nb > 0 || kb >= 128);
                    if (!full) {
#pragma unroll
                        for (int e = 0; e < 4; ++e) { const int s = kb + 4 * kq + e; const bool ok = (s > i) && (s <= i + 128) && (SAMPLE || nb > 0 || s >= 128);
                            a[e] = ok ? a[e] : -INFINITY; } }
#pragma unroll
                    for (int e = 0; e < 4; ++e) mx = fmaxf(mx, a[e]);
                    S[cc][tt] = a; }
            mx = fmaxf(mx, __shfl_xor(mx, 16)); mx = fmaxf(mx, __shfl_xor(mx, 32));
            float den = 0.f;
#pragma unroll
            for (int cc = 0; cc < 5; ++cc)
#pragma unroll
                for (int tt = 0; tt < 2; ++tt)
#pragma unroll
                    for (int e = 0; e < 4; ++e) { const float pe = __expf(S[cc][tt][e] - mx); S[cc][tt][e] = pe; den += pe; }
            den += __shfl_xor(den, 16); den += __shfl_xor(den, 32);
            den += __expf(sink - mx);
            const float rden = 1.f / den;
            bf16x8 pf[5];
#pragma unroll
            for (int cc = 0; cc < 5; ++cc) { float t8[8];
#pragma unroll
                for (int e = 0; e < 4; ++e) { t8[e] = S[cc][0][e]; t8[4 + e] = S[cc][1][e]; }
                pf[cc] = pack8(t8); }
#pragma unroll
            for (int dt = 0; dt < 4; ++dt) { f32x4 o = (f32x4){0.f, 0.f, 0.f, 0.f};
#pragma unroll
                for (int cc = 0; cc < 5; ++cc) { const LAS bf16* vp = Vt + (32 * (c0 + cc) + 4 * kq + (q16 >> 2)) * SWA_VS + 16 * dt + 4 * (q16 & 3);
                    const v2u lo = vtr(vp), hi = vtr(vp + 16 * SWA_VS);
                    v4u av; av.x = lo.x; av.y = lo.y; av.z = hi.x; av.w = hi.y;
                    o = __builtin_amdgcn_mfma_f32_16x16x32_bf16(__builtin_bit_cast(bf16x8, av), pf[cc], o, 0, 0, 0); }
                v2u w; w.x = pk2(o[0] * rden, o[1] * rden); w.y = pk2(o[2] * rden, o[3] * rden);
                *(v2u*)(AO + row * 1024 + h * 64 + 16 * dt + 4 * kq) = w; }
        }
    }
    __syncthreads();
}

constexpr int MEM_KS = 136, MEM_VS = 136, MEM_VOFF = 256 * MEM_KS * 2;
static_assert(MEM_VOFF + 256 * MEM_VS * 2 <= LDS_CTL_OFF && 128 * SG_VS * 2 <= LDS_CTL_OFF, "LDS");
template <bool SAMPLE>
__device__ __forceinline__ void mem_unit(const Params& p, int l, LAS unsigned char* lds, int unit, int tid, int wave, int lane) {
    const bf16* MQ = (const bf16*)(p.ws + W_MQ); bf16* MO = (bf16*)(p.ws + W_MO);
    LAS bf16* Kl = (LAS bf16*)lds; LAS bf16* Vt = (LAS bf16*)(lds + MEM_VOFF);
    int b, h, qt;
    if (!SAMPLE) { qt = unit & 15; h = (unit >> 4) & 3; b = unit >> 6; } else { h = unit & 3; b = unit >> 2; qt = 0; }
    {
        const int sub = tid & 15;
        float kg[8]; pg8::ld8f(p.in[I_MKG] + l * 128 + 8 * sub, kg);
#pragma unroll 1
        for (int hb = 0; hb < 2; ++hb) {
            float kk[4][8], vv[4][8];
#pragma unroll
            for (int it = 0; it < 4; ++it) { const int s = (tid >> 4) + 32 * (4 * hb + it);
                const float* kp; const float* vp;
                if (!SAMPLE) { kp = (const float*)(p.ws + W_MKV) + ((size_t)l * 1024 + b * 256 + s) * 1024 + h * 128 + sub * 8; vp = kp + 512; }
                else { const size_t o = ((((size_t)l * 128 + b) * 256 + s) * 4 + h) * 128 + sub * 8; kp = p.in[I_CMK] + o; vp = p.in[I_CMV] + o; }
                if (SAMPLE) { pg8::ld8f_nt(kp, kk[it]); pg8::ld8f_nt(vp, vv[it]); } else { pg8::ld8f(kp, kk[it]); pg8::ld8f(vp, vv[it]); } }
#pragma unroll
            for (int it = 0; it < 4; ++it) { const int s = (tid >> 4) + 32 * (4 * hb + it);
                float (&k)[8] = kk[it]; float (&v)[8] = vv[it];
                if (!SAMPLE) { float ss = 0.f;
#pragma unroll
                    for (int e = 0; e < 8; ++e) ss += k[e] * k[e];
                    ss += __shfl_xor(ss, 1); ss += __shfl_xor(ss, 2); ss += __shfl_xor(ss, 4); ss += __shfl_xor(ss, 8);
                    const float rs = rsqrtf(ss * (1.f / 128.f) + EPS);
#pragma unroll
                    for (int e = 0; e < 8; ++e) k[e] *= rs * kg[e];
                    if (qt == 0) { const size_t o = ((((size_t)l * 4 + b) * 256 + s) * 4 + h) * 128 + sub * 8;
                        *(f32x4*)(p.out + O_MKP + o) = (f32x4){k[0], k[1], k[2], k[3]}; *(f32x4*)(p.out + O_MKP + o + 4) = (f32x4){k[4], k[5], k[6], k[7]};
                        *(f32x4*)(p.out + O_MVP + o) = (f32x4){v[0], v[1], v[2], v[3]}; *(f32x4*)(p.out + O_MVP + o + 4) = (f32x4){v[4], v[5], v[6], v[7]}; }
                }
                *(LAS bf16x8*)(Kl + s * MEM_KS + sub * 8) = pack8(k);
                *(LAS bf16x8*)(Vt + s * MEM_VS + sub * 8) = pack8(v);
            }
        }
    }
    __syncthreads();
    if (!SAMPLE || wave == 0) {
#pragma unroll 1
      for (int qq = 0; qq < (SAMPLE ? 1 : 4); ++qq) {
        int q16 = lane & 15, kq = lane >> 4; asm volatile("" : "+v"(q16), "+v"(kq));
        size_t row; bool st;
        if (!SAMPLE) { row = (size_t)b * 8192 + (qt * 4 + qq) * 128 + 16 * wave + q16; st = true; } else { row = (size_t)MP + 8 * b + (q16 & 7); st = q16 < 8; }
        bf16x8 qf[4];
        {
            float qv[4][8]; float ss = 0.f;
#pragma unroll
            for (int dc = 0; dc < 4; ++dc) { unpack8(*(const v4u*)(MQ + row * 512 + h * 128 + 32 * dc + 8 * kq), qv[dc]);
#pragma unroll
                for (int e = 0; e < 8; ++e) ss += qv[dc][e] * qv[dc][e]; }
            ss += __shfl_xor(ss, 16); ss += __shfl_xor(ss, 32);
            const float rs = rsqrtf(ss * (1.f / 128.f) + EPS) * 0.08838834764831845f;
#pragma unroll
            for (int dc = 0; dc < 4; ++dc) { float qg[8]; pg8::ld8f(p.in[I_MQG] + l * 128 + 32 * dc + 8 * kq, qg);
#pragma unroll
                for (int e = 0; e < 8; ++e) qv[dc][e] *= rs * qg[e];
                qf[dc] = pack8(qv[dc]); }
        }
        f32x4 S[8][2]; float mx = -INFINITY;
#pragma unroll
        for (int cc = 0; cc < 8; ++cc)
#pragma unroll
            for (int tt = 0; tt < 2; ++tt) { const int kb = 32 * cc + 16 * tt; f32x4 a = (f32x4){0.f, 0.f, 0.f, 0.f};
#pragma unroll
                for (int dc = 0; dc < 4; ++dc) { const bf16x8 kf = *(const LAS bf16x8*)(Kl + (kb + q16) * MEM_KS + 32 * dc + 8 * kq);
                    a = __builtin_amdgcn_mfma_f32_16x16x32_bf16(kf, qf[dc], a, 0, 0, 0); }
#pragma unroll
                for (int e = 0; e < 4; ++e) mx = fmaxf(mx, a[e]);
                S[cc][tt] = a; }
        mx = fmaxf(mx, __shfl_xor(mx, 16)); mx = fmaxf(mx, __shfl_xor(mx, 32));
        float den = 0.f;
#pragma unroll
        for (int cc = 0; cc < 8; ++cc)
#pragma unroll
            for (int tt = 0; tt < 2; ++tt)
#pragma unroll
                for (int e = 0; e < 4; ++e) { const float pe = __expf(S[cc][tt][e] - mx); S[cc][tt][e] = pe; den += pe; }
        den += __shfl_xor(den, 16); den += __shfl_xor(den, 32);
        const float rden = 1.f / den;
        bf16x8 pf[8];
#pragma unroll
        for (int cc = 0; cc < 8; ++cc) { float t8[8];
#pragma unroll
            for (int e = 0; e < 4; ++e) { t8[e] = S[cc][0][e]; t8[4 + e] = S[cc][1][e]; }
            pf[cc] = pack8(t8); }
#pragma unroll
        for (int dt = 0; dt < 8; ++dt) { f32x4 o = (f32x4){0.f, 0.f, 0.f, 0.f};
#pragma unroll
            for (int cc = 0; cc < 8; ++cc) { const LAS bf16* vp = Vt + (32 * cc + 4 * kq + (q16 >> 2)) * MEM_VS + 16 * dt + 4 * (q16 & 3);
                const v2u lo = vtr(vp), hi = vtr(vp + 16 * MEM_VS);
                v4u av; av.x = lo.x; av.y = lo.y; av.z = hi.x; av.w = hi.y;
                o = __builtin_amdgcn_mfma_f32_16x16x32_bf16(__builtin_bit_cast(bf16x8, av), pf[cc], o, 0, 0, 0); }
            if (st) { v2u w; w.x = pk2(o[0] * rden, o[1] * rden); w.y = pk2(o[2] * rden, o[3] * rden);
                *(v2u*)(MO + row * 512 + h * 128 + 16 * dt + 4 * kq) = w; } }
      }
    }
    __syncthreads();
}

#ifndef REP_LIGHT
#define REP_LIGHT 1
#endif
#ifndef REP_G9
#define REP_G9 1
#endif
#ifndef REP_G10
#define REP_G10 1
#endif
#ifndef REP_PRO
#define REP_PRO 1
#endif
#ifndef REP_MEM
#define REP_MEM 1
#endif
#ifndef REP_P15
#define REP_P15 1
#endif
#ifndef REP_SYNC
#define REP_SYNC 1
#endif
#define GSYNC() do { for (int r_ = 0; r_ < REP_SYNC; ++r_) xcd_barrier(xbar); } while (0)
#define PHASE_IDS int t_ = threadIdx.x; asm volatile("" : "+v"(t_)); const int tid = t_, lane = tid & 63, wave = __builtin_amdgcn_readfirstlane(tid >> 6); const int gw = bx * NWAVES + wave; (void)gw; (void)lane; (void)tid;
__global__ void __launch_bounds__(NTHR, 2) fwd_megakernel(Params p) {
    extern __shared__ __attribute__((aligned(16))) unsigned char lds_raw[];
    LAS unsigned char* lds = (LAS unsigned char*)lds_raw;
    cg::grid_group grid = cg::this_grid();
    const int G = gridDim.x, bx = blockIdx.x;
    const int wave0 = __builtin_amdgcn_readfirstlane((int)threadIdx.x >> 6);
    const int ngw = G * NWAVES;
    unsigned char* ws = p.ws;
    bf16* XN = (bf16*)(ws + W_XN);
    float* SSb = (float*)(ws + W_SS);
    float* X = p.out;
    typedef pg8::bf16_t pb;

    if (threadIdx.x < 16) ((LAS unsigned*)(lds + LDS_CTL_OFF))[threadIdx.x] = 0u;
    __syncthreads();
    const XcdBarrier xbar = xcd_barrier_post((unsigned*)(ws + W_CTL), (volatile LAS unsigned*)(lds + LDS_CTL_OFF));
    for (int rep = 0; rep < REP_LIGHT * REP_PRO; ++rep) { PHASE_IDS prologue(p, lds, gw, ngw, wave, lane); }
    grid.sync();

    auto layer_body = [&](auto LC) __attribute__((always_inline)) {
        constexpr int l = decltype(LC)::value;
        unsigned char* wl = ws + W_LAYER + (size_t)l * WL_SIZE;
        if (l == 0) {
            { pg8::Gemm g{(const pb*)XN, (const pb*)(ws + W_WIN), MT, 1536, 1024}; pg8::StaticOrder S; S.init(MP, 1536, G, bx);
              pg8::EpiAct E{(pb*)(ws + W_PROJ), 1536, 4, SSb};
              pg8::gemm_phase<pg8::EpiAct, pg8::StaticOrder, true, true>(lds, g, S, E, wave0);
              pg8::mini_gemm<pg8::EpiAct, true>(lds, g.A, g.Bt, 1024, 24, E, bx, G, wave0); }
        } else {
            pg8::Gemm g{(const pb*)XN, (const pb*)(ws + W_WQKV), MT, 1536, 1024}; pg8::StaticOrder S; S.init(MP, 1536, G, bx);
            pg8::EpiQKV E{(pb*)(ws + W_PROJ), (float*)(ws + W_KV32), SSb + (size_t)3 * MT};
            pg8::gemm_phase<pg8::EpiQKV, pg8::StaticOrder, true, true>(lds, g, S, E, wave0);
            pg8::mini_gemm<pg8::EpiQKV, true>(lds, g.A, g.Bt, 1024, 24, E, bx, G, wave0);
        }
        GSYNC();
        if (l == 0) {
#ifndef NO_SGU
            PHASE_IDS
            for (int rep = 0; rep < REP_LIGHT; ++rep)
            for (int u = bx; u < 256 + 128; u += G) { if (u < 256) sgu_prompt_unit(p, lds, u, tid, wave, lane); else sgu_sample_unit(p, lds, u - 256, tid, wave, lane); }
#pragma unroll 1
            for (int ll = 0; ll < 2; ++ll) {
              pg8::EpiRes E{(float*)(ws + W_MKV) + (size_t)ll * 1024 * 1024, nullptr, nullptr, 0, nullptr, nullptr, 0};
              pg8::mini_gemm(lds, (const pb*)(ws + W_MN) + (size_t)ll * 1024 * 1024, (const pb*)(ws + W_LAYER + (size_t)ll * WL_SIZE + WL_WKV), 1024, 8, E, (bx + G - 128 - 64 * ll) % G, G, wave0, 0); }
#endif
        } else {
#ifndef NO_SWA
            PHASE_IDS
            for (int rep = 0; rep < REP_LIGHT; ++rep)
            for (int u = bx; u < 1024 + 512; u += G) { if (u < 1024) swa_unit<false>(p, lds, u, tid, wave, lane); else swa_unit<true>(p, lds, u - 1024, tid, wave, lane); }
#endif
        }
        GSYNC();
        {
            pg8::Gemm g{(const pb*)(ws + W_AO), (const pb*)(ws + (l == 0 ? W_WOUT : W_CWO)), MT, 1024, 1024}; pg8::StaticOrder S; S.init(MP, 1024, G, bx);
            pg8::EpiRes E{nullptr, nullptr, nullptr, 1, (pb*)XN, SSb + (size_t)(1 + 3 * l) * MT, 1};
            pg8::gemm_phase<pg8::EpiRes, pg8::StaticOrder, true, true>(lds, g, S, E, wave0);
            pg8::mini_gemm<pg8::EpiRes, true, true>(lds, g.A, g.Bt, 1024, 16, E, bx, G, wave0);
        }
        GSYNC();
        {
            pg8::Gemm g{(const pb*)XN, (const pb*)(wl + WL_WQ), MT, 512, 1024}; pg8::StaticOrder S; S.init(MP, 512, G, bx);
            pg8::EpiAct E{(pb*)(ws + W_MQ), 512, 0, SSb + (size_t)(1 + 3 * l) * MT};
            pg8::gemm_phase<pg8::EpiAct, pg8::StaticOrder, true, true>(lds, g, S, E, wave0);
            pg8::mini_gemm<pg8::EpiAct, true, true>(lds, g.A, g.Bt, 1024, 8, E, bx, G, wave0);
        }
        GSYNC();
#ifndef NO_MEM
        { PHASE_IDS
        for (int rep = 0; rep < REP_LIGHT * REP_MEM; ++rep)
        for (int u = bx; u < 256 + 512; u += G) { if (u < 256) mem_unit<false>(p, l, lds, u, tid, wave, lane); else mem_unit<true>(p, l, lds, u - 256, tid, wave, lane); } }
#endif
        GSYNC();
        {
            pg8::Gemm g{(const pb*)(ws + W_MO), (const pb*)(wl + WL_WO), MT, 1024, 512}; pg8::StaticOrder S; S.init(MP, 1024, G, bx);
            pg8::EpiRes E{nullptr, nullptr, nullptr, 1, (pb*)XN, SSb + (size_t)(2 + 3 * l) * MT, 1};
            pg8::gemm_phase<pg8::EpiRes, pg8::StaticOrder, true, true>(lds, g, S, E, wave0);
            pg8::mini_gemm<pg8::EpiRes, true, true>(lds, g.A, g.Bt, 512, 16, E, bx, G, wave0);
        }
        GSYNC();
        {
            pg8::Gemm g{(const pb*)XN, (const pb*)(wl + WL_WUP), MT, DFF, 1024}; pg8::SplitOrder S; S.init(DFF, G, bx);
            pg8::EpiG E{(pb*)(ws + W_G), p.out + O_FCP + (size_t)l * 4 * 2 * DFF, p.out + O_FCS + (size_t)l * 128 * 2 * DFF, SSb + (size_t)(2 + 3 * l) * MT};
            for (int rep = 0; rep < REP_G9; ++rep) pg8::gemm_phase<pg8::EpiG, pg8::SplitOrder, true, true>(lds, g, S, E, wave0);
        }
        GSYNC();
        {
            pg8::Gemm g{(const pb*)XN, (const pb*)(wl + WL_WUP) + (size_t)DFF * 1024, MT, DFF, 1024}; pg8::SplitOrder S; S.init(DFF, G, bx);
            pg8::EpiH E{(const pb*)(ws + W_G), (pb*)(ws + W_H), p.in[I_FCW] + (size_t)l * 3 * DFF, p.in[I_FCB] + (size_t)l * DFF, p.in[I_CFC] + (size_t)l * 128 * 2 * DFF, SSb + (size_t)(2 + 3 * l) * MT};
            for (int rep = 0; rep < REP_G10; ++rep) pg8::gemm_phase<pg8::EpiH, pg8::SplitOrder, true, true>(lds, g, S, E, wave0);
        }
        GSYNC();
        {
            pg8::Gemm g{(const pb*)(ws + W_H), (const pb*)(wl + WL_WDN), MT, 1024, DFF}; pg8::StaticOrder S; S.init(MP, 1024, G, bx);
            pg8::EpiRes E{l == 0 ? nullptr : X, nullptr, nullptr, 1, (pb*)XN, SSb + (size_t)3 * MT, l == 0};
            pg8::gemm_phase<pg8::EpiRes, pg8::StaticOrder, true, true>(lds, g, S, E, wave0);
            pg8::mini_gemm<pg8::EpiRes, true, true>(lds, g.A, g.Bt, DFF, 16, E, bx, G, wave0);
        }
        GSYNC();
    };
    layer_body(std::integral_constant<int, 0>{});
    layer_body(std::integral_constant<int, 1>{});
}

extern "C" void kernel_launch(void* const* d_in, const int* in_sizes, int n_in, void* d_out, int out_size, void* d_ws, size_t ws_size, hipStream_t stream) {
    static int grid_blocks = 0;
    if (grid_blocks == 0) {
        if (n_in != N_IN || (size_t)out_size != O_END || ws_size < W_NEED) { fprintf(stderr, "kernel_launch: unexpected shapes: n_in %d out %d ws %zu (need %zu)\n", n_in, out_size, ws_size, (size_t)W_NEED); grid_blocks = -1; return; }
        int dev = 0, cus = 0, per_cu = 0;
        hipGetDevice(&dev);
        hipDeviceGetAttribute(&cus, hipDeviceAttributeMultiprocessorCount, dev);
        if (hipFuncSetAttribute((const void*)fwd_megakernel, hipFuncAttributeMaxDynamicSharedMemorySize, LDS_BYTES) != hipSuccess) { fprintf(stderr, "kernel_launch: hipFuncSetAttribute failed\n"); grid_blocks = -1; return; }
        if (hipOccupancyMaxActiveBlocksPerMultiprocessor(&per_cu, (const void*)fwd_megakernel, NTHR, LDS_BYTES) != hipSuccess || per_cu < 1) { fprintf(stderr, "kernel_launch: occupancy query failed (%d)\n", per_cu); (void)hipGetLastError(); grid_blocks = -1; return; }
        grid_blocks = cus * per_cu;
    }
    if (grid_blocks < 0) return;
    if (hipMemsetAsync((char*)d_ws + W_CTL, 0, CTL_BYTES, stream) != hipSuccess) { fprintf(stderr, "kernel_launch: memset failed\n"); return; }
    Params p{};
    for (int i = 0; i < N_IN; ++i) p.in[i] = (const float*)d_in[i];
    p.out = (float*)d_out; p.ws = (unsigned char*)d_ws;
    void* args[] = {&p};
    hipError_t e = hipLaunchCooperativeKernel((const void*)fwd_megakernel, dim3(grid_blocks), dim3(NTHR), args, LDS_BYTES, stream);
    if (e != hipSuccess) fprintf(stderr, "cooperative launch failed: %s (grid %d)\n", hipGetErrorString(e), grid_blocks);
}
```
